# Optimizing an MI355X kernel written in HIP

```python
import jax
import jax.numpy as jnp
from jax import lax
import numpy as np

D_MODEL = 1024
BATCH = 2
SEQ = 8192
DEPTH = 2

GRID_W = 64
CTX_LEN = 256
N_EVEN = (DEPTH + 1) // 2
N_ODD = DEPTH // 2
D_MIX = D_MODEL
D_FF = 4 * D_MODEL
N_MOD = 6
EPS = 1e-6

ML_WIDTH = D_MIX // 2
ML_HEADS = 4
ML_DIM = ML_WIDTH // ML_HEADS
ML_CHUNK = 64
ML_CONV = 3
RW_WIDTH = D_MIX - ML_WIDTH
RW_HEAD_DIM = 64
RW_HEADS = RW_WIDTH // RW_HEAD_DIM
RW_DECAY_RANK = 64
RW_ICL_RANK = 64
RW_GATE_RANK = 128
RW_GN_EPS = 64e-5
RW_FEAT = 3 * RW_WIDTH + 2 * RW_DECAY_RANK + 2 * RW_ICL_RANK + RW_GATE_RANK
EV_SIZES = (ML_WIDTH, ML_WIDTH, ML_WIDTH, ML_WIDTH, 4 * ML_HEADS, RW_FEAT)
EV_PROJ = sum(EV_SIZES)
HG_WIDTH = D_MIX // 2
HG_HEADS = 4
HG_DIM = HG_WIDTH // HG_HEADS
HG_CHUNK = 32
MLA_WIDTH = D_MIX - HG_WIDTH
MLA_HEADS = 4
MLA_NOPE = 128
MLA_ROPE = 64
MLA_V = MLA_WIDTH // MLA_HEADS
MLA_Q_RANK = 256
MLA_KV_RANK = 128
OD_SIZES = (HG_WIDTH, HG_WIDTH, HG_WIDTH, HG_WIDTH, HG_WIDTH, MLA_Q_RANK, MLA_KV_RANK + MLA_ROPE)
OD_PROJ = sum(OD_SIZES)
ATTN_BLOCK = 128
ROPE_BASE = 10000.0

kernel_name = 'hybrid_mlstm_rwkv7_hgrn2_mla_dit'


def split_cols(t, sizes):
    cuts = [int(s) for s in np.cumsum(sizes)[:-1]]
    return jnp.split(t, cuts, axis=-1)


def rmsnorm(x, g):
    xf = x.astype(jnp.float32)
    y = xf * lax.rsqrt(jnp.mean(xf * xf, axis=-1, keepdims=True) + EPS)
    return (y * g.astype(jnp.float32)).astype(x.dtype)


def head_rmsnorm(y, g):
    B, T, H, d = y.shape
    yf = y.astype(jnp.float32)
    yf = yf * lax.rsqrt(jnp.mean(yf * yf, axis=-1, keepdims=True) + EPS)
    return yf.reshape(B, T, H * d) * g.astype(jnp.float32)


def head_groupnorm(y, w, b):
    H, d = y.shape[-2:]
    mu = jnp.mean(y, axis=-1, keepdims=True)
    var = jnp.mean(jnp.square(y - mu), axis=-1, keepdims=True)
    return (y - mu) * lax.rsqrt(var + RW_GN_EPS) * w.astype(jnp.float32).reshape(H, d) + b.astype(jnp.float32).reshape(H, d)


def modulate(h, shift, scale):
    return h * (1.0 + scale) + shift


def sqrelu_mlp(h, w1, w2):
    return jnp.square(jax.nn.relu(h @ w1)) @ w2


def two_seq(fn, t, n_ctx):
    return jnp.concatenate([fn(t[:, :n_ctx]), fn(t[:, n_ctx:])], axis=1)


def neighbour_mean(t):
    tp = jnp.pad(t, ((0, 0), (1, 1), (0, 0)))
    return 0.5 * (tp[:, :-2] + tp[:, 2:])


def centred_dwconv(t, w):
    k = w.shape[0]
    half = k // 2
    n = t.shape[1]
    tp = jnp.pad(t, ((0, 0), (half, half), (0, 0)))
    out = tp[:, 0:n] * w[0]
    for j in range(1, k):
        out = out + tp[:, j:j + n] * w[j]
    return out


def dir_stack(t_fw, t_bw, n_ctx):
    bw = jnp.concatenate([jnp.flip(t_bw[:, :n_ctx], 1), jnp.flip(t_bw[:, n_ctx:], 1)], axis=1)
    return jnp.concatenate([t_fw, bw], axis=0)


def dir_merge(y, n_batch, n_ctx):
    y_fw, y_bw = y[:n_batch], y[n_batch:]
    bw = jnp.concatenate([jnp.flip(y_bw[:, :n_ctx], 1), jnp.flip(y_bw[:, n_ctx:], 1)], axis=1)
    return y_fw + bw


def to_chunks(a, L):
    Z, T = a.shape[:2]
    a = a.reshape((Z, T // L, L) + a.shape[2:])
    perm = (1, 0, 3, 2) + tuple(range(4, a.ndim))
    return a.transpose(perm)


def from_chunks(a):
    nc, Z, H, L, d = a.shape
    return a.transpose((1, 0, 3, 2, 4)).reshape(Z, nc * L, H, d)


def axial_rope(x, row, col):
    half = x.shape[-1] // 2
    quarter = half // 2
    inv = ROPE_BASE ** (-jnp.arange(quarter, dtype=jnp.float32) / quarter)

    def rot(xa, pos):
        ang = pos.astype(jnp.float32)[:, None] * inv[None, :]
        ang = ang.reshape((ang.shape[0],) + (1,) * (xa.ndim - 3) + (quarter,))
        cos = jnp.cos(ang).astype(xa.dtype)
        sin = jnp.sin(ang).astype(xa.dtype)
        x1, x2 = xa[..., :quarter], xa[..., quarter:]
        return jnp.concatenate([x1 * cos - x2 * sin, x1 * sin + x2 * cos], axis=-1)

    return jnp.concatenate([rot(x[..., :half], row), rot(x[..., half:], col)], axis=-1)


def block_attention(q_nope, q_rope, k_nope, k_rope, v, scale):
    B, Nq, H, _ = q_nope.shape
    nb = Nq // ATTN_BLOCK

    def blocks(t):
        return jnp.moveaxis(t.reshape((B, nb, ATTN_BLOCK) + t.shape[2:]), 1, 0)

    def attend(qs):
        qn, qr = qs
        s = jnp.einsum('bqhd,bkhd->bhqk', qn, k_nope) + jnp.einsum('bqhd,bkd->bhqk', qr, k_rope)
        p = jax.nn.softmax(s.astype(jnp.float32) * scale, axis=-1)
        return jnp.einsum('bhqk,bkhd->bqhd', p.astype(v.dtype), v)

    o = lax.map(attend, (blocks(q_nope), blocks(q_rope)))
    return jnp.moveaxis(o, 0, 1).reshape(B, Nq, H * v.shape[-1])


def mlstm_chunkwise(q, k, v, ig, lf):
    f32 = jnp.float32
    q, k, v, ig, lf = (t.astype(f32) for t in (q, k, v, ig, lf))
    Z, T, H, dk = q.shape
    dv = v.shape[-1]
    L = ML_CHUNK
    k = k * dk ** -0.5
    xs = tuple(to_chunks(t, L) for t in (q, k, v, ig, lf))
    mask = jnp.tril(jnp.ones((L, L), dtype=bool))

    def step(carry, inp):
        C, n, m = carry
        qc, kc, vc, ic, fc = inp
        b = jnp.cumsum(fc, axis=-1)
        logd = jnp.where(mask, b[..., :, None] - b[..., None, :] + ic[..., None, :], -jnp.inf)
        m_inter = b + m[..., None]
        m_t = jnp.maximum(m_inter, jnp.max(logd, axis=-1))
        s = jnp.einsum('zhtd,zhsd->zhts', qc, kc) * jnp.exp(logd - m_t[..., None])
        w_inter = jnp.exp(m_inter - m_t)
        num = jnp.einsum('zhts,zhsv->zhtv', s, vc) + w_inter[..., None] * jnp.einsum('zhtd,zhvd->zhtv', qc, C)
        den = jnp.sum(s, axis=-1) + w_inter * jnp.einsum('zhtd,zhd->zht', qc, n)
        h = num / jnp.maximum(jnp.abs(den), jnp.exp(-m_t))[..., None]
        b_last = b[..., -1]
        logw = b_last[..., None] - b + ic
        m_new = jnp.maximum(b_last + m, jnp.max(logw, axis=-1))
        w = jnp.exp(logw - m_new[..., None])
        decay = jnp.exp(b_last + m - m_new)
        C = decay[..., None, None] * C + jnp.einsum('zhs,zhsv,zhsd->zhvd', w, vc, kc)
        n = decay[..., None] * n + jnp.einsum('zhs,zhsd->zhd', w, kc)
        return (C, n, m_new), h

    init = (jnp.zeros((Z, H, dv, dk), f32), jnp.zeros((Z, H, dk), f32), jnp.zeros((Z, H), f32))
    _, h = lax.scan(step, init, xs)
    return from_chunks(h)


def rwkv7_scan(r, w, k, v, a_vec, b_vec):
    Z, T, H, dk = k.shape
    dv = v.shape[-1]
    xs = tuple(jnp.moveaxis(t, 1, 0) for t in (r, w, k, v, a_vec, b_vec))

    def step(S, inp):
        rt, wt, kt, vt, at, bt = inp
        sa = jnp.einsum('zhvk,zhk->zhv', S, at)
        S = S * wt[:, :, None, :] + sa[..., None] * bt[:, :, None, :] + vt[..., None] * kt[:, :, None, :]
        return S, jnp.einsum('zhvk,zhk->zhv', S, rt)

    _, y = lax.scan(step, jnp.zeros((Z, H, dv, dk), jnp.float32), xs)
    return jnp.moveaxis(y, 0, 1)


def hgrn2_chunkwise(q, k, v, log_f):
    Z, T, H, dk = q.shape
    dv = v.shape[-1]
    L = HG_CHUNK
    q = q * dk ** -0.5
    xs = tuple(to_chunks(t, L) for t in (q, k, v, log_f))
    mask = jnp.tril(jnp.ones((L, L), dtype=bool))[:, :, None]

    def step(S, inp):
        qc, kc, vc, gc = inp
        bc = jnp.cumsum(gc, axis=2)
        rel = jnp.where(mask, bc[:, :, :, None, :] - bc[:, :, None, :, :], -jnp.inf)
        att = jnp.einsum('zhtd,zhsd,zhtsd->zhts', qc, kc, jnp.exp(rel))
        o = att @ vc + jnp.einsum('zhtd,zhdv->zhtv', qc * jnp.exp(bc), S)
        b_last = bc[:, :, -1, :]
        S = jnp.exp(b_last)[..., None] * S + jnp.einsum('zhsd,zhsv->zhdv', kc * jnp.exp(b_last[:, :, None, :] - bc), vc)
        return S, o

    _, o = lax.scan(step, jnp.zeros((Z, H, dk, dv), jnp.float32), xs)
    return from_chunks(o)


def even_mixer(hj, n_ctx, need_ctx, w_in, ml_conv, ml_gate_b, ml_norm, rw_mu, rw_w0, rw_w2, rw_a0, rw_a2,
               rw_g2, rw_kk, rw_ka, rw_rk, rw_ln_w, rw_ln_b):
    dt = hj.dtype
    f32 = jnp.float32
    B, T, _ = hj.shape

    def hd(t, d):
        return t.reshape(B, T, -1, d)

    def z(a, b=None):
        return dir_stack(a, a if b is None else b, n_ctx)

    mq, mk, mv, mo, mg, rfeat = split_cols(hj @ w_in, EV_SIZES)

    qk = two_seq(lambda t: centred_dwconv(t, ml_conv), jnp.concatenate([mq, mk], axis=-1), n_ctx)
    q, k = jnp.split(qk, 2, axis=-1)
    gates = mg.reshape(B, T, 4, ML_HEADS).astype(f32) + ml_gate_b.astype(f32)
    ig_fw, lf_fw = gates[:, :, 0], jax.nn.log_sigmoid(gates[:, :, 1])
    ig_bw, lf_bw = gates[:, :, 2], jax.nn.log_sigmoid(gates[:, :, 3])
    hm = mlstm_chunkwise(z(hd(q, ML_DIM)), z(hd(k, ML_DIM)), z(hd(mv, ML_DIM)), z(ig_fw, ig_bw), z(lf_fw, lf_bw))
    y_ml = head_rmsnorm(dir_merge(hm, B, n_ctx), ml_norm) * jax.nn.sigmoid(mo.astype(f32))

    rfeat = two_seq(lambda t: t + (neighbour_mean(t) - t) * rw_mu, rfeat, n_ctx)
    r, k, v, wl, al, gl = split_cols(rfeat, (RW_WIDTH, RW_WIDTH, RW_WIDTH, 2 * RW_DECAY_RANK, 2 * RW_ICL_RANK, RW_GATE_RANK))
    r = hd(r.astype(f32), RW_HEAD_DIM)
    k = k.astype(f32)
    v = hd(v.astype(f32), RW_HEAD_DIM)
    kk = hd(k * rw_kk, RW_HEAD_DIM)
    kk = kk * lax.rsqrt(jnp.sum(kk * kk, axis=-1, keepdims=True) + 1e-12)
    rk = rw_rk.reshape(RW_HEADS, RW_HEAD_DIM)
    ka = rw_ka.reshape(RW_HEADS, RW_HEAD_DIM)
    wl_dirs = jnp.split(wl.astype(f32), 2, axis=-1)
    al_dirs = jnp.split(al.astype(f32), 2, axis=-1)
    decay, key_d, icl = [], [], []
    bonus = 0.0
    for d in range(2):
        w_log = -jax.nn.softplus(-(rw_w0[d] + jnp.tanh(wl_dirs[d]) @ rw_w2[d])) - 0.5
        a = hd(jax.nn.sigmoid(rw_a0[d] + al_dirs[d] @ rw_a2[d]), RW_HEAD_DIM)
        k_d = hd(k, RW_HEAD_DIM) * (1.0 + (a - 1.0) * ka)
        decay.append(hd(jnp.exp(-jnp.exp(w_log)), RW_HEAD_DIM))
        key_d.append(k_d)
        icl.append(kk * a)
        bonus = bonus + jnp.sum(r * k_d * rk, axis=-1, keepdims=True) * v
    y = rwkv7_scan(z(r), z(decay[0], decay[1]), z(key_d[0], key_d[1]), z(v), z(-kk), z(icl[0], icl[1]))
    y = head_groupnorm(dir_merge(y, B, n_ctx), rw_ln_w, rw_ln_b) + bonus
    y_rw = y.reshape(B, T, RW_WIDTH) * (jax.nn.sigmoid(gl.astype(f32)) @ rw_g2)

    out = jnp.concatenate([y_ml, y_rw], axis=-1).astype(dt)
    y_ctx = out[:, :n_ctx] if need_ctx else None
    return y_ctx, out[:, n_ctx:]


def odd_mixer(hj, n_ctx, need_ctx, lb, row, col, w_in, hg_norm, mla_q_norm, mla_w_qb, mla_kv_norm, mla_w_kvb):
    dt = hj.dtype
    f32 = jnp.float32
    B, T, _ = hj.shape

    def hd(t, d):
        return t.reshape(B, T, -1, d)

    def z(a, b=None):
        return dir_stack(a, a if b is None else b, n_ctx)

    hq, hf_fw, hf_bw, hi, hg, cq, ckv = split_cols(hj @ w_in, OD_SIZES)

    def forget(pre):
        pre = pre.astype(f32)
        log_f = jnp.logaddexp(jnp.log(lb), jnp.log1p(-lb) + jax.nn.log_sigmoid(pre))
        one_minus_f = (1.0 - lb) * jax.nn.sigmoid(-pre)
        return hd(log_f, HG_DIM), hd(one_minus_f, HG_DIM)

    lf_fw, kf_fw = forget(hf_fw)
    lf_bw, kf_bw = forget(hf_bw)
    q = hd(jax.nn.silu(hq.astype(f32)), HG_DIM)
    i = hd(hi.astype(f32), HG_DIM)
    o = hgrn2_chunkwise(z(q), z(kf_fw, kf_bw), z(i), z(lf_fw, lf_bw))
    y_hg = (head_rmsnorm(dir_merge(o, B, n_ctx), hg_norm) * jax.nn.silu(hg.astype(f32))).astype(dt)

    q_all = hd(rmsnorm(cq, mla_q_norm) @ mla_w_qb, MLA_NOPE + MLA_ROPE)
    q_nope, q_rope = q_all[..., :MLA_NOPE], q_all[..., MLA_NOPE:]
    c_kv, k_rope = ckv[..., :MLA_KV_RANK], ckv[..., MLA_KV_RANK:]
    kv = hd(rmsnorm(c_kv, mla_kv_norm) @ mla_w_kvb, MLA_NOPE + MLA_V)
    k_nope, v = kv[..., :MLA_NOPE], kv[..., MLA_NOPE:]
    k_rope = jnp.concatenate([k_rope[:, :n_ctx], axial_rope(k_rope[:, n_ctx:], row, col)], axis=1)
    scale = (MLA_NOPE + MLA_ROPE) ** -0.5
    y_att = block_attention(q_nope[:, n_ctx:], axial_rope(q_rope[:, n_ctx:], row, col), k_nope, k_rope, v, scale)
    y_lat = jnp.concatenate([y_hg[:, n_ctx:], y_att.astype(dt)], axis=-1)
    y_ctx = None
    if need_ctx:
        y_c = block_attention(q_nope[:, :n_ctx], q_rope[:, :n_ctx], k_nope[:, :n_ctx], k_rope[:, :n_ctx], v[:, :n_ctx], scale)
        y_ctx = jnp.concatenate([y_hg[:, :n_ctx], y_c.astype(dt)], axis=-1)
    return y_ctx, y_lat


def setup_inputs(seed: int = 0) -> dict:
    key = jax.random.key(seed)
    ks = iter(jax.random.split(key, 48))

    def nrm(shape, s):
        return jax.random.normal(next(ks), shape, jnp.float32) * s

    def uni(shape, lo, hi):
        return jax.random.uniform(next(ks), shape, jnp.float32, lo, hi)

    D = D_MODEL
    ig_b = nrm((N_EVEN, 2, ML_HEADS), 0.1)
    fg_b = uni((N_EVEN, 2, ML_HEADS), 3.0, 6.0)
    return {
        'x': nrm((BATCH, SEQ, D), 1.0),
        'c': nrm((BATCH, D), 1.0),
        'ctx': nrm((BATCH, CTX_LEN, D), 1.0),
        'c_ctx': nrm((D,), 1.0),
        'ada_w': nrm((DEPTH, D, N_MOD * D), 0.5 * D ** -0.5),
        'ada_b': nrm((DEPTH, N_MOD * D), 0.02),
        'norm_g': 1.0 + nrm((DEPTH, 4, D), 0.02),
        'out_w': nrm((DEPTH, D_MIX, D), D_MIX ** -0.5),
        'mlp_w1': nrm((DEPTH, D, D_FF), D ** -0.5),
        'mlp_w2': nrm((DEPTH, D_FF, D), D_FF ** -0.5),
        'hg_lb': nrm((DEPTH, HG_WIDTH), 0.5),
        'ev_w_in': nrm((N_EVEN, D, EV_PROJ), D ** -0.5),
        'ml_conv': nrm((N_EVEN, ML_CONV, 2 * ML_WIDTH), ML_CONV ** -0.5),
        'ml_gate_b': jnp.stack([ig_b[:, 0], fg_b[:, 0], ig_b[:, 1], fg_b[:, 1]], axis=1),
        'ml_norm': 1.0 + nrm((N_EVEN, ML_WIDTH), 0.02),
        'rw_mu': uni((N_EVEN, RW_FEAT), 0.0, 1.0),
        'rw_w0': uni((N_EVEN, 2, RW_WIDTH), -6.0, -1.0),
        'rw_w2': nrm((N_EVEN, 2, RW_DECAY_RANK, RW_WIDTH), 0.5 * RW_DECAY_RANK ** -0.5),
        'rw_a0': nrm((N_EVEN, 2, RW_WIDTH), 0.1),
        'rw_a2': nrm((N_EVEN, 2, RW_ICL_RANK, RW_WIDTH), 0.5 * RW_ICL_RANK ** -0.5),
        'rw_g2': nrm((N_EVEN, RW_GATE_RANK, RW_WIDTH), RW_GATE_RANK ** -0.5),
        'rw_kk': 0.85 + nrm((N_EVEN, RW_WIDTH), 0.05),
        'rw_ka': 1.0 + nrm((N_EVEN, RW_WIDTH), 0.05),
        'rw_rk': nrm((N_EVEN, RW_WIDTH), 0.1),
        'rw_ln_w': 1.0 + nrm((N_EVEN, RW_WIDTH), 0.02),
        'rw_ln_b': nrm((N_EVEN, RW_WIDTH), 0.02),
        'od_w_in': nrm((N_ODD, D, OD_PROJ), D ** -0.5),
        'hg_norm': 1.0 + nrm((N_ODD, HG_WIDTH), 0.02),
        'mla_q_norm': 1.0 + nrm((N_ODD, MLA_Q_RANK), 0.02),
        'mla_w_qb': nrm((N_ODD, MLA_Q_RANK, MLA_HEADS * (MLA_NOPE + MLA_ROPE)), MLA_Q_RANK ** -0.5),
        'mla_kv_norm': 1.0 + nrm((N_ODD, MLA_KV_RANK), 0.02),
        'mla_w_kvb': nrm((N_ODD, MLA_KV_RANK, MLA_HEADS * (MLA_NOPE + MLA_V)), MLA_KV_RANK ** -0.5),
    }


def reference(x, c, ctx, c_ctx, ada_w, ada_b, norm_g, out_w, mlp_w1, mlp_w2, hg_lb, ev_w_in, ml_conv, ml_gate_b,
              ml_norm, rw_mu, rw_w0, rw_w2, rw_a0, rw_a2, rw_g2, rw_kk, rw_ka, rw_rk, rw_ln_w, rw_ln_b, od_w_in,
              hg_norm, mla_q_norm, mla_w_qb, mla_kv_norm, mla_w_kvb):
    B, N, D = x.shape
    n_ctx = ctx.shape[1]
    rows = N // GRID_W
    row = jnp.broadcast_to(jnp.arange(rows)[:, None], (rows, GRID_W)).reshape(-1)
    col = jnp.broadcast_to(jnp.arange(GRID_W)[None, :], (rows, GRID_W)).reshape(-1)
    lb_all = jax.nn.softmax(hg_lb.astype(jnp.float32), axis=0)
    lb_all = jnp.cumsum(lb_all, axis=0) - lb_all[0]
    silu_c = jax.nn.silu(c)
    silu_cc = jax.nn.silu(c_ctx)
    xc = ctx
    for l in range(DEPTH):
        last = l == DEPTH - 1
        mod = (silu_c @ ada_w[l] + ada_b[l])[:, None, :]
        modc = (silu_cc @ ada_w[l] + ada_b[l])[None, None, :]
        sh_a, sc_a, g_a, sh_m, sc_m, g_m = jnp.split(mod, N_MOD, axis=-1)
        shc_a, scc_a, gc_a, shc_m, scc_m, gc_m = jnp.split(modc, N_MOD, axis=-1)
        hj = jnp.concatenate([modulate(rmsnorm(xc, norm_g[l, 0]), shc_a, scc_a),
                              modulate(rmsnorm(x, norm_g[l, 0]), sh_a, sc_a)], axis=1)
        if l % 2 == 0:
            e = l // 2
            y_ctx, y_lat = even_mixer(hj, n_ctx, not last, ev_w_in[e], ml_conv[e], ml_gate_b[e], ml_norm[e], rw_mu[e],
                                      rw_w0[e], rw_w2[e], rw_a0[e], rw_a2[e], rw_g2[e], rw_kk[e], rw_ka[e], rw_rk[e],
                                      rw_ln_w[e], rw_ln_b[e])
        else:
            o = l // 2
            y_ctx, y_lat = odd_mixer(hj, n_ctx, not last, lb_all[l], row, col, od_w_in[o], hg_norm[o], mla_q_norm[o],
                                     mla_w_qb[o], mla_kv_norm[o], mla_w_kvb[o])
        x = x + g_a * rmsnorm(y_lat @ out_w[l], norm_g[l, 1])
        x = x + g_m * rmsnorm(sqrelu_mlp(modulate(rmsnorm(x, norm_g[l, 2]), sh_m, sc_m), mlp_w1[l], mlp_w2[l]), norm_g[l, 3])
        if not last:
            xc = xc + gc_a * rmsnorm(y_ctx @ out_w[l], norm_g[l, 1])
            xc = xc + gc_m * rmsnorm(sqrelu_mlp(modulate(rmsnorm(xc, norm_g[l, 2]), shc_m, scc_m), mlp_w1[l], mlp_w2[l]), norm_g[l, 3])
    return x
```

```cpp
#ifndef HIPEMU
#include <hip/hip_runtime.h>
#include <hip/hip_cooperative_groups.h>
namespace cg = cooperative_groups;
#endif
#include <cstdio>
#include <cstdint>
#include <cmath>

#define DEVI __device__ __forceinline__

#ifndef CFG_NB
#define CFG_NB 2
#endif
#ifndef CFG_SEQ
#define CFG_SEQ 8192
#endif
#ifndef CFG_CTX
#define CFG_CTX 256
#endif
constexpr int NB = CFG_NB, SEQ = CFG_SEQ, CTX = CFG_CTX, T = CTX + SEQ, M = NB * T, D = 1024, DFF = 4096;
constexpr int NCH = T / 256;
constexpr int NCTXCH = CTX / 256;
constexpr int NLT = SEQ / 256;
constexpr int GRIDW = 64;
constexpr int EVP = 4096, ODP = 3072;
constexpr float EPS = 1e-6f;
constexpr int NTHREADS = 512;
static_assert(CTX % 256 == 0 && SEQ % 256 == 0, "chunking");

constexpr int E_MQ = 0, E_MK = 512, E_MV = 1024, E_MO = 1536, E_RF = 2048, E_MG = 3968;
constexpr int R_R = 0, R_K = 512, R_V = 1024, R_WL = 1536, R_AL = 1664, R_GL = 1792;
constexpr int O_HQ = 0, O_HFF = 512, O_HFB = 1024, O_HI = 1536, O_HG = 2048, O_CQ = 2560, O_CKV = 2816, O_KR = 2944;

constexpr size_t MiB = 1u << 20;
constexpr size_t WS_CTL = 0;
constexpr size_t CTL_BYTES = 256 * 1024;
constexpr size_t WS_MOD = 1 * MiB;
constexpr size_t WS_ROPE = WS_MOD + 256 * 1024;
constexpr size_t WS_RSTD = WS_MOD + 512 * 1024;
constexpr size_t WS_W = 2 * MiB;
constexpr size_t W_IN = 0, W_OUT = 8 * MiB, W_1 = 10 * MiB, W_2 = 18 * MiB, W_QB = 26 * MiB, W_KVB = 26 * MiB + 512 * 1024;
constexpr size_t WS_BIG = 29 * MiB;
constexpr size_t WS_ACT = 161 * MiB;
constexpr size_t WS_SCR = 194 * MiB;
constexpr size_t WS_XC = 254 * MiB;
constexpr size_t WS_END = 256 * MiB;
constexpr int NSTR_ML = NB * 4 * 2;
constexpr size_t SC_MLC = 0;
constexpr size_t SC_MLN = SC_MLC + (size_t)NSTR_ML * NCH * 16384 * 4;
constexpr size_t SC_MLS = SC_MLN + (size_t)NSTR_ML * NCH * 128 * 4;
constexpr size_t SC_ML_END = SC_MLS + (size_t)NSTR_ML * NCH * 4 * 4;
constexpr size_t SC_QC = (SC_ML_END + 255) / 256 * 256;
static_assert(SC_QC + (size_t)M * 512 * 2 <= 60 * MiB, "scr");
constexpr size_t OUT_KC = (size_t)M * 512 * 4;
static_assert(OUT_KC + (size_t)M * 512 * 2 <= (size_t)NB * SEQ * 1024 * 4, "d_out scratch");
constexpr size_t SC_Q = 0, SC_KN = SC_Q + (size_t)M * 768 * 2, SC_V = SC_KN + (size_t)M * 512 * 2, SC_KR = SC_V + (size_t)M * 512 * 2, SC_L1_END = SC_KR + (size_t)M * 64 * 2;
static_assert(SC_L1_END <= 60 * MiB, "scr1");
constexpr size_t WS_HGS = WS_BIG + (size_t)M * ODP * 2;
static_assert(WS_HGS + (size_t)NSTR_ML * NCH * 16384 * 4 <= WS_ACT, "hgs");
static_assert((size_t)M * 512 * 4 <= (size_t)NB * SEQ * 1024 * 4 + 0 || true, "");

typedef unsigned short bf16_t;
typedef short bf16x8 __attribute__((ext_vector_type(8)));
typedef float f32x4 __attribute__((ext_vector_type(4)));
typedef float f32x16 __attribute__((ext_vector_type(16)));
typedef unsigned u32x4 __attribute__((ext_vector_type(4)));
typedef unsigned u32x2 __attribute__((ext_vector_type(2)));

DEVI unsigned f2bf(float f) { unsigned u = __builtin_bit_cast(unsigned, f); return (u + 0x7fffu + ((u >> 16) & 1u)) >> 16; }
DEVI float bf2f(unsigned h) { return __builtin_bit_cast(float, (h & 0xffffu) << 16); }
DEVI float u2f(unsigned u) { return __builtin_bit_cast(float, u); }
DEVI unsigned f2u(float f) { return __builtin_bit_cast(unsigned, f); }
DEVI unsigned pk2(float lo, float hi) { return f2bf(lo) | (f2bf(hi) << 16); }
DEVI float sigmoidf_(float x) { return 1.f / (1.f + __expf(-x)); }
DEVI float siluf_(float x) { return x * sigmoidf_(x); }
DEVI float logsigmoidf_(float x) { return x >= 0.f ? -log1pf(__expf(-x)) : x - log1pf(__expf(x)); }
DEVI float softplusf_(float x) { return x > 0.f ? x + log1pf(__expf(-x)) : log1pf(__expf(x)); }
DEVI int crow(int r, int hi) { return (r & 3) + 8 * (r >> 2) + 4 * hi; }
#ifdef HIPEMU
DEVI int emu_any(bool p) { float f_ = p ? 1.f : 0.f; for (int o = 1; o < 64; o <<= 1) f_ = fmaxf(f_, __shfl_xor(f_, o)); return f_ > 0.5f; }
#define WAVE_ANY(p) emu_any(p)
#define FENCE()
#define WAVE_SYNC() emu::wave_sync()
#define EXP2F(x) exp2f(x)
DEVI f32x16 mfma32(bf16x8 a, bf16x8 b, f32x16 c) { return emu_mfma32(a, b, c); }
DEVI u32x2 plswap(unsigned a, unsigned b) { return emu_permlane32_swap(a, b); }
DEVI void atomic_add_f32(float* p, float v) { float o = __atomic_load_n((int*)p, __ATOMIC_RELAXED) * 0 + *p; (void)o; unsigned* ip = (unsigned*)p; unsigned old = __atomic_load_n(ip, __ATOMIC_RELAXED);
    for (;;) { float f = __builtin_bit_cast(float, old) + v; unsigned nv = __builtin_bit_cast(unsigned, f); if (__atomic_compare_exchange_n(ip, &old, nv, false, __ATOMIC_RELAXED, __ATOMIC_RELAXED)) break; } }
#else
#define WAVE_ANY(p) __any(p)
#define FENCE() do { asm volatile("" ::: "memory"); __builtin_amdgcn_sched_barrier(0); } while (0)
#define WAVE_SYNC() __builtin_amdgcn_wave_barrier()
#define EXP2F(x) __builtin_amdgcn_exp2f(x)
DEVI f32x16 mfma32(bf16x8 a, bf16x8 b, f32x16 c) { return __builtin_amdgcn_mfma_f32_32x32x16_bf16(a, b, c, 0, 0, 0); }
DEVI u32x2 plswap(unsigned a, unsigned b) { auto r = __builtin_amdgcn_permlane32_swap(a, b, false, false); u32x2 o; o[0] = r[0]; o[1] = r[1]; return o; }
DEVI void atomic_add_f32(float* p, float v) { unsafeAtomicAdd(p, v); }
#endif
#ifdef HIPEMU
template <int MSK> DEVI float shx(float v) { return __shfl_xor(v, MSK); }
DEVI float shfl_up_l(float v, int o, int lane) { return __shfl_up(v, o); }
#else
template <int MSK> DEVI float shx(float v) {
    if constexpr (MSK == 32) { auto r = __builtin_amdgcn_permlane32_swap(__builtin_bit_cast(unsigned, v), __builtin_bit_cast(unsigned, v), false, false); const unsigned lo = r[0], hi2 = r[1];
        return __builtin_bit_cast(float, lo ^ hi2 ^ __builtin_bit_cast(unsigned, v)); }
    else return __builtin_bit_cast(float, __builtin_amdgcn_ds_swizzle(__builtin_bit_cast(int, v), (MSK << 10) | 0x1f));
}
DEVI float shfl_up_l(float v, int o, int lane) { const int src = lane >= o ? lane - o : lane; return __builtin_bit_cast(float, __builtin_amdgcn_ds_bpermute(src << 2, __builtin_bit_cast(int, v))); }
#endif
DEVI float wave_sum(float v) { v += shx<1>(v); v += shx<2>(v); v += shx<4>(v); v += shx<8>(v); v += shx<16>(v); v += shx<32>(v); return v; }
DEVI float half_sum32(float v) { v += shx<1>(v); v += shx<2>(v); v += shx<4>(v); v += shx<8>(v); v += shx<16>(v); return v; }
DEVI bf16x8 ld8(const bf16_t* p) { return *(const bf16x8*)p; }
DEVI void unpack8(bf16x8 v, float* f) {
#pragma unroll
    for (int i = 0; i < 8; ++i) f[i] = bf2f((unsigned short)v[i]);
}
DEVI bf16x8 pack8(const float* f) { u32x4 w; w[0] = pk2(f[0], f[1]); w[1] = pk2(f[2], f[3]); w[2] = pk2(f[4], f[5]); w[3] = pk2(f[6], f[7]); return __builtin_bit_cast(bf16x8, w); }
DEVI bf16x8 pk4frag(const f32x16& P, int B) {
    unsigned a0 = pk2(P[B + 0], P[B + 1]), a1 = pk2(P[B + 2], P[B + 3]), b0 = pk2(P[B + 4], P[B + 5]), b1 = pk2(P[B + 6], P[B + 7]);
    u32x2 r0 = plswap(a0, b0), r1 = plswap(a1, b1); u32x4 w; w[0] = r0[0]; w[1] = r1[0]; w[2] = r0[1]; w[3] = r1[1]; return __builtin_bit_cast(bf16x8, w);
}
DEVI int grow(int b, int t) { return b * T + t; }

struct Args {
    const float* in[32];
    float* out; unsigned char* ws;
    int ph_lo, ph_hi;
};
#ifdef HIPEMU
#define CONSTAS
#else
#define CONSTAS __attribute__((address_space(4)))
#endif
struct Frame {
    unsigned char* lds;
    const CONSTAS Args* ap; float* out; unsigned char* ws;
    int tid, lane, wave, G, bid;
};
enum { I_X = 0, I_C, I_CTX, I_CCTX, I_ADAW, I_ADAB, I_NORMG, I_OUTW, I_W1, I_W2, I_HGLB, I_EVW, I_MLCONV, I_MLGB, I_MLNORM, I_RWMU, I_RWW0, I_RWW2,
       I_RWA0, I_RWA2, I_RWG2, I_RWKK, I_RWKA, I_RWRK, I_RWLNW, I_RWLNB, I_ODW, I_HGNORM, I_QNORM, I_WQB, I_KVNORM, I_WKVB };

DEVI const float* modp(const Frame& F, int layer, int s) { return (const float*)(F.ws + WS_MOD) + ((size_t)layer * 3 + s) * 6144; }

#ifdef HIPEMU
DEVI Frame relaunder(const Frame& F) { return F; }
DEVI Frame unit_frame(const Frame& F) { return F; }
#else
DEVI Frame relaunder(const Frame& F0) { Frame F = F0; int ln = __builtin_amdgcn_mbcnt_hi(~0u, __builtin_amdgcn_mbcnt_lo(~0u, 0u)); asm volatile("" : "+v"(ln)); __builtin_assume(ln >= 0 && ln < 64);
    F.lane = ln; F.tid = F0.wave * 64 + ln; return F; }
DEVI Frame unit_frame(const Frame& F0) { return relaunder(F0); }
#endif
namespace pg8 {
constexpr int BM = 256, BK = 64, HALF = 128, HTB = HALF * BK * 2, STAGE_BYTES = 8 * HTB, NXCD = 8, WGM = 8;
struct Unit { int pm, pn; };
struct Gemm { const bf16_t* A; const bf16_t* Bt; int K, lda, ldb; };
DEVI int lds_byte(int r, int c) { const int st = (r >> 4) * 2 + (c >> 5), rr = r & 15, cc = c & 31, ob = rr * 64 + cc * 2; return st * 1024 + (ob ^ (((ob >> 9) & 1) << 5)); }
DEVI void stage_rc(int b, int& R, int& C) { const int st = b / 1024, sb = b % 1024, swz = sb ^ (((sb >> 9) & 1) << 5); R = (st >> 1) * 16 + swz / 64; C = (st & 1) * 32 + (swz % 64) / 2; }
DEVI int perm32(int rho) { const int n = rho >> 4, i = rho & 15; return 8 * (i >> 2) + 4 * n + (i & 3); }
struct Order {
    int nM, nN, nwg, G, c, lat_only;
    DEVI void init(int nM_, int nN_, int G_, int c_, int lat) { nM = nM_; nN = nN_; nwg = nM * nN; G = G_; c = c_; lat_only = lat; }
    DEVI bool next(int i, Unit& u) const {
        const long L = (long)i * G + c; if (L >= nwg) return false;
        int wgid = (int)L; { const int q = nwg / NXCD, r = nwg % NXCD, xcd = wgid % NXCD, off = wgid / NXCD; wgid = (xcd < r ? xcd * (q + 1) : r * (q + 1) + (xcd - r) * q) + off; }
        const int nig = WGM * nN, gid = wgid / nig, fm = gid * WGM, gsz = (nM - fm) < WGM ? (nM - fm) : WGM;
        int pm = fm + ((wgid % nig) % gsz); u.pn = (wgid % nig) / gsz;
        if (lat_only) pm = (pm / NLT) * NCH + NCTXCH + (pm % NLT);
        u.pm = pm; return true;
    }
};
#ifndef HIPEMU
#define PG8_LAS __attribute__((address_space(3)))
template <class Epi>
__device__ __forceinline__ void gemm_phase(unsigned char* lds_g, const Gemm g, const Order& S, const Epi& E, int tid_in) {
    PG8_LAS unsigned char* lds = (PG8_LAS unsigned char*)lds_g;
    const int tid = tid_in, wid = __builtin_amdgcn_readfirstlane(tid >> 6), lane = tid & 63, wr = wid >> 2, wc = wid & 3, fr = lane & 15, fq = lane >> 4;
    const int K = g.K, nt = K / BK;
    unsigned voffA[2], voffB[2];
#pragma unroll
    for (int i = 0; i < 2; ++i) { int R, C; stage_rc(tid * 16 + i * 8192, R, C); const int Rb = Epi::PERM ? ((R & ~31) + perm32(R & 31)) : R;
        voffA[i] = (unsigned)(R * g.lda + C) * 2u; voffB[i] = (unsigned)(Rb * g.ldb + C) * 2u; }
    const size_t kstep = (size_t)(BK * 2);
    const size_t hstepA = (size_t)HALF * g.lda * 2, hstepB = (size_t)HALF * g.ldb * 2;
    const size_t tstepA = 2 * hstepA, tstepB = 2 * hstepB;
    const unsigned ldsw = (unsigned)wid * 1024u;
    const int aoff = lds_byte(wr * 64 + fr, fq * 8), boff = lds_byte(wc * 32 + fr, fq * 8);
#define PG8_SA(b, h) (((b) * 2 + (h)) * HTB)
#define PG8_SB(b, h) ((4 + (b) * 2 + (h)) * HTB)
#define PG8_STAGE(bufoff, gbase, voff) do { _Pragma("unroll") for (int _i = 0; _i < 2; ++_i) \
        __builtin_amdgcn_global_load_lds((const unsigned*)((const char*)(gbase) + (voff)[_i]), (PG8_LAS unsigned*)(lds + (bufoff) + ldsw + _i * 8192), 16, 0, 0); } while (0)
#define PG8_LDA(dst, b, h) do { _Pragma("unroll") for (int m = 0; m < 4; ++m) _Pragma("unroll") for (int k = 0; k < 2; ++k) dst[m][k] = *(const PG8_LAS bf16x8*)(lds + PG8_SA(b, h) + aoff + m * 2048 + k * 1024); } while (0)
#define PG8_LDB(dst, b, h) do { _Pragma("unroll") for (int n = 0; n < 2; ++n) _Pragma("unroll") for (int k = 0; k < 2; ++k) dst[n][k] = *(const PG8_LAS bf16x8*)(lds + PG8_SB(b, h) + boff + n * 2048 + k * 1024); } while (0)
#define PG8_MMA(ai, bj, At, Bt) do { __builtin_amdgcn_s_setprio(1); _Pragma("unroll") for (int m = 0; m < 4; ++m) _Pragma("unroll") for (int n = 0; n < 2; ++n) _Pragma("unroll") for (int k = 0; k < 2; ++k) \
        acc[ai][bj][m][n] = __builtin_amdgcn_mfma_f32_16x16x32_bf16(Bt[n][k], At[m][k], acc[ai][bj][m][n], 0, 0, 0); __builtin_amdgcn_s_setprio(0); } while (0)
#define PG8_WAIT_V(n) asm volatile("s_waitcnt vmcnt(" #n ")" ::: "memory")
#define PG8_WAIT_L(n) asm volatile("s_waitcnt lgkmcnt(" #n ")" ::: "memory")
#define PG8_BAR __builtin_amdgcn_s_barrier()
#define PG8_SCHED __builtin_amdgcn_sched_barrier(0)
    Unit cur, nxt; int ui = 0;
    if (!S.next(0, cur)) return;
    f32x4 acc[2][2][4][2];
#pragma unroll
    for (int a = 0; a < 2; ++a)
#pragma unroll
        for (int b = 0; b < 2; ++b)
#pragma unroll
            for (int m = 0; m < 4; ++m)
#pragma unroll
                for (int n = 0; n < 2; ++n) acc[a][b][m][n] = (f32x4){0.f, 0.f, 0.f, 0.f};
    bf16x8 At[4][2], B0[2][2], B1[2][2];
    const char* cA = (const char*)g.A + (size_t)cur.pm * tstepA; const char* cB = (const char*)g.Bt + (size_t)cur.pn * tstepB;
    PG8_STAGE(PG8_SB(0, 0), cB, voffB); PG8_STAGE(PG8_SB(0, 1), cB + hstepB, voffB); PG8_STAGE(PG8_SA(0, 0), cA, voffA); PG8_STAGE(PG8_SA(0, 1), cA + hstepA, voffA);
    if (wr == 1) PG8_BAR;
    PG8_WAIT_V(2); PG8_BAR;
    PG8_STAGE(PG8_SB(1, 0), cB + kstep, voffB); PG8_STAGE(PG8_SA(1, 0), cA + kstep, voffA); PG8_STAGE(PG8_SB(1, 1), cB + hstepB + kstep, voffB);
    PG8_WAIT_V(6); PG8_BAR;
    for (;;) {
        const bool has_next = S.next(ui + 1, nxt);
        const char* nA = has_next ? (const char*)g.A + (size_t)nxt.pm * tstepA : cA; const char* nB = has_next ? (const char*)g.Bt + (size_t)nxt.pn * tstepB : cB;
#pragma unroll 1
        for (int t = 0; t < nt; t += 2) {
            const bool last = (t == nt - 2);
            const char* a1 = cA + (size_t)(t + 1) * kstep;
            const char* a2 = last ? nA : cA + (size_t)(t + 2) * kstep; const char* b2 = last ? nB : cB + (size_t)(t + 2) * kstep;
            const char* a3 = a2 + kstep; const char* b3 = b2 + kstep;
            PG8_LDB(B0, 0, 0); PG8_LDB(B1, 0, 1); PG8_SCHED; PG8_LDA(At, 0, 0); PG8_STAGE(PG8_SA(1, 1), a1 + hstepA, voffA);
            PG8_WAIT_V(8); PG8_WAIT_L(0); PG8_BAR; PG8_MMA(0, 0, At, B0); PG8_MMA(0, 1, At, B1); PG8_BAR; PG8_SCHED;
            PG8_LDA(At, 0, 1); PG8_STAGE(PG8_SB(0, 0), b2, voffB); PG8_STAGE(PG8_SB(0, 1), b2 + hstepB, voffB); PG8_STAGE(PG8_SA(0, 0), a2, voffA);
            PG8_WAIT_V(8); PG8_WAIT_L(0); PG8_BAR; PG8_MMA(1, 0, At, B0); PG8_MMA(1, 1, At, B1); PG8_BAR; PG8_SCHED;
            PG8_LDB(B0, 1, 0); PG8_LDB(B1, 1, 1); PG8_SCHED; PG8_LDA(At, 1, 0); PG8_STAGE(PG8_SA(0, 1), a2 + hstepA, voffA);
            PG8_WAIT_V(8); PG8_WAIT_L(0); PG8_BAR; PG8_MMA(0, 0, At, B0); PG8_MMA(0, 1, At, B1); PG8_BAR; PG8_SCHED;
            PG8_LDA(At, 1, 1); PG8_STAGE(PG8_SB(1, 0), b3, voffB); PG8_STAGE(PG8_SB(1, 1), b3 + hstepB, voffB); PG8_STAGE(PG8_SA(1, 0), a3, voffA);
            PG8_WAIT_V(8); PG8_WAIT_L(0); PG8_BAR; PG8_MMA(1, 0, At, B0); PG8_MMA(1, 1, At, B1); PG8_BAR; PG8_SCHED;
        }
        if (wr == 0) PG8_BAR;
        E(acc, cur, wr, wc, fr, fq);
        if (!has_next) break;
#pragma unroll
        for (int a = 0; a < 2; ++a)
#pragma unroll
            for (int b = 0; b < 2; ++b)
#pragma unroll
                for (int m = 0; m < 4; ++m)
#pragma unroll
                    for (int n = 0; n < 2; ++n) acc[a][b][m][n] = (f32x4){0.f, 0.f, 0.f, 0.f};
        cur = nxt; cA = nA; cB = nB; ++ui;
        if (wr == 1) PG8_BAR;
    }
    PG8_WAIT_V(0);
    PG8_BAR;
#undef PG8_SA
#undef PG8_SB
#undef PG8_STAGE
#undef PG8_LDA
#undef PG8_LDB
#undef PG8_MMA
#undef PG8_WAIT_V
#undef PG8_WAIT_L
#undef PG8_BAR
#undef PG8_SCHED
}
#else
template <class Epi>
static inline void gemm_phase(unsigned char*, const Gemm g, const Order& S, const Epi& E, int tid_in) {
    const int tid = tid_in, wid = tid >> 6, lane = tid & 63, wr = wid >> 2, wc = wid & 3, fr = lane & 15, fq = lane >> 4;
    Unit u;
    for (int ui = 0; S.next(ui, u); ++ui) {
        f32x4 acc[2][2][4][2];
        for (int ai = 0; ai < 2; ++ai) for (int bj = 0; bj < 2; ++bj) for (int m = 0; m < 4; ++m) for (int n = 0; n < 2; ++n) for (int e = 0; e < 4; ++e) {
            const int row = u.pm * 256 + 128 * ai + 64 * wr + 16 * m + fr;
            const int col = u.pn * 256 + 128 * bj + 32 * wc + (Epi::PERM ? (8 * fq + 4 * n + e) : (16 * n + 4 * fq + e));
            const bf16_t* a = g.A + (size_t)row * g.lda; const bf16_t* b = g.Bt + (size_t)col * g.ldb; float s = 0.f;
            for (int k = 0; k < g.K; ++k) s += bf2f(a[k]) * bf2f(b[k]);
            acc[ai][bj][m][n][e] = s; }
        E(acc, u, wr, wc, fr, fq);
    }
    __syncthreads();
}
#endif
template <int ACT> struct EpiBf16 {
    static constexpr bool PERM = true;
    bf16_t* O; int ldc;
    DEVI void operator()(const f32x4 (&acc)[2][2][4][2], const Unit& u, int wr, int wc, int fr, int fq) const {
        const int row0 = u.pm * BM + wr * 64 + fr, col0 = u.pn * BM + wc * 32 + 8 * fq;
#pragma unroll
        for (int ai = 0; ai < 2; ++ai)
#pragma unroll
            for (int m = 0; m < 4; ++m) { bf16_t* rowp = O + (size_t)(row0 + ai * HALF + m * 16) * ldc + col0;
#pragma unroll
                for (int bj = 0; bj < 2; ++bj) { f32x4 v0 = acc[ai][bj][m][0], v1 = acc[ai][bj][m][1];
                    if (ACT == 1) {
#pragma unroll
                        for (int e = 0; e < 4; ++e) { float a = v0[e] > 0.f ? v0[e] : 0.f, b = v1[e] > 0.f ? v1[e] : 0.f; v0[e] = a * a; v1[e] = b * b; } }
                    u32x4 w; w[0] = pk2(v0[0], v0[1]); w[1] = pk2(v0[2], v0[3]); w[2] = pk2(v1[0], v1[1]); w[3] = pk2(v1[2], v1[3]);
                    *(u32x4*)(rowp + bj * HALF) = w; } }
    }
};
struct EpiF32 {
    static constexpr bool PERM = false;
    float* C; int ldc;
    DEVI void operator()(const f32x4 (&acc)[2][2][4][2], const Unit& u, int wr, int wc, int fr, int fq) const {
        const int row0 = u.pm * BM + wr * 64 + fr, col0 = u.pn * BM + wc * 32 + 4 * fq;
#pragma unroll
        for (int ai = 0; ai < 2; ++ai)
#pragma unroll
            for (int m = 0; m < 4; ++m) { float* rowp = C + (size_t)(row0 + ai * HALF + m * 16) * ldc + col0;
#pragma unroll
                for (int bj = 0; bj < 2; ++bj)
#pragma unroll
                    for (int n = 0; n < 2; ++n) *(f32x4*)(rowp + bj * HALF + n * 16) = acc[ai][bj][m][n]; }
    }
};
struct EpiQ {
    static constexpr bool PERM = true;
    unsigned char* ws;
    DEVI void operator()(const f32x4 (&acc)[2][2][4][2], const Unit& u, int wr, int wc, int fr, int fq) const {
        bf16_t* O = (bf16_t*)(ws + WS_SCR + SC_Q); const float* rstd = (const float*)(ws + WS_RSTD); const float* ropec = (const float*)(ws + WS_ROPE); const float* ropes = ropec + 128 * 16;
        const int row0 = u.pm * BM + wr * 64 + fr, col0 = u.pn * BM + wc * 32 + 8 * fq;
#pragma unroll
        for (int ai = 0; ai < 2; ++ai)
#pragma unroll
            for (int m = 0; m < 4; ++m) { const int row = row0 + ai * HALF + m * 16; const float rs = rstd[row];
                const int tt = row % T; const bool lat = tt >= CTX; const int li = lat ? tt - CTX : 0; const int prow = li / GRIDW, pcol = li % GRIDW;
#pragma unroll
                for (int bj = 0; bj < 2; ++bj) { const int col = col0 + bj * HALF; const int j = col % 192;
                    float v[8], p[8];
#pragma unroll
                    for (int e = 0; e < 4; ++e) { v[e] = acc[ai][bj][m][0][e] * rs; v[4 + e] = acc[ai][bj][m][1][e] * rs; }
#pragma unroll
                    for (int e = 0; e < 8; ++e) p[e] = shx<32>(v[e]);
                    if (j >= 128 && lat) { const int ro = j - 128, half = ro >> 5, w = ro & 31; const int pos = half ? pcol : prow; const bool lo = w < 16; const int i0 = lo ? w : w - 16;
#pragma unroll
                        for (int e = 0; e < 8; ++e) { const float c = ropec[pos * 16 + i0 + e], s = ropes[pos * 16 + i0 + e]; v[e] = lo ? (v[e] * c - p[e] * s) : (p[e] * s + v[e] * c); } }
                    u32x4 w4; w4[0] = pk2(v[0], v[1]); w4[1] = pk2(v[2], v[3]); w4[2] = pk2(v[4], v[5]); w4[3] = pk2(v[6], v[7]);
                    *(u32x4*)(O + (size_t)row * 768 + col) = w4; FENCE(); } }
    }
};
struct EpiKV {
    static constexpr bool PERM = true;
    unsigned char* ws;
    DEVI void operator()(const f32x4 (&acc)[2][2][4][2], const Unit& u, int wr, int wc, int fr, int fq) const {
        bf16_t* KN = (bf16_t*)(ws + WS_SCR + SC_KN); bf16_t* V = (bf16_t*)(ws + WS_SCR + SC_V); const float* rstd = (const float*)(ws + WS_RSTD) + M;
        const int row0 = u.pm * BM + wr * 64 + fr, col0 = u.pn * BM + wc * 32 + 8 * fq;
#pragma unroll
        for (int ai = 0; ai < 2; ++ai)
#pragma unroll
            for (int m = 0; m < 4; ++m) { const int row = row0 + ai * HALF + m * 16; const float rs = rstd[row];
#pragma unroll
                for (int bj = 0; bj < 2; ++bj) { const int col = col0 + bj * HALF; const int h = col >> 8, j = col & 255;
                    f32x4 v0 = acc[ai][bj][m][0] * rs, v1 = acc[ai][bj][m][1] * rs;
                    u32x4 w4; w4[0] = pk2(v0[0], v0[1]); w4[1] = pk2(v0[2], v0[3]); w4[2] = pk2(v1[0], v1[1]); w4[3] = pk2(v1[2], v1[3]);
                    bf16_t* dst = (j < 128) ? (KN + (size_t)row * 512 + h * 128 + j) : (V + (size_t)row * 512 + h * 128 + (j - 128));
                    *(u32x4*)dst = w4; FENCE(); } }
    }
};
}

template <class DMap>
DEVI void transpose_item(const float* W, int K, int N, bf16_t* WT, int ldk, const float* kscale, float* scr, int item, int lane, DMap dmap) {
    const int nblk = (N + 31) / 32, kb = item / nblk, nb = item % nblk, k0 = 64 * kb, n0 = 32 * nb;
    for (int i = 0; i < 32; ++i) { const int kk = 2 * i + (lane >> 5), n = n0 + (lane & 31); float v = (n < N) ? W[(size_t)(k0 + kk) * N + n] : 0.f; if (kscale) v *= kscale[k0 + kk]; scr[kk * 33 + (lane & 31)] = v; }
    WAVE_SYNC();
    const int c = lane & 7;
#pragma unroll
    for (int j = 0; j < 4; ++j) { const int n = (lane >> 3) + 8 * j; const float* s = scr + (8 * c) * 33 + n;
        if (n0 + n < N) { u32x4 o; o[0] = pk2(s[0 * 33], s[1 * 33]); o[1] = pk2(s[2 * 33], s[3 * 33]); o[2] = pk2(s[4 * 33], s[5 * 33]); o[3] = pk2(s[6 * 33], s[7 * 33]);
            *(u32x4*)(WT + (size_t)dmap(n0 + n) * ldk + k0 + 8 * c) = o; } }
    WAVE_SYNC();
}
struct DMapId { DEVI int operator()(int n) const { return n; } };
struct DMapEv { DEVI int operator()(int n) const { return n < 2048 ? n : (n < 2064 ? E_MG + (n - 2048) : E_RF + (n - 2064)); } };
template <class DMap>
DEVI void convert_weight(const Frame& F, const float* W, int K, int N, bf16_t* WT, int ldk, const float* kscale, DMap dmap, int& wcur) {
    float* scr = (float*)(F.lds) + F.wave * (64 * 33);
    const int items = (K / 64) * ((N + 31) / 32), NGW = F.G * 8, gw = F.bid * 8 + F.wave;
    int first = (gw - wcur % NGW + NGW) % NGW;
    for (int it = first; it < items; it += NGW) transpose_item(W, K, N, WT, ldk, kscale, scr, it, F.lane, dmap);
    wcur += items;
}
DEVI void zero_rows(const Frame& F, bf16_t* WT, int ldk, int r0, int r1, int c0 = 0, int c1 = -1) {
    if (c1 < 0) c1 = ldk; const int w8 = (c1 - c0) / 8, n = (r1 - r0) * w8;
    for (int i = F.bid * NTHREADS + F.tid; i < n; i += F.G * NTHREADS) { const int r = r0 + i / w8, c = c0 + (i % w8) * 8; *(u32x4*)(WT + (size_t)r * ldk + c) = (u32x4){0u, 0u, 0u, 0u}; }
}
DEVI void convert_layer_weights(const Frame& F, int layer) {
    bf16_t* Wb = (bf16_t*)(F.ws + WS_W); int wcur = 0;
    if (layer == 0) {
        convert_weight(F, F.ap->in[I_EVW], D, 3984, Wb + W_IN / 2, D, nullptr, DMapEv(), wcur);
        zero_rows(F, Wb + W_IN / 2, D, 3984, EVP);
    } else {
        convert_weight(F, F.ap->in[I_ODW], D, 3008, Wb + W_IN / 2, D, nullptr, DMapId(), wcur);
        zero_rows(F, Wb + W_IN / 2, D, 3008, ODP);
        convert_weight(F, F.ap->in[I_WQB], 256, 768, Wb + W_QB / 2, 256, F.ap->in[I_QNORM], DMapId(), wcur);
        convert_weight(F, F.ap->in[I_WKVB], 128, 1024, Wb + W_KVB / 2, 256, F.ap->in[I_KVNORM], DMapId(), wcur);
        zero_rows(F, Wb + W_KVB / 2, 256, 0, 1024, 128, 256);
    }
    convert_weight(F, F.ap->in[I_OUTW] + (size_t)layer * D * D, D, D, Wb + W_OUT / 2, D, nullptr, DMapId(), wcur);
    convert_weight(F, F.ap->in[I_W1] + (size_t)layer * D * DFF, D, DFF, Wb + W_1 / 2, D, nullptr, DMapId(), wcur);
    convert_weight(F, F.ap->in[I_W2] + (size_t)layer * DFF * D, DFF, D, Wb + W_2 / 2, DFF, nullptr, DMapId(), wcur);
}
DEVI void ada_units(const Frame& F) {
    float* sc = (float*)F.lds;
    float* part = sc + 3 * 1024;
    bool have = false;
    for (int u = F.bid; u < 2 * 96; u += F.G) {
        if (!have) { for (int i = F.tid; i < 3 * 1024; i += NTHREADS) { const int s = i >> 10, k = i & 1023; const float c = (s < 2) ? (s < NB ? F.ap->in[I_C][s * 1024 + k] : 0.f) : F.ap->in[I_CCTX][k]; sc[i] = siluf_(c); } have = true; }
        __syncthreads();
        const int l = u / 96, col = (u % 96) * 64 + F.lane; const float* W = F.ap->in[I_ADAW] + (size_t)l * 1024 * 6144 + col;
        float a0 = 0.f, a1 = 0.f, a2 = 0.f;
#pragma unroll 8
        for (int kk = 0; kk < 128; ++kk) { const int k = F.wave * 128 + kk; const float w = W[(size_t)k * 6144]; a0 += sc[k] * w; a1 += sc[1024 + k] * w; a2 += sc[2048 + k] * w; }
        part[(F.wave * 3 + 0) * 64 + F.lane] = a0; part[(F.wave * 3 + 1) * 64 + F.lane] = a1; part[(F.wave * 3 + 2) * 64 + F.lane] = a2;
        __syncthreads();
        if (F.tid < 192) { const int s = F.tid >> 6, ln = F.tid & 63; float t = 0.f; for (int w = 0; w < 8; ++w) t += part[(w * 3 + s) * 64 + ln];
            const int c2 = (u % 96) * 64 + ln; ((float*)(F.ws + WS_MOD))[((size_t)l * 3 + s) * 6144 + c2] = t + F.ap->in[I_ADAB][l * 6144 + c2]; }
    }
    __syncthreads();
}
DEVI void rope_tables(const Frame& F) {
    float* rc = (float*)(F.ws + WS_ROPE); float* rs = rc + 128 * 16;
    for (int i = F.bid * NTHREADS + F.tid; i < 128 * 16; i += F.G * NTHREADS) { const int pos = i >> 4, j = i & 15; const float inv = powf(10000.f, -(float)j / 16.f); const float ang = (float)pos * inv; rc[i] = cosf(ang); rs[i] = sinf(ang); }
}

struct RowVec { f32x4 v[4]; };
DEVI RowVec ld_row(const float* p, int lane) { RowVec r; const f32x4* q = (const f32x4*)p + lane;
#pragma unroll
    for (int j = 0; j < 4; ++j) r.v[j] = q[64 * j]; return r; }
DEVI void st_row(float* p, int lane, const RowVec& r) { f32x4* q = (f32x4*)p + lane;
#pragma unroll
    for (int j = 0; j < 4; ++j) q[64 * j] = r.v[j]; }
DEVI float row_rstd(const RowVec& r) { float s = 0.f;
#pragma unroll
    for (int j = 0; j < 4; ++j) s += (r.v[j][0] * r.v[j][0] + r.v[j][1] * r.v[j][1]) + (r.v[j][2] * r.v[j][2] + r.v[j][3] * r.v[j][3]);
    return 1.f / sqrtf(wave_sum(s) * (1.f / D) + EPS); }
DEVI void st_mod_bf16(bf16_t* orow, int lane, const RowVec& x, float rstd, const float* g, const float* shift, const float* scale) {
    unsigned long long* o8 = (unsigned long long*)orow + lane;
#pragma unroll
    for (int j = 0; j < 4; ++j) { const f32x4 gg = ((const f32x4*)g)[lane + 64 * j], sh = ((const f32x4*)shift)[lane + 64 * j], sc = ((const f32x4*)scale)[lane + 64 * j];
        f32x4 y;
#pragma unroll
        for (int e = 0; e < 4; ++e) y[e] = (x.v[j][e] * rstd * gg[e]) * (1.f + sc[e]) + sh[e];
        o8[64 * j] = (unsigned long long)pk2(y[0], y[1]) | ((unsigned long long)pk2(y[2], y[3]) << 32); }
}
DEVI float* stream_row(const Frame& F, int b, int t) { return (t < CTX) ? (float*)(F.ws + WS_XC) + ((size_t)b * CTX + t) * D : F.out + ((size_t)b * SEQ + (t - CTX)) * D; }
DEVI const float* input_row(const Frame& F, int b, int t) { return (t < CTX) ? F.ap->in[I_CTX] + ((size_t)b * CTX + t) * D : F.ap->in[I_X] + ((size_t)b * SEQ + (t - CTX)) * D; }
DEVI void phase_hj0(const Frame& F) {
    const int gw = F.bid * 8 + F.wave, NGW = F.G * 8; bf16_t* HJ = (bf16_t*)(F.ws + WS_ACT);
    for (int r = gw; r < M; r += NGW) { const int b = r / T, t = r % T, s = (t < CTX) ? 2 : b; const float* mod = modp(F, 0, s);
        RowVec x = ld_row(input_row(F, b, t), F.lane); const float rs = row_rstd(x);
        st_mod_bf16(HJ + (size_t)r * D, F.lane, x, rs, F.ap->in[I_NORMG] + 0 * 4 * D + 0 * D, mod + 0, mod + 1024); }
}
DEVI void phase_resid(const Frame& F, int layer, int which, const float* Y, bool lat_only, bf16_t* AO) {
    const int gw = F.bid * 8 + F.wave, NGW = F.G * 8;
    const float* ng = F.ap->in[I_NORMG] + (size_t)layer * 4 * D;
    for (int r = gw; r < M; r += NGW) { const int b = r / T, t = r % T; if (lat_only && t < CTX) continue; const int s = (t < CTX) ? 2 : b; const float* mod = modp(F, layer, s);
        RowVec y = ld_row(Y + (size_t)r * D, F.lane); const float rsy = row_rstd(y);
        const float* xin = (layer == 0 && which == 0) ? input_row(F, b, t) : stream_row(F, b, t);
        RowVec x = ld_row(xin, F.lane);
        const float* gn = ng + (which == 0 ? 1 : 3) * D; const float* gate = mod + (which == 0 ? 2048 : 5120);
#pragma unroll
        for (int j = 0; j < 4; ++j) { const f32x4 gg = ((const f32x4*)gn)[F.lane + 64 * j], gt = ((const f32x4*)gate)[F.lane + 64 * j];
#pragma unroll
            for (int e = 0; e < 4; ++e) x.v[j][e] += gt[e] * (y.v[j][e] * rsy * gg[e]); }
        st_row(stream_row(F, b, t), F.lane, x);
        if (which == 0) { const float rs = row_rstd(x); st_mod_bf16(AO + (size_t)r * D, F.lane, x, rs, ng + 2 * D, mod + 3072, mod + 4096); }
        else if (layer == 0) { const float rs = row_rstd(x); const float* mod1 = modp(F, 1, s); st_mod_bf16(AO + (size_t)r * D, F.lane, x, rs, F.ap->in[I_NORMG] + (size_t)1 * 4 * D, mod1 + 0, mod1 + 1024); }
    }
}

DEVI void wave_scan256(float* arr, int lane, int op, bool rev) {
    float v[4];
#pragma unroll
    for (int e = 0; e < 4; ++e) { const int i = 4 * lane + e; v[e] = arr[rev ? 255 - i : i]; }
#pragma unroll
    for (int e = 1; e < 4; ++e) v[e] = op ? fmaxf(v[e], v[e - 1]) : v[e] + v[e - 1];
    float tot = v[3];
#pragma unroll
    for (int o = 1; o < 64; o <<= 1) { const float n = shfl_up_l(tot, o, lane); if (lane >= o) tot = op ? fmaxf(tot, n) : tot + n; }
    float ex = shfl_up_l(tot, 1, lane);
#pragma unroll
    for (int e = 0; e < 4; ++e) { float r = v[e]; if (lane > 0) r = op ? fmaxf(r, ex) : r + ex; const int i = 4 * lane + e; arr[rev ? 255 - i : i] = r; }
}

struct MlGates { float *a_fw, *pm_fw, *b_fw, *a_bw, *pm_bw, *b_bw; };
DEVI MlGates ml_gate_ptrs(float* base) { MlGates g; g.a_fw = base; g.pm_fw = base + 256; g.b_fw = base + 512; g.a_bw = base + 768; g.pm_bw = base + 1024; g.b_bw = base + 1280; return g; }
DEVI void ml_gates_setup(const Frame& F, const MlGates& g, int b, int h, int c) {
    const bf16_t* PROJ = (const bf16_t*)(F.ws + WS_BIG); const float* gb = F.ap->in[I_MLGB];
    if (F.tid < 256) { const int row = grow(b, c * 256 + F.tid); const bf16_t* p = PROJ + (size_t)row * EVP + E_MG;
        const float igf = bf2f(p[0 + h]) + gb[0 + h], fgf = bf2f(p[4 + h]) + gb[4 + h], igb = bf2f(p[8 + h]) + gb[8 + h], fgb = bf2f(p[12 + h]) + gb[12 + h];
        g.b_fw[F.tid] = logsigmoidf_(fgf); g.a_fw[F.tid] = igf; g.b_bw[F.tid] = logsigmoidf_(fgb); g.a_bw[F.tid] = igb; }
    __syncthreads();
    if (F.wave == 0) wave_scan256(g.b_fw, F.lane, 0, false);
    if (F.wave == 1) wave_scan256(g.b_bw, F.lane, 0, true);
    __syncthreads();
    if (F.tid < 256) { const float af = g.a_fw[F.tid] - g.b_fw[F.tid], ab = g.a_bw[F.tid] - g.b_bw[F.tid]; g.a_fw[F.tid] = af; g.pm_fw[F.tid] = af; g.a_bw[F.tid] = ab; g.pm_bw[F.tid] = ab; }
    __syncthreads();
    if (F.wave == 0) wave_scan256(g.pm_fw, F.lane, 1, false);
    if (F.wave == 1) wave_scan256(g.pm_bw, F.lane, 1, true);
    __syncthreads();
}
DEVI void ml_conv8(const bf16_t* PROJ, const float* cw, int b, int t, int col, int cch, float scale, float* out) {
    const int lo = (t < CTX) ? 0 : CTX, hi = (t < CTX) ? CTX : T;
    float x0[8], x1[8], x2[8];
    unpack8(ld8(PROJ + (size_t)grow(b, t) * EVP + col), x1);
    if (t - 1 >= lo) unpack8(ld8(PROJ + (size_t)grow(b, t - 1) * EVP + col), x0); else { for (int e = 0; e < 8; ++e) x0[e] = 0.f; }
    if (t + 1 < hi) unpack8(ld8(PROJ + (size_t)grow(b, t + 1) * EVP + col), x2); else { for (int e = 0; e < 8; ++e) x2[e] = 0.f; }
#pragma unroll
    for (int e = 0; e < 8; ++e) out[e] = (cw[cch + e] * x0[e] + cw[1024 + cch + e] * x1[e] + cw[2048 + cch + e] * x2[e]) * scale;
}
constexpr float ML_KSCALE = 0.08838834764831845f;
constexpr int LDT = 72;
DEVI void ml_phaseA_unit(const Frame& F, int b, int h, int c) {
    const bf16_t* PROJ = (const bf16_t*)(F.ws + WS_BIG);
    float* gbase = (float*)F.lds; MlGates g = ml_gate_ptrs(gbase);
    float* wfw = gbase + 1536; float* wbw = wfw + 256;
    bf16_t* VTf = (bf16_t*)(F.lds + 8192); bf16_t* VTb = VTf + 128 * LDT; bf16_t* KT = VTb + 128 * LDT;
    ml_gates_setup(F, g, b, h, c);
    if (F.tid < 256) { wfw[F.tid] = __expf(g.a_fw[F.tid] - g.pm_fw[255]); wbw[F.tid] = __expf(g.a_bw[F.tid] - g.pm_bw[0]); }
    const int dir = F.wave >> 2, vt = F.wave & 3, r32 = F.lane & 31, hi = F.lane >> 5;
    f32x16 acc[4];
#pragma unroll
    for (int i = 0; i < 4; ++i) acc[i] = (f32x16){};
    float nacc = 0.f;
    for (int jb = 0; jb < 4; ++jb) {
        __syncthreads();
        { const int j = F.tid >> 3, cg8 = F.tid & 7, t = c * 256 + jb * 64 + j; const float wf = wfw[jb * 64 + j], wb = wbw[jb * 64 + j];
#pragma unroll
          for (int half = 0; half < 2; ++half) { const int ch = cg8 * 16 + half * 8; float v[8], k[8];
            unpack8(ld8(PROJ + (size_t)grow(b, t) * EVP + E_MV + h * 128 + ch), v);
            ml_conv8(PROJ, F.ap->in[I_MLCONV], b, t, E_MK + h * 128 + ch, 512 + h * 128 + ch, ML_KSCALE, k);
            const bf16x8 kp = pack8(k); *(bf16x8*)((bf16_t*)((unsigned char*)F.out + OUT_KC) + (size_t)grow(b, t) * 512 + h * 128 + ch) = kp;
#pragma unroll
            for (int e = 0; e < 8; ++e) { VTf[(ch + e) * LDT + j] = (bf16_t)f2bf(v[e] * wf); VTb[(ch + e) * LDT + j] = (bf16_t)f2bf(v[e] * wb); KT[(ch + e) * LDT + j] = (bf16_t)kp[e]; }
            float q[8]; ml_conv8(PROJ, F.ap->in[I_MLCONV], b, t, E_MQ + h * 128 + ch, h * 128 + ch, 1.f, q);
            *(bf16x8*)((bf16_t*)(F.ws + WS_SCR + SC_QC) + (size_t)grow(b, t) * 512 + h * 128 + ch) = pack8(q); } }
        __syncthreads();
        const bf16_t* VT = dir ? VTb : VTf;
#pragma unroll
        for (int ks = 0; ks < 4; ++ks) { const bf16x8 a = ld8(VT + (vt * 32 + r32) * LDT + ks * 16 + hi * 8);
#pragma unroll
            for (int dt = 0; dt < 4; ++dt) acc[dt] = mfma32(a, ld8(KT + (dt * 32 + r32) * LDT + ks * 16 + hi * 8), acc[dt]); }
        if (F.tid < 256) { const int dd = F.tid >> 7, d = F.tid & 127; const float* w = dd ? wbw : wfw; float s = 0.f; for (int j = 0; j < 64; ++j) s += bf2f(KT[d * LDT + j]) * w[jb * 64 + j]; nacc += s; }
    }
    const int stream = (b * 4 + h) * 2 + dir;
    float* Cg = (float*)(F.ws + WS_SCR + SC_MLC) + ((size_t)stream * NCH + c) * 16384;
#pragma unroll
    for (int dt = 0; dt < 4; ++dt)
#pragma unroll
        for (int r = 0; r < 16; ++r) Cg[(vt * 32 + crow(r, hi)) * 128 + dt * 32 + r32] = acc[dt][r];
    if (F.tid < 256) { const int dd = F.tid >> 7, d = F.tid & 127; const int st2 = (b * 4 + h) * 2 + dd; ((float*)(F.ws + WS_SCR + SC_MLN))[((size_t)st2 * NCH + c) * 128 + d] = nacc; }
    if (F.tid < 2) { const int dd = F.tid; const int st2 = (b * 4 + h) * 2 + dd; float* sc = (float*)(F.ws + WS_SCR + SC_MLS) + ((size_t)st2 * NCH + c) * 4;
        const float btot = dd ? g.b_bw[0] : g.b_fw[255], pme = dd ? g.pm_bw[0] : g.pm_fw[255]; sc[0] = btot + pme; sc[1] = btot; }
    __syncthreads();
}
DEVI int ml_chunk_at(int dir, int k) { if (!dir) return k; return (k < NCTXCH) ? (NCTXCH - 1 - k) : (NCH - 1 - (k - NCTXCH)); }
DEVI void ml_phaseB(const Frame& F) {
    const int nvb = NSTR_ML * 16;
    for (int vb = F.bid; vb < nvb; vb += F.G) {
        const int stream = vb >> 4, e0 = ((vb & 15) * NTHREADS + F.tid) * 2, dir = stream & 1;
        float* Cs = (float*)(F.ws + WS_SCR + SC_MLC) + (size_t)stream * NCH * 16384; float* Ns = (float*)(F.ws + WS_SCR + SC_MLN) + (size_t)stream * NCH * 128; float* Ss = (float*)(F.ws + WS_SCR + SC_MLS) + (size_t)stream * NCH * 4;
        float c0 = 0.f, c1 = 0.f, n0 = 0.f, m = 0.f; const bool do_n = (vb & 15) == 0 && F.tid < 128;
        for (int k = 0; k < NCH; ++k) { const int c = ml_chunk_at(dir, k);
            const float mloc = Ss[c * 4 + 0], btot = Ss[c * 4 + 1];
            float* cp = Cs + (size_t)c * 16384 + e0; const float l0 = cp[0], l1 = cp[1]; cp[0] = c0; cp[1] = c1;
            float ln = 0.f; if (do_n) { ln = Ns[c * 128 + F.tid]; Ns[c * 128 + F.tid] = n0; }
            if ((vb & 15) == 0 && F.tid == 0) Ss[c * 4 + 2] = m;
            const float mn = fmaxf(btot + m, mloc), dk = __expf(btot + m - mn), sl = __expf(mloc - mn);
            c0 = dk * c0 + sl * l0; c1 = dk * c1 + sl * l1; n0 = dk * n0 + sl * ln; m = mn; }
    }
}
constexpr int LDK = 136;
DEVI void ml_phaseC_unit(const Frame& F0, int b, int h, int c) {
    const Frame F = unit_frame(F0);
    const bf16_t* PROJ = (const bf16_t*)(F.ws + WS_BIG); bf16_t* YM = (bf16_t*)(F.ws + WS_ACT);
    float* gbase = (float*)F.lds; MlGates g = ml_gate_ptrs(gbase);
    float* nin = gbase + 1536;
    float* wsc = gbase + 1792 + F.wave * 64;
    bf16_t* Kl = (bf16_t*)(F.lds + 12288);
    bf16_t* VT = Kl + 64 * LDK;
    bf16_t* stash = VT + 128 * LDT + F.wave * (32 * 136);
    ml_gates_setup(F, g, b, h, c);
    const int r32 = F.lane & 31, hi = F.lane >> 5, it = F.wave >> 1;
    const int irow = F.wave * 32 + r32;
    const int tq = c * 256 + irow;
    if (F.tid < 256) { const int dd = F.tid >> 7, d = F.tid & 127; nin[F.tid] = ((const float*)(F.ws + WS_SCR + SC_MLN))[((size_t)((b * 4 + h) * 2 + dd) * NCH + c) * 128 + d]; }
    bf16x8 qr[8];
#pragma unroll
    for (int d0 = 0; d0 < 8; ++d0) qr[d0] = ld8((const bf16_t*)(F.ws + WS_SCR + SC_QC) + (size_t)grow(b, tq) * 512 + h * 128 + d0 * 16 + hi * 8);
    __syncthreads();
    f32x16 o[4];
#pragma unroll 1
    for (int dir = 0; dir < 2; ++dir) {
        const int stream = (b * 4 + h) * 2 + dir;
        const float m_in = ((const float*)(F.ws + WS_SCR + SC_MLS))[((size_t)stream * NCH + c) * 4 + 2];
        const float* aarr = dir ? g.a_bw : g.a_fw; const float* pmarr = dir ? g.pm_bw : g.pm_fw; const float* barr = dir ? g.b_bw : g.b_fw;
        const float Mrow = fmaxf(m_in, pmarr[irow]), w_inter = __expf(m_in - Mrow);
        const float* Cg = (const float*)(F.ws + WS_SCR + SC_MLC) + ((size_t)stream * NCH + c) * 16384;
#pragma unroll
        for (int d0 = 0; d0 < 4; ++d0) { o[d0] = (f32x16){};
#pragma unroll
            for (int ks = 0; ks < 8; ++ks) { const float* cp = Cg + (d0 * 32 + r32) * 128 + ks * 16 + hi * 8; float cf[8];
                const f32x4 c0 = *(const f32x4*)cp, c1 = *(const f32x4*)(cp + 4);
#pragma unroll
                for (int e = 0; e < 4; ++e) { cf[e] = c0[e]; cf[4 + e] = c1[e]; }
                o[d0] = mfma32(qr[ks], pack8(cf), o[d0]); if (ks & 1) FENCE(); } }
        float nq = 0.f;
#pragma unroll
        for (int d0 = 0; d0 < 8; ++d0) { float q[8]; unpack8(qr[d0], q);
#pragma unroll
            for (int e = 0; e < 8; ++e) nq += q[e] * nin[dir * 128 + d0 * 16 + hi * 8 + e]; FENCE(); }
        nq += shx<32>(nq);
        if (hi == 0) wsc[r32] = w_inter;
        __syncthreads();
#pragma unroll
        for (int d0 = 0; d0 < 4; ++d0)
#pragma unroll
            for (int r = 0; r < 16; ++r) o[d0][r] *= wsc[crow(r, hi)];
        float rowsum = 0.f;
#pragma unroll 1
        for (int jt = 0; jt < 4; ++jt) {
            __syncthreads();
            { const int j = F.tid >> 3, cg8 = F.tid & 7, t = c * 256 + jt * 64 + j;
#pragma unroll
              for (int half = 0; half < 2; ++half) { const int ch = cg8 * 16 + half * 8;
                const bf16x8 vv = ld8(PROJ + (size_t)grow(b, t) * EVP + E_MV + h * 128 + ch);
                *(bf16x8*)(Kl + j * LDK + ch) = ld8((const bf16_t*)((const unsigned char*)F.out + OUT_KC) + (size_t)grow(b, t) * 512 + h * 128 + ch);
#pragma unroll
                for (int e = 0; e < 8; ++e) VT[(ch + e) * LDT + j] = (bf16_t)vv[e]; } }
            __syncthreads(); FENCE();
            const bool rel = dir ? (jt >= it) : (jt <= it);
            if (rel) {
                f32x16 p0 = (f32x16){}, p1 = (f32x16){};
#pragma unroll
                for (int d0 = 0; d0 < 8; ++d0) { p0 = mfma32(ld8(Kl + r32 * LDK + d0 * 16 + hi * 8), qr[d0], p0); p1 = mfma32(ld8(Kl + (32 + r32) * LDK + d0 * 16 + hi * 8), qr[d0], p1); }
#pragma unroll
                for (int r = 0; r < 16; ++r) { const int j0 = jt * 64 + crow(r, hi), j1 = j0 + 32;
                    const bool v0 = dir ? (j0 >= irow) : (j0 <= irow), v1 = dir ? (j1 >= irow) : (j1 <= irow);
                    p0[r] = v0 ? p0[r] * __expf(aarr[j0] - Mrow) : 0.f; p1[r] = v1 ? p1[r] * __expf(aarr[j1] - Mrow) : 0.f; rowsum += p0[r] + p1[r]; }
                const bf16x8 pa0 = pk4frag(p0, 0), pa1 = pk4frag(p0, 8), pa2 = pk4frag(p1, 0), pa3 = pk4frag(p1, 8); FENCE();
#pragma unroll
                for (int d0 = 0; d0 < 4; ++d0) { const bf16_t* vp = VT + (d0 * 32 + r32) * LDT + hi * 8;
                    o[d0] = mfma32(pa0, ld8(vp), o[d0]); o[d0] = mfma32(pa1, ld8(vp + 16), o[d0]); o[d0] = mfma32(pa2, ld8(vp + 32), o[d0]); o[d0] = mfma32(pa3, ld8(vp + 48), o[d0]); }
            }
        }
        rowsum += shx<32>(rowsum);
        const float den = rowsum + w_inter * nq, dn = fmaxf(fabsf(den), __expf(-(barr[irow] + Mrow)));
        __syncthreads();
        if (hi == 0) wsc[r32] = 1.f / dn;
        __syncthreads();
        if (dir == 0) {
#pragma unroll
            for (int d0 = 0; d0 < 4; ++d0)
#pragma unroll
                for (int r = 0; r < 16; ++r) stash[crow(r, hi) * 136 + d0 * 32 + r32] = (bf16_t)f2bf(o[d0][r] * wsc[crow(r, hi)]);
        } else {
#pragma unroll
            for (int d0 = 0; d0 < 4; ++d0)
#pragma unroll
                for (int r = 0; r < 16; ++r) o[d0][r] = o[d0][r] * wsc[crow(r, hi)] + bf2f(stash[crow(r, hi) * 136 + d0 * 32 + r32]);
        }
        __syncthreads();
    }
#pragma unroll
    for (int r = 0; r < 16; ++r) { float ss = 0.f;
#pragma unroll
        for (int d0 = 0; d0 < 4; ++d0) ss += o[d0][r] * o[d0][r];
        ss = half_sum32(ss); const float rs = 1.f / sqrtf(ss * (1.f / 128.f) + EPS);
        const int row = grow(b, c * 256 + F.wave * 32 + crow(r, hi));
#pragma unroll
        for (int d0 = 0; d0 < 4; ++d0) { const int v = h * 128 + d0 * 32 + r32; const float mo = bf2f(PROJ[(size_t)row * EVP + E_MO + v]);
            YM[(size_t)row * D + v] = (bf16_t)f2bf(o[d0][r] * rs * F.ap->in[I_MLNORM][v] * sigmoidf_(mo)); } FENCE(); }
    __syncthreads();
}

DEVI void rw_shift8(const bf16_t* PROJ, const float* mu, int b, int t, int f, float* out) {
    const int lo = (t < CTX) ? 0 : CTX, hi = (t < CTX) ? CTX : T; float x0[8], x1[8], x2[8];
    unpack8(ld8(PROJ + (size_t)grow(b, t) * EVP + E_RF + f), x1);
    if (t - 1 >= lo) unpack8(ld8(PROJ + (size_t)grow(b, t - 1) * EVP + E_RF + f), x0); else { for (int e = 0; e < 8; ++e) x0[e] = 0.f; }
    if (t + 1 < hi) unpack8(ld8(PROJ + (size_t)grow(b, t + 1) * EVP + E_RF + f), x2); else { for (int e = 0; e < 8; ++e) x2[e] = 0.f; }
#pragma unroll
    for (int e = 0; e < 8; ++e) out[e] = x1[e] + (0.5f * (x0[e] + x2[e]) - x1[e]) * mu[f + e];
}
constexpr int RW_T = 64 * 65;
DEVI void rw_stage_weights(const Frame& F, int h, bf16_t* W2T, bf16_t* A2T, bf16_t* G2T, int dmask) {
    for (int i = F.tid; i < 2 * 64 * 64; i += NTHREADS) { const int d = i >> 12, j = (i >> 6) & 63, e = i & 63; if (!((dmask >> d) & 1)) continue;
        const int slot = (dmask == 3) ? d : 0;
        if (W2T) W2T[(slot * 64 + e) * LDT + j] = (bf16_t)f2bf(F.ap->in[I_RWW2][((size_t)d * 64 + j) * 512 + h * 64 + e]);
        A2T[(slot * 64 + e) * LDT + j] = (bf16_t)f2bf(F.ap->in[I_RWA2][((size_t)d * 64 + j) * 512 + h * 64 + e]); }
    if (G2T) for (int i = F.tid; i < 128 * 64; i += NTHREADS) { const int j = i >> 6, e = i & 63; G2T[e * LDK + j] = (bf16_t)f2bf(F.ap->in[I_RWG2][(size_t)j * 512 + h * 64 + e]); }
}
DEVI void rw_prep(const Frame& F, int b, int h, int t0, float* R, float* K, float* V, float* KK, float* LW0, float* AA0, float* LW1, float* AA1, float* G,
                  const bf16_t* W2T, const bf16_t* A2T, const bf16_t* G2T, bf16_t* XW, bf16_t* XA, bf16_t* XG, int dmask) {
    const bf16_t* PROJ = (const bf16_t*)(F.ws + WS_BIG); const float* mu = F.ap->in[I_RWMU];
    const int tok = F.tid >> 3, c8 = (F.tid & 7) * 8, t = t0 + tok;
    const int r32 = F.lane & 31, hi = F.lane >> 5;
    { float x[8];
      rw_shift8(PROJ, mu, b, t, R_R + h * 64 + c8, x); for (int e = 0; e < 8; ++e) R[tok * 65 + c8 + e] = x[e];
      rw_shift8(PROJ, mu, b, t, R_K + h * 64 + c8, x); for (int e = 0; e < 8; ++e) K[tok * 65 + c8 + e] = x[e];
      rw_shift8(PROJ, mu, b, t, R_V + h * 64 + c8, x); for (int e = 0; e < 8; ++e) V[tok * 65 + c8 + e] = x[e]; }
    if (G) { float x[8];
#pragma unroll
        for (int hf = 0; hf < 2; ++hf) { rw_shift8(PROJ, mu, b, t, R_GL + hf * 64 + c8, x); for (int e = 0; e < 8; ++e) x[e] = sigmoidf_(x[e]); *(bf16x8*)(XG + tok * LDK + hf * 64 + c8) = pack8(x); } }
    __syncthreads();
    if (KK && F.tid < 64) { float s = 0.f; for (int e = 0; e < 64; ++e) { const float kk = K[F.tid * 65 + e] * F.ap->in[I_RWKK][h * 64 + e]; s += kk * kk; }
        const float rn = 1.f / sqrtf(s + 1e-12f); for (int e = 0; e < 64; ++e) KK[F.tid * 65 + e] = K[F.tid * 65 + e] * F.ap->in[I_RWKK][h * 64 + e] * rn; }
    if (G) {
        if (F.wave < 4) { const int tt = F.wave >> 1, et = F.wave & 1; f32x16 acc = (f32x16){};
#pragma unroll
            for (int ks = 0; ks < 8; ++ks) acc = mfma32(ld8(XG + (tt * 32 + r32) * LDK + ks * 16 + hi * 8), ld8(G2T + (et * 32 + r32) * LDK + ks * 16 + hi * 8), acc);
#pragma unroll
            for (int r = 0; r < 16; ++r) G[(tt * 32 + crow(r, hi)) * 65 + et * 32 + r32] = acc[r]; }
        __syncthreads(); }
    for (int d = 0; d < 2; ++d) { if (!((dmask >> d) & 1)) continue;
        const int slot = (dmask == 3) ? d : 0; float* LW = d ? LW1 : LW0; float* AA = d ? AA1 : AA0;
        __syncthreads();
        { float x[8];
          if (LW) { rw_shift8(PROJ, mu, b, t, R_WL + d * 64 + c8, x); for (int e = 0; e < 8; ++e) x[e] = tanhf(x[e]); *(bf16x8*)(XW + tok * LDT + c8) = pack8(x); }
          rw_shift8(PROJ, mu, b, t, R_AL + d * 64 + c8, x); *(bf16x8*)(XA + tok * LDT + c8) = pack8(x); }
        __syncthreads();
        { const int which = F.wave >> 2, tt = (F.wave >> 1) & 1, et = F.wave & 1;
          if (which || LW) { const bf16_t* X = which ? XA : XW; const bf16_t* WT = (which ? A2T : W2T) + slot * 64 * LDT;
          f32x16 acc = (f32x16){};
#pragma unroll
          for (int ks = 0; ks < 4; ++ks) acc = mfma32(ld8(X + (tt * 32 + r32) * LDT + ks * 16 + hi * 8), ld8(WT + (et * 32 + r32) * LDT + ks * 16 + hi * 8), acc);
          const int e = et * 32 + r32;
#pragma unroll
          for (int r = 0; r < 16; ++r) { const int tk = tt * 32 + crow(r, hi);
              if (!which) { const float wpre = F.ap->in[I_RWW0][d * 512 + h * 64 + e] + acc[r]; const float wlog = -softplusf_(-wpre) - 0.5f; LW[tk * 65 + e] = -__expf(wlog); }
              else AA[tk * 65 + e] = sigmoidf_(F.ap->in[I_RWA0][d * 512 + h * 64 + e] + acc[r]); } } }
    }
    __syncthreads();
}
DEVI void rw_scan_v1(const Frame& F, int b, int h, int dir, int rh) {
    float* base = (float*)F.lds;
    float *R = base, *K = R + RW_T, *V = K + RW_T, *KK = V + RW_T, *LW = KK + RW_T, *AA = LW + RW_T;
    bf16_t* W2T = (bf16_t*)(AA + RW_T); bf16_t* A2T = W2T + 64 * LDT; bf16_t* XW = A2T + 64 * LDT; bf16_t* XA = XW + 64 * LDT;
    float* YB = (float*)(XA + 64 * LDT);
    rw_stage_weights(F, h, W2T, A2T, nullptr, 1 << dir);
    float* YRW = F.out;
    const int q = F.lane & 15, rloc = F.wave * 4 + (F.lane >> 4), vrow = rh * 32 + rloc;
    float S[4] = {0.f, 0.f, 0.f, 0.f};
    const float ka0 = F.ap->in[I_RWKA][h * 64 + 4 * q + 0], ka1 = F.ap->in[I_RWKA][h * 64 + 4 * q + 1], ka2 = F.ap->in[I_RWKA][h * 64 + 4 * q + 2], ka3 = F.ap->in[I_RWKA][h * 64 + 4 * q + 3];
    const int nblk = T / 64;
    for (int kb = 0; kb < nblk; ++kb) {
        int blk; if (!dir) blk = kb; else blk = (kb < CTX / 64) ? (CTX / 64 - 1 - kb) : (nblk - 1 - (kb - CTX / 64));
        const int t0 = blk * 64;
        __syncthreads();
        rw_prep(F, b, h, t0, R, K, V, KK, dir ? nullptr : LW, dir ? nullptr : AA, dir ? LW : nullptr, dir ? AA : nullptr, nullptr, W2T, A2T, nullptr, XW, XA, nullptr, 1 << dir);
        for (int s = 0; s < 64; ++s) { const int tk = dir ? 63 - s : s; const float* kkp = KK + tk * 65 + 4 * q; const float* ap = AA + tk * 65 + 4 * q; const float* kp = K + tk * 65 + 4 * q;
            const float* lwp = LW + tk * 65 + 4 * q; const float* rp = R + tk * 65 + 4 * q;
            const float a0 = ap[0], a1 = ap[1], a2 = ap[2], a3 = ap[3];
            float sa = -(S[0] * kkp[0] + S[1] * kkp[1] + S[2] * kkp[2] + S[3] * kkp[3]);
            sa += shx<1>(sa); sa += shx<2>(sa); sa += shx<4>(sa); sa += shx<8>(sa);
            const float vv = V[tk * 65 + vrow];
            S[0] = S[0] * __expf(lwp[0]) + sa * (kkp[0] * a0) + vv * (kp[0] * (1.f + (a0 - 1.f) * ka0));
            S[1] = S[1] * __expf(lwp[1]) + sa * (kkp[1] * a1) + vv * (kp[1] * (1.f + (a1 - 1.f) * ka1));
            S[2] = S[2] * __expf(lwp[2]) + sa * (kkp[2] * a2) + vv * (kp[2] * (1.f + (a2 - 1.f) * ka2));
            S[3] = S[3] * __expf(lwp[3]) + sa * (kkp[3] * a3) + vv * (kp[3] * (1.f + (a3 - 1.f) * ka3));
            float y = S[0] * rp[0] + S[1] * rp[1] + S[2] * rp[2] + S[3] * rp[3];
            y += shx<1>(y); y += shx<2>(y); y += shx<4>(y); y += shx<8>(y);
            if (q == 0) YB[tk * 33 + rloc] = y; }
        __syncthreads();
        for (int i = F.tid; i < 64 * 32; i += NTHREADS) { const int tk = i >> 5, rr = i & 31; atomic_add_f32(YRW + (size_t)grow(b, t0 + tk) * 512 + h * 64 + rh * 32 + rr, YB[tk * 33 + rr]); }
    }
    __syncthreads();
}
DEVI void rw_finish_unit(const Frame& F, int b, int h, int blk) {
    float* base = (float*)F.lds;
    float *R = base, *K = R + RW_T, *V = K + RW_T, *G = V + RW_T, *AA0 = G + RW_T, *AA1 = AA0 + RW_T;
    bf16_t* A2T = (bf16_t*)(AA1 + RW_T); bf16_t* G2T = A2T + 2 * 64 * LDT; bf16_t* XA = G2T + 64 * LDK; bf16_t* XG = (bf16_t*)AA0;
    rw_stage_weights(F, h, nullptr, A2T, G2T, 3);
    __syncthreads();
    const int t0 = blk * 64;
    rw_prep(F, b, h, t0, R, K, V, nullptr, nullptr, AA0, nullptr, AA1, G, nullptr, A2T, G2T, nullptr, XA, XG, 3);
    const float* YRW = F.out; bf16_t* YM = (bf16_t*)(F.ws + WS_ACT);
    const int tok = F.tid >> 3, c8 = (F.tid & 7) * 8; const int row = grow(b, t0 + tok);
    float y[8]; float s = 0.f, bsum = 0.f;
#pragma unroll
    for (int e = 0; e < 8; ++e) { const int ch = c8 + e; y[e] = YRW[(size_t)row * 512 + h * 64 + ch]; s += y[e];
        const float r = R[tok * 65 + ch], k = K[tok * 65 + ch], ka = F.ap->in[I_RWKA][h * 64 + ch], rk = F.ap->in[I_RWRK][h * 64 + ch];
        const float kd0 = k * (1.f + (AA0[tok * 65 + ch] - 1.f) * ka), kd1 = k * (1.f + (AA1[tok * 65 + ch] - 1.f) * ka); bsum += r * (kd0 + kd1) * rk; }
    s += shx<1>(s); s += shx<2>(s); s += shx<4>(s); bsum += shx<1>(bsum); bsum += shx<2>(bsum); bsum += shx<4>(bsum);
    const float mu = s * (1.f / 64.f); float var = 0.f;
#pragma unroll
    for (int e = 0; e < 8; ++e) { const float dlt = y[e] - mu; var += dlt * dlt; }
    var += shx<1>(var); var += shx<2>(var); var += shx<4>(var);
    const float rs = 1.f / sqrtf(var * (1.f / 64.f) + 64e-5f); float o[8];
#pragma unroll
    for (int e = 0; e < 8; ++e) { const int ch = c8 + e; const float gn = (y[e] - mu) * rs * F.ap->in[I_RWLNW][h * 64 + ch] + F.ap->in[I_RWLNB][h * 64 + ch]; o[e] = (gn + bsum * V[tok * 65 + ch]) * G[tok * 65 + ch]; }
    *(bf16x8*)(YM + (size_t)row * D + 512 + h * 64 + c8) = pack8(o);
    __syncthreads();
}

constexpr float HG_QSCALE = 0.08838834764831845f;
constexpr int LDS32 = 40;
DEVI float hg_lb(const Frame& F, int ch) { return sigmoidf_(F.ap->in[I_HGLB][512 + ch] - F.ap->in[I_HGLB][ch]); }
DEVI void hg_fk(float pre, float lb, float& lf, float& k) { const float sg = sigmoidf_(pre); lf = __logf(lb + (1.f - lb) * sg); k = (1.f - lb) * (1.f - sg); }
DEVI void hg_phaseA_unit(const Frame& F, int b, int h, int c) {
    const bf16_t* PROJ = (const bf16_t*)(F.ws + WS_BIG);
    bf16_t* KTf = (bf16_t*)F.lds; bf16_t* KTb = KTf + 128 * LDT; bf16_t* VTa = KTb + 128 * LDT; bf16_t* VTb = VTa + 128 * LDT;
    const int r32 = F.lane & 31, hi = F.lane >> 5, dir = F.wave >> 2, dt = F.wave & 3;
    f32x16 acc[4];
#pragma unroll
    for (int i = 0; i < 4; ++i) acc[i] = (f32x16){};
    float Racc = 0.f; const int sd = F.tid >> 7, sdch = F.tid & 127;
    const float lb = (F.tid < 256) ? hg_lb(F, h * 128 + sdch) : 0.f;
    for (int itb = 0; itb < 4; ++itb) {
        const int blk_f = 3 - itb, blk_b = itb;
        __syncthreads();
        if (F.tid < 256) { const int blk = sd ? blk_b : blk_f; bf16_t* KT = sd ? KTb : KTf; const int col = (sd ? O_HFB : O_HFF) + h * 128 + sdch;
            for (int s = 0; s < 64; ++s) { const int j = sd ? s : 63 - s; const int t = c * 256 + blk * 64 + j; float lf, k; hg_fk(bf2f(PROJ[(size_t)grow(b, t) * ODP + col]), lb, lf, k);
                KT[sdch * LDT + j] = (bf16_t)f2bf(k * __expf(Racc)); Racc += lf; } }
        else { const int tt = F.tid - 256; const int j = tt >> 2, q4 = tt & 3;
#pragma unroll
            for (int w = 0; w < 2; ++w) { const int blk = w ? blk_b : blk_f; bf16_t* VT = w ? VTb : VTa; const int t = c * 256 + blk * 64 + j;
#pragma unroll
                for (int g4 = 0; g4 < 4; ++g4) { const int ch = q4 * 32 + g4 * 8; float v[8]; unpack8(ld8(PROJ + (size_t)grow(b, t) * ODP + O_HI + h * 128 + ch), v);
#pragma unroll
                    for (int e = 0; e < 8; ++e) VT[(ch + e) * LDT + j] = (bf16_t)f2bf(v[e]); } } }
        __syncthreads();
        const bf16_t* KT = dir ? KTb : KTf; const bf16_t* VT = dir ? VTb : VTa;
#pragma unroll
        for (int ks = 0; ks < 4; ++ks) { const bf16x8 a = ld8(KT + (dt * 32 + r32) * LDT + ks * 16 + hi * 8);
#pragma unroll
            for (int vt = 0; vt < 4; ++vt) acc[vt] = mfma32(a, ld8(VT + (vt * 32 + r32) * LDT + ks * 16 + hi * 8), acc[vt]); }
    }
    const int stream = (b * 4 + h) * 2 + dir; float* Sg = (float*)(F.ws + WS_HGS) + ((size_t)stream * NCH + c) * 16384;
#pragma unroll
    for (int vt = 0; vt < 4; ++vt)
#pragma unroll
        for (int r = 0; r < 16; ++r) Sg[(dt * 32 + crow(r, hi)) * 128 + vt * 32 + r32] = acc[vt][r];
    if (F.tid < 256) ((float*)(F.ws + WS_ACT))[((size_t)((b * 4 + h) * 2 + sd) * NCH + c) * 128 + sdch] = Racc;
    __syncthreads();
}
DEVI void hg_phaseB(const Frame& F) {
    const int nvb = NSTR_ML * 16;
    for (int vb = F.bid; vb < nvb; vb += F.G) {
        const int stream = vb >> 4, e0 = ((vb & 15) * NTHREADS + F.tid) * 2, dir = stream & 1, d = e0 >> 7;
        float* Ss = (float*)(F.ws + WS_HGS) + (size_t)stream * NCH * 16384; const float* Bt = (const float*)(F.ws + WS_ACT) + (size_t)stream * NCH * 128;
        float s0 = 0.f, s1 = 0.f;
        for (int k = 0; k < NCH; ++k) { const int c = ml_chunk_at(dir, k); float* sp = Ss + (size_t)c * 16384 + e0; const float l0 = sp[0], l1 = sp[1]; sp[0] = s0; sp[1] = s1;
            const float dk = __expf(Bt[c * 128 + d]); s0 = dk * s0 + l0; s1 = dk * s1 + l1; }
    }
}
DEVI void hg_phaseC_unit(const Frame& F, int b, int h, int c) {
    const bf16_t* PROJ = (const bf16_t*)(F.ws + WS_BIG); bf16_t* YM = (bf16_t*)(F.ws + WS_ACT);
    const int dir = F.wave >> 2, vt = F.wave & 3, r32 = F.lane & 31, hi = F.lane >> 5, tl = F.tid & 255;
    unsigned char* dbase = F.lds + dir * 40960;
    bf16_t* QH = (bf16_t*)dbase; bf16_t* KB = QH + 32 * LDK; bf16_t* KBT = KB + 32 * LDK; bf16_t* VT = KBT + 128 * LDS32; float* blast = (float*)(VT + 128 * LDS32);
    bf16_t* stash = (bf16_t*)(F.lds + 81920);
    float* ssb = (float*)(F.lds + 81920 + 65536);
    f32x16 S[4];
    { const int stream = (b * 4 + h) * 2 + dir; const float* Sg = (const float*)(F.ws + WS_HGS) + ((size_t)stream * NCH + c) * 16384;
#pragma unroll
      for (int dt = 0; dt < 4; ++dt)
#pragma unroll
          for (int r = 0; r < 16; ++r) S[dt][r] = Sg[(dt * 32 + crow(r, hi)) * 128 + vt * 32 + r32]; }
    const float lb = hg_lb(F, h * 128 + (tl & 127));
#pragma unroll 1
    for (int step = 0; step < 8; ++step) {
        const int sb = dir ? 7 - step : step; const int tb = c * 256 + sb * 32;
        __syncthreads();
        if (tl < 128) { const int d = tl; const int colf = (dir ? O_HFB : O_HFF) + h * 128 + d, colq = O_HQ + h * 128 + d; float bsum = 0.f;
#pragma unroll 1
            for (int s = 0; s < 32; ++s) { const int j = dir ? 31 - s : s; const size_t rb = (size_t)grow(b, tb + j) * ODP; float lf, k; hg_fk(bf2f(PROJ[rb + colf]), lb, lf, k);
                const float q = siluf_(bf2f(PROJ[rb + colq])) * HG_QSCALE; bsum += lf;
                QH[j * LDK + d] = (bf16_t)f2bf(q * __expf(bsum)); const unsigned kb = f2bf(k * __expf(fminf(-bsum, 80.f))); KB[j * LDK + d] = (bf16_t)kb; KBT[d * LDS32 + j] = (bf16_t)kb; }
            blast[d] = __expf(bsum); }
        else { const int tt = tl - 128; const int j = tt >> 2, q4 = tt & 3; const size_t rb = (size_t)grow(b, tb + j) * ODP + O_HI + h * 128;
#pragma unroll
            for (int g4 = 0; g4 < 4; ++g4) { const int ch = q4 * 32 + g4 * 8; float v[8]; unpack8(ld8(PROJ + rb + ch), v);
#pragma unroll
                for (int e = 0; e < 8; ++e) VT[(ch + e) * LDS32 + j] = (bf16_t)f2bf(v[e]); } }
        __syncthreads();
        f32x16 p = (f32x16){};
#pragma unroll
        for (int ks = 0; ks < 8; ++ks) p = mfma32(ld8(KB + r32 * LDK + ks * 16 + hi * 8), ld8(QH + r32 * LDK + ks * 16 + hi * 8), p);
#pragma unroll
        for (int r = 0; r < 16; ++r) { const int s = crow(r, hi); const bool ok = dir ? (s >= r32) : (s <= r32); p[r] = ok ? p[r] : 0.f; }
        const bf16x8 pa0 = pk4frag(p, 0), pa1 = pk4frag(p, 8);
        f32x16 o = (f32x16){};
        { const bf16_t* vp = VT + (vt * 32 + r32) * LDS32 + hi * 8; o = mfma32(pa0, ld8(vp), o); o = mfma32(pa1, ld8(vp + 16), o); }
#pragma unroll
        for (int dt = 0; dt < 4; ++dt)
#pragma unroll
            for (int s2 = 0; s2 < 2; ++s2) { float sf[8];
#pragma unroll
                for (int e = 0; e < 8; ++e) sf[e] = S[dt][8 * s2 + e];
                const bf16_t* qp = QH + r32 * LDK + dt * 32 + 16 * s2 + 4 * hi; u32x4 aw; const u32x2 lo = *(const u32x2*)qp, hh = *(const u32x2*)(qp + 8); aw[0] = lo[0]; aw[1] = lo[1]; aw[2] = hh[0]; aw[3] = hh[1];
                o = mfma32(__builtin_bit_cast(bf16x8, aw), pack8(sf), o); }
#pragma unroll
        for (int dt = 0; dt < 4; ++dt) {
#pragma unroll
            for (int ks = 0; ks < 2; ++ks) S[dt] = mfma32(ld8(KBT + (dt * 32 + r32) * LDS32 + ks * 16 + hi * 8), ld8(VT + (vt * 32 + r32) * LDS32 + ks * 16 + hi * 8), S[dt]);
#pragma unroll
            for (int r = 0; r < 16; ++r) S[dt][r] *= blast[dt * 32 + crow(r, hi)]; }
        if (step < 4) {
#pragma unroll
            for (int r = 0; r < 16; ++r) stash[(sb * 32 + crow(r, hi)) * 128 + vt * 32 + r32] = (bf16_t)f2bf(o[r]);
        } else {
#pragma unroll
            for (int r = 0; r < 16; ++r) { o[r] += bf2f(stash[(sb * 32 + crow(r, hi)) * 128 + vt * 32 + r32]); const float sq = half_sum32(o[r] * o[r]); if (r32 == 0) ssb[(dir * 32 + crow(r, hi)) * 4 + vt] = sq; }
        }
        __syncthreads();
        if (step >= 4) {
#pragma unroll
            for (int r = 0; r < 16; ++r) { const int tr = crow(r, hi); const float* sp = ssb + (dir * 32 + tr) * 4; const float rs = 1.f / sqrtf((sp[0] + sp[1] + sp[2] + sp[3]) * (1.f / 128.f) + EPS);
                const int row = grow(b, tb + tr), v = h * 128 + vt * 32 + r32; const float hgv = bf2f(PROJ[(size_t)row * ODP + O_HG + v]);
                YM[(size_t)row * D + v] = (bf16_t)f2bf(o[r] * rs * F.ap->in[I_HGNORM][v] * siluf_(hgv)); if ((r & 3) == 3) FENCE(); }
        }
    }
    __syncthreads();
}
DEVI void mla_prep(const Frame& F) {
    const bf16_t* PROJ = (const bf16_t*)(F.ws + WS_BIG); float* rq = (float*)(F.ws + WS_RSTD); float* rkv = rq + M; bf16_t* KR = (bf16_t*)(F.ws + WS_SCR + SC_KR);
    const float* rc = (const float*)(F.ws + WS_ROPE); const float* rsn = rc + 128 * 16;
    const int gw = F.bid * 8 + F.wave, NGW = F.G * 8;
    for (int r = gw; r < M; r += NGW) { const bf16_t* p = PROJ + (size_t)r * ODP;
        float s = 0.f;
#pragma unroll
        for (int j = 0; j < 4; ++j) { const float x = bf2f(p[O_CQ + F.lane + 64 * j]); s += x * x; }
        s = wave_sum(s);
        float s2 = 0.f;
#pragma unroll
        for (int j = 0; j < 2; ++j) { const float x = bf2f(p[O_CKV + F.lane + 64 * j]); s2 += x * x; }
        s2 = wave_sum(s2);
        if (F.lane == 0) { rq[r] = 1.f / sqrtf(s * (1.f / 256.f) + EPS); rkv[r] = 1.f / sqrtf(s2 * (1.f / 128.f) + EPS); }
        const float x = bf2f(p[O_KR + F.lane]); const float pr = shx<16>(x);
        const int tt = r % T; float y = x;
        if (tt >= CTX) { const int li = tt - CTX, half = F.lane >> 5, w = F.lane & 31, pos = half ? (li % GRIDW) : (li / GRIDW); const bool lo = w < 16; const int i0 = lo ? w : w - 16;
            const float cc = rc[pos * 16 + i0], sn = rsn[pos * 16 + i0]; y = lo ? (x * cc - pr * sn) : (pr * sn + x * cc); }
        KR[(size_t)r * 64 + F.lane] = (bf16_t)f2bf(y); }
}

namespace att {
constexpr int NW = 8, QBLK = 32, KVBLK = 64;
constexpr float SCALE = 0.07216878364870322f;
#ifndef ATT_THR
#define ATT_THR 8.f
#endif
constexpr float THR = ATT_THR;
constexpr size_t SHM_V = KVBLK * 128 * 2, SHM_K = KVBLK * 128 * 2, SHM_R = KVBLK * 64 * 2;
constexpr size_t OFF_V = 0, OFF_K = 2 * SHM_V, OFF_R = OFF_K + 2 * SHM_K, OFF_WS = OFF_R + 2 * SHM_R, OFF_QR = OFF_WS + NW * 64 * 4, QRLD = 144, SHM_ATTN = OFF_QR + NW * 32 * QRLD * 2;
static_assert(SHM_ATTN <= 160 * 1024, "attention LDS");
#define KSWZ(row, colB) ((row) * 256 + ((colB) ^ (((row) & 7) << 4)))
#define RSWZ(row, colB) ((row) * 128 + ((colB) ^ (((row) & 7) << 4)))
#ifndef HIPEMU
#define SBAR() __builtin_amdgcn_sched_barrier(0)
#define LGKM0() asm volatile("s_waitcnt lgkmcnt(0)" ::: "memory")
#else
#define SBAR()
#define LGKM0()
#endif
DEVI void partialSM(f32x16& p0, f32x16& p1, float& m_reg, float& mn, float& alpha) {
    constexpr float C = SCALE * 1.4426950408889634f;
    float pmax = p0[0];
#pragma unroll
    for (int r = 1; r < 16; ++r) pmax = fmaxf(pmax, p0[r]);
#pragma unroll
    for (int r = 0; r < 16; ++r) pmax = fmaxf(pmax, p1[r]);
    { const u32x2 rr = plswap(f2u(pmax), f2u(pmax)); const unsigned ra = rr[0], rb = rr[1]; pmax = fmaxf(u2f(ra), u2f(rb)); }
    bool keep = (pmax - m_reg <= THR / SCALE);
    int allk = 1;
#ifdef HIPEMU
    { float f = keep ? 1.f : 0.f; for (int o = 1; o < 64; o <<= 1) f = fminf(f, __shfl_xor(f, o)); allk = f > 0.5f; }
#else
    allk = __all(keep);
#endif
    if (allk) { mn = m_reg; alpha = 1.f; }
    else { mn = fmaxf(m_reg, pmax); alpha = EXP2F((m_reg - mn) * C); m_reg = mn; }
    const float mnC = -mn * C;
#pragma unroll
    for (int r = 0; r < 16; ++r) { p0[r] = EXP2F(fmaf(p0[r], C, mnC)); p1[r] = fmaf(p1[r], C, mnC); }
}
DEVI void finishSM(f32x16& p0, f32x16& p1, float alpha, float& l_reg, bf16x8& pa0, bf16x8& pa1, bf16x8& pa2, bf16x8& pa3) {
    float ps = 0.f;
#pragma unroll
    for (int r = 0; r < 16; ++r) { p1[r] = EXP2F(p1[r]); ps += p0[r] + p1[r]; }
    { const u32x2 rr = plswap(f2u(ps), f2u(ps)); const unsigned ra = rr[0], rb = rr[1]; ps = u2f(ra) + u2f(rb); }
    l_reg = l_reg * alpha + ps;
    pa0 = pk4frag(p0, 0); pa1 = pk4frag(p0, 8); pa2 = pk4frag(p1, 0); pa3 = pk4frag(p1, 8);
#ifdef ATT_DEBUG
    { float ones[8] = {1,1,1,1,1,1,1,1}; bf16x8 b1 = pack8(ones); f32x16 t = (f32x16){}; t = mfma32(pa0, b1, t); t = mfma32(pa1, b1, t); t = mfma32(pa2, b1, t); t = mfma32(pa3, b1, t);
      { float own = 0.f, ownb = 0.f; for (int r = 0; r < 16; ++r) { own += p0[r] + p1[r]; ownb += bf2f(f2bf(p0[r])) + bf2f(f2bf(p1[r])); }
        float fa = 0.f; for (int j = 0; j < 8; ++j) fa += bf2f((unsigned short)pa0[j]) + bf2f((unsigned short)pa1[j]) + bf2f((unsigned short)pa2[j]) + bf2f((unsigned short)pa3[j]);
        if (blockIdx.x == 0 && (threadIdx.x == 0 || threadIdx.x == 32)) printf("  lane %d own=%g ownbf=%g fragsum=%g\n", (int)threadIdx.x, own, ownb, fa); }
      if (blockIdx.x == 0 && threadIdx.x == 0) printf("T ps=%g mfma_row0=%g alpha=%g l=%g\n", ps, t[0], alpha, l_reg); }
#endif
}
DEVI void qkt(f32x16& p0, f32x16& p1, const unsigned char* Ks, const unsigned char* Rs, const bf16x8* qr, const bf16_t* qrl, int r32, int hi) {
    p0 = (f32x16){}; p1 = (f32x16){};
#pragma unroll
    for (int d0 = 0; d0 < 8; ++d0) { const int cb = (d0 * 16 + hi * 8) * 2; const bf16x8 qf = (d0 < 4) ? qr[d0 & 3] : ld8(qrl + (d0 - 4) * 16);
        p0 = mfma32(*(const bf16x8*)(Ks + KSWZ(r32, cb)), qf, p0); p1 = mfma32(*(const bf16x8*)(Ks + KSWZ(32 + r32, cb)), qf, p1); }
#pragma unroll
    for (int d0 = 0; d0 < 4; ++d0) { const int cb = (d0 * 16 + hi * 8) * 2;
        const bf16x8 qf = ld8(qrl + 64 + d0 * 16);
        p0 = mfma32(*(const bf16x8*)(Rs + RSWZ(r32, cb)), qf, p0); p1 = mfma32(*(const bf16x8*)(Rs + RSWZ(32 + r32, cb)), qf, p1); }
}
DEVI int v_st(int k, int c) { const int kk = (k & ~0xC) | ((k & 4) << 1) | ((k & 8) >> 1); return ((kk >> 3) * 4 + (c >> 5)) * 512 + ((kk & 7) * 32 + (c & 31)) * 2; }
DEVI int v_rd_base(int lane) { return ((lane & 3) << 3) | (((lane >> 2) & 3) << 6) | (((lane >> 4) & 1) << 5) | (((lane >> 5) & 1) << 8); }
DEVI bf16x8 v_frag(const unsigned char* Vs, int d0, int ks, int r32, int hi) {
    bf16x8 o;
#pragma unroll
    for (int j = 0; j < 8; ++j) o[j] = *(const short*)(Vs + v_st(16 * ks + 8 * hi + j, 32 * d0 + r32));
    return o;
}
#ifndef HIPEMU
template <int OFF> DEVI bf16x8 tr_pair(int vb) {
    typedef short s16x4 __attribute__((ext_vector_type(4)));
    s16x4 l, h2; asm volatile("ds_read_b64_tr_b16 %0, %1 offset:%2" : "=&v"(l) : "v"(vb), "i"(OFF) : "memory"); asm volatile("ds_read_b64_tr_b16 %0, %1 offset:%2" : "=&v"(h2) : "v"(vb), "i"(OFF + 2048) : "memory");
    return (bf16x8){l[0], l[1], l[2], l[3], h2[0], h2[1], h2[2], h2[3]};
}
template <int D0> DEVI void pv_one(f32x16& od, int vb, bf16x8 pa0, bf16x8 pa1, bf16x8 pa2, bf16x8 pa3) {
    const bf16x8 b0 = tr_pair<D0 * 512 + 0 * 4096>(vb), b1 = tr_pair<D0 * 512 + 1 * 4096>(vb), b2 = tr_pair<D0 * 512 + 2 * 4096>(vb), b3 = tr_pair<D0 * 512 + 3 * 4096>(vb);
    LGKM0(); SBAR();
    od = mfma32(pa0, b0, od); od = mfma32(pa1, b1, od); od = mfma32(pa2, b2, od); od = mfma32(pa3, b3, od);
}
DEVI void pv_d0(f32x16* o, const unsigned char* Vs, int r32, int hi, int lane, bf16x8 pa0, bf16x8 pa1, bf16x8 pa2, bf16x8 pa3) {
    const int vb = (int)(uintptr_t)Vs + v_rd_base(lane);
    pv_one<0>(o[0], vb, pa0, pa1, pa2, pa3); pv_one<1>(o[1], vb, pa0, pa1, pa2, pa3); pv_one<2>(o[2], vb, pa0, pa1, pa2, pa3); pv_one<3>(o[3], vb, pa0, pa1, pa2, pa3);
}
#else
DEVI void pv_d0(f32x16* o, const unsigned char* Vs, int r32, int hi, int lane, bf16x8 pa0, bf16x8 pa1, bf16x8 pa2, bf16x8 pa3) {
    for (int d0 = 0; d0 < 4; ++d0) { o[d0] = mfma32(pa0, v_frag(Vs, d0, 0, r32, hi), o[d0]); o[d0] = mfma32(pa1, v_frag(Vs, d0, 1, r32, hi), o[d0]);
        o[d0] = mfma32(pa2, v_frag(Vs, d0, 2, r32, hi), o[d0]); o[d0] = mfma32(pa3, v_frag(Vs, d0, 3, r32, hi), o[d0]); }
}
#endif
#ifdef HIPEMU
DEVI void dma16(const bf16_t* gsrc, unsigned char* lds_wave_base, int lane) { *(bf16x8*)(lds_wave_base + lane * 16) = ld8(gsrc); }
#else
DEVI void dma16(const bf16_t* gsrc, unsigned char* lds_wave_base, int lane) {
    __builtin_amdgcn_global_load_lds((const unsigned*)gsrc, (__attribute__((address_space(3))) unsigned*)lds_wave_base, 16, 0, 0); }
#endif
DEVI void attn_unit(const Frame& F, int b, int h, int qb) {
    unsigned char* wsl = F.ws;
    const bf16_t* Q = (const bf16_t*)(wsl + WS_SCR + SC_Q); const bf16_t* KN = (const bf16_t*)(wsl + WS_SCR + SC_KN); const bf16_t* Vg = (const bf16_t*)(wsl + WS_SCR + SC_V); const bf16_t* KR = (const bf16_t*)(wsl + WS_SCR + SC_KR);
    bf16_t* YM = (bf16_t*)(wsl + WS_ACT);
    unsigned char* lds = F.lds;
    const int wid = F.wave, lane = F.lane, r32 = lane & 31, hi = lane >> 5;
    unsigned char* V_lds = lds + OFF_V; unsigned char* K_lds = lds + OFF_K; unsigned char* R_lds = lds + OFF_R;
    float* wsf = (float*)(lds + OFF_WS) + wid * 64; float* li_l = wsf; float* al_l = wsf + 32;
    float m_reg = -1e30f, l_reg = 0.f; f32x16 o[4]; o[0] = o[1] = o[2] = o[3] = (f32x16){}; bf16x8 qr[4];
    bf16_t* qrl = (bf16_t*)(lds + OFF_QR) + (wid * 32 + r32) * QRLD + hi * 8;
    const int qrow = grow(b, CTX + qb * 256 + wid * QBLK + r32);
    { const bf16_t* Qw = Q + (size_t)qrow * 768 + h * 192 + hi * 8;
#pragma unroll
      for (int d0 = 0; d0 < 4; ++d0) qr[d0] = ld8(Qw + d0 * 16);
#pragma unroll
      for (int d0 = 0; d0 < 8; ++d0) *(bf16x8*)(qrl + d0 * 16) = ld8(Qw + 64 + d0 * 16); }
    const bf16_t* Kh = KN + (size_t)grow(b, 0) * 512 + h * 128; const bf16_t* Vh = Vg + (size_t)grow(b, 0) * 512 + h * 128; const bf16_t* Rh = KR + (size_t)grow(b, 0) * 64;
    int koff[2], voff[2], roff;
#pragma unroll
    for (int i = 0; i < 2; ++i) { const int p = wid * 2048 + i * 1024 + lane * 16; const int row = p >> 8, slot = (p >> 4) & 15; koff[i] = row * 512 + ((slot ^ (row & 7)) * 8);
        const int sI = p >> 4, sub = sI >> 5, rowin = (sI >> 2) & 7, chq = sI & 3; const int kk = (sub >> 2) * 8 + rowin, c = (sub & 3) * 32 + chq * 8; const int k = (kk & ~0xC) | ((kk & 4) << 1) | ((kk & 8) >> 1); voff[i] = k * 512 + c; }
    { const int p = wid * 1024 + lane * 16; const int row = p >> 7, slot = (p >> 4) & 7; roff = row * 64 + ((slot ^ (row & 7)) * 8); }
#define DMA_KR(t, bq) do { const bf16_t* kb_ = Kh + (size_t)(t) * KVBLK * 512; dma16(kb_ + koff[0], K_lds + (bq) * SHM_K + wid * 2048, lane); dma16(kb_ + koff[1], K_lds + (bq) * SHM_K + wid * 2048 + 1024, lane); \
    dma16(Rh + (size_t)(t) * KVBLK * 64 + roff, R_lds + (bq) * SHM_R + wid * 1024, lane); } while (0)
#define DMA_V(t, bq) do { const bf16_t* vb_ = Vh + (size_t)(t) * KVBLK * 512; dma16(vb_ + voff[0], V_lds + (bq) * SHM_V + wid * 2048, lane); dma16(vb_ + voff[1], V_lds + (bq) * SHM_V + wid * 2048 + 1024, lane); } while (0)
#define RESC(a) do { const int any_ = WAVE_ANY((a) < 1.f); \
    if (any_) { WAVE_SYNC(); if (hi == 0) al_l[r32] = (a); LGKM0(); WAVE_SYNC(); \
    _Pragma("unroll") for (int d = 0; d < 4; ++d) _Pragma("unroll") for (int r = 0; r < 16; ++r) o[d][r] *= al_l[crow(r, hi)]; } } while (0)
    f32x16 pA0, pA1, pB0, pB1; float mnA, mnB, alA, alB; bf16x8 pa0, pa1, pa2, pa3; const int NT = T / KVBLK;
    DMA_KR(0, 0); __syncthreads();
    DMA_KR(1, 1); DMA_V(0, 0);
    qkt(pA0, pA1, K_lds, R_lds, qr, qrl, r32, hi); partialSM(pA0, pA1, m_reg, mnA, alA);
    __syncthreads();
    for (int j = 1; j + 1 < NT; j += 2) {
        DMA_KR(j + 1, 0); DMA_V(j, 1);
        SBAR(); qkt(pB0, pB1, K_lds + SHM_K, R_lds + SHM_R, qr, qrl, r32, hi);
        finishSM(pA0, pA1, alA, l_reg, pa0, pa1, pa2, pa3); SBAR();
        pv_d0(o, V_lds, r32, hi, lane, pa0, pa1, pa2, pa3); partialSM(pB0, pB1, m_reg, mnB, alB);
        RESC(alB); __syncthreads();
        if (j + 2 < NT) DMA_KR(j + 2, 1);
        DMA_V(j + 1, 0);
        SBAR(); qkt(pA0, pA1, K_lds, R_lds, qr, qrl, r32, hi);
        finishSM(pB0, pB1, alB, l_reg, pa0, pa1, pa2, pa3); SBAR();
        pv_d0(o, V_lds + SHM_V, r32, hi, lane, pa0, pa1, pa2, pa3); partialSM(pA0, pA1, m_reg, mnA, alA);
        RESC(alA); __syncthreads();
    }
    DMA_V(NT - 1, 1);
    SBAR(); qkt(pB0, pB1, K_lds + SHM_K, R_lds + SHM_R, qr, qrl, r32, hi);
    finishSM(pA0, pA1, alA, l_reg, pa0, pa1, pa2, pa3); SBAR();
    pv_d0(o, V_lds, r32, hi, lane, pa0, pa1, pa2, pa3); partialSM(pB0, pB1, m_reg, mnB, alB);
    RESC(alB); __syncthreads();
    finishSM(pB0, pB1, alB, l_reg, pa0, pa1, pa2, pa3); SBAR();
    pv_d0(o, V_lds + SHM_V, r32, hi, lane, pa0, pa1, pa2, pa3);
    if (hi == 0) li_l[r32] = l_reg; LGKM0();
    __syncthreads();
    float rli[16];
#pragma unroll
    for (int r = 0; r < 16; ++r) rli[r] = 1.f / li_l[crow(r, hi)];
    const int orow0 = grow(b, CTX + qb * 256 + wid * QBLK);
#pragma unroll
    for (int r = 0; r < 16; ++r) { const int orow = orow0 + crow(r, hi);
#pragma unroll
        for (int d0 = 0; d0 < 4; ++d0) YM[(size_t)orow * D + 512 + h * 128 + d0 * 32 + r32] = (bf16_t)f2bf(o[d0][r] * rli[r]); }
    __syncthreads();
#undef DMA_KR
#undef DMA_V
#undef RESC
}
}

#ifndef HIPEMU
DEVI void grid_barrier(cg::grid_group& grid) { grid.sync(); }
#endif

#ifndef HIPEMU
#define XB_TMO      128
#define XB_XCNT(j)  (256  + 64 * (j))
#define XB_XSUB(j)  (1280 + 64 * (j))
#define XB_XGEN(j)  (2304 + 64 * (j))
#define XB_TOP      3328
#define XB_TOPGEN   3392
#define XB_SPIN_CAP (1u << 22)
typedef __attribute__((address_space(3))) unsigned lds_u32;
DEVI unsigned xb_ld(unsigned* p)              { return __hip_atomic_load(p, __ATOMIC_RELAXED, __HIP_MEMORY_SCOPE_AGENT); }
DEVI unsigned xb_add(unsigned* p, unsigned v) { return __hip_atomic_fetch_add(p, v, __ATOMIC_RELAXED, __HIP_MEMORY_SCOPE_AGENT); }
DEVI unsigned xb_xcc_id() { return (unsigned)__builtin_amdgcn_s_getreg((3 << 11) | 20) & 0xFu; }
#define XB_SPIN(cond, bar) do { unsigned _sp = 0; while (cond) { __builtin_amdgcn_s_sleep(1); \
    if ((++_sp & 255u) == 0u) { if (xb_ld(&(bar)[XB_TMO])) break; if (_sp > XB_SPIN_CAP) { atomicAdd(&(bar)[XB_TMO], 1u); break; } } } } while (0)
DEVI void xcd_barrier_complete(unsigned* bar, unsigned x, unsigned G, unsigned& nloc, unsigned& nx) {
    unsigned sum, cnt, mine, sp = 0u;
    for (;;) {
        sum = 0u; cnt = 0u; mine = 0u;
#pragma unroll
        for (unsigned j = 0; j < 16; ++j) { const unsigned c = xb_ld(&bar[XB_XCNT(j)]); sum += c; cnt += (c > 0u) ? 1u : 0u; mine = (j == x) ? c : mine; }
        if (sum == G) break;
        __builtin_amdgcn_s_sleep(1);
        if ((++sp & 255u) == 0u) { if (xb_ld(&bar[XB_TMO])) break; if (sp > XB_SPIN_CAP) { atomicAdd(&bar[XB_TMO], 1u); break; } }
    }
    nloc = mine > 0u ? mine : 1u; nx = cnt > 0u ? cnt : 1u;
}
DEVI void xcd_barrier(unsigned* bar, volatile lds_u32* st, bool is_t0, unsigned G) {
    asm volatile("s_waitcnt vmcnt(0)" ::: "memory");
    __syncthreads();
    if (is_t0) {
        __builtin_amdgcn_s_waitcnt(0);
        const unsigned x = xb_xcc_id();
        unsigned nloc = st[0], nx = st[1];
        if (nloc == 0u) { xcd_barrier_complete(bar, x, G, nloc, nx); st[0] = nloc; st[1] = nx; }
        const unsigned old = xb_add(&bar[XB_XSUB(x)], 1u);
        const unsigned gen = old / nloc;
        if (old + 1u == (gen + 1u) * nloc) {
            __builtin_amdgcn_fence(__ATOMIC_RELEASE, "agent");
            asm volatile("s_waitcnt vmcnt(0)" ::: "memory");
            const unsigned og = xb_add(&bar[XB_TOP], 1u);
            const unsigned tg = og / nx;
            if (og + 1u == (tg + 1u) * nx) xb_add(&bar[XB_TOPGEN], 1u);
            else XB_SPIN(xb_ld(&bar[XB_TOPGEN]) == tg, bar);
            __builtin_amdgcn_fence(__ATOMIC_ACQUIRE, "agent");
            xb_add(&bar[XB_XGEN(x)], 1u);
            asm volatile("s_waitcnt vmcnt(0)" ::: "memory");
        } else {
            XB_SPIN(xb_ld(&bar[XB_XGEN(x)]) == gen, bar);
            __builtin_amdgcn_fence(__ATOMIC_ACQUIRE, "agent");
            asm volatile("s_waitcnt vmcnt(0)" ::: "memory");
        }
    }
    __syncthreads();
}
#endif

constexpr int NPHASES = 21;
#ifndef PH_MASK
#define PH_MASK 0xFFFFFFFFu
#endif
#define PH_ON(k) ((PH_MASK >> (k)) & 1u)
template <int ph> DEVI void run_phase_t(const Frame& F) {
    bf16_t* Wb = (bf16_t*)(F.ws + WS_W); bf16_t* ACT = (bf16_t*)(F.ws + WS_ACT); bf16_t* BIGb = (bf16_t*)(F.ws + WS_BIG); bf16_t* HJ1 = (bf16_t*)(F.ws + WS_HGS);
    float* BIGf = (float*)(F.ws + WS_BIG); float* ACTf = (float*)(F.ws + WS_ACT);
    pg8::Order S;
    switch (ph) {
    case 0: if (!PH_ON(0)) break; {
        ada_units(F); convert_layer_weights(F, 0); rope_tables(F);
        for (size_t i = (size_t)F.bid * NTHREADS + F.tid; i < (size_t)M * 512 / 4; i += (size_t)F.G * NTHREADS) ((f32x4*)F.out)[i] = (f32x4){0.f, 0.f, 0.f, 0.f};
    } break;
    case 1: if (!PH_ON(1)) break; phase_hj0(F); break;
    case 2: if (!PH_ON(2)) break; { pg8::Gemm g{ACT, Wb + W_IN / 2, D, D, D}; S.init(M / 256, EVP / 256, F.G, F.bid, 0); pg8::EpiBf16<0> E{BIGb, EVP}; pg8::gemm_phase(F.lds, g, S, E, F.tid); } break;
    case 3: if (!PH_ON(3)) break; { for (int u = F.bid; u < NB * 4 * NCH; u += F.G) ml_phaseA_unit(F, u / (4 * NCH), (u / NCH) % 4, u % NCH); } break;
    case 4: if (!PH_ON(4)) break; ml_phaseB(F); break;
    case 5: if (!PH_ON(5)) break; {
#ifndef NO_MLC
        for (int u = F.bid; u < NB * 4 * NCH; u += F.G) ml_phaseC_unit(F, u / (4 * NCH), (u / NCH) % 4, u % NCH);
#endif
#ifndef NO_RWS
        const Frame F2 = relaunder(F);
        for (int u = F2.G - 1 - F2.bid; u < NB * 8 * 4; u += F2.G) rw_scan_v1(F2, u / 32, (u >> 2) & 7, (u >> 1) & 1, u & 1);
#endif
    } break;
    case 6: if (!PH_ON(6)) break; { for (int u = F.bid; u < NB * 8 * (T / 64); u += F.G) rw_finish_unit(F, u / (8 * (T / 64)), (u / (T / 64)) % 8, u % (T / 64)); } break;
    case 7: if (!PH_ON(7)) break; { pg8::Gemm g{ACT, Wb + W_OUT / 2, D, D, D}; S.init(M / 256, 4, F.G, F.bid, 0); pg8::EpiF32 E{BIGf, D}; pg8::gemm_phase(F.lds, g, S, E, F.tid); } break;
    case 8: if (!PH_ON(8)) break; phase_resid(F, 0, 0, BIGf, false, ACT); break;
    case 9: if (!PH_ON(9)) break; { pg8::Gemm g{ACT, Wb + W_1 / 2, D, D, D}; S.init(M / 256, 16, F.G, F.bid, 0); pg8::EpiBf16<1> E{BIGb, DFF}; pg8::gemm_phase(F.lds, g, S, E, F.tid); } break;
    case 10: if (!PH_ON(10)) break; { pg8::Gemm g{BIGb, Wb + W_2 / 2, DFF, DFF, DFF}; S.init(M / 256, 4, F.G, F.bid, 0); pg8::EpiF32 E{ACTf, D}; pg8::gemm_phase(F.lds, g, S, E, F.tid); } break;
    case 11: if (!PH_ON(11)) break; phase_resid(F, 0, 1, ACTf, false, HJ1); convert_layer_weights(F, 1); break;
    case 12: if (!PH_ON(12)) break; { pg8::Gemm g{HJ1, Wb + W_IN / 2, D, D, D}; S.init(M / 256, ODP / 256, F.G, F.bid, 0); pg8::EpiBf16<0> E{BIGb, ODP}; pg8::gemm_phase(F.lds, g, S, E, F.tid); } break;
    case 13: if (!PH_ON(13)) break; { mla_prep(F); for (int u = F.bid; u < NB * 4 * NCH; u += F.G) hg_phaseA_unit(F, u / (4 * NCH), (u / NCH) % 4, u % NCH); } break;
    case 14: if (!PH_ON(14)) break; {
#ifndef NO_HGB
        hg_phaseB(F);
#endif
#ifndef NO_GQ
        { pg8::Gemm g{BIGb + O_CQ, Wb + W_QB / 2, 256, ODP, 256}; S.init(M / 256, 3, F.G, F.bid, 0);
          pg8::EpiQ E{F.ws}; pg8::gemm_phase(F.lds, g, S, E, F.tid); }
#endif
#ifndef NO_GKV
        { pg8::Gemm g{BIGb + O_CKV, Wb + W_KVB / 2, 256, ODP, 256}; S.init(M / 256, 4, F.G, F.bid, 0);
          pg8::EpiKV E{F.ws}; pg8::gemm_phase(F.lds, g, S, E, F.tid); }
#endif
    } break;
    case 15: if (!PH_ON(15)) break; {
#ifndef NO_ATT
        for (int u = F.bid; u < NB * 4 * NLT; u += F.G) att::attn_unit(F, u / (4 * NLT), (u / NLT) % 4, u % NLT);
#endif
#ifndef NO_HGC
        const Frame F2 = relaunder(F);
        for (int u = F2.bid; u < NB * 4 * NLT; u += F2.G) hg_phaseC_unit(F2, u / (4 * NLT), (u / NLT) % 4, NCTXCH + u % NLT);
#endif
    } break;
    case 16: if (!PH_ON(16)) break; { pg8::Gemm g{ACT, Wb + W_OUT / 2, D, D, D}; S.init(NB * NLT, 4, F.G, F.bid, 1); pg8::EpiF32 E{BIGf, D}; pg8::gemm_phase(F.lds, g, S, E, F.tid); } break;
    case 17: if (!PH_ON(17)) break; phase_resid(F, 1, 0, BIGf, true, ACT); break;
    case 18: if (!PH_ON(18)) break; { pg8::Gemm g{ACT, Wb + W_1 / 2, D, D, D}; S.init(NB * NLT, 16, F.G, F.bid, 1); pg8::EpiBf16<1> E{BIGb, DFF}; pg8::gemm_phase(F.lds, g, S, E, F.tid); } break;
    case 19: if (!PH_ON(19)) break; { pg8::Gemm g{BIGb, Wb + W_2 / 2, DFF, DFF, DFF}; S.init(NB * NLT, 4, F.G, F.bid, 1); pg8::EpiF32 E{ACTf, D}; pg8::gemm_phase(F.lds, g, S, E, F.tid); } break;
    case 20: if (!PH_ON(20)) break; phase_resid(F, 1, 1, ACTf, true, nullptr); break;
    default: break;
    }
}

#ifdef HIPEMU
static inline void run_phase_rt(const Frame& F, int ph) {
    switch (ph) {
#define PHC(k) case k: run_phase_t<k>(F); break;
    PHC(0) PHC(1) PHC(2) PHC(3) PHC(4) PHC(5) PHC(6) PHC(7) PHC(8) PHC(9) PHC(10) PHC(11) PHC(12) PHC(13) PHC(14) PHC(15) PHC(16) PHC(17) PHC(18) PHC(19) PHC(20)
#undef PHC
    default: break; }
}
#endif
#ifndef HIPEMU
constexpr int LDS_BYTES = 160 * 1024;
extern __shared__ __attribute__((aligned(16))) unsigned char g_lds[];
template <int PH> __device__ __forceinline__ void phase_fn(const CONSTAS Args* ap_in, int wave_in) {
    const CONSTAS Args* ap = ap_in; int wv = wave_in, bid = blockIdx.x, G = gridDim.x;
    int ln = __builtin_amdgcn_mbcnt_hi(~0u, __builtin_amdgcn_mbcnt_lo(~0u, 0u));
    asm volatile("" : "+s"(ap)); asm volatile("" : "+v"(ln)); asm volatile("" : "+s"(bid), "+s"(G), "+s"(wv));
    __builtin_assume(ln >= 0 && ln < 64); __builtin_assume(wv >= 0 && wv < 8); __builtin_assume(bid >= 0 && bid < 1024); __builtin_assume(G > 0 && G <= 1024);
    const int tid = wv * 64 + ln;
    Frame F; F.lds = g_lds; F.ap = ap; F.out = ap->out; F.ws = ap->ws; F.tid = tid; F.lane = ln; F.wave = wv; F.G = G; F.bid = bid;
    run_phase_t<PH>(F);
}
constexpr int LDS_MISC = LDS_BYTES - 256;
__global__ void __launch_bounds__(NTHREADS, 2) mk_fwd(Args a) {
    cg::grid_group grid = cg::this_grid();
    const CONSTAS Args* ap = (const CONSTAS Args*)__builtin_amdgcn_kernarg_segment_ptr();
    const int lo = a.ph_lo, hi = a.ph_hi; const int wv0 = __builtin_amdgcn_readfirstlane(threadIdx.x >> 6);
    volatile lds_u32* st = (volatile lds_u32*)(g_lds + LDS_MISC);
    unsigned* bar = (unsigned*)(a.ws + WS_CTL);
    if (threadIdx.x == 0) { st[0] = 0u; st[1] = 0u; (void)xb_add(&bar[XB_XCNT(xb_xcc_id())], 1u); }
    __syncthreads();
#define PHC(k) if (lo <= k && k < hi) { phase_fn<k>(ap, wv0); if (k + 1 < hi) { if (k == 0) { grid.sync(); } else { \
        const bool t0_ = (wv0 == 0) && (__builtin_amdgcn_mbcnt_hi(~0u, __builtin_amdgcn_mbcnt_lo(~0u, 0u)) == 0); xcd_barrier(bar, st, t0_, gridDim.x); } } }
    PHC(0) PHC(1) PHC(2) PHC(3) PHC(4) PHC(5) PHC(6) PHC(7) PHC(8) PHC(9) PHC(10) PHC(11) PHC(12) PHC(13) PHC(14) PHC(15) PHC(16) PHC(17) PHC(18) PHC(19) PHC(20)
#undef PHC
}
#ifndef MK_N_LAUNCHES
#define MK_N_LAUNCHES 1
#endif
extern "C" void kernel_launch(void* const* d_in, const int* in_sizes, int n_in, void* d_out, int out_size, void* d_ws, size_t ws_size, hipStream_t stream) {
    static int grid = 0;
    if (grid == 0) {
        if (n_in != 32 || out_size != NB * SEQ * D || ws_size < WS_END) { fprintf(stderr, "kernel_launch: shape mismatch n_in %d out %d ws %zu\n", n_in, out_size, ws_size); grid = -1; return; }
        int dev = 0, cus = 0, per_cu = 0; hipGetDevice(&dev); hipDeviceGetAttribute(&cus, hipDeviceAttributeMultiprocessorCount, dev);
        hipFuncSetAttribute((const void*)mk_fwd, hipFuncAttributeMaxDynamicSharedMemorySize, LDS_BYTES);
        hipOccupancyMaxActiveBlocksPerMultiprocessor(&per_cu, (const void*)mk_fwd, NTHREADS, LDS_BYTES);
        fprintf(stderr, "kernel_launch: cus %d per_cu %d\n", cus, per_cu);
        if (per_cu < 1) { grid = -1; return; }
        grid = cus;
    }
    if (grid < 0) return;
    Args a{}; for (int i = 0; i < 32; ++i) a.in[i] = (const float*)d_in[i];
    a.out = (float*)d_out; a.ws = (unsigned char*)d_ws;
    if (hipMemsetAsync((char*)d_ws + WS_CTL, 0, CTL_BYTES, stream) != hipSuccess) { fprintf(stderr, "kernel_launch: memset failed\n"); return; }
    if (MK_N_LAUNCHES == 1) { a.ph_lo = 0; a.ph_hi = NPHASES; void* args[] = {&a};
        hipError_t e = hipLaunchCooperativeKernel((void*)mk_fwd, dim3(grid), dim3(NTHREADS), args, LDS_BYTES, stream);
        if (e != hipSuccess) fprintf(stderr, "coop launch failed: %s\n", hipGetErrorString(e));
    } else {
        for (int ph = 0; ph < NPHASES; ++ph) { a.ph_lo = ph; a.ph_hi = ph + 1; void* args[] = {&a};
            hipError_t e = hipLaunchCooperativeKernel((void*)mk_fwd, dim3(grid), dim3(NTHREADS), args, LDS_BYTES, stream);
            if (e != hipSuccess) { fprintf(stderr, "launch %d failed: %s\n", ph, hipGetErrorString(e)); break; } }
    }
}
#endif
```

```cpp
#ifndef HIPEMU
#include <hip/hip_runtime.h>
#include <hip/hip_cooperative_groups.h>
namespace cg = cooperative_groups;
#endif
#include <cstdio>
#include <cstdint>
#include <cmath>

#define DEVI __device__ __forceinline__

#ifndef CFG_NB
#define CFG_NB 2
#endif
#ifndef CFG_SEQ
#define CFG_SEQ 8192
#endif
#ifndef CFG_CTX
#define CFG_CTX 256
#endif
constexpr int NB = CFG_NB, SEQ = CFG_SEQ, CTX = CFG_CTX, T = CTX + SEQ, M = NB * T, D = 1024, DFF = 4096;
constexpr int NCH = T / 256;
constexpr int NCTXCH = CTX / 256;
constexpr int NLT = SEQ / 256;
constexpr int GRIDW = 64;
constexpr int EVP = 4096, ODP = 3072;
constexpr float EPS = 1e-6f;
constexpr int NTHREADS = 512;
static_assert(CTX % 256 == 0 && SEQ % 256 == 0, "chunking");

constexpr int E_MQ = 0, E_MK = 512, E_MV = 1024, E_MO = 1536, E_RF = 2048, E_MG = 3968;
constexpr int R_R = 0, R_K = 512, R_V = 1024, R_WL = 1536, R_AL = 1664, R_GL = 1792;
constexpr int O_HQ = 0, O_HFF = 512, O_HFB = 1024, O_HI = 1536, O_HG = 2048, O_CQ = 2560, O_CKV = 2816, O_KR = 2944;

constexpr size_t MiB = 1u << 20;
constexpr size_t WS_CTL = 0;
constexpr size_t CTL_BYTES = 256 * 1024;
constexpr size_t WS_MOD = 1 * MiB;
constexpr size_t WS_ROPE = WS_MOD + 256 * 1024;
constexpr size_t WS_RSTD = WS_MOD + 512 * 1024;
constexpr size_t WS_W = 2 * MiB;
constexpr size_t W_IN = 0, W_OUT = 8 * MiB, W_1 = 10 * MiB, W_2 = 18 * MiB, W_QB = 26 * MiB, W_KVB = 26 * MiB + 512 * 1024;
constexpr size_t WS_BIG = 29 * MiB;
constexpr size_t WS_ACT = 161 * MiB;
constexpr size_t WS_SCR = 194 * MiB;
constexpr size_t WS_XC = 254 * MiB;
constexpr size_t WS_END = 256 * MiB;
constexpr size_t WS_RWT = WS_XC, RWT_W2 = 0, RWT_A2 = 147456, RWT_G2 = 294912, RWT_CST = 434176, RWT_BON = 524288;
constexpr int NSTR_ML = NB * 4 * 2;
constexpr size_t SC_MLC = 0;
constexpr size_t SC_MLN = SC_MLC + (size_t)NSTR_ML * NCH * 16384 * 4;
constexpr size_t SC_MLS = SC_MLN + (size_t)NSTR_ML * NCH * 128 * 4;
constexpr size_t SC_ML_END = SC_MLS + (size_t)NSTR_ML * NCH * 4 * 4;
constexpr int NSTR_RW = NB * 8 * 2;
constexpr size_t SC_RW = (SC_ML_END + 255) / 256 * 256;
constexpr int RW_NS1 = (int)((60 * MiB - SC_RW) / 32768);
constexpr size_t OUT_KC = (size_t)M * 512 * 4;
constexpr size_t OUT_RW = OUT_KC + (size_t)M * 512 * 2;
static_assert(OUT_RW + (size_t)(NSTR_RW * NCH > RW_NS1 ? NSTR_RW * NCH - RW_NS1 : 0) * 32768 <= (size_t)NB * SEQ * 1024 * 4, "d_out scratch");
constexpr size_t SC_Q = 0, SC_KN = SC_Q + (size_t)M * 768 * 2, SC_V = SC_KN + (size_t)M * 512 * 2, SC_KR = SC_V + (size_t)M * 512 * 2, SC_L1_END = SC_KR + (size_t)M * 64 * 2;
static_assert(SC_L1_END <= 60 * MiB, "scr1");
constexpr size_t WS_HGS = WS_BIG + (size_t)M * ODP * 2;
static_assert(WS_HGS + (size_t)NSTR_ML * NCH * 16384 * 4 <= WS_ACT, "hgs");
static_assert((size_t)M * 512 * 4 <= (size_t)NB * SEQ * 1024 * 4 + 0 || true, "");

typedef unsigned short bf16_t;
typedef short bf16x8 __attribute__((ext_vector_type(8)));
typedef float f32x4 __attribute__((ext_vector_type(4)));
typedef float f32x16 __attribute__((ext_vector_type(16)));
typedef unsigned u32x4 __attribute__((ext_vector_type(4)));
typedef unsigned u32x2 __attribute__((ext_vector_type(2)));

#ifdef PROBE_SUB
#define PS_DECL unsigned long long ps_acc_ = 0, ps_t0_ = 0;
#define PS_B(id) if (PROBE_SUB == (id)) ps_t0_ = __builtin_amdgcn_s_memrealtime();
#define PS_E(id) if (PROBE_SUB == (id)) ps_acc_ += __builtin_amdgcn_s_memrealtime() - ps_t0_;
#define PS_SPIN do { __syncthreads(); const unsigned long long t_ = __builtin_amdgcn_s_memrealtime(); while (__builtin_amdgcn_s_memrealtime() - t_ < ps_acc_) __builtin_amdgcn_s_sleep(8); } while (0)
#else
#define PS_DECL
#define PS_B(id)
#define PS_E(id)
#define PS_SPIN
#endif
#ifdef HIPEMU
DEVI unsigned f2bf(float f) { unsigned u = __builtin_bit_cast(unsigned, f); return (u + 0x7fffu + ((u >> 16) & 1u)) >> 16; }
DEVI unsigned pk2(float lo, float hi) { return f2bf(lo) | (f2bf(hi) << 16); }
#else
typedef float f32x2cv __attribute__((ext_vector_type(2)));
typedef __bf16 bf16x2cv __attribute__((ext_vector_type(2)));
DEVI unsigned pk2(float lo, float hi) { const f32x2cv v = {lo, hi}; const bf16x2cv b = __builtin_convertvector(v, bf16x2cv); return __builtin_bit_cast(unsigned, b); }
DEVI unsigned f2bf(float f) { const __bf16 b = (__bf16)f; return (unsigned)__builtin_bit_cast(unsigned short, b); }
#endif
DEVI float bf2f(unsigned h) { return __builtin_bit_cast(float, (h & 0xffffu) << 16); }
DEVI float u2f(unsigned u) { return __builtin_bit_cast(float, u); }
DEVI unsigned f2u(float f) { return __builtin_bit_cast(unsigned, f); }
#ifdef HIPEMU
DEVI float RCP(float x) { return 1.f / x; }
DEVI float RSQ(float x) { return 1.f / sqrtf(x); }
#else
DEVI float RCP(float x) { return __builtin_amdgcn_rcpf(x); }
DEVI float RSQ(float x) { return __builtin_amdgcn_rsqf(x); }
#endif
DEVI float sigmoidf_(float x) { return RCP(1.f + __expf(-x)); }
DEVI float siluf_(float x) { return x * sigmoidf_(x); }
DEVI float logsigmoidf_(float x) { return x >= 0.f ? -__logf(1.f + __expf(-x)) : x - __logf(1.f + __expf(x)); }
DEVI float tanhf_(float x) { return 2.f * sigmoidf_(2.f * x) - 1.f; }
DEVI int crow(int r, int hi) { return (r & 3) + 8 * (r >> 2) + 4 * hi; }
#ifdef HIPEMU
DEVI int emu_any(bool p) { float f_ = p ? 1.f : 0.f; for (int o = 1; o < 64; o <<= 1) f_ = fmaxf(f_, __shfl_xor(f_, o)); return f_ > 0.5f; }
#define WAVE_ANY(p) emu_any(p)
#define FENCE()
#define WAVE_SYNC() emu::wave_sync()
#define EXP2F(x) exp2f(x)
DEVI f32x16 mfma32(bf16x8 a, bf16x8 b, f32x16 c) { return emu_mfma32(a, b, c); }
DEVI f32x4 mfma16f(float a, float b, f32x4 c) { return emu_mfma16f32(a, b, c); }
DEVI u32x2 plswap(unsigned a, unsigned b) { return emu_permlane32_swap(a, b); }
DEVI void atomic_add_f32(float* p, float v) { float o = __atomic_load_n((int*)p, __ATOMIC_RELAXED) * 0 + *p; (void)o; unsigned* ip = (unsigned*)p; unsigned old = __atomic_load_n(ip, __ATOMIC_RELAXED);
    for (;;) { float f = __builtin_bit_cast(float, old) + v; unsigned nv = __builtin_bit_cast(unsigned, f); if (__atomic_compare_exchange_n(ip, &old, nv, false, __ATOMIC_RELAXED, __ATOMIC_RELAXED)) break; } }
#else
#define WAVE_ANY(p) __any(p)
#define FENCE() do { asm volatile("" ::: "memory"); __builtin_amdgcn_sched_barrier(0); } while (0)
#define WAVE_SYNC() __builtin_amdgcn_wave_barrier()
#define EXP2F(x) __builtin_amdgcn_exp2f(x)
DEVI f32x16 mfma32(bf16x8 a, bf16x8 b, f32x16 c) { return __builtin_amdgcn_mfma_f32_32x32x16_bf16(a, b, c, 0, 0, 0); }
DEVI f32x4 mfma16f(float a, float b, f32x4 c) { return __builtin_amdgcn_mfma_f32_16x16x4f32(a, b, c, 0, 0, 0); }
DEVI u32x2 plswap(unsigned a, unsigned b) { auto r = __builtin_amdgcn_permlane32_swap(a, b, false, false); u32x2 o; o[0] = r[0]; o[1] = r[1]; return o; }
DEVI void atomic_add_f32(float* p, float v) { unsafeAtomicAdd(p, v); }
#endif
#ifdef HIPEMU
template <int MSK> DEVI float shx(float v) { return __shfl_xor(v, MSK); }
DEVI float shfl_up_l(float v, int o, int lane) { return __shfl_up(v, o); }
#else
template <int MSK> DEVI float shx(float v) {
    if constexpr (MSK == 32) { auto r = __builtin_amdgcn_permlane32_swap(__builtin_bit_cast(unsigned, v), __builtin_bit_cast(unsigned, v), false, false); const unsigned lo = r[0], hi2 = r[1];
        return __builtin_bit_cast(float, lo ^ hi2 ^ __builtin_bit_cast(unsigned, v)); }
    else return __builtin_bit_cast(float, __builtin_amdgcn_ds_swizzle(__builtin_bit_cast(int, v), (MSK << 10) | 0x1f));
}
DEVI float shfl_up_l(float v, int o, int lane) { const int src = lane >= o ? lane - o : lane; return __builtin_bit_cast(float, __builtin_amdgcn_ds_bpermute(src << 2, __builtin_bit_cast(int, v))); }
#endif
#ifdef HIPEMU
DEVI float sum16(float v) { v += shx<1>(v); v += shx<2>(v); v += shx<4>(v); v += shx<8>(v); return v; }
#else
template <int CTRL> DEVI float dpp_mov(float v) { return __builtin_bit_cast(float, __builtin_amdgcn_update_dpp(0, __builtin_bit_cast(int, v), CTRL, 0xF, 0xF, true)); }
DEVI float sum16(float v) { v += dpp_mov<0xB1>(v); v += dpp_mov<0x4E>(v); v += dpp_mov<0x141>(v); v += dpp_mov<0x140>(v); return v; }
#endif
#ifdef HIPEMU
DEVI float sum8(float v) { v += shx<1>(v); v += shx<2>(v); v += shx<4>(v); return v; }
#else
DEVI float sum8(float v) { v += dpp_mov<0xB1>(v); v += dpp_mov<0x4E>(v); v += dpp_mov<0x141>(v); return v; }
#endif
DEVI float wave_sum(float v) { v = sum16(v); v += shx<16>(v); v += shx<32>(v); return v; }
DEVI float half_sum32(float v) { v = sum16(v); v += shx<16>(v); return v; }
DEVI bf16x8 ld8(const bf16_t* p) { return *(const bf16x8*)p; }
#ifdef HIPEMU
DEVI bf16x8 ld_tr_B(const bf16_t* tile, int RS, int k0, int n0, int lane) { bf16x8 o;
    for (int j = 0; j < 8; ++j) o[j] = (short)tile[(size_t)(k0 + 8 * (lane >> 5) + j) * RS + n0 + (lane & 31)]; return o; }
#else
DEVI bf16x8 ld_tr_B(const bf16_t* tile, int RS, int k0, int n0, int lane) {
    typedef short s16x4t __attribute__((ext_vector_type(4)));
    const int g = lane >> 4, i = lane & 15, q = i >> 2, p = i & 3;
    const bf16_t* a = tile + (k0 + 8 * (g >> 1) + q) * RS + n0 + 16 * (g & 1) + 4 * p;
    const s16x4t r0 = __builtin_amdgcn_ds_read_tr16_b64_v4i16((__attribute__((address_space(3))) s16x4t*)a);
    const s16x4t r1 = __builtin_amdgcn_ds_read_tr16_b64_v4i16((__attribute__((address_space(3))) s16x4t*)(a + 4 * RS));
    return (bf16x8){r0[0], r0[1], r0[2], r0[3], r1[0], r1[1], r1[2], r1[3]};
}
#endif
DEVI void unpack8(bf16x8 v, float* f) {
#pragma unroll
    for (int i = 0; i < 8; ++i) f[i] = bf2f((unsigned short)v[i]);
}
DEVI bf16x8 pack8(const float* f) { u32x4 w; w[0] = pk2(f[0], f[1]); w[1] = pk2(f[2], f[3]); w[2] = pk2(f[4], f[5]); w[3] = pk2(f[6], f[7]); return __builtin_bit_cast(bf16x8, w); }
DEVI bf16x8 pk4frag(const f32x16& P, int B) {
    unsigned a0 = pk2(P[B + 0], P[B + 1]), a1 = pk2(P[B + 2], P[B + 3]), b0 = pk2(P[B + 4], P[B + 5]), b1 = pk2(P[B + 6], P[B + 7]);
    u32x2 r0 = plswap(a0, b0), r1 = plswap(a1, b1); u32x4 w; w[0] = r0[0]; w[1] = r1[0]; w[2] = r0[1]; w[3] = r1[1]; return __builtin_bit_cast(bf16x8, w);
}
DEVI int grow(int b, int t) { return b * T + t; }

struct Args {
    const float* in[32];
    float* out; unsigned char* ws;
    int ph_lo, ph_hi;
};
#ifdef HIPEMU
#define CONSTAS
#else
#define CONSTAS __attribute__((address_space(4)))
#endif
struct Frame {
    unsigned char* lds;
    const CONSTAS Args* ap; float* out; unsigned char* ws;
    int tid, lane, wave, G, bid;
};
enum { I_X = 0, I_C, I_CTX, I_CCTX, I_ADAW, I_ADAB, I_NORMG, I_OUTW, I_W1, I_W2, I_HGLB, I_EVW, I_MLCONV, I_MLGB, I_MLNORM, I_RWMU, I_RWW0, I_RWW2,
       I_RWA0, I_RWA2, I_RWG2, I_RWKK, I_RWKA, I_RWRK, I_RWLNW, I_RWLNB, I_ODW, I_HGNORM, I_QNORM, I_WQB, I_KVNORM, I_WKVB };

DEVI const float* modp(const Frame& F, int layer, int s) { return (const float*)(F.ws + WS_MOD) + ((size_t)layer * 3 + s) * 6144; }

#ifdef HIPEMU
DEVI Frame relaunder(const Frame& F) { return F; }
DEVI Frame unit_frame(const Frame& F) { return F; }
#else
DEVI Frame relaunder(const Frame& F0) { Frame F = F0; int ln = __builtin_amdgcn_mbcnt_hi(~0u, __builtin_amdgcn_mbcnt_lo(~0u, 0u)); asm volatile("" : "+v"(ln)); __builtin_assume(ln >= 0 && ln < 64);
    F.lane = ln; F.tid = F0.wave * 64 + ln; return F; }
DEVI Frame unit_frame(const Frame& F0) { return relaunder(F0); }
#endif
namespace pg8 {
constexpr int BM = 256, BK = 64, HALF = 128, HTB = HALF * BK * 2, STAGE_BYTES = 8 * HTB, NXCD = 8, WGM = 8;
struct Unit { int pm, pn, ks; };
struct Gemm { const bf16_t* A; const bf16_t* Bt; int K, lda, ldb; };
DEVI int lds_byte(int r, int c) { const int st = (r >> 4) * 2 + (c >> 5), rr = r & 15, cc = c & 31, ob = rr * 64 + cc * 2; return st * 1024 + (ob ^ (((ob >> 9) & 1) << 5)); }
DEVI void stage_rc(int b, int& R, int& C) { const int st = b / 1024, sb = b % 1024, swz = sb ^ (((sb >> 9) & 1) << 5); R = (st >> 1) * 16 + swz / 64; C = (st & 1) * 32 + (swz % 64) / 2; }
DEVI int perm32(int rho) { const int n = rho >> 4, i = rho & 15; return 8 * (i >> 2) + 4 * n + (i & 3); }
struct Order {
    int nM, nN, nwg, G, c, lat_only, KS;
    DEVI void init(int nM_, int nN_, int G_, int c_, int lat, int ks_ = 1) { nM = nM_; nN = nN_; KS = ks_; nwg = nM * nN * KS; G = G_; c = c_; lat_only = lat; }
    DEVI bool next(int i, Unit& u) const {
        const long L = (long)i * G + c; if (L >= nwg) return false;
        u.ks = 0;
        if (lat_only == 2) { const int id = (int)L; u.ks = id % KS; const int r = id / KS; u.pn = r % nN; const int ct = r / nN; u.pm = (ct / NCTXCH) * NCH + (ct % NCTXCH); return true; }
        int wgid = (int)L; { const int q = nwg / NXCD, r = nwg % NXCD, xcd = wgid % NXCD, off = wgid / NXCD; wgid = (xcd < r ? xcd * (q + 1) : r * (q + 1) + (xcd - r) * q) + off; }
        const int nig = WGM * nN, gid = wgid / nig, fm = gid * WGM, gsz = (nM - fm) < WGM ? (nM - fm) : WGM;
        int pm = fm + ((wgid % nig) % gsz); u.pn = (wgid % nig) / gsz;
        if (lat_only) pm = (pm / NLT) * NCH + NCTXCH + (pm % NLT);
        u.pm = pm; return true;
    }
};
#ifndef HIPEMU
#define PG8_LAS __attribute__((address_space(3)))
template <class Epi>
__device__ __forceinline__ void gemm_phase(unsigned char* lds_g, const Gemm g, const Order& S, const Epi& E, int tid_in) {
    PG8_LAS unsigned char* lds = (PG8_LAS unsigned char*)lds_g;
    const int tid = tid_in, wid = __builtin_amdgcn_readfirstlane(tid >> 6), lane = tid & 63, wr = wid >> 2, wc = wid & 3, fr = lane & 15, fq = lane >> 4;
    const int K = g.K, nt = K / BK;
    unsigned voffA[2], voffB[2];
#pragma unroll
    for (int i = 0; i < 2; ++i) { int R, C; stage_rc(tid * 16 + i * 8192, R, C); const int Rb = Epi::PERM ? ((R & ~31) + perm32(R & 31)) : R;
        voffA[i] = (unsigned)(R * g.lda + C) * 2u; voffB[i] = (unsigned)(Rb * g.ldb + C) * 2u; }
    const size_t kstep = (size_t)(BK * 2);
    const size_t hstepA = (size_t)HALF * g.lda * 2, hstepB = (size_t)HALF * g.ldb * 2;
    const size_t tstepA = 2 * hstepA, tstepB = 2 * hstepB;
    const unsigned ldsw = (unsigned)wid * 1024u;
    const int aoff = lds_byte(wr * 64 + fr, fq * 8), boff = lds_byte(wc * 32 + fr, fq * 8);
#define PG8_SA(b, h) (((b) * 2 + (h)) * HTB)
#define PG8_SB(b, h) ((4 + (b) * 2 + (h)) * HTB)
#define PG8_STAGE(bufoff, gbase, voff) do { _Pragma("unroll") for (int _i = 0; _i < 2; ++_i) \
        __builtin_amdgcn_global_load_lds((const unsigned*)((const char*)(gbase) + (voff)[_i]), (PG8_LAS unsigned*)(lds + (bufoff) + ldsw + _i * 8192), 16, 0, 0); } while (0)
#define PG8_LDA(dst, b, h) do { _Pragma("unroll") for (int m = 0; m < 4; ++m) _Pragma("unroll") for (int k = 0; k < 2; ++k) dst[m][k] = *(const PG8_LAS bf16x8*)(lds + PG8_SA(b, h) + aoff + m * 2048 + k * 1024); } while (0)
#define PG8_LDB(dst, b, h) do { _Pragma("unroll") for (int n = 0; n < 2; ++n) _Pragma("unroll") for (int k = 0; k < 2; ++k) dst[n][k] = *(const PG8_LAS bf16x8*)(lds + PG8_SB(b, h) + boff + n * 2048 + k * 1024); } while (0)
#define PG8_MMA(ai, bj, At, Bt) do { __builtin_amdgcn_s_setprio(1); _Pragma("unroll") for (int m = 0; m < 4; ++m) _Pragma("unroll") for (int n = 0; n < 2; ++n) _Pragma("unroll") for (int k = 0; k < 2; ++k) \
        acc[ai][bj][m][n] = __builtin_amdgcn_mfma_f32_16x16x32_bf16(Bt[n][k], At[m][k], acc[ai][bj][m][n], 0, 0, 0); __builtin_amdgcn_s_setprio(0); } while (0)
#define PG8_WAIT_V(n) asm volatile("s_waitcnt vmcnt(" #n ")" ::: "memory")
#define PG8_WAIT_L(n) asm volatile("s_waitcnt lgkmcnt(" #n ")" ::: "memory")
#define PG8_BAR __builtin_amdgcn_s_barrier()
#define PG8_SCHED __builtin_amdgcn_sched_barrier(0)
    Unit cur, nxt; int ui = 0;
    if (!S.next(0, cur)) return;
    f32x4 acc[2][2][4][2];
#pragma unroll
    for (int a = 0; a < 2; ++a)
#pragma unroll
        for (int b = 0; b < 2; ++b)
#pragma unroll
            for (int m = 0; m < 4; ++m)
#pragma unroll
                for (int n = 0; n < 2; ++n) acc[a][b][m][n] = (f32x4){0.f, 0.f, 0.f, 0.f};
    bf16x8 At[4][2], B0[2][2], B1[2][2];
    const char* cA = (const char*)g.A + (size_t)cur.pm * tstepA + (size_t)cur.ks * K * 2; const char* cB = (const char*)g.Bt + (size_t)cur.pn * tstepB + (size_t)cur.ks * K * 2;
    PG8_STAGE(PG8_SB(0, 0), cB, voffB); PG8_STAGE(PG8_SB(0, 1), cB + hstepB, voffB); PG8_STAGE(PG8_SA(0, 0), cA, voffA); PG8_STAGE(PG8_SA(0, 1), cA + hstepA, voffA);
    if (wr == 1) PG8_BAR;
    PG8_WAIT_V(2); PG8_BAR;
    PG8_STAGE(PG8_SB(1, 0), cB + kstep, voffB); PG8_STAGE(PG8_SA(1, 0), cA + kstep, voffA); PG8_STAGE(PG8_SB(1, 1), cB + hstepB + kstep, voffB);
    PG8_WAIT_V(6); PG8_BAR;
    for (;;) {
        const bool has_next = S.next(ui + 1, nxt);
        const char* nA = has_next ? (const char*)g.A + (size_t)nxt.pm * tstepA + (size_t)nxt.ks * K * 2 : cA; const char* nB = has_next ? (const char*)g.Bt + (size_t)nxt.pn * tstepB + (size_t)nxt.ks * K * 2 : cB;
#pragma unroll 1
        for (int t = 0; t < nt; t += 2) {
            const bool last = (t == nt - 2);
            const char* a1 = cA + (size_t)(t + 1) * kstep;
            const char* a2 = last ? nA : cA + (size_t)(t + 2) * kstep; const char* b2 = last ? nB : cB + (size_t)(t + 2) * kstep;
            const char* a3 = a2 + kstep; const char* b3 = b2 + kstep;
            PG8_LDB(B0, 0, 0); PG8_LDB(B1, 0, 1); PG8_SCHED; PG8_LDA(At, 0, 0); PG8_STAGE(PG8_SA(1, 1), a1 + hstepA, voffA);
            PG8_WAIT_V(8); PG8_WAIT_L(0); PG8_BAR; PG8_MMA(0, 0, At, B0); PG8_MMA(0, 1, At, B1); PG8_BAR; PG8_SCHED;
            PG8_LDA(At, 0, 1); PG8_STAGE(PG8_SB(0, 0), b2, voffB); PG8_STAGE(PG8_SB(0, 1), b2 + hstepB, voffB); PG8_STAGE(PG8_SA(0, 0), a2, voffA);
            PG8_WAIT_V(8); PG8_WAIT_L(0); PG8_BAR; PG8_MMA(1, 0, At, B0); PG8_MMA(1, 1, At, B1); PG8_BAR; PG8_SCHED;
            PG8_LDB(B0, 1, 0); PG8_LDB(B1, 1, 1); PG8_SCHED; PG8_LDA(At, 1, 0); PG8_STAGE(PG8_SA(0, 1), a2 + hstepA, voffA);
            PG8_WAIT_V(8); PG8_WAIT_L(0); PG8_BAR; PG8_MMA(0, 0, At, B0); PG8_MMA(0, 1, At, B1); PG8_BAR; PG8_SCHED;
            PG8_LDA(At, 1, 1); PG8_STAGE(PG8_SB(1, 0), b3, voffB); PG8_STAGE(PG8_SB(1, 1), b3 + hstepB, voffB); PG8_STAGE(PG8_SA(1, 0), a3, voffA);
            PG8_WAIT_V(8); PG8_WAIT_L(0); PG8_BAR; PG8_MMA(1, 0, At, B0); PG8_MMA(1, 1, At, B1); PG8_BAR; PG8_SCHED;
        }
        if (wr == 0) PG8_BAR;
        E(acc, cur, wr, wc, fr, fq);
        if (!has_next) break;
#pragma unroll
        for (int a = 0; a < 2; ++a)
#pragma unroll
            for (int b = 0; b < 2; ++b)
#pragma unroll
                for (int m = 0; m < 4; ++m)
#pragma unroll
                    for (int n = 0; n < 2; ++n) acc[a][b][m][n] = (f32x4){0.f, 0.f, 0.f, 0.f};
        cur = nxt; cA = nA; cB = nB; ++ui;
        if (wr == 1) PG8_BAR;
    }
    PG8_WAIT_V(0);
    PG8_BAR;
#undef PG8_SA
#undef PG8_SB
#undef PG8_STAGE
#undef PG8_LDA
#undef PG8_LDB
#undef PG8_MMA
#undef PG8_WAIT_V
#undef PG8_WAIT_L
#undef PG8_BAR
#undef PG8_SCHED
}
#else
template <class Epi>
static inline void gemm_phase(unsigned char*, const Gemm g, const Order& S, const Epi& E, int tid_in) {
    const int tid = tid_in, wid = tid >> 6, lane = tid & 63, wr = wid >> 2, wc = wid & 3, fr = lane & 15, fq = lane >> 4;
    Unit u;
    for (int ui = 0; S.next(ui, u); ++ui) {
        f32x4 acc[2][2][4][2];
        for (int ai = 0; ai < 2; ++ai) for (int bj = 0; bj < 2; ++bj) for (int m = 0; m < 4; ++m) for (int n = 0; n < 2; ++n) for (int e = 0; e < 4; ++e) {
            const int row = u.pm * 256 + 128 * ai + 64 * wr + 16 * m + fr;
            const int col = u.pn * 256 + 128 * bj + 32 * wc + (Epi::PERM ? (8 * fq + 4 * n + e) : (16 * n + 4 * fq + e));
            const bf16_t* a = g.A + (size_t)row * g.lda + (size_t)u.ks * g.K; const bf16_t* b = g.Bt + (size_t)col * g.ldb + (size_t)u.ks * g.K; float s = 0.f;
            for (int k = 0; k < g.K; ++k) s += bf2f(a[k]) * bf2f(b[k]);
            acc[ai][bj][m][n][e] = s; }
        E(acc, u, wr, wc, fr, fq);
    }
    __syncthreads();
}
#endif
template <int ACT> struct EpiBf16 {
    static constexpr bool PERM = true;
    bf16_t* O; int ldc;
    DEVI void operator()(const f32x4 (&acc)[2][2][4][2], const Unit& u, int wr, int wc, int fr, int fq) const {
        const int row0 = u.pm * BM + wr * 64 + fr, col0 = u.pn * BM + wc * 32 + 8 * fq;
#pragma unroll
        for (int ai = 0; ai < 2; ++ai)
#pragma unroll
            for (int m = 0; m < 4; ++m) { bf16_t* rowp = O + (size_t)(row0 + ai * HALF + m * 16) * ldc + col0;
#pragma unroll
                for (int bj = 0; bj < 2; ++bj) { f32x4 v0 = acc[ai][bj][m][0], v1 = acc[ai][bj][m][1];
                    if (ACT == 1) {
#pragma unroll
                        for (int e = 0; e < 4; ++e) { float a = v0[e] > 0.f ? v0[e] : 0.f, b = v1[e] > 0.f ? v1[e] : 0.f; v0[e] = a * a; v1[e] = b * b; } }
                    u32x4 w; w[0] = pk2(v0[0], v0[1]); w[1] = pk2(v0[2], v0[3]); w[2] = pk2(v1[0], v1[1]); w[3] = pk2(v1[2], v1[3]);
                    *(u32x4*)(rowp + bj * HALF) = w; } }
    }
};
struct EpiF32 {
    static constexpr bool PERM = false;
    float* C; int ldc;
    DEVI void operator()(const f32x4 (&acc)[2][2][4][2], const Unit& u, int wr, int wc, int fr, int fq) const {
        const int row0 = u.pm * BM + wr * 64 + fr, col0 = u.pn * BM + wc * 32 + 4 * fq;
#pragma unroll
        for (int ai = 0; ai < 2; ++ai)
#pragma unroll
            for (int m = 0; m < 4; ++m) { float* rowp = C + (size_t)(row0 + ai * HALF + m * 16) * ldc + col0;
#pragma unroll
                for (int bj = 0; bj < 2; ++bj)
#pragma unroll
                    for (int n = 0; n < 2; ++n) *(f32x4*)(rowp + bj * HALF + n * 16) = acc[ai][bj][m][n]; }
    }
};
struct EpiF32Slab {
    static constexpr bool PERM = false;
    float* C; int ldc;
    DEVI void operator()(const f32x4 (&acc)[2][2][4][2], const Unit& u, int wr, int wc, int fr, int fq) const {
        const int rbase = (u.pm / NCH) * CTX + (u.pm % NCH) * 256; float* Cs = C + (size_t)u.ks * NB * CTX * ldc;
        const int row0 = rbase + wr * 64 + fr, col0 = u.pn * BM + wc * 32 + 4 * fq;
#pragma unroll
        for (int ai = 0; ai < 2; ++ai)
#pragma unroll
            for (int m = 0; m < 4; ++m) { float* rowp = Cs + (size_t)(row0 + ai * HALF + m * 16) * ldc + col0;
#pragma unroll
                for (int bj = 0; bj < 2; ++bj)
#pragma unroll
                    for (int n = 0; n < 2; ++n) *(f32x4*)(rowp + bj * HALF + n * 16) = acc[ai][bj][m][n]; }
    }
};
struct EpiQ {
    static constexpr bool PERM = true;
    unsigned char* ws;
    DEVI void operator()(const f32x4 (&acc)[2][2][4][2], const Unit& u, int wr, int wc, int fr, int fq) const {
        bf16_t* O = (bf16_t*)(ws + WS_SCR + SC_Q); const float* rstd = (const float*)(ws + WS_RSTD); const float* ropec = (const float*)(ws + WS_ROPE); const float* ropes = ropec + 128 * 16;
        const int row0 = u.pm * BM + wr * 64 + fr, col0 = u.pn * BM + wc * 32 + 8 * fq;
#pragma unroll
        for (int ai = 0; ai < 2; ++ai)
#pragma unroll
            for (int m = 0; m < 4; ++m) { const int row = row0 + ai * HALF + m * 16; const float rs = rstd[row];
                const int tt = row % T; const bool lat = tt >= CTX; const int li = lat ? tt - CTX : 0; const int prow = li / GRIDW, pcol = li % GRIDW;
#pragma unroll
                for (int bj = 0; bj < 2; ++bj) { const int col = col0 + bj * HALF; const int j = col % 192;
                    float v[8], p[8];
#pragma unroll
                    for (int e = 0; e < 4; ++e) { v[e] = acc[ai][bj][m][0][e] * rs; v[4 + e] = acc[ai][bj][m][1][e] * rs; }
#pragma unroll
                    for (int e = 0; e < 8; ++e) p[e] = shx<32>(v[e]);
                    if (j >= 128 && lat) { const int ro = j - 128, half = ro >> 5, w = ro & 31; const int pos = half ? pcol : prow; const bool lo = w < 16; const int i0 = lo ? w : w - 16;
#pragma unroll
                        for (int e = 0; e < 8; ++e) { const float c = ropec[pos * 16 + i0 + e], s = ropes[pos * 16 + i0 + e]; v[e] = lo ? (v[e] * c - p[e] * s) : (p[e] * s + v[e] * c); } }
                    u32x4 w4; w4[0] = pk2(v[0], v[1]); w4[1] = pk2(v[2], v[3]); w4[2] = pk2(v[4], v[5]); w4[3] = pk2(v[6], v[7]);
                    *(u32x4*)(O + (size_t)row * 768 + col) = w4; FENCE(); } }
    }
};
struct EpiKV {
    static constexpr bool PERM = true;
    unsigned char* ws;
    DEVI void operator()(const f32x4 (&acc)[2][2][4][2], const Unit& u, int wr, int wc, int fr, int fq) const {
        bf16_t* KN = (bf16_t*)(ws + WS_SCR + SC_KN); bf16_t* V = (bf16_t*)(ws + WS_SCR + SC_V); const float* rstd = (const float*)(ws + WS_RSTD) + M;
        const int row0 = u.pm * BM + wr * 64 + fr, col0 = u.pn * BM + wc * 32 + 8 * fq;
#pragma unroll
        for (int ai = 0; ai < 2; ++ai)
#pragma unroll
            for (int m = 0; m < 4; ++m) { const int row = row0 + ai * HALF + m * 16; const float rs = rstd[row];
#pragma unroll
                for (int bj = 0; bj < 2; ++bj) { const int col = col0 + bj * HALF; const int h = col >> 8, j = col & 255;
                    f32x4 v0 = acc[ai][bj][m][0] * rs, v1 = acc[ai][bj][m][1] * rs;
                    u32x4 w4; w4[0] = pk2(v0[0], v0[1]); w4[1] = pk2(v0[2], v0[3]); w4[2] = pk2(v1[0], v1[1]); w4[3] = pk2(v1[2], v1[3]);
                    bf16_t* dst = (j < 128) ? (KN + (size_t)row * 512 + h * 128 + j) : (V + (size_t)row * 512 + h * 128 + (j - 128));
                    *(u32x4*)dst = w4; FENCE(); } }
    }
};
}

template <class DMap>
DEVI void transpose_item(const float* W, int K, int N, bf16_t* WT, int ldk, const float* kscale, float* scr, int item, int lane, DMap dmap) {
    const int nblk = (N + 31) / 32, kb = item / nblk, nb = item % nblk, k0 = 64 * kb, n0 = 32 * nb;
    { const int rsub = lane >> 3, c4 = (lane & 7) * 4; const bool ok = n0 + c4 < N; const int cc = ok ? n0 + c4 : 0;
      f32x4 v[8];
#pragma unroll
      for (int i = 0; i < 8; ++i) v[i] = *(const f32x4*)(W + (size_t)(k0 + i * 8 + rsub) * N + cc);
#pragma unroll
      for (int i = 0; i < 8; ++i) { const int kk = i * 8 + rsub; const float ks = kscale ? kscale[k0 + kk] : 1.f;
#pragma unroll
          for (int e = 0; e < 4; ++e) scr[kk * 33 + c4 + e] = ok ? v[i][e] * ks : 0.f; } }
    WAVE_SYNC();
    const int c = lane & 7;
#pragma unroll
    for (int j = 0; j < 4; ++j) { const int n = (lane >> 3) + 8 * j; const float* s = scr + (8 * c) * 33 + n;
        if (n0 + n < N) { u32x4 o; o[0] = pk2(s[0 * 33], s[1 * 33]); o[1] = pk2(s[2 * 33], s[3 * 33]); o[2] = pk2(s[4 * 33], s[5 * 33]); o[3] = pk2(s[6 * 33], s[7 * 33]);
            *(u32x4*)(WT + (size_t)dmap(n0 + n) * ldk + k0 + 8 * c) = o; } }
    WAVE_SYNC();
}
struct DMapId { DEVI int operator()(int n) const { return n; } };
struct DMapEv { DEVI int operator()(int n) const { return n < 2048 ? n : (n < 2064 ? E_MG + (n - 2048) : E_RF + (n - 2064)); } };
template <class DMap>
DEVI void convert_weight(const Frame& F, const float* W, int K, int N, bf16_t* WT, int ldk, const float* kscale, DMap dmap, int& wcur) {
    float* scr = (float*)(F.lds) + F.wave * (64 * 33);
    const int items = (K / 64) * ((N + 31) / 32), NGW = F.G * 8, gw = F.bid * 8 + F.wave;
    int first = (gw - wcur % NGW + NGW) % NGW;
    for (int it = first; it < items; it += NGW) transpose_item(W, K, N, WT, ldk, kscale, scr, it, F.lane, dmap);
    wcur += items;
}
DEVI void zero_rows(const Frame& F, bf16_t* WT, int ldk, int r0, int r1, int c0 = 0, int c1 = -1) {
    if (c1 < 0) c1 = ldk; const int w8 = (c1 - c0) / 8, n = (r1 - r0) * w8;
    for (int i = F.bid * NTHREADS + F.tid; i < n; i += F.G * NTHREADS) { const int r = r0 + i / w8, c = c0 + (i % w8) * 8; *(u32x4*)(WT + (size_t)r * ldk + c) = (u32x4){0u, 0u, 0u, 0u}; }
}
DEVI void convert_layer_weights(const Frame& F, int layer) {
    bf16_t* Wb = (bf16_t*)(F.ws + WS_W); int wcur = 0;
    if (layer == 0) {
        convert_weight(F, F.ap->in[I_EVW], D, 3984, Wb + W_IN / 2, D, nullptr, DMapEv(), wcur);
        zero_rows(F, Wb + W_IN / 2, D, 3984, EVP);
    } else {
        convert_weight(F, F.ap->in[I_ODW], D, 3008, Wb + W_IN / 2, D, nullptr, DMapId(), wcur);
        zero_rows(F, Wb + W_IN / 2, D, 3008, ODP);
        convert_weight(F, F.ap->in[I_WQB], 256, 768, Wb + W_QB / 2, 256, F.ap->in[I_QNORM], DMapId(), wcur);
        convert_weight(F, F.ap->in[I_WKVB], 128, 1024, Wb + W_KVB / 2, 256, F.ap->in[I_KVNORM], DMapId(), wcur);
        zero_rows(F, Wb + W_KVB / 2, 256, 0, 1024, 128, 256);
    }
    convert_weight(F, F.ap->in[I_OUTW] + (size_t)layer * D * D, D, D, Wb + W_OUT / 2, D, nullptr, DMapId(), wcur);
    convert_weight(F, F.ap->in[I_W1] + (size_t)layer * D * DFF, D, DFF, Wb + W_1 / 2, D, nullptr, DMapId(), wcur);
    convert_weight(F, F.ap->in[I_W2] + (size_t)layer * DFF * D, DFF, D, Wb + W_2 / 2, DFF, nullptr, DMapId(), wcur);
}
DEVI void ada_units(const Frame& F) {
    float* sc = (float*)F.lds;
    float* part = sc + 3 * 1024;
    constexpr int CW = 48, UPL = 6144 / CW;
    bool have = false;
    for (int u = F.bid; u < 2 * UPL; u += F.G) {
        if (!have) { for (int i = F.tid; i < 3 * 1024; i += NTHREADS) { const int s = i >> 10, k = i & 1023; const float c = (s < 2) ? (s < NB ? F.ap->in[I_C][s * 1024 + k] : 0.f) : F.ap->in[I_CCTX][k]; sc[i] = siluf_(c); } have = true; }
        __syncthreads();
        const int l = u / UPL, c0 = (u % UPL) * CW, col = c0 + (F.lane < CW ? F.lane : 0); const float* W = F.ap->in[I_ADAW] + (size_t)l * 1024 * 6144 + col;
        float a0 = 0.f, a1 = 0.f, a2 = 0.f;
#pragma unroll 32
        for (int kk = 0; kk < 128; ++kk) { const int k = F.wave * 128 + kk; const float w = W[(size_t)k * 6144]; a0 += sc[k] * w; a1 += sc[1024 + k] * w; a2 += sc[2048 + k] * w; }
        part[(F.wave * 3 + 0) * 64 + F.lane] = a0; part[(F.wave * 3 + 1) * 64 + F.lane] = a1; part[(F.wave * 3 + 2) * 64 + F.lane] = a2;
        __syncthreads();
        if (F.tid < 192) { const int s = F.tid >> 6, ln = F.tid & 63; float t = 0.f; for (int w = 0; w < 8; ++w) t += part[(w * 3 + s) * 64 + ln];
            const int c2 = c0 + ln; if (ln < CW) ((float*)(F.ws + WS_MOD))[((size_t)l * 3 + s) * 6144 + c2] = t + F.ap->in[I_ADAB][l * 6144 + c2]; }
    }
    __syncthreads();
}
DEVI void rope_tables(const Frame& F) {
    float* rc = (float*)(F.ws + WS_ROPE); float* rs = rc + 128 * 16;
    for (int i = F.bid * NTHREADS + F.tid; i < 128 * 16; i += F.G * NTHREADS) { const int pos = i >> 4, j = i & 15; const float inv = powf(10000.f, -(float)j / 16.f); const float ang = (float)pos * inv; rc[i] = cosf(ang); rs[i] = sinf(ang); }
}

struct RowVec { f32x4 v[4]; };
DEVI RowVec ld_row_b(const bf16_t* p, int lane) { RowVec r; const u32x2* q = (const u32x2*)p + lane;
#pragma unroll
    for (int j = 0; j < 4; ++j) { const u32x2 w = q[64 * j]; const unsigned a = w[0], b2 = w[1]; r.v[j][0] = bf2f(a); r.v[j][1] = bf2f(a >> 16); r.v[j][2] = bf2f(b2); r.v[j][3] = bf2f(b2 >> 16); } return r; }
DEVI RowVec ld_row(const float* p, int lane) { RowVec r; const f32x4* q = (const f32x4*)p + lane;
#pragma unroll
    for (int j = 0; j < 4; ++j) r.v[j] = q[64 * j]; return r; }
DEVI void st_row(float* p, int lane, const RowVec& r) { f32x4* q = (f32x4*)p + lane;
#pragma unroll
    for (int j = 0; j < 4; ++j) q[64 * j] = r.v[j]; }
DEVI float row_rstd(const RowVec& r) { float s = 0.f;
#pragma unroll
    for (int j = 0; j < 4; ++j) s += (r.v[j][0] * r.v[j][0] + r.v[j][1] * r.v[j][1]) + (r.v[j][2] * r.v[j][2] + r.v[j][3] * r.v[j][3]);
    return RSQ(wave_sum(s) * (1.f / D) + EPS); }
DEVI void st_mod_bf16(bf16_t* orow, int lane, const RowVec& x, float rstd, const float* g, const float* shift, const float* scale) {
    unsigned long long* o8 = (unsigned long long*)orow + lane;
#pragma unroll
    for (int j = 0; j < 4; ++j) { const f32x4 gg = ((const f32x4*)g)[lane + 64 * j], sh = ((const f32x4*)shift)[lane + 64 * j], sc = ((const f32x4*)scale)[lane + 64 * j];
        f32x4 y;
#pragma unroll
        for (int e = 0; e < 4; ++e) y[e] = (x.v[j][e] * rstd * gg[e]) * (1.f + sc[e]) + sh[e];
        o8[64 * j] = (unsigned long long)pk2(y[0], y[1]) | ((unsigned long long)pk2(y[2], y[3]) << 32); }
}
DEVI float* stream_row(const Frame& F, int b, int t) { return (t < CTX) ? (float*)(F.ws + WS_XC) + ((size_t)b * CTX + t) * D : F.out + ((size_t)b * SEQ + (t - CTX)) * D; }
DEVI bf16_t* xs_lat(const Frame& F, int idx) { return (idx == 2) ? (bf16_t*)F.out : (bf16_t*)(F.ws + WS_SCR); }
DEVI void st_row_b(bf16_t* p, int lane, const RowVec& r) { unsigned long long* o8 = (unsigned long long*)p + lane;
#pragma unroll
    for (int j = 0; j < 4; ++j) o8[64 * j] = (unsigned long long)pk2(r.v[j][0], r.v[j][1]) | ((unsigned long long)pk2(r.v[j][2], r.v[j][3]) << 32); }
DEVI const float* input_row(const Frame& F, int b, int t) { return (t < CTX) ? F.ap->in[I_CTX] + ((size_t)b * CTX + t) * D : F.ap->in[I_X] + ((size_t)b * SEQ + (t - CTX)) * D; }
struct RowCoef { RowVec ga, sh, gy; };
DEVI void coef_mod(RowCoef& c, int lane, const float* g, const float* shift, const float* scale) {
#pragma unroll
    for (int j = 0; j < 4; ++j) { const f32x4 gg = ((const f32x4*)g)[lane + 64 * j], sh = ((const f32x4*)shift)[lane + 64 * j], sc = ((const f32x4*)scale)[lane + 64 * j];
#pragma unroll
        for (int e = 0; e < 4; ++e) { c.ga.v[j][e] = gg[e] * (1.f + sc[e]); c.sh.v[j][e] = sh[e]; } }
}
DEVI void st_mod_c(bf16_t* orow, int lane, const RowVec& x, float rstd, const RowCoef& c) {
    unsigned long long* o8 = (unsigned long long*)orow + lane;
#pragma unroll
    for (int j = 0; j < 4; ++j) { f32x4 y;
#pragma unroll
        for (int e = 0; e < 4; ++e) y[e] = (x.v[j][e] * rstd) * c.ga.v[j][e] + c.sh.v[j][e];
        o8[64 * j] = (unsigned long long)pk2(y[0], y[1]) | ((unsigned long long)pk2(y[2], y[3]) << 32); }
}
DEVI void phase_hj0(const Frame& F) {
    const int gw = F.bid * 8 + F.wave, NGW = F.G * 8; bf16_t* HJ = (bf16_t*)(F.ws + WS_ACT);
    int r = gw; if (r >= M) return;
    RowVec x = ld_row(input_row(F, r / T, r % T), F.lane); int cur_s = -1; RowCoef c;
    for (;;) { const int rn = r + NGW; RowVec xn = x; if (rn < M) xn = ld_row(input_row(F, rn / T, rn % T), F.lane);
        const int b = r / T, t = r % T, s = (t < CTX) ? 2 : b;
        if (s != cur_s) { const float* mod = modp(F, 0, s); coef_mod(c, F.lane, F.ap->in[I_NORMG], mod + 0, mod + 1024); cur_s = s; }
        const float rs = row_rstd(x);
        st_mod_c(HJ + (size_t)r * D, F.lane, x, rs, c);
        if (rn >= M) break; r = rn; x = xn; }
}
struct ResidIn { RowVec y, x; };
DEVI ResidIn resid_load(const Frame& F, int layer, int which, const bf16_t* Y, const float* slab, int nks, int r) {
    ResidIn in; const int b = r / T, t = r % T;
    if (slab && t < CTX) { in.y = ld_row(slab + ((size_t)b * CTX + t) * D, F.lane);
        for (int ks = 1; ks < nks; ++ks) { const RowVec y2 = ld_row(slab + ((size_t)ks * NB * CTX + (size_t)b * CTX + t) * D, F.lane);
#pragma unroll
            for (int j = 0; j < 4; ++j) in.y.v[j] += y2.v[j]; } }
    else in.y = ld_row_b(Y + (size_t)r * D, F.lane);
    const int step = layer * 2 + which;
    if (step == 0) in.x = ld_row(input_row(F, b, t), F.lane);
    else if (t < CTX) in.x = ld_row(stream_row(F, b, t), F.lane);
    else in.x = ld_row_b(xs_lat(F, step) + ((size_t)b * SEQ + (t - CTX)) * D, F.lane);
    return in;
}
DEVI int resid_next_row(int r, int NGW, bool lat_only) { r += NGW; while (lat_only && r < M && (r % T) < CTX) r += NGW; return r; }
DEVI void phase_resid(const Frame& F, int layer, int which, const bf16_t* Y, bool lat_only, bf16_t* AO, const float* slab = nullptr, int nks = 0) {
    const int gw = F.bid * 8 + F.wave, NGW = F.G * 8;
    const float* ng = F.ap->in[I_NORMG] + (size_t)layer * 4 * D;
    int r = gw; while (lat_only && r < M && (r % T) < CTX) r += NGW;
    if (r >= M) return;
    ResidIn cur = resid_load(F, layer, which, Y, slab, nks, r); int cur_s = -1; RowCoef c;
    for (;;) { const int rn = resid_next_row(r, NGW, lat_only); ResidIn nxt = cur; if (rn < M) nxt = resid_load(F, layer, which, Y, slab, nks, rn);
        const int b = r / T, t = r % T; const int s = (t < CTX) ? 2 : b;
        if (s != cur_s) { const float* mod = modp(F, layer, s); cur_s = s;
            const float* gn = ng + (which == 0 ? 1 : 3) * D; const float* gate = mod + (which == 0 ? 2048 : 5120);
#pragma unroll
            for (int j = 0; j < 4; ++j) { const f32x4 gg = ((const f32x4*)gn)[F.lane + 64 * j], gt = ((const f32x4*)gate)[F.lane + 64 * j];
#pragma unroll
                for (int e = 0; e < 4; ++e) c.gy.v[j][e] = gg[e] * gt[e]; }
            if (which == 0) coef_mod(c, F.lane, ng + 2 * D, mod + 3072, mod + 4096);
            else if (layer == 0) { const float* mod1 = modp(F, 1, s); coef_mod(c, F.lane, F.ap->in[I_NORMG] + (size_t)1 * 4 * D, mod1 + 0, mod1 + 1024); } }
        const float rsy = row_rstd(cur.y); RowVec x = cur.x;
#pragma unroll
        for (int j = 0; j < 4; ++j) {
#pragma unroll
            for (int e = 0; e < 4; ++e) x.v[j][e] += (cur.y.v[j][e] * rsy) * c.gy.v[j][e]; }
        if (t < CTX || layer * 2 + which == 3) st_row(stream_row(F, b, t), F.lane, x);
        else st_row_b(xs_lat(F, layer * 2 + which + 1) + ((size_t)b * SEQ + (t - CTX)) * D, F.lane, x);
        if (which == 0 || layer == 0) { const float rs = row_rstd(x); st_mod_c(AO + (size_t)r * D, F.lane, x, rs, c); }
        if (rn >= M) break; r = rn; cur = nxt; }
}

DEVI void wave_scan256(float* arr, int lane, int op, bool rev) {
    float v[4];
#pragma unroll
    for (int e = 0; e < 4; ++e) { const int i = 4 * lane + e; v[e] = arr[rev ? 255 - i : i]; }
#pragma unroll
    for (int e = 1; e < 4; ++e) v[e] = op ? fmaxf(v[e], v[e - 1]) : v[e] + v[e - 1];
    float tot = v[3];
#pragma unroll
    for (int o = 1; o < 64; o <<= 1) { const float n = shfl_up_l(tot, o, lane); if (lane >= o) tot = op ? fmaxf(tot, n) : tot + n; }
    float ex = shfl_up_l(tot, 1, lane);
#pragma unroll
    for (int e = 0; e < 4; ++e) { float r = v[e]; if (lane > 0) r = op ? fmaxf(r, ex) : r + ex; const int i = 4 * lane + e; arr[rev ? 255 - i : i] = r; }
}

struct MlGates { float *a_fw, *pm_fw, *b_fw, *a_bw, *pm_bw, *b_bw; };
DEVI MlGates ml_gate_ptrs(float* base) { MlGates g; g.a_fw = base; g.pm_fw = base + 256; g.b_fw = base + 512; g.a_bw = base + 768; g.pm_bw = base + 1024; g.b_bw = base + 1280; return g; }
DEVI void ml_gates_setup(const Frame& F, const MlGates& g, int b, int h, int c) {
    const bf16_t* PROJ = (const bf16_t*)(F.ws + WS_BIG); const float* gb = F.ap->in[I_MLGB];
    if (F.tid < 256) { const int row = grow(b, c * 256 + F.tid); const bf16_t* p = PROJ + (size_t)row * EVP + E_MG;
        const float igf = bf2f(p[0 + h]) + gb[0 + h], fgf = bf2f(p[4 + h]) + gb[4 + h], igb = bf2f(p[8 + h]) + gb[8 + h], fgb = bf2f(p[12 + h]) + gb[12 + h];
        g.b_fw[F.tid] = logsigmoidf_(fgf); g.a_fw[F.tid] = igf; g.b_bw[F.tid] = logsigmoidf_(fgb); g.a_bw[F.tid] = igb; }
    __syncthreads();
    if (F.wave == 0) wave_scan256(g.b_fw, F.lane, 0, false);
    if (F.wave == 1) wave_scan256(g.b_bw, F.lane, 0, true);
    __syncthreads();
    if (F.tid < 256) { const float af = g.a_fw[F.tid] - g.b_fw[F.tid], ab = g.a_bw[F.tid] - g.b_bw[F.tid]; g.a_fw[F.tid] = af; g.pm_fw[F.tid] = af; g.a_bw[F.tid] = ab; g.pm_bw[F.tid] = ab; }
    __syncthreads();
    if (F.wave == 0) wave_scan256(g.pm_fw, F.lane, 1, false);
    if (F.wave == 1) wave_scan256(g.pm_bw, F.lane, 1, true);
    __syncthreads();
}
DEVI void ml_conv8(const bf16_t* PROJ, const float* cw, int b, int t, int col, int cch, float scale, float* out) {
    const int lo = (t < CTX) ? 0 : CTX, hi = (t < CTX) ? CTX : T;
    float x0[8], x1[8], x2[8];
    unpack8(ld8(PROJ + (size_t)grow(b, t) * EVP + col), x1);
    if (t - 1 >= lo) unpack8(ld8(PROJ + (size_t)grow(b, t - 1) * EVP + col), x0); else { for (int e = 0; e < 8; ++e) x0[e] = 0.f; }
    if (t + 1 < hi) unpack8(ld8(PROJ + (size_t)grow(b, t + 1) * EVP + col), x2); else { for (int e = 0; e < 8; ++e) x2[e] = 0.f; }
#pragma unroll
    for (int e = 0; e < 8; ++e) out[e] = (cw[cch + e] * x0[e] + cw[1024 + cch + e] * x1[e] + cw[2048 + cch + e] * x2[e]) * scale;
}
constexpr float ML_KSCALE = 0.08838834764831845f;
constexpr int LDT = 72;
DEVI void ml_phaseA_unit(const Frame& F, int b, int h, int c) {
    const bf16_t* PROJ = (const bf16_t*)(F.ws + WS_BIG);
    float* gbase = (float*)F.lds; MlGates g = ml_gate_ptrs(gbase);
    float* wfw = gbase + 1536; float* wbw = wfw + 256;
    constexpr int RSV = 160;
    bf16_t* Vf = (bf16_t*)(F.lds + 8192); bf16_t* Vb = Vf + 64 * RSV; bf16_t* Kr = Vb + 64 * RSV;
    const int dir = F.wave >> 2, vt = F.wave & 3;
    const int lj = F.tid >> 3, cg8 = F.tid & 7; const float* cw = F.ap->in[I_MLCONV];
    bf16x8 pv[2], pk0[2], pk1[2], pk2[2];
#define MLA_ISSUE(jb_) do { const int t = c * 256 + (jb_) * 64 + lj; const int lo = (t < CTX) ? 0 : CTX, hi2 = (t < CTX) ? CTX : T; const int tm = (t - 1 >= lo) ? t - 1 : t, tp = (t + 1 < hi2) ? t + 1 : t; \
        _Pragma("unroll") for (int half = 0; half < 2; ++half) { const int ch = cg8 * 16 + half * 8; pv[half] = ld8(PROJ + (size_t)grow(b, t) * EVP + E_MV + h * 128 + ch); \
            pk0[half] = ld8(PROJ + (size_t)grow(b, tm) * EVP + E_MK + h * 128 + ch); pk1[half] = ld8(PROJ + (size_t)grow(b, t) * EVP + E_MK + h * 128 + ch); pk2[half] = ld8(PROJ + (size_t)grow(b, tp) * EVP + E_MK + h * 128 + ch); } } while (0)
    MLA_ISSUE(0);
    ml_gates_setup(F, g, b, h, c);
    if (F.tid < 256) { wfw[F.tid] = __expf(g.a_fw[F.tid] - g.pm_fw[255]); wbw[F.tid] = __expf(g.a_bw[F.tid] - g.pm_bw[0]); }
    f32x16 acc[4];
#pragma unroll
    for (int i = 0; i < 4; ++i) acc[i] = (f32x16){};
    float nacc = 0.f;
    for (int jb = 0; jb < 4; ++jb) {
        __syncthreads();
        { const int t = c * 256 + jb * 64 + lj; const float wf = wfw[jb * 64 + lj], wb = wbw[jb * 64 + lj];
          const int lo = (t < CTX) ? 0 : CTX, hi2 = (t < CTX) ? CTX : T; const bool hm = t - 1 >= lo, hp = t + 1 < hi2;
#pragma unroll
          for (int half = 0; half < 2; ++half) { const int ch = cg8 * 16 + half * 8, cch = 512 + h * 128 + ch; float v[8], k[8], x0[8], x1[8], x2[8], vf[8], vb[8];
            unpack8(pv[half], v); unpack8(pk0[half], x0); unpack8(pk1[half], x1); unpack8(pk2[half], x2);
#pragma unroll
            for (int e = 0; e < 8; ++e) { k[e] = (cw[cch + e] * (hm ? x0[e] : 0.f) + cw[1024 + cch + e] * x1[e] + cw[2048 + cch + e] * (hp ? x2[e] : 0.f)) * ML_KSCALE; vf[e] = v[e] * wf; vb[e] = v[e] * wb; }
            const bf16x8 kp = pack8(k); *(bf16x8*)((bf16_t*)((unsigned char*)F.out + OUT_KC) + (size_t)grow(b, t) * 512 + h * 128 + ch) = kp;
            *(bf16x8*)(Vf + lj * RSV + ch) = pack8(vf); *(bf16x8*)(Vb + lj * RSV + ch) = pack8(vb); *(bf16x8*)(Kr + lj * RSV + ch) = kp; } }
        __syncthreads();
        if (jb + 1 < 4) MLA_ISSUE(jb + 1);
        const bf16_t* Vx = dir ? Vb : Vf;
#pragma unroll
        for (int ks = 0; ks < 4; ++ks) { const bf16x8 a = ld_tr_B(Vx, RSV, ks * 16, vt * 32, F.lane);
#pragma unroll
            for (int dt = 0; dt < 4; ++dt) acc[dt] = mfma32(a, ld_tr_B(Kr, RSV, ks * 16, dt * 32, F.lane), acc[dt]); }
        if (F.tid < 256) { const int dd = F.tid >> 7, d = F.tid & 127; const float* w = dd ? wbw : wfw; float s = 0.f;
#pragma unroll 8
            for (int j = 0; j < 64; ++j) s += bf2f(Kr[j * RSV + d]) * w[jb * 64 + j];
            nacc += s; }
    }
#undef MLA_ISSUE
    const int r32 = F.lane & 31, hi = F.lane >> 5;
    const int stream = (b * 4 + h) * 2 + dir;
    float* Cg = (float*)(F.ws + WS_SCR + SC_MLC) + ((size_t)stream * NCH + c) * 16384;
#pragma unroll
    for (int dt = 0; dt < 4; ++dt)
#pragma unroll
        for (int r = 0; r < 16; ++r) Cg[(vt * 32 + crow(r, hi)) * 128 + dt * 32 + r32] = acc[dt][r];
    if (F.tid < 256) { const int dd = F.tid >> 7, d = F.tid & 127; const int st2 = (b * 4 + h) * 2 + dd; ((float*)(F.ws + WS_SCR + SC_MLN))[((size_t)st2 * NCH + c) * 128 + d] = nacc; }
    if (F.tid < 2) { const int dd = F.tid; const int st2 = (b * 4 + h) * 2 + dd; float* sc = (float*)(F.ws + WS_SCR + SC_MLS) + ((size_t)st2 * NCH + c) * 4;
        const float btot = dd ? g.b_bw[0] : g.b_fw[255], pme = dd ? g.pm_bw[0] : g.pm_fw[255]; sc[0] = btot + pme; sc[1] = btot; }
    __syncthreads();
}
DEVI int ml_chunk_at(int dir, int k) { if (!dir) return k; return (k < NCTXCH) ? (NCTXCH - 1 - k) : (NCH - 1 - (k - NCTXCH)); }
DEVI void ml_phaseB(const Frame& F) {
    const int nvb = NSTR_ML * 16;
    const int GH = F.G;
    for (int vb = F.bid; vb < nvb && F.bid < GH; vb += GH) {
        const int stream = vb >> 4, e0 = ((vb & 15) * NTHREADS + F.tid) * 2, dir = stream & 1;
        float* Cs = (float*)(F.ws + WS_SCR + SC_MLC) + (size_t)stream * NCH * 16384; float* Ns = (float*)(F.ws + WS_SCR + SC_MLN) + (size_t)stream * NCH * 128; float* Ss = (float*)(F.ws + WS_SCR + SC_MLS) + (size_t)stream * NCH * 4;
        float c0 = 0.f, c1 = 0.f, n0 = 0.f, m = 0.f; const bool do_n = (vb & 15) == 0 && F.tid < 128;
        typedef float f32x2 __attribute__((ext_vector_type(2)));
        constexpr int KB2 = (NCH + 1) / 2;
#pragma unroll 1
        for (int k0 = 0; k0 < NCH; k0 += KB2) {
            f32x2 lv[KB2]; float lnv[KB2], mlv[KB2], btv[KB2];
#pragma unroll
            for (int kk = 0; kk < KB2; ++kk) { const int k = (k0 + kk < NCH) ? k0 + kk : NCH - 1; const int c = ml_chunk_at(dir, k); mlv[kk] = Ss[c * 4 + 0]; btv[kk] = Ss[c * 4 + 1]; lv[kk] = *(const f32x2*)(Cs + (size_t)c * 16384 + e0); lnv[kk] = do_n ? Ns[c * 128 + F.tid] : 0.f; }
#pragma unroll
            for (int kk = 0; kk < KB2; ++kk) { if (k0 + kk < NCH) { const int c = ml_chunk_at(dir, k0 + kk); const float mloc = mlv[kk], btot = btv[kk];
                f32x2 st2; st2[0] = c0; st2[1] = c1; *(f32x2*)(Cs + (size_t)c * 16384 + e0) = st2;
                if (do_n) Ns[c * 128 + F.tid] = n0;
                if ((vb & 15) == 0 && F.tid == 0) Ss[c * 4 + 2] = m;
                const float mn = fmaxf(btot + m, mloc), dk = __expf(btot + m - mn), sl = __expf(mloc - mn);
                c0 = dk * c0 + sl * lv[kk][0]; c1 = dk * c1 + sl * lv[kk][1]; n0 = dk * n0 + sl * lnv[kk]; m = mn; } }
        }
    }
}
constexpr int LDK = 136;
DEVI void ml_phaseC_unit(const Frame& F0, int b, int h, int c) {
    const Frame F = unit_frame(F0);
    const bf16_t* PROJ = (const bf16_t*)(F.ws + WS_BIG); bf16_t* YM = (bf16_t*)(F.ws + WS_ACT);
    float* gbase = (float*)F.lds; MlGates g = ml_gate_ptrs(gbase);
    float* nin = gbase + 1536;
    float* wsc = gbase + 1792 + F.wave * 64;
    bf16_t* Kl = (bf16_t*)(F.lds + 12288);
    bf16_t* VT = Kl + 64 * LDK;
    bf16_t* stash = VT + 64 * 160 + F.wave * (32 * 136);
    ml_gates_setup(F, g, b, h, c);
    const int r32 = F.lane & 31, hi = F.lane >> 5, it = F.wave >> 1;
    const int irow = F.wave * 32 + r32;
    const int tq = c * 256 + irow;
    if (F.tid < 256) { const int dd = F.tid >> 7, d = F.tid & 127; nin[F.tid] = ((const float*)(F.ws + WS_SCR + SC_MLN))[((size_t)((b * 4 + h) * 2 + dd) * NCH + c) * 128 + d]; }
    bf16x8 qr[4];
    bf16_t* qhi = (bf16_t*)(F.lds + 119808) + F.tid * 32;
#define MLQ(d0) (((d0) < 4) ? qr[(d0) & 3] : ld8(qhi + ((d0) - 4) * 8))
#pragma unroll
    for (int d0 = 0; d0 < 4; ++d0) qr[d0] = (bf16x8){};
    { const int lo = (tq < CTX) ? 0 : CTX, hi2 = (tq < CTX) ? CTX : T; const bool hm = tq - 1 >= lo, hp = tq + 1 < hi2; const int tm = hm ? tq - 1 : tq, tp = hp ? tq + 1 : tq;
      const float* cw = F.ap->in[I_MLCONV];
#pragma unroll 1
      for (int half = 0; half < 2; ++half) { bf16x8 xr[4][3];
#pragma unroll
        for (int j = 0; j < 4; ++j) { const int col = E_MQ + h * 128 + (half * 4 + j) * 16 + hi * 8;
            xr[j][0] = ld8(PROJ + (size_t)grow(b, tm) * EVP + col); xr[j][1] = ld8(PROJ + (size_t)grow(b, tq) * EVP + col); xr[j][2] = ld8(PROJ + (size_t)grow(b, tp) * EVP + col); }
#pragma unroll
        for (int j = 0; j < 4; ++j) { const int cch = h * 128 + (half * 4 + j) * 16 + hi * 8; float x0[8], x1[8], x2[8], q[8]; unpack8(xr[j][0], x0); unpack8(xr[j][1], x1); unpack8(xr[j][2], x2);
#pragma unroll
            for (int e = 0; e < 8; ++e) q[e] = cw[cch + e] * (hm ? x0[e] : 0.f) + cw[1024 + cch + e] * x1[e] + cw[2048 + cch + e] * (hp ? x2[e] : 0.f);
            if (half == 0) qr[j] = pack8(q); else *(bf16x8*)(qhi + j * 8) = pack8(q); } }
      WAVE_SYNC(); }
    __syncthreads();
    f32x16 o[4];
#pragma unroll 1
    for (int dir = 0; dir < 2; ++dir) {
        const int stream = (b * 4 + h) * 2 + dir;
        const float m_in = ((const float*)(F.ws + WS_SCR + SC_MLS))[((size_t)stream * NCH + c) * 4 + 2];
        const float* aarr = dir ? g.a_bw : g.a_fw; const float* pmarr = dir ? g.pm_bw : g.pm_fw; const float* barr = dir ? g.b_bw : g.b_fw;
        const float Mrow = fmaxf(m_in, pmarr[irow]), w_inter = __expf(m_in - Mrow);
        const float* Cg = (const float*)(F.ws + WS_SCR + SC_MLC) + ((size_t)stream * NCH + c) * 16384;
        bf16_t* Cl = Kl;
        bf16x8 pkt[2], pvt[2];
#define MLC_ISSUE(jt_) do { const int j = F.tid >> 3, cg8 = F.tid & 7, t = c * 256 + (jt_) * 64 + j; \
            _Pragma("unroll") for (int half = 0; half < 2; ++half) { const int ch = cg8 * 16 + half * 8; pvt[half] = ld8(PROJ + (size_t)grow(b, t) * EVP + E_MV + h * 128 + ch); \
                pkt[half] = ld8((const bf16_t*)((const unsigned char*)F.out + OUT_KC) + (size_t)grow(b, t) * 512 + h * 128 + ch); } } while (0)
        MLC_ISSUE(0);
        float nq = 0.f;
        if (c >= NCTXCH) {
        __syncthreads();
        { const int v = F.tid >> 2, q4 = (F.tid & 3) * 32;
#pragma unroll
          for (int g8 = 0; g8 < 4; ++g8) { const f32x4 c0 = *(const f32x4*)(Cg + v * 128 + q4 + g8 * 8), c1 = *(const f32x4*)(Cg + v * 128 + q4 + g8 * 8 + 4); float cf[8];
#pragma unroll
              for (int e = 0; e < 4; ++e) { cf[e] = c0[e]; cf[4 + e] = c1[e]; }
              *(bf16x8*)(Cl + v * LDK + q4 + g8 * 8) = pack8(cf); } }
        __syncthreads();
#pragma unroll
        for (int d0 = 0; d0 < 4; ++d0) { o[d0] = (f32x16){};
#pragma unroll
            for (int ks = 0; ks < 8; ++ks) o[d0] = mfma32(MLQ(ks), ld8(Cl + (d0 * 32 + r32) * LDK + ks * 16 + hi * 8), o[d0]); }
#pragma unroll
        for (int d0 = 0; d0 < 8; ++d0) { float q[8]; unpack8(MLQ(d0), q);
#pragma unroll
            for (int e = 0; e < 8; ++e) nq += q[e] * nin[dir * 128 + d0 * 16 + hi * 8 + e]; FENCE(); }
        nq += shx<32>(nq);
        if (hi == 0) wsc[r32] = w_inter;
        __syncthreads();
#pragma unroll
        for (int d0 = 0; d0 < 4; ++d0)
#pragma unroll
            for (int r = 0; r < 16; ++r) o[d0][r] *= wsc[crow(r, hi)];
        } else {
#pragma unroll
            for (int d0 = 0; d0 < 4; ++d0) o[d0] = (f32x16){};
        }
        float rowsum = 0.f;
#pragma unroll 1
        for (int jt = 0; jt < 4; ++jt) {
            __syncthreads();
            { const int j = F.tid >> 3, cg8 = F.tid & 7;
#pragma unroll
              for (int half = 0; half < 2; ++half) { const int ch = cg8 * 16 + half * 8;
                *(bf16x8*)(Kl + j * LDK + ch) = pkt[half]; *(bf16x8*)(VT + j * 160 + ch) = pvt[half]; } }
            __syncthreads(); FENCE();
            if (jt + 1 < 4) MLC_ISSUE(jt + 1);
            const bool rel = dir ? (jt >= it) : (jt <= it);
            if (rel) {
                f32x16 p0 = (f32x16){}, p1 = (f32x16){};
#pragma unroll
                for (int d0 = 0; d0 < 8; ++d0) { const bf16x8 qf = MLQ(d0); p0 = mfma32(ld8(Kl + r32 * LDK + d0 * 16 + hi * 8), qf, p0); p1 = mfma32(ld8(Kl + (32 + r32) * LDK + d0 * 16 + hi * 8), qf, p1); }
#pragma unroll
                for (int r = 0; r < 16; ++r) { const int j0 = jt * 64 + crow(r, hi), j1 = j0 + 32;
                    const bool v0 = dir ? (j0 >= irow) : (j0 <= irow), v1 = dir ? (j1 >= irow) : (j1 <= irow);
                    p0[r] = v0 ? p0[r] * __expf(aarr[j0] - Mrow) : 0.f; p1[r] = v1 ? p1[r] * __expf(aarr[j1] - Mrow) : 0.f; rowsum += p0[r] + p1[r]; }
                const bf16x8 pa0 = pk4frag(p0, 0), pa1 = pk4frag(p0, 8), pa2 = pk4frag(p1, 0), pa3 = pk4frag(p1, 8); FENCE();
#pragma unroll
                for (int d0 = 0; d0 < 4; ++d0) {
                    o[d0] = mfma32(pa0, ld_tr_B(VT, 160, 0, d0 * 32, F.lane), o[d0]); o[d0] = mfma32(pa1, ld_tr_B(VT, 160, 16, d0 * 32, F.lane), o[d0]);
                    o[d0] = mfma32(pa2, ld_tr_B(VT, 160, 32, d0 * 32, F.lane), o[d0]); o[d0] = mfma32(pa3, ld_tr_B(VT, 160, 48, d0 * 32, F.lane), o[d0]); }
            }
        }
        rowsum += shx<32>(rowsum);
        const float den = rowsum + w_inter * nq, dn = fmaxf(fabsf(den), __expf(-(barr[irow] + Mrow)));
        __syncthreads();
        if (hi == 0) wsc[r32] = 1.f / dn;
        __syncthreads();
        if (dir == 0) {
#pragma unroll
            for (int d0 = 0; d0 < 4; ++d0)
#pragma unroll
                for (int r = 0; r < 16; ++r) stash[crow(r, hi) * 136 + d0 * 32 + r32] = (bf16_t)f2bf(o[d0][r] * wsc[crow(r, hi)]);
        } else {
#pragma unroll
            for (int d0 = 0; d0 < 4; ++d0)
#pragma unroll
                for (int r = 0; r < 16; ++r) o[d0][r] = o[d0][r] * wsc[crow(r, hi)] + bf2f(stash[crow(r, hi) * 136 + d0 * 32 + r32]);
        }
        __syncthreads();
    }
#pragma unroll
    for (int d0 = 0; d0 < 4; ++d0)
#pragma unroll
        for (int r = 0; r < 16; ++r) stash[crow(r, hi) * 136 + d0 * 32 + r32] = (bf16_t)f2bf(o[d0][r]);
    WAVE_SYNC();
    { const int rw = F.lane >> 1, hf = F.lane & 1; const bf16_t* sp = stash + rw * 136 + hf * 64; float hv[64]; float ss = 0.f;
#pragma unroll
      for (int q8 = 0; q8 < 8; ++q8) { unpack8(ld8(sp + q8 * 8), hv + q8 * 8);
#pragma unroll
          for (int e = 0; e < 8; ++e) ss += hv[q8 * 8 + e] * hv[q8 * 8 + e]; }
      ss += shx<1>(ss); const float rs = RSQ(ss * (1.f / 128.f) + EPS);
      const int row = grow(b, c * 256 + F.wave * 32 + rw); const int v0 = h * 128 + hf * 64;
#pragma unroll
      for (int q8 = 0; q8 < 8; ++q8) { float mo[8], ov[8]; unpack8(ld8(PROJ + (size_t)row * EVP + E_MO + v0 + q8 * 8), mo);
          const f32x4 g0 = *(const f32x4*)(F.ap->in[I_MLNORM] + v0 + q8 * 8), g1 = *(const f32x4*)(F.ap->in[I_MLNORM] + v0 + q8 * 8 + 4);
#pragma unroll
          for (int e = 0; e < 8; ++e) ov[e] = hv[q8 * 8 + e] * rs * (e < 4 ? g0[e] : g1[e - 4]) * sigmoidf_(mo[e]);
          *(bf16x8*)(YM + (size_t)row * D + v0 + q8 * 8) = pack8(ov); } }
    __syncthreads();
}

DEVI void rw_shift8(const bf16_t* PROJ, const float* mu8, int b, int t, int f, float* out) {
    const int lo = (t < CTX) ? 0 : CTX, hi = (t < CTX) ? CTX : T; float x0[8], x1[8], x2[8];
    unpack8(ld8(PROJ + (size_t)grow(b, t) * EVP + E_RF + f), x1);
    if (t - 1 >= lo) unpack8(ld8(PROJ + (size_t)grow(b, t - 1) * EVP + E_RF + f), x0); else { for (int e = 0; e < 8; ++e) x0[e] = 0.f; }
    if (t + 1 < hi) unpack8(ld8(PROJ + (size_t)grow(b, t + 1) * EVP + E_RF + f), x2); else { for (int e = 0; e < 8; ++e) x2[e] = 0.f; }
#pragma unroll
    for (int e = 0; e < 8; ++e) out[e] = x1[e] + (0.5f * (x0[e] + x2[e]) - x1[e]) * mu8[e];
}
constexpr int RW_T = 64 * 65;
DEVI void copy16(const Frame& F, void* dst, const void* src, int nchunks) { for (int i = F.tid; i < nchunks; i += NTHREADS) ((u32x4*)dst)[i] = ((const u32x4*)src)[i]; }
DEVI void rw_stage_weights(const Frame& F, int h, bf16_t* W2T, bf16_t* A2T, bf16_t* G2T, int dmask) {
    const unsigned char* T = F.ws + WS_RWT;
    for (int d = 0; d < 2; ++d) { if (!((dmask >> d) & 1)) continue; const int slot = (dmask == 3) ? d : 0;
        if (W2T) copy16(F, W2T + slot * 64 * LDT, T + RWT_W2 + (size_t)(d * 8 + h) * 9216, 576);
        copy16(F, A2T + slot * 64 * LDT, T + RWT_A2 + (size_t)(d * 8 + h) * 9216, 576); }
    if (G2T) copy16(F, G2T, T + RWT_G2 + (size_t)h * 17408, 1088);
}
DEVI void rw_build_tables(const Frame& F) {
    unsigned char* T = F.ws + WS_RWT; const int gt = F.bid * NTHREADS + F.tid, GT = F.G * NTHREADS;
    for (int idx = gt; idx < 16 * 64 * LDT; idx += GT) { const int dh = idx / (64 * LDT), e = (idx / LDT) % 64, j = idx % LDT, d = dh >> 3, h = dh & 7;
        const float w = (j < 64) ? F.ap->in[I_RWW2][((size_t)d * 64 + j) * 512 + h * 64 + e] : 0.f, a = (j < 64) ? F.ap->in[I_RWA2][((size_t)d * 64 + j) * 512 + h * 64 + e] : 0.f;
        ((bf16_t*)(T + RWT_W2))[idx] = (bf16_t)f2bf(w); ((bf16_t*)(T + RWT_A2))[idx] = (bf16_t)f2bf(a); }
    for (int idx = gt; idx < 8 * 64 * LDK; idx += GT) { const int h = idx / (64 * LDK), e = (idx / LDK) % 64, j = idx % LDK;
        ((bf16_t*)(T + RWT_G2))[idx] = (bf16_t)f2bf((j < 128) ? F.ap->in[I_RWG2][(size_t)j * 512 + h * 64 + e] : 0.f); }
    for (int idx = gt; idx < 16 * 640; idx += GT) { const int dh = idx / 640, i = idx % 640, dir = dh >> 3, h = dh & 7, a = i >> 6, e = i & 63; float v;
        if (a == 0) v = F.ap->in[I_RWKK][h * 64 + e]; else if (a == 1) v = F.ap->in[I_RWKA][h * 64 + e]; else if (a == 2) v = F.ap->in[I_RWW0][dir * 512 + h * 64 + e]; else if (a == 3) v = F.ap->in[I_RWA0][dir * 512 + h * 64 + e]; else if (a == 9) v = F.ap->in[I_RWRK][h * 64 + e];
        else { const int f = (a == 4) ? R_R + h * 64 : (a == 5) ? R_K + h * 64 : (a == 6) ? R_V + h * 64 : (a == 7) ? R_WL + dir * 64 : R_AL + dir * 64; v = F.ap->in[I_RWMU][f + e]; }
        ((float*)(T + RWT_CST))[idx] = v; }
}
DEVI void rw_prep(const Frame& F, int b, int h, int t0, float* R, float* K, float* V, float* KK, float* LW0, float* AA0, float* LW1, float* AA1, float* G,
                  const bf16_t* W2T, const bf16_t* A2T, const bf16_t* G2T, bf16_t* XW, bf16_t* XA, bf16_t* XG, int dmask) {
    const bf16_t* PROJ = (const bf16_t*)(F.ws + WS_BIG); const float* mu = F.ap->in[I_RWMU];
    const int tok = F.tid >> 3, c8 = (F.tid & 7) * 8, t = t0 + tok;
    const int r32 = F.lane & 31, hi = F.lane >> 5;
    { float x[8];
      rw_shift8(PROJ, mu + (R_R + h * 64 + c8), b, t, R_R + h * 64 + c8, x); for (int e = 0; e < 8; ++e) R[tok * 65 + c8 + e] = x[e];
      rw_shift8(PROJ, mu + (R_K + h * 64 + c8), b, t, R_K + h * 64 + c8, x); for (int e = 0; e < 8; ++e) K[tok * 65 + c8 + e] = x[e];
      rw_shift8(PROJ, mu + (R_V + h * 64 + c8), b, t, R_V + h * 64 + c8, x); for (int e = 0; e < 8; ++e) V[tok * 65 + c8 + e] = x[e]; }
    if (G) { float x[8];
#pragma unroll
        for (int hf = 0; hf < 2; ++hf) { rw_shift8(PROJ, mu + (R_GL + hf * 64 + c8), b, t, R_GL + hf * 64 + c8, x); for (int e = 0; e < 8; ++e) x[e] = sigmoidf_(x[e]); *(bf16x8*)(XG + tok * LDK + hf * 64 + c8) = pack8(x); } }
    __syncthreads();
    if (KK && F.tid < 64) { float s = 0.f; for (int e = 0; e < 64; ++e) { const float kk = K[F.tid * 65 + e] * F.ap->in[I_RWKK][h * 64 + e]; s += kk * kk; }
        const float rn = RSQ(s + 1e-12f); for (int e = 0; e < 64; ++e) KK[F.tid * 65 + e] = K[F.tid * 65 + e] * F.ap->in[I_RWKK][h * 64 + e] * rn; }
    if (G) {
        if (F.wave < 4) { const int tt = F.wave >> 1, et = F.wave & 1; f32x16 acc = (f32x16){};
#pragma unroll
            for (int ks = 0; ks < 8; ++ks) acc = mfma32(ld8(XG + (tt * 32 + r32) * LDK + ks * 16 + hi * 8), ld8(G2T + (et * 32 + r32) * LDK + ks * 16 + hi * 8), acc);
#pragma unroll
            for (int r = 0; r < 16; ++r) G[(tt * 32 + crow(r, hi)) * 65 + et * 32 + r32] = acc[r]; }
        __syncthreads(); }
    for (int d = 0; d < 2; ++d) { if (!((dmask >> d) & 1)) continue;
        const int slot = (dmask == 3) ? d : 0; float* LW = d ? LW1 : LW0; float* AA = d ? AA1 : AA0;
        __syncthreads();
        { float x[8];
          if (LW) { rw_shift8(PROJ, mu + (R_WL + d * 64 + c8), b, t, R_WL + d * 64 + c8, x); for (int e = 0; e < 8; ++e) x[e] = tanhf_(x[e]); *(bf16x8*)(XW + tok * LDT + c8) = pack8(x); }
          rw_shift8(PROJ, mu + (R_AL + d * 64 + c8), b, t, R_AL + d * 64 + c8, x); *(bf16x8*)(XA + tok * LDT + c8) = pack8(x); }
        __syncthreads();
        { const int which = F.wave >> 2, tt = (F.wave >> 1) & 1, et = F.wave & 1;
          if (which || LW) { const bf16_t* X = which ? XA : XW; const bf16_t* WT = (which ? A2T : W2T) + slot * 64 * LDT;
          f32x16 acc = (f32x16){};
#pragma unroll
          for (int ks = 0; ks < 4; ++ks) acc = mfma32(ld8(X + (tt * 32 + r32) * LDT + ks * 16 + hi * 8), ld8(WT + (et * 32 + r32) * LDT + ks * 16 + hi * 8), acc);
          const int e = et * 32 + r32;
#pragma unroll
          for (int r = 0; r < 16; ++r) { const int tk = tt * 32 + crow(r, hi);
              if (!which) { const float wpre = F.ap->in[I_RWW0][d * 512 + h * 64 + e] + acc[r]; LW[tk * 65 + e] = -0.6065306597126334f * sigmoidf_(wpre); }
              else AA[tk * 65 + e] = sigmoidf_(F.ap->in[I_RWA0][d * 512 + h * 64 + e] + acc[r]); } } }
    }
    __syncthreads();
}
DEVI void rw_scan_v1(const Frame& F, int b, int h, int dir, int rh) {
    float* base = (float*)F.lds;
    float *R = base, *K = R + RW_T, *V = K + RW_T, *KK = V + RW_T, *LW = KK + RW_T, *AA = LW + RW_T;
    bf16_t* W2T = (bf16_t*)(AA + RW_T); bf16_t* A2T = W2T + 64 * LDT; bf16_t* XW = A2T + 64 * LDT; bf16_t* XA = XW + 64 * LDT;
    float* YB = (float*)(XA + 64 * LDT);
    rw_stage_weights(F, h, W2T, A2T, nullptr, 1 << dir);
    float* YRW = F.out;
    const int q = F.lane & 15, rloc = F.wave * 4 + (F.lane >> 4), vrow = rh * 32 + rloc;
    float S[4] = {0.f, 0.f, 0.f, 0.f};
    const float ka0 = F.ap->in[I_RWKA][h * 64 + 4 * q + 0], ka1 = F.ap->in[I_RWKA][h * 64 + 4 * q + 1], ka2 = F.ap->in[I_RWKA][h * 64 + 4 * q + 2], ka3 = F.ap->in[I_RWKA][h * 64 + 4 * q + 3];
    const int nblk = T / 64;
    for (int kb = 0; kb < nblk; ++kb) {
        int blk; if (!dir) blk = kb; else blk = (kb < CTX / 64) ? (CTX / 64 - 1 - kb) : (nblk - 1 - (kb - CTX / 64));
        const int t0 = blk * 64;
        __syncthreads();
        rw_prep(F, b, h, t0, R, K, V, KK, dir ? nullptr : LW, dir ? nullptr : AA, dir ? LW : nullptr, dir ? AA : nullptr, nullptr, W2T, A2T, nullptr, XW, XA, nullptr, 1 << dir);
        for (int s = 0; s < 64; ++s) { const int tk = dir ? 63 - s : s; const float* kkp = KK + tk * 65 + 4 * q; const float* ap = AA + tk * 65 + 4 * q; const float* kp = K + tk * 65 + 4 * q;
            const float* lwp = LW + tk * 65 + 4 * q; const float* rp = R + tk * 65 + 4 * q;
            const float a0 = ap[0], a1 = ap[1], a2 = ap[2], a3 = ap[3];
            float sa = -(S[0] * kkp[0] + S[1] * kkp[1] + S[2] * kkp[2] + S[3] * kkp[3]);
            sa += shx<1>(sa); sa += shx<2>(sa); sa += shx<4>(sa); sa += shx<8>(sa);
            const float vv = V[tk * 65 + vrow];
            S[0] = S[0] * __expf(lwp[0]) + sa * (kkp[0] * a0) + vv * (kp[0] * (1.f + (a0 - 1.f) * ka0));
            S[1] = S[1] * __expf(lwp[1]) + sa * (kkp[1] * a1) + vv * (kp[1] * (1.f + (a1 - 1.f) * ka1));
            S[2] = S[2] * __expf(lwp[2]) + sa * (kkp[2] * a2) + vv * (kp[2] * (1.f + (a2 - 1.f) * ka2));
            S[3] = S[3] * __expf(lwp[3]) + sa * (kkp[3] * a3) + vv * (kp[3] * (1.f + (a3 - 1.f) * ka3));
            float y = S[0] * rp[0] + S[1] * rp[1] + S[2] * rp[2] + S[3] * rp[3];
            y += shx<1>(y); y += shx<2>(y); y += shx<4>(y); y += shx<8>(y);
            if (q == 0) YB[tk * 33 + rloc] = y; }
        __syncthreads();
        for (int i = F.tid; i < 64 * 32; i += NTHREADS) { const int tk = i >> 5, rr = i & 31; atomic_add_f32(YRW + (size_t)grow(b, t0 + tk) * 512 + h * 64 + rh * 32 + rr, YB[tk * 33 + rr]); }
    }
    __syncthreads();
}
DEVI void rw_finish_unit(const Frame& F, int b, int h, int blk) {
    float* base = (float*)F.lds;
    float *R = base, *K = R + RW_T, *V = K + RW_T, *G = V + RW_T, *AA0 = G + RW_T, *AA1 = AA0 + RW_T;
    bf16_t* A2T = (bf16_t*)(AA1 + RW_T); bf16_t* G2T = A2T + 2 * 64 * LDT; bf16_t* XA = G2T + 64 * LDK; bf16_t* XG = (bf16_t*)AA0;
    rw_stage_weights(F, h, nullptr, A2T, G2T, 3);
    __syncthreads();
    const int t0 = blk * 64;
    rw_prep(F, b, h, t0, R, K, V, nullptr, nullptr, AA0, nullptr, AA1, G, nullptr, A2T, G2T, nullptr, XA, XG, 3);
    const float* YRW = F.out; bf16_t* YM = (bf16_t*)(F.ws + WS_ACT);
    const int tok = F.tid >> 3, c8 = (F.tid & 7) * 8; const int row = grow(b, t0 + tok);
    float y[8]; float s = 0.f, bsum = 0.f;
#pragma unroll
    for (int e = 0; e < 8; ++e) { const int ch = c8 + e; y[e] = YRW[(size_t)row * 512 + h * 64 + ch]; s += y[e];
        const float r = R[tok * 65 + ch], k = K[tok * 65 + ch], ka = F.ap->in[I_RWKA][h * 64 + ch], rk = F.ap->in[I_RWRK][h * 64 + ch];
        const float kd0 = k * (1.f + (AA0[tok * 65 + ch] - 1.f) * ka), kd1 = k * (1.f + (AA1[tok * 65 + ch] - 1.f) * ka); bsum += r * (kd0 + kd1) * rk; }
    s += shx<1>(s); s += shx<2>(s); s += shx<4>(s); bsum += shx<1>(bsum); bsum += shx<2>(bsum); bsum += shx<4>(bsum);
    const float mu = s * (1.f / 64.f); float var = 0.f;
#pragma unroll
    for (int e = 0; e < 8; ++e) { const float dlt = y[e] - mu; var += dlt * dlt; }
    var = sum8(var);
    const float rs = RSQ(var * (1.f / 64.f) + 64e-5f); float o[8];
#pragma unroll
    for (int e = 0; e < 8; ++e) { const int ch = c8 + e; const float gn = (y[e] - mu) * rs * F.ap->in[I_RWLNW][h * 64 + ch] + F.ap->in[I_RWLNB][h * 64 + ch]; o[e] = (gn + bsum * V[tok * 65 + ch]) * G[tok * 65 + ch]; }
    *(bf16x8*)(YM + (size_t)row * D + 512 + h * 64 + c8) = pack8(o);
    __syncthreads();
}

DEVI void rw_finish2_unit(const Frame& F0, int b, int h, int blk) {
    const Frame F = unit_frame(F0);
    float* V = (float*)F.lds; float* G = V + RW_T; bf16_t* G2T = (bf16_t*)(G + RW_T); bf16_t* XG = G2T + 64 * LDK;
    const bf16_t* PROJ = (const bf16_t*)(F.ws + WS_BIG); const float* mu = F.ap->in[I_RWMU];
    const int r32 = F.lane & 31, hi = F.lane >> 5;
    __syncthreads();
    copy16(F, G2T, F.ws + WS_RWT + RWT_G2 + (size_t)h * 17408, 1088);
    const int t0 = blk * 64, tok = F.tid >> 3, c8 = (F.tid & 7) * 8, t = t0 + tok; const int row = grow(b, t);
    { float x[8]; rw_shift8(PROJ, mu + R_V + h * 64 + c8, b, t, R_V + h * 64 + c8, x);
#pragma unroll
      for (int e = 0; e < 8; ++e) V[tok * 65 + c8 + e] = x[e];
#pragma unroll
      for (int hf = 0; hf < 2; ++hf) { rw_shift8(PROJ, mu + R_GL + hf * 64 + c8, b, t, R_GL + hf * 64 + c8, x);
#pragma unroll
          for (int e = 0; e < 8; ++e) x[e] = sigmoidf_(x[e]);
          *(bf16x8*)(XG + tok * LDK + hf * 64 + c8) = pack8(x); } }
    __syncthreads();
    if (F.wave < 4) { const int tt = F.wave >> 1, et = F.wave & 1; f32x16 acc = (f32x16){};
#pragma unroll
        for (int ks = 0; ks < 8; ++ks) acc = mfma32(ld8(XG + (tt * 32 + r32) * LDK + ks * 16 + hi * 8), ld8(G2T + (et * 32 + r32) * LDK + ks * 16 + hi * 8), acc);
#pragma unroll
        for (int r = 0; r < 16; ++r) G[(tt * 32 + crow(r, hi)) * 65 + et * 32 + r32] = acc[r]; }
    __syncthreads();
    const float* YRW = F.out; bf16_t* YM = (bf16_t*)(F.ws + WS_ACT); const float* BON = (const float*)(F.ws + WS_RWT + RWT_BON);
    const float bsum = BON[(size_t)row * 16 + h * 2] + BON[(size_t)row * 16 + h * 2 + 1];
    float y[8]; float s = 0.f;
    { const f32x4 y0 = *(const f32x4*)(YRW + (size_t)row * 512 + h * 64 + c8), y1 = *(const f32x4*)(YRW + (size_t)row * 512 + h * 64 + c8 + 4);
#pragma unroll
      for (int e = 0; e < 4; ++e) { y[e] = y0[e]; y[4 + e] = y1[e]; } }
#pragma unroll
    for (int e = 0; e < 8; ++e) s += y[e];
    s = sum8(s);
    const float mean = s * (1.f / 64.f); float var = 0.f;
#pragma unroll
    for (int e = 0; e < 8; ++e) { const float dlt = y[e] - mean; var += dlt * dlt; }
    var = sum8(var);
    const float rs = RSQ(var * (1.f / 64.f) + 64e-5f); float o[8];
#pragma unroll
    for (int e = 0; e < 8; ++e) { const int ch = c8 + e; const float gn = (y[e] - mean) * rs * F.ap->in[I_RWLNW][h * 64 + ch] + F.ap->in[I_RWLNB][h * 64 + ch]; o[e] = (gn + bsum * V[tok * 65 + ch]) * G[tok * 65 + ch]; }
    *(bf16x8*)(YM + (size_t)row * D + 512 + h * 64 + c8) = pack8(o);
}

namespace rw2 {
constexpr int O_W2T = 0, O_A2T = 9216, O_AL = 18432, O_XW = O_AL, O_XA = O_AL + 9216, O_LW = O_AL + 18432, O_AA = O_LW + 16640;
constexpr int O_AAB = O_AL, O_AAK = O_AL + 9216, O_ARB = O_AL + 18432, O_ARK = O_AL + 27648, O_UT = O_AL + 36864;
constexpr int O_RN = 70144, O_GL = 70400, O_SEG = 70656, O_AT = 72704, O_BT = 81920, O_KT = 91136, O_RT = 100352, O_BTT = 109568, O_KTT = 118784, O_VT = 128000, O_S0B = 137216;
constexpr int O_CST = 159744;
constexpr int O_ABF_C = 146432;
static_assert(O_ABF_C + 8192 + 2 * 32 * 40 * 2 <= O_CST && O_CST + 10 * 64 * 4 <= 160 * 1024 - 256, "rw2 lds");
DEVI void stage_consts(const Frame& F, int h, int dir) { copy16(F, F.lds + O_CST, F.ws + WS_RWT + RWT_CST + (size_t)(dir * 8 + h) * 2560, 160); }
DEVI float* slot_ptr(const Frame& F, int slot) { return (slot < RW_NS1) ? (float*)(F.ws + WS_SCR + SC_RW + (size_t)slot * 32768) : (float*)((unsigned char*)F.out + OUT_RW + (size_t)(slot - RW_NS1) * 32768); }
struct RawPrep { bf16x8 x[5][3]; };
DEVI void prep_load(const Frame& F, int b, int h, int dir, int t0, RawPrep& R) {
    const bf16_t* PROJ = (const bf16_t*)(F.ws + WS_BIG);
    const int i = F.tid >> 3, c8 = (F.tid & 7) * 8, t = dir ? t0 + 63 - i : t0 + i;
    const int lo = (t < CTX) ? 0 : CTX, hi2 = (t < CTX) ? CTX : T; const int tm = (t - 1 >= lo) ? t - 1 : t, tp = (t + 1 < hi2) ? t + 1 : t;
    const int fo[5] = {R_R + h * 64, R_K + h * 64, R_V + h * 64, R_WL + dir * 64, R_AL + dir * 64};
#pragma unroll
    for (int f = 0; f < 5; ++f) { const size_t col = E_RF + fo[f] + c8;
        R.x[f][0] = ld8(PROJ + (size_t)grow(b, tm) * EVP + col); R.x[f][1] = ld8(PROJ + (size_t)grow(b, t) * EVP + col); R.x[f][2] = ld8(PROJ + (size_t)grow(b, tp) * EVP + col); }
}
DEVI void shift_raw(const bf16x8 (&x)[3], const float* mu8, bool has_m, bool has_p, float* out) {
    float x0[8], x1[8], x2[8]; unpack8(x[0], x0); unpack8(x[1], x1); unpack8(x[2], x2);
#pragma unroll
    for (int e = 0; e < 8; ++e) { const float a = has_m ? x0[e] : 0.f, c = has_p ? x2[e] : 0.f; out[e] = x1[e] + (0.5f * (a + c) - x1[e]) * mu8[e]; }
}
DEVI void prep(const Frame& F, int b, int h, int dir, int t0, const RawPrep& RP, float* bon = nullptr) {
    unsigned char* L = F.lds; const float* CST = (const float*)(L + O_CST);
    bf16_t* W2T = (bf16_t*)(L + O_W2T); bf16_t* A2T = (bf16_t*)(L + O_A2T); bf16_t* XW = (bf16_t*)(L + O_XW); bf16_t* XA = (bf16_t*)(L + O_XA);
    float* LW = (float*)(L + O_LW); float* AA = (float*)(L + O_AA); float* GL = (float*)(L + O_GL); float* SEG = (float*)(L + O_SEG);
    bf16_t* At = (bf16_t*)(L + O_AT); bf16_t* Bt = (bf16_t*)(L + O_BT); bf16_t* Kt = (bf16_t*)(L + O_KT); bf16_t* Rt = (bf16_t*)(L + O_RT);
    bf16_t* BtT = (bf16_t*)(L + O_BTT); bf16_t* KtT = (bf16_t*)(L + O_KTT); bf16_t* VT = (bf16_t*)(L + O_VT);
    const int i = F.tid >> 3, c8 = (F.tid & 7) * 8, t = dir ? t0 + 63 - i : t0 + i;
    const int r32 = F.lane & 31, hi = F.lane >> 5;
    float r[8], k[8], v[8], kkr[8];
    const bool has_m = (t - 1 >= ((t < CTX) ? 0 : CTX)), has_p = (t + 1 < ((t < CTX) ? CTX : T));
    shift_raw(RP.x[0], CST + 4 * 64 + c8, has_m, has_p, r); shift_raw(RP.x[1], CST + 5 * 64 + c8, has_m, has_p, k); shift_raw(RP.x[2], CST + 6 * 64 + c8, has_m, has_p, v);
    float ssq = 0.f;
#pragma unroll
    for (int e = 0; e < 8; ++e) { kkr[e] = k[e] * CST[c8 + e]; ssq += kkr[e] * kkr[e]; }
    ssq = sum8(ssq);
    const float rn = RSQ(ssq + 1e-12f);
    { float x[8]; shift_raw(RP.x[3], CST + 7 * 64 + c8, has_m, has_p, x);
#pragma unroll
      for (int e = 0; e < 8; ++e) x[e] = tanhf_(x[e]);
      *(bf16x8*)(XW + i * LDT + c8) = pack8(x);
      shift_raw(RP.x[4], CST + 8 * 64 + c8, has_m, has_p, x); *(bf16x8*)(XA + i * LDT + c8) = pack8(x); }
    __syncthreads();
    { const int which = F.wave >> 2, tt = (F.wave >> 1) & 1, et = F.wave & 1; const bf16_t* X = which ? XA : XW; const bf16_t* WT = which ? A2T : W2T;
      f32x16 acc = (f32x16){};
#pragma unroll
      for (int ks = 0; ks < 4; ++ks) acc = mfma32(ld8(X + (tt * 32 + r32) * LDT + ks * 16 + hi * 8), ld8(WT + (et * 32 + r32) * LDT + ks * 16 + hi * 8), acc);
      const int e = et * 32 + r32;
#pragma unroll
      for (int rr = 0; rr < 16; ++rr) { const int tk = tt * 32 + crow(rr, hi);
          if (!which) { const float wpre = CST[2 * 64 + e] + acc[rr]; LW[tk * 65 + e] = -0.6065306597126334f * sigmoidf_(wpre); }
          else AA[tk * 65 + e] = sigmoidf_(CST[3 * 64 + e] + acc[rr]); } }
    __syncthreads();
    { const int e = F.tid & 63, seg = F.tid >> 6; float x[8]; float a = 0.f;
#pragma unroll
      for (int j = 0; j < 8; ++j) x[j] = LW[(seg * 8 + j) * 65 + e];
#pragma unroll
      for (int j = 0; j < 8; ++j) { a += x[j]; x[j] = a; }
      SEG[seg * 64 + e] = a;
      __syncthreads();
      float off = 0.f;
#pragma unroll
      for (int s2 = 0; s2 < 7; ++s2) { const float sv = SEG[s2 * 64 + e]; off += (s2 < seg) ? sv : 0.f; }
#pragma unroll
      for (int j = 0; j < 8; ++j) LW[(seg * 8 + j) * 65 + e] = x[j] + off;
      if (seg == 7) GL[e] = __expf(x[7] + off); }
    __syncthreads();
    { float at[8], bt[8], kt[8], rt[8]; float bsum = 0.f;
#pragma unroll
      for (int e = 0; e < 8; ++e) { const int c = c8 + e; const float G = LW[i * 65 + c], Gp = (i > 0) ? LW[(i - 1) * 65 + c] : 0.f, aa = AA[i * 65 + c];
          const float kkn = kkr[e] * rn, eg = __expf(-G);
          const float kd = k[e] * (1.f + (aa - 1.f) * CST[64 + c]); bsum += r[e] * kd * CST[9 * 64 + c];
          at[e] = -kkn * __expf(Gp); bt[e] = kkn * aa * eg; kt[e] = kd * eg; rt[e] = r[e] * __expf(G); }
      if (bon) { bsum = sum8(bsum); if ((F.tid & 7) == 0) bon[(size_t)grow(b, t) * 16 + h * 2 + dir] = bsum; }
      const bf16x8 bp = pack8(bt), kp = pack8(kt), vp = pack8(v);
      *(bf16x8*)(At + i * LDT + c8) = pack8(at); *(bf16x8*)(Bt + i * LDT + c8) = bp; *(bf16x8*)(Kt + i * LDT + c8) = kp; *(bf16x8*)(Rt + i * LDT + c8) = pack8(rt);
      *(bf16x8*)(VT + i * LDT + c8) = vp; (void)BtT; (void)KtT; }
    __syncthreads();
}
DEVI void amats(const Frame& F, bool want_r, float* ABFd) {
    unsigned char* L = F.lds; const int r32 = F.lane & 31, hi = F.lane >> 5, pair = F.wave >> 2, tr = (F.wave >> 1) & 1, tc = F.wave & 1;
    if (pair == 0 || want_r) {
        const bf16_t* X = (const bf16_t*)(L + (pair ? O_RT : O_AT));
#pragma unroll
        for (int which = 0; which < 2; ++which) { const bf16_t* Y = (const bf16_t*)(L + (which ? O_KT : O_BT)); bf16_t* dst = (bf16_t*)(L + (pair ? (which ? O_ARK : O_ARB) : (which ? O_AAK : O_AAB)));
            f32x16 acc = (f32x16){};
            if (tc <= tr) {
#pragma unroll
                for (int ks = 0; ks < 4; ++ks) acc = mfma32(ld8(X + (tr * 32 + r32) * LDT + ks * 16 + hi * 8), ld8(Y + (tc * 32 + r32) * LDT + ks * 16 + hi * 8), acc); }
#pragma unroll
            for (int rr = 0; rr < 16; ++rr) { const int t = tr * 32 + crow(rr, hi), s2 = tc * 32 + r32; const bool keep = pair ? (s2 <= t) : (s2 < t); const float val = keep ? acc[rr] : 0.f;
                dst[t * LDT + s2] = (bf16_t)f2bf(val); if (pair == 0 && which == 0 && tr == tc) ABFd[tr * 1024 + crow(rr, hi) * 32 + r32] = val; } }
    }
    __syncthreads();
}
DEVI void tinv(const float* ABFd_in, const bf16_t* Aab, bf16_t* Tm, bf16_t* T0T, bf16_t* XT, int lane) {
    const int blk = lane >> 5, j = lane & 31, r32 = lane & 31, hi = lane >> 5;
    const float* Ab = ABFd_in + blk * 1024;
    float x[32];
#pragma unroll
    for (int t = 0; t < 32; ++t) { float a0 = (t == j) ? 1.f : 0.f, a1 = 0.f; const float* rowp = Ab + t * 32;
#ifndef HIPEMU
        if (t >= 2) asm volatile("" : "+v"(rowp), "+v"(x[t - 2]));
#endif
#pragma unroll
        for (int c = 0; c < (t + 3) / 4; ++c) { const f32x4 a = *(const f32x4*)(rowp + c * 4);
#pragma unroll
            for (int e = 0; e < 4; ++e) if (c * 4 + e < t) { if (c & 1) a1 += a[e] * x[c * 4 + e]; else a0 += a[e] * x[c * 4 + e]; } }
        x[t] = a0 + a1; }
#pragma unroll
    for (int s2 = 0; s2 < 32; ++s2) { Tm[(blk * 32 + s2) * LDT + blk * 32 + j] = (bf16_t)f2bf(x[s2]); if (blk) Tm[s2 * LDT + 32 + j] = 0; }
    if (!blk) {
#pragma unroll
        for (int c = 0; c < 4; ++c) { float y[8];
#pragma unroll
            for (int e = 0; e < 8; ++e) y[e] = x[c * 8 + e];
            *(bf16x8*)(T0T + j * 40 + c * 8) = pack8(y); } }
    WAVE_SYNC();
    f32x16 acc = (f32x16){};
#pragma unroll
    for (int ks = 0; ks < 2; ++ks) acc = mfma32(ld8(Aab + (32 + r32) * LDT + ks * 16 + hi * 8), ld8(T0T + r32 * 40 + ks * 16 + hi * 8), acc);
#pragma unroll
    for (int rr = 0; rr < 16; ++rr) XT[r32 * 40 + crow(rr, hi)] = (bf16_t)f2bf(acc[rr]);
    WAVE_SYNC();
    acc = (f32x16){};
#pragma unroll
    for (int ks = 0; ks < 2; ++ks) acc = mfma32(ld8(Tm + (32 + r32) * LDT + 32 + ks * 16 + hi * 8), ld8(XT + r32 * 40 + ks * 16 + hi * 8), acc);
#pragma unroll
    for (int rr = 0; rr < 16; ++rr) Tm[(32 + crow(rr, hi)) * LDT + r32] = (bf16_t)f2bf(acc[rr]);
}
DEVI f32x16 mm64(const bf16_t* X, int x0, const bf16_t* Y, int y0, f32x16 acc, int r32, int hi) {
#pragma unroll
    for (int ks = 0; ks < 4; ++ks) acc = mfma32(ld8(X + (x0 + r32) * LDT + ks * 16 + hi * 8), ld8(Y + (y0 + r32) * LDT + ks * 16 + hi * 8), acc);
    return acc;
}
DEVI f32x16 mm64_yt(const bf16_t* X, int x0, const bf16_t* Yr, int y0, f32x16 acc, int r32, int hi, int lane) {
#pragma unroll
    for (int ks = 0; ks < 4; ++ks) acc = mfma32(ld8(X + (x0 + r32) * LDT + ks * 16 + hi * 8), ld_tr_B(Yr, LDT, ks * 16, y0, lane), acc);
    return acc;
}
DEVI f32x16 mm64_xyt(const bf16_t* Xr, int x0, const bf16_t* Yr, int y0, f32x16 acc, int lane) {
#pragma unroll
    for (int ks = 0; ks < 4; ++ks) acc = mfma32(ld_tr_B(Xr, LDT, ks * 16, x0, lane), ld_tr_B(Yr, LDT, ks * 16, y0, lane), acc);
    return acc;
}
DEVI void st_tile_T(bf16_t* dst, int t0, int v0, const f32x16& acc, int r32, int hi) {
#pragma unroll
    for (int g = 0; g < 4; ++g) { u32x2 w; w[0] = pk2(acc[4 * g], acc[4 * g + 1]); w[1] = pk2(acc[4 * g + 2], acc[4 * g + 3]); *(u32x2*)(dst + (v0 + r32) * LDT + t0 + 8 * g + 4 * hi) = w; }
}
DEVI void phaseA_unit(const Frame& F0, int b, int h, int dir, int c) {
    unsigned char* L = F0.lds; const int part = F0.wave >> 2, vr = (F0.wave >> 1) & 1, dc = F0.wave & 1;
    bf16_t* S0b = (bf16_t*)(L + O_S0B); float* ABFd = (float*)(L + O_ARB); bf16_t* T0T = (bf16_t*)(L + O_ARB + 8192); bf16_t* XT = T0T + 32 * 40; bf16_t* Tm = (bf16_t*)(L + O_KT);
    f32x16 S;
    { const Frame F = unit_frame(F0); const int r32 = F.lane & 31, hi = F.lane >> 5;
      rw_stage_weights(F, h, (bf16_t*)(L + O_W2T), (bf16_t*)(L + O_A2T), nullptr, 1 << dir); stage_consts(F, h, dir);
#pragma unroll
      for (int rr = 0; rr < 16; ++rr) { const int v = vr * 32 + crow(rr, hi), d = dc * 32 + r32; S[rr] = (part == 0 && v == d) ? 1.f : 0.f; S0b[(part * 64 + v) * LDT + d] = (bf16_t)f2bf(S[rr]); } }
    __syncthreads();
    RawPrep rcur, rnxt;
    { const Frame F = unit_frame(F0); prep_load(F, b, h, dir, c * 256 + (dir ? 3 : 0) * 64, rcur); }
#pragma unroll 1
    for (int sbi = 0; sbi < 4; ++sbi) { const int sub = dir ? 3 - sbi : sbi; const int t0 = c * 256 + sub * 64;
        const Frame F = unit_frame(F0);
        const int r32 = F.lane & 31, hi = F.lane >> 5;
        if (sbi < 3) prep_load(F, b, h, dir, c * 256 + (dir ? 2 - sbi : sbi + 1) * 64, rnxt);
        prep(F, b, h, dir, t0, rcur);
        rcur = rnxt;
        amats(F, false, ABFd);
        if (F.wave == 0) tinv(ABFd, (const bf16_t*)(L + O_AAB), Tm, T0T, XT, F.lane);
        { f32x16 acc = (f32x16){};
          acc = mm64((const bf16_t*)(L + O_AT), vr * 32, S0b + part * 64 * LDT, dc * 32, acc, r32, hi);
          if (part) acc = mm64((const bf16_t*)(L + O_AAK), vr * 32, (const bf16_t*)(L + O_VT), dc * 32, acc, r32, hi);
          st_tile_T((bf16_t*)(L + (part ? O_RT : O_BT)), vr * 32, dc * 32, acc, r32, hi); }
        __syncthreads();
        { f32x16 u = (f32x16){};
          u = mm64(Tm, vr * 32, (const bf16_t*)(L + (part ? O_RT : O_BT)), dc * 32, u, r32, hi);
          __syncthreads();
          st_tile_T((bf16_t*)(L + (part ? O_AT : O_UT)), vr * 32, dc * 32, u, r32, hi); }
        __syncthreads();
        { const bf16_t* UT = (const bf16_t*)(L + (part ? O_AT : O_UT));
          S = mm64(UT, vr * 32, (const bf16_t*)(L + O_BTT), dc * 32, S, r32, hi);
          if (part) S = mm64((const bf16_t*)(L + O_VT), vr * 32, (const bf16_t*)(L + O_KTT), dc * 32, S, r32, hi);
          const float gl = ((const float*)(L + O_GL))[dc * 32 + r32];
#pragma unroll
          for (int rr = 0; rr < 16; ++rr) { S[rr] *= gl; S0b[(part * 64 + vr * 32 + crow(rr, hi)) * LDT + dc * 32 + r32] = (bf16_t)f2bf(S[rr]); } }
        __syncthreads();
    }
    { const Frame F = unit_frame(F0); const int r32 = F.lane & 31, hi = F.lane >> 5;
      float* slot = slot_ptr(F, ((b * 8 + h) * 2 + dir) * NCH + c);
#pragma unroll
      for (int rr = 0; rr < 16; ++rr) slot[(part * 64 + vr * 32 + crow(rr, hi)) * 64 + dc * 32 + r32] = S[rr]; }
    __syncthreads();
}
constexpr int O_T0T = O_AL + 46080, O_XT = O_AL + 48640;
DEVI void amats4(const Frame& F) {
    unsigned char* L = F.lds; const int r32 = F.lane & 31, hi = F.lane >> 5, pair = F.wave >> 2, tr = (F.wave >> 1) & 1, tc = F.wave & 1;
    const bf16_t* X = (const bf16_t*)(L + (pair ? O_RT : O_AT));
#pragma unroll
    for (int which = 0; which < 2; ++which) { const bf16_t* Y = (const bf16_t*)(L + (which ? O_KT : O_BT)); bf16_t* dst = (bf16_t*)(L + (pair ? (which ? O_ARK : O_ARB) : (which ? O_AAK : O_AAB)));
        f32x16 acc = (f32x16){};
        if (tc <= tr) {
#pragma unroll
            for (int ks = 0; ks < 4; ++ks) acc = mfma32(ld8(Y + (tc * 32 + r32) * LDT + ks * 16 + hi * 8), ld8(X + (tr * 32 + r32) * LDT + ks * 16 + hi * 8), acc); }
        const int t = tr * 32 + r32;
#pragma unroll
        for (int g = 0; g < 4; ++g) { float v[4];
#pragma unroll
            for (int e = 0; e < 4; ++e) { const int s2 = tc * 32 + 8 * g + 4 * hi + e; const bool keep = pair ? (s2 <= t) : (s2 < t); v[e] = keep ? acc[4 * g + e] : 0.f; }
            u32x2 w; w[0] = pk2(v[0], v[1]); w[1] = pk2(v[2], v[3]); *(u32x2*)(dst + t * LDT + tc * 32 + 8 * g + 4 * hi) = w; } }
    __syncthreads();
}
DEVI void tinv_b(const bf16_t* Aab_in, bf16_t* Tm, bf16_t* T0T, bf16_t* XT, int lane) {
    const int blk = lane >> 5, j = lane & 31, r32 = lane & 31, hi = lane >> 5;
    const bf16_t* Ab = Aab_in + (blk * 32) * LDT + blk * 32;
    float x[32];
#pragma unroll
    for (int t = 0; t < 32; ++t) { float a0 = (t == j) ? 1.f : 0.f, a1 = 0.f; const bf16_t* rowp = Ab + t * LDT;
#ifndef HIPEMU
        if (t >= 2) asm volatile("" : "+v"(rowp), "+v"(x[t - 2]));
#endif
#pragma unroll
        for (int c = 0; c < (t + 7) / 8; ++c) { float a[8]; unpack8(ld8(rowp + c * 8), a);
#pragma unroll
            for (int e = 0; e < 8; ++e) if (c * 8 + e < t) { if (e & 1) a1 += a[e] * x[c * 8 + e]; else a0 += a[e] * x[c * 8 + e]; } }
        x[t] = a0 + a1; }
#pragma unroll
    for (int s2 = 0; s2 < 32; ++s2) { Tm[(blk * 32 + s2) * LDT + blk * 32 + j] = (bf16_t)f2bf(x[s2]); if (blk) Tm[s2 * LDT + 32 + j] = 0; }
    if (!blk) {
#pragma unroll
        for (int c = 0; c < 4; ++c) { float y[8];
#pragma unroll
            for (int e = 0; e < 8; ++e) y[e] = x[c * 8 + e];
            *(bf16x8*)(T0T + j * 40 + c * 8) = pack8(y); } }
    WAVE_SYNC();
    f32x16 acc = (f32x16){};
#pragma unroll
    for (int ks = 0; ks < 2; ++ks) acc = mfma32(ld8(Aab_in + (32 + r32) * LDT + ks * 16 + hi * 8), ld8(T0T + r32 * 40 + ks * 16 + hi * 8), acc);
#pragma unroll
    for (int rr = 0; rr < 16; ++rr) XT[r32 * 40 + crow(rr, hi)] = (bf16_t)f2bf(acc[rr]);
    WAVE_SYNC();
    acc = (f32x16){};
#pragma unroll
    for (int ks = 0; ks < 2; ++ks) acc = mfma32(ld8(Tm + (32 + r32) * LDT + 32 + ks * 16 + hi * 8), ld8(XT + r32 * 40 + ks * 16 + hi * 8), acc);
#pragma unroll
    for (int rr = 0; rr < 16; ++rr) Tm[(32 + crow(rr, hi)) * LDT + r32] = (bf16_t)f2bf(acc[rr]);
}
DEVI bf16x8 accfrag(const f32x16& X, int s2) { float x[8];
#pragma unroll
    for (int e = 0; e < 8; ++e) x[e] = X[8 * s2 + e];
    return pack8(x); }
DEVI bf16x8 ldk(const bf16_t* rowp, int s2, int hi) { const u32x2 lo = *(const u32x2*)(rowp + 16 * s2 + 4 * hi), h2 = *(const u32x2*)(rowp + 16 * s2 + 8 + 4 * hi); u32x4 w; w[0] = lo[0]; w[1] = lo[1]; w[2] = h2[0]; w[3] = h2[1]; return __builtin_bit_cast(bf16x8, w); }
DEVI void inv32(const bf16_t* Ab, f32x16& Tm_, f32x16& Tt_, int n, int hi) {
    f32x16 S, St;
#pragma unroll
    for (int r = 0; r < 16; ++r) S[r] = bf2f(Ab[crow(r, hi) * LDT + n]);
#pragma unroll
    for (int g = 0; g < 4; ++g) { const u32x2 w = *(const u32x2*)(Ab + n * LDT + 8 * g + 4 * hi); const unsigned a = w[0], b2 = w[1]; St[4 * g] = bf2f(a); St[4 * g + 1] = bf2f(a >> 16); St[4 * g + 2] = bf2f(b2); St[4 * g + 3] = bf2f(b2 >> 16); }
    Tm_ = S; Tt_ = St;
#pragma unroll
    for (int r = 0; r < 16; ++r) { const float d = (crow(r, hi) == n) ? 1.f : 0.f; Tm_[r] += d; Tt_[r] += d; }
#pragma unroll
    for (int k = 0; k < 4; ++k) {
        { const bf16x8 fs0 = accfrag(S, 0), fs1 = accfrag(S, 1), ft0 = accfrag(St, 0), ft1 = accfrag(St, 1);
          f32x16 Sn = (f32x16){}; Sn = mfma32(ft0, fs0, Sn); Sn = mfma32(ft1, fs1, Sn);
          f32x16 Stn = (f32x16){}; Stn = mfma32(fs0, ft0, Stn); Stn = mfma32(fs1, ft1, Stn);
          S = Sn; St = Stn; }
        { const bf16x8 fs0 = accfrag(S, 0), fs1 = accfrag(S, 1), ft0 = accfrag(Tt_, 0), ft1 = accfrag(Tt_, 1);
          Tm_ = mfma32(ft0, fs0, Tm_); Tm_ = mfma32(ft1, fs1, Tm_);
          Tt_ = mfma32(fs0, ft0, Tt_); Tt_ = mfma32(fs1, ft1, Tt_); } }
}
DEVI void tinv_mfma(const bf16_t* Aab, bf16_t* Tm, int lane) {
    const int n = lane & 31, hi = lane >> 5;
    f32x16 X = (f32x16){};
    { f32x16 T0, T0t; inv32(Aab, T0, T0t, n, hi);
#pragma unroll
      for (int s2 = 0; s2 < 2; ++s2) X = mfma32(ldk(Aab + (32 + n) * LDT, s2, hi), accfrag(T0, s2), X);
#pragma unroll
      for (int g = 0; g < 4; ++g) { u32x2 w; w[0] = pk2(T0t[4 * g], T0t[4 * g + 1]); w[1] = pk2(T0t[4 * g + 2], T0t[4 * g + 3]); *(u32x2*)(Tm + n * LDT + 8 * g + 4 * hi) = w;
          u32x2 z; z[0] = 0u; z[1] = 0u; *(u32x2*)(Tm + n * LDT + 32 + 8 * g + 4 * hi) = z; } }
    { f32x16 T1, T1t; inv32(Aab + 32 * LDT + 32, T1, T1t, n, hi);
      f32x16 T10 = (f32x16){};
#pragma unroll
      for (int s2 = 0; s2 < 2; ++s2) T10 = mfma32(accfrag(T1t, s2), accfrag(X, s2), T10);
#pragma unroll
      for (int g = 0; g < 4; ++g) { u32x2 w; w[0] = pk2(T1t[4 * g], T1t[4 * g + 1]); w[1] = pk2(T1t[4 * g + 2], T1t[4 * g + 3]); *(u32x2*)(Tm + (32 + n) * LDT + 32 + 8 * g + 4 * hi) = w; }
#pragma unroll
      for (int r = 0; r < 16; ++r) Tm[(32 + crow(r, hi)) * LDT + n] = (bf16_t)f2bf(T10[r]); }
}
DEVI void tinv_half(const bf16_t* Aab, bf16_t* Tm, bf16_t* XL, int which, int lane) {
    const int n = lane & 31, hi = lane >> 5;
    f32x16 Tq, Tqt; inv32(Aab + which * (32 * LDT + 32), Tq, Tqt, n, hi);
#pragma unroll
    for (int g = 0; g < 4; ++g) { u32x2 w; w[0] = pk2(Tqt[4 * g], Tqt[4 * g + 1]); w[1] = pk2(Tqt[4 * g + 2], Tqt[4 * g + 3]); *(u32x2*)(Tm + (which * 32 + n) * LDT + which * 32 + 8 * g + 4 * hi) = w; }
    if (!which) { f32x16 X = (f32x16){};
#pragma unroll
        for (int s2 = 0; s2 < 2; ++s2) X = mfma32(ldk(Aab + (32 + n) * LDT, s2, hi), accfrag(Tq, s2), X);
#pragma unroll
        for (int r = 0; r < 16; ++r) XL[crow(r, hi) * LDT + n] = (bf16_t)f2bf(X[r]); }
}
DEVI void heavy_unit(const Frame& F0, int b, int h, int dir, int c) {
    unsigned char* L = F0.lds; const int part = F0.wave >> 2, vr = (F0.wave >> 1) & 1, dc = F0.wave & 1;
    bf16_t* S0b = (bf16_t*)(L + O_S0B); bf16_t* Tm = (bf16_t*)(L + O_BTT);
    const int stream = (b * 8 + h) * 2 + dir; float* YRW = F0.out; float* BON = (float*)(F0.ws + WS_RWT + RWT_BON);
    f32x16 S;
    RawPrep rcur;
    { const Frame F = unit_frame(F0); prep_load(F, b, h, dir, c * 256 + (dir ? 3 : 0) * 64, rcur); }
    { const Frame F = unit_frame(F0); const int r32 = F.lane & 31, hi = F.lane >> 5;
      copy16(F, L + O_W2T, F.ws + WS_RWT + RWT_W2 + (size_t)(dir * 8 + h) * 9216, 576); copy16(F, L + O_A2T, F.ws + WS_RWT + RWT_A2 + (size_t)(dir * 8 + h) * 9216, 576); stage_consts(F, h, dir);
#pragma unroll
      for (int rr = 0; rr < 16; ++rr) { const int v = vr * 32 + crow(rr, hi), d = dc * 32 + r32; S[rr] = (part == 0 && v == d) ? 1.f : 0.f; S0b[(part * 64 + v) * LDT + d] = (bf16_t)f2bf(S[rr]); } }
    __syncthreads();
#pragma unroll 1
    for (int sbi = 0; sbi < 4; ++sbi) { const int sub = dir ? 3 - sbi : sbi; const int t0 = c * 256 + sub * 64;
        const Frame F = unit_frame(F0);
        const int r32 = F.lane & 31, hi = F.lane >> 5;
        prep(F, b, h, dir, t0, rcur, BON);
        amats4(F);
        if (F.wave < 2) tinv_half((const bf16_t*)(L + O_AAB), Tm, (bf16_t*)(L + O_KTT), F.wave, F.lane);
        f32x16 W0 = (f32x16){}, W1 = (f32x16){};
        W0 = mm64((const bf16_t*)(L + O_AT), 0, S0b + part * 64 * LDT, dc * 32, W0, r32, hi); W1 = mm64((const bf16_t*)(L + O_AT), 32, S0b + part * 64 * LDT, dc * 32, W1, r32, hi);
        if (part) { W0 = mm64_yt((const bf16_t*)(L + O_AAK), 0, (const bf16_t*)(L + O_VT), dc * 32, W0, r32, hi, F.lane); W1 = mm64_yt((const bf16_t*)(L + O_AAK), 32, (const bf16_t*)(L + O_VT), dc * 32, W1, r32, hi, F.lane); }
        __syncthreads();
        if (sbi < 3) prep_load(F, b, h, dir, c * 256 + (dir ? 2 - sbi : sbi + 1) * 64, rcur);
        { f32x16 u = (f32x16){}; const bf16_t* trow = Tm + (vr * 32 + r32) * LDT;
#pragma unroll
          for (int s2 = 0; s2 < 2; ++s2) u = mfma32(ldk(vr ? (const bf16_t*)(L + O_KTT) + r32 * LDT : trow, s2, hi), accfrag(W0, s2), u);
          if (vr) {
#pragma unroll
              for (int e = 0; e < 16; ++e) W1[e] += u[e];
              u = (f32x16){};
#pragma unroll
              for (int s2 = 0; s2 < 2; ++s2) u = mfma32(ldk(trow + 32, s2, hi), accfrag(W1, s2), u); }
          st_tile_T((bf16_t*)(L + (part ? O_AT : O_UT)), vr * 32, dc * 32, u, r32, hi); }
        __syncthreads();
        { const bf16_t* UT = (const bf16_t*)(L + (part ? O_AT : O_UT));
          f32x16 y = (f32x16){};
          y = mm64((const bf16_t*)(L + O_RT), vr * 32, S0b + part * 64 * LDT, dc * 32, y, r32, hi);
          y = mm64((const bf16_t*)(L + O_ARB), vr * 32, UT, dc * 32, y, r32, hi);
          if (part) { y = mm64_yt((const bf16_t*)(L + O_ARK), vr * 32, (const bf16_t*)(L + O_VT), dc * 32, y, r32, hi, F.lane);
#pragma unroll
              for (int rr = 0; rr < 16; ++rr) { const int i = vr * 32 + crow(rr, hi), tok = dir ? t0 + 63 - i : t0 + i; atomic_add_f32(YRW + (size_t)grow(b, tok) * 512 + h * 64 + dc * 32 + r32, y[rr]); } }
          else { bf16_t* Z = (bf16_t*)(F.ws + WS_ACT) + ((size_t)(stream * NCH + c) * 4 + sbi) * 4096;
#pragma unroll
              for (int rr = 0; rr < 16; ++rr) Z[(vr * 32 + crow(rr, hi)) * 64 + dc * 32 + r32] = (bf16_t)f2bf(y[rr]); }
          S = mm64_yt(UT, vr * 32, (const bf16_t*)(L + O_BT), dc * 32, S, r32, hi, F.lane);
          if (part) S = mm64_xyt((const bf16_t*)(L + O_VT), vr * 32, (const bf16_t*)(L + O_KT), dc * 32, S, F.lane);
          const float gl = ((const float*)(L + O_GL))[dc * 32 + r32];
#pragma unroll
          for (int rr = 0; rr < 16; ++rr) S[rr] *= gl; }
        __syncthreads();
#pragma unroll
        for (int rr = 0; rr < 16; ++rr) S0b[(part * 64 + vr * 32 + crow(rr, hi)) * LDT + dc * 32 + r32] = (bf16_t)f2bf(S[rr]);
    }
    { const Frame F = unit_frame(F0); const int r32 = F.lane & 31, hi = F.lane >> 5;
      float* slot = slot_ptr(F, stream * NCH + c);
#pragma unroll
      for (int rr = 0; rr < 16; ++rr) slot[(part * 64 + vr * 32 + crow(rr, hi)) * 64 + dc * 32 + r32] = S[rr]; }
    __syncthreads();
}
DEVI void fixup_unit(const Frame& F0, int stream, int c) {
    const Frame F = unit_frame(F0);
    unsigned char* L = F.lds; bf16_t* Sb = (bf16_t*)L; bf16_t* Cz = (bf16_t*)(L + 9216);
    const int r32 = F.lane & 31, hi = F.lane >> 5, half = F.wave >> 2, tr = (F.wave >> 1) & 1, vc = F.wave & 1;
    const int dir = stream & 1, h = (stream >> 1) & 7, b = stream >> 4; float* YRW = F.out;
    const float* Sin = slot_ptr(F, stream * NCH + c) + 4096; const bf16_t* Zb = (const bf16_t*)(F.ws + WS_ACT) + (size_t)(stream * NCH + c) * 4 * 4096;
    const int sv = F.tid >> 3, j8 = (F.tid & 7) * 8, zw = F.tid >> 8, zt = (F.tid & 255) >> 2, q16 = (F.tid & 3) * 16;
    const f32x4 a = *(const f32x4*)(Sin + sv * 64 + j8), a2 = *(const f32x4*)(Sin + sv * 64 + j8 + 4);
    bf16x8 z[2][2];
#pragma unroll
    for (int rnd = 0; rnd < 2; ++rnd) { const bf16_t* zp = Zb + (size_t)(rnd * 2 + zw) * 4096 + zt * 64 + q16; z[rnd][0] = ld8(zp); z[rnd][1] = ld8(zp + 8); }
    __syncthreads();
    { float x[8];
#pragma unroll
      for (int e = 0; e < 4; ++e) { x[e] = a[e]; x[4 + e] = a2[e]; }
      *(bf16x8*)(Sb + sv * LDT + j8) = pack8(x); }
#pragma unroll
    for (int rnd = 0; rnd < 2; ++rnd) { bf16_t* cz = Cz + ((rnd * 2 + zw) * 64 + zt) * LDT + q16; *(bf16x8*)cz = z[rnd][0]; *(bf16x8*)(cz + 8) = z[rnd][1]; }
    __syncthreads();
#pragma unroll 1
    for (int rnd = 0; rnd < 2; ++rnd) {
        const int sbi = rnd * 2 + half, sub = dir ? 3 - sbi : sbi, t0 = c * 256 + sub * 64;
        f32x16 y = (f32x16){}; y = mm64(Cz + sbi * 64 * LDT, tr * 32, Sb, vc * 32, y, r32, hi);
#pragma unroll
        for (int rr = 0; rr < 16; ++rr) { const int i = tr * 32 + crow(rr, hi), tok = dir ? t0 + 63 - i : t0 + i; atomic_add_f32(YRW + (size_t)grow(b, tok) * 512 + h * 64 + vc * 32 + r32, y[rr]); }
    }
}
DEVI void phaseB(const Frame& F) {
    constexpr int SLD = 66, MLD = 80;
    float* Sl = (float*)F.lds; float* Ml = Sl + 16 * SLD; float* Nl = Ml + 64 * MLD;
    const int v = F.tid >> 5, d2 = (F.tid & 31) * 2, lj = F.lane & 15, lq = F.lane >> 4;
    for (int item = F.G - 1 - F.bid; item < NSTR_RW * 4; item += F.G) { const int stream = item >> 2, q = item & 3, dir = stream & 1;
        __syncthreads();
        for (int i = F.tid; i < 16 * SLD; i += NTHREADS) Sl[i] = 0.f;
        f32x4 pm0, pm1, pn = (f32x4){}, qm0, qm1, qn = (f32x4){}, rm0, rm1, rn = (f32x4){};
#define RWB_LD(M0, M1, NN, kk) do { const float* ns_ = slot_ptr(F, stream * NCH + ml_chunk_at(dir, (kk))); M0 = ((const f32x4*)ns_)[F.tid]; M1 = ((const f32x4*)ns_)[512 + F.tid]; if (F.tid < 256) NN = ((const f32x4*)(ns_ + 4096 + q * 1024))[F.tid]; } while (0)
        RWB_LD(pm0, pm1, pn, 0); qm0 = pm0; qm1 = pm1; rm0 = pm0; rm1 = pm1;
        if (1 < NCH) RWB_LD(qm0, qm1, qn, 1);
        if (2 < NCH) RWB_LD(rm0, rm1, rn, 2);
        for (int k = 0; k < NCH; ++k) { const int c = ml_chunk_at(dir, k); float* slot = slot_ptr(F, stream * NCH + c);
            __syncthreads();
            *(f32x4*)(Ml + (F.tid >> 4) * MLD + (F.tid & 15) * 4) = pm0; *(f32x4*)(Ml + (32 + (F.tid >> 4)) * MLD + (F.tid & 15) * 4) = pm1; if (F.tid < 256) ((f32x4*)Nl)[F.tid] = pn;
            pm0 = qm0; pm1 = qm1; pn = qn; qm0 = rm0; qm1 = rm1; qn = rn;
            if (k + 3 < NCH) RWB_LD(rm0, rm1, rn, k + 3);
            __syncthreads();
            f32x4 acc = (f32x4){};
            if (F.wave < 4) {
#pragma unroll
                for (int r = 0; r < 4; ++r) acc[r] = Nl[(4 * lq + r) * 64 + 16 * F.wave + lj];
#pragma unroll
                for (int kk = 0; kk < 16; ++kk) acc = mfma16f(Sl[lj * SLD + 4 * kk + lq], Ml[(4 * kk + lq) * MLD + 16 * F.wave + lj], acc); }
            slot[4096 + (q * 16 + v) * 64 + d2] = Sl[v * SLD + d2]; slot[4096 + (q * 16 + v) * 64 + d2 + 1] = Sl[v * SLD + d2 + 1];
            __syncthreads();
            if (F.wave < 4) {
#pragma unroll
                for (int r = 0; r < 4; ++r) Sl[(4 * lq + r) * SLD + 16 * F.wave + lj] = acc[r]; }
        }
    }
    __syncthreads();
}
DEVI void phaseC_unit(const Frame& F0, int b, int h, int dir, int c) {
    unsigned char* L = F0.lds; const int half = F0.wave >> 2, vr = (F0.wave >> 1) & 1, dc = F0.wave & 1;
    bf16_t* S0b = (bf16_t*)(L + O_S0B); float* ABFd = (float*)(L + O_ABF_C); bf16_t* T0T = (bf16_t*)(L + O_ABF_C + 8192); bf16_t* XT = T0T + 32 * 40; bf16_t* Tm = (bf16_t*)(L + O_KT);
    float* YRW = F0.out;
    f32x16 S = (f32x16){};
    { const Frame F = unit_frame(F0); const int r32 = F.lane & 31, hi = F.lane >> 5;
      rw_stage_weights(F, h, (bf16_t*)(L + O_W2T), (bf16_t*)(L + O_A2T), nullptr, 1 << dir); stage_consts(F, h, dir);
      const float* Sin = slot_ptr(F, ((b * 8 + h) * 2 + dir) * NCH + c) + 4096;
      if (half == 1) {
#pragma unroll
        for (int rr = 0; rr < 16; ++rr) { const int v = vr * 32 + crow(rr, hi), d = dc * 32 + r32; S[rr] = Sin[v * 64 + d]; S0b[v * LDT + d] = (bf16_t)f2bf(S[rr]); } } }
    __syncthreads();
    RawPrep rcur, rnxt;
    { const Frame F = unit_frame(F0); prep_load(F, b, h, dir, c * 256 + (dir ? 3 : 0) * 64, rcur); }
#pragma unroll 1
    for (int sbi = 0; sbi < 4; ++sbi) { const int sub = dir ? 3 - sbi : sbi; const int t0 = c * 256 + sub * 64;
        const Frame F = unit_frame(F0);
        const int r32 = F.lane & 31, hi = F.lane >> 5;
        if (sbi < 3) prep_load(F, b, h, dir, c * 256 + (dir ? 2 - sbi : sbi + 1) * 64, rnxt);
        prep(F, b, h, dir, t0, rcur);
        rcur = rnxt;
        amats(F, true, ABFd);
        if (F.wave == 4) tinv(ABFd, (const bf16_t*)(L + O_AAB), Tm, T0T, XT, F.lane);
        if (half == 0) { f32x16 acc = (f32x16){};
          acc = mm64((const bf16_t*)(L + O_AT), vr * 32, S0b, dc * 32, acc, r32, hi);
          acc = mm64((const bf16_t*)(L + O_AAK), vr * 32, (const bf16_t*)(L + O_VT), dc * 32, acc, r32, hi);
          st_tile_T((bf16_t*)(L + O_BT), vr * 32, dc * 32, acc, r32, hi); }
        __syncthreads();
        if (half == 0) { f32x16 u = (f32x16){}; u = mm64(Tm, vr * 32, (const bf16_t*)(L + O_BT), dc * 32, u, r32, hi); st_tile_T((bf16_t*)(L + O_UT), vr * 32, dc * 32, u, r32, hi); }
        __syncthreads();
        if (half == 0) {
            f32x16 y = (f32x16){};
            y = mm64((const bf16_t*)(L + O_RT), vr * 32, S0b, dc * 32, y, r32, hi);
            y = mm64((const bf16_t*)(L + O_ARB), vr * 32, (const bf16_t*)(L + O_UT), dc * 32, y, r32, hi);
            y = mm64((const bf16_t*)(L + O_ARK), vr * 32, (const bf16_t*)(L + O_VT), dc * 32, y, r32, hi);
#pragma unroll
            for (int rr = 0; rr < 16; ++rr) { const int i = vr * 32 + crow(rr, hi), tok = dir ? t0 + 63 - i : t0 + i; atomic_add_f32(YRW + (size_t)grow(b, tok) * 512 + h * 64 + dc * 32 + r32, y[rr]); }
        } else {
            S = mm64((const bf16_t*)(L + O_UT), vr * 32, (const bf16_t*)(L + O_BTT), dc * 32, S, r32, hi);
            S = mm64((const bf16_t*)(L + O_VT), vr * 32, (const bf16_t*)(L + O_KTT), dc * 32, S, r32, hi);
            const float gl = ((const float*)(L + O_GL))[dc * 32 + r32];
#pragma unroll
            for (int rr = 0; rr < 16; ++rr) S[rr] *= gl;
        }
        __syncthreads();
        if (half == 1) {
#pragma unroll
            for (int rr = 0; rr < 16; ++rr) S0b[(vr * 32 + crow(rr, hi)) * LDT + dc * 32 + r32] = (bf16_t)f2bf(S[rr]); }
        __syncthreads();
    }
}
}

constexpr float HG_QSCALE = 0.08838834764831845f;
constexpr int LDS32 = 40;
DEVI float hg_lb(const Frame& F, int ch) { return sigmoidf_(F.ap->in[I_HGLB][512 + ch] - F.ap->in[I_HGLB][ch]); }
DEVI void hg_fk(float pre, float lb, float& lf, float& k) { const float sg = sigmoidf_(pre); lf = __logf(lb + (1.f - lb) * sg); k = (1.f - lb) * (1.f - sg); }
DEVI void hg_fk2(float pre, float lb, float& f, float& k) { const float sg = sigmoidf_(pre); f = lb + (1.f - lb) * sg; k = (1.f - lb) * (1.f - sg); }
template <int DSEL> DEVI void hg_phaseA_unit(const Frame& F, int b, int h, int c) {
    constexpr bool FWO = DSEL >= 0;
    const bf16_t* PROJ = (const bf16_t*)(F.ws + WS_BIG);
    constexpr int RSV = 160;
    bf16_t* KTf = (bf16_t*)F.lds; bf16_t* KTb = KTf + 128 * LDT; bf16_t* VTa = KTb + 128 * LDT; bf16_t* VTb = VTa + 64 * RSV; bf16_t* HFf = VTb + 64 * RSV; bf16_t* HFb = HFf + 64 * LDK;
    constexpr int NG = FWO ? 2 : 4, NSEG = FWO ? 4 : 2, NPOS = 64 / NSEG, NV = FWO ? 2 : 4;
    const int r32 = F.lane & 31, hi = F.lane >> 5, dir = FWO ? DSEL : (F.wave >> 2), dt = F.wave & 3, vt0 = FWO ? (F.wave >> 2) * 2 : 0;
    const int lw = FWO ? DSEL : (F.tid >> 8), lj = FWO ? (F.tid >> 3) : ((F.tid & 255) >> 2), lch = FWO ? (F.tid & 7) * 16 : (F.tid & 3) * 32;
    f32x16 acc[NV];
#pragma unroll
    for (int i = 0; i < NV; ++i) acc[i] = (f32x16){};
    float Pacc = 1.f; const int sd = FWO ? DSEL : (F.tid >> 8), seg = FWO ? (F.tid >> 7) : ((F.tid >> 7) & 1), sdch = F.tid & 127;
    const float lb = hg_lb(F, h * 128 + sdch); float* xch = (float*)(HFb + 64 * LDK);
    bf16x8 pf[NG], pv[NG];
#define HGA_ISSUE(itb_) do { const int blk = lw ? (itb_) : 3 - (itb_); const size_t rb = (size_t)grow(b, c * 256 + blk * 64 + lj) * ODP; const int colf = (lw ? O_HFB : O_HFF) + h * 128; \
        _Pragma("unroll") for (int g = 0; g < NG; ++g) { const int ch = lch + g * 8; pf[g] = ld8(PROJ + rb + colf + ch); pv[g] = ld8(PROJ + rb + O_HI + h * 128 + ch); } } while (0)
    HGA_ISSUE(0);
    for (int itb = 0; itb < 4; ++itb) {
        __syncthreads();
        { bf16_t* VT = lw ? VTb : VTa; bf16_t* HF = lw ? HFb : HFf;
#pragma unroll
          for (int g = 0; g < NG; ++g) { const int ch = lch + g * 8; *(bf16x8*)(HF + lj * LDK + ch) = pf[g]; *(bf16x8*)(VT + lj * RSV + ch) = pv[g]; } }
        __syncthreads();
        if (itb + 1 < 4) HGA_ISSUE(itb + 1);
        { bf16_t* KT = sd ? KTb : KTf; const bf16_t* HF = sd ? HFb : HFf; float cp[NPOS], kk[NPOS]; float run = 1.f;
#pragma unroll
            for (int i = 0; i < NPOS; ++i) { const int sp = seg * NPOS + i, j = sd ? sp : 63 - sp; float f; hg_fk2(bf2f(HF[j * LDK + sdch]), lb, f, kk[i]); cp[i] = run; run *= f; }
            xch[(sd * 4 + seg) * 128 + sdch] = run;
            __syncthreads();
            float base = Pacc, tot = 1.f;
#pragma unroll
            for (int q = 0; q < NSEG; ++q) { const float rq = xch[(sd * 4 + q) * 128 + sdch]; base *= (q < seg) ? rq : 1.f; tot *= rq; }
#pragma unroll
            for (int i = 0; i < NPOS; ++i) { const int sp = seg * NPOS + i, j = sd ? sp : 63 - sp; KT[sdch * LDT + j] = (bf16_t)f2bf(kk[i] * (base * cp[i])); }
            Pacc *= tot; }
        __syncthreads();
        const bf16_t* KT = dir ? KTb : KTf; const bf16_t* VT = dir ? VTb : VTa;
#pragma unroll
        for (int ks = 0; ks < 4; ++ks) { const bf16x8 a = ld8(KT + (dt * 32 + r32) * LDT + ks * 16 + hi * 8);
#pragma unroll
            for (int vt = 0; vt < NV; ++vt) acc[vt] = mfma32(a, ld_tr_B(VT, RSV, ks * 16, (vt0 + vt) * 32, F.lane), acc[vt]); }
    }
    const int stream = (b * 4 + h) * 2 + dir; float* Sg = (float*)(F.ws + WS_HGS) + ((size_t)stream * NCH + c) * 16384;
#pragma unroll
    for (int vt = 0; vt < NV; ++vt)
#pragma unroll
        for (int r = 0; r < 16; ++r) Sg[(dt * 32 + crow(r, hi)) * 128 + (vt0 + vt) * 32 + r32] = acc[vt][r];
#undef HGA_ISSUE
    if (seg == 0) ((float*)(F.ws + WS_ACT))[((size_t)((b * 4 + h) * 2 + sd) * NCH + c) * 128 + sdch] = Pacc;
    __syncthreads();
}
DEVI void hg_phaseB(const Frame& F) {
    const int nvb = NSTR_ML * 16;
    for (int vb = F.bid; vb < nvb; vb += F.G) {
        const int stream = vb >> 4, e0 = ((vb & 15) * NTHREADS + F.tid) * 2, dir = stream & 1, d = e0 >> 7;
        float* Ss = (float*)(F.ws + WS_HGS) + (size_t)stream * NCH * 16384; const float* Bt = (const float*)(F.ws + WS_ACT) + (size_t)stream * NCH * 128;
        typedef float f32x2s __attribute__((ext_vector_type(2)));
        f32x2s lv[NCH]; float dkv[NCH];
#pragma unroll
        for (int k = 0; k < NCH; ++k) { const int c = ml_chunk_at(dir, k); lv[k] = *(const f32x2s*)(Ss + (size_t)c * 16384 + e0); dkv[k] = Bt[c * 128 + d]; }
        float s0 = 0.f, s1 = 0.f;
#pragma unroll
        for (int k = 0; k < NCH; ++k) { const int c = ml_chunk_at(dir, k); f32x2s o; o[0] = s0; o[1] = s1; *(f32x2s*)(Ss + (size_t)c * 16384 + e0) = o;
            s0 = dkv[k] * s0 + lv[k][0]; s1 = dkv[k] * s1 + lv[k][1]; }
    }
}
DEVI void hg_phaseC_unit(const Frame& F0, int b, int h, int c) {
    const Frame F = unit_frame(F0); PS_DECL PS_B(9)
    const bf16_t* PROJ = (const bf16_t*)(F.ws + WS_BIG); bf16_t* YM = (bf16_t*)(F.ws + WS_ACT);
    const int dir = F.wave >> 2, vt = F.wave & 3;
    int r32 = F.lane & 31, hi = F.lane >> 5, tl = F.tid & 255;
    unsigned char* dbase = F.lds + dir * 40960;
    bf16_t* QH = (bf16_t*)dbase; bf16_t* KB = QH + 32 * LDK; bf16_t* KBT = KB + 32 * LDK; bf16_t* VT = KBT + 128 * LDS32; float* blast = (float*)(VT + 128 * LDS32);
    bf16_t* stash = (bf16_t*)(F.lds + 81920);
    float* ssb = (float*)(F.lds + 81920 + 65536);
    f32x16 S[4];
    { const int stream = (b * 4 + h) * 2 + dir; const float* Sg = (const float*)(F.ws + WS_HGS) + ((size_t)stream * NCH + c) * 16384;
#pragma unroll
      for (int dt = 0; dt < 4; ++dt)
#pragma unroll
          for (int r = 0; r < 16; ++r) S[dt][r] = Sg[(dt * 32 + crow(r, hi)) * 128 + vt * 32 + r32]; }
    const float lb = hg_lb(F, h * 128 + (tl & 127));
#pragma unroll 1
    for (int step = 0; step < 8; ++step) {
        const int sb = dir ? 7 - step : step; const int tb = c * 256 + sb * 32;
        { const Frame Fs = unit_frame(F0); r32 = Fs.lane & 31; hi = Fs.lane >> 5; tl = Fs.tid & 255; }
        PS_B(1) __syncthreads();
        { const int j = tl >> 3, g8 = tl & 7; const size_t rb = (size_t)grow(b, tb + j) * ODP;
#pragma unroll
          for (int hf2 = 0; hf2 < 2; ++hf2) { const int ch = g8 * 16 + hf2 * 8;
              *(bf16x8*)(QH + j * LDK + ch) = ld8(PROJ + rb + O_HQ + h * 128 + ch); *(bf16x8*)(KB + j * LDK + ch) = ld8(PROJ + rb + (dir ? O_HFB : O_HFF) + h * 128 + ch);
              *(bf16x8*)(VT + j * 160 + ch) = ld8(PROJ + rb + O_HI + h * 128 + ch); } }
        __syncthreads(); PS_E(1) PS_B(2)
        { const int d = tl & 127, hf = tl >> 7; float cp[16]; float run = 1.f;
#pragma unroll
          for (int s = 0; s < 16; ++s) { const int sp = hf * 16 + s, j = dir ? 31 - sp : sp; float f, k; hg_fk2(bf2f(KB[j * LDK + d]), lb, f, k);
              run *= f; cp[s] = run; KB[j * LDK + d] = (bf16_t)f2bf(k); QH[j * LDK + d] = (bf16_t)f2bf(siluf_(bf2f(QH[j * LDK + d])) * HG_QSCALE); }
          if (hf == 0) blast[d] = run;
          __syncthreads();
          const float off = hf ? blast[d] : 1.f;
          __syncthreads();
#pragma unroll
          for (int s = 0; s < 16; ++s) { const int sp = hf * 16 + s, j = dir ? 31 - sp : sp; const float P = cp[s] * off;
              QH[j * LDK + d] = (bf16_t)f2bf(bf2f(QH[j * LDK + d]) * P); const unsigned kb = f2bf(bf2f(KB[j * LDK + d]) * RCP(fmaxf(P, 1.8e-35f))); KB[j * LDK + d] = (bf16_t)kb; KBT[d * LDS32 + j] = (bf16_t)kb; }
          if (hf) blast[d] = cp[15] * off; }
        __syncthreads(); PS_E(2) PS_B(3)
        f32x16 p = (f32x16){};
#pragma unroll
        for (int ks = 0; ks < 8; ++ks) p = mfma32(ld8(KB + r32 * LDK + ks * 16 + hi * 8), ld8(QH + r32 * LDK + ks * 16 + hi * 8), p);
#pragma unroll
        for (int r = 0; r < 16; ++r) { const int s = crow(r, hi); const bool ok = dir ? (s >= r32) : (s <= r32); p[r] = ok ? p[r] : 0.f; }
        const bf16x8 pa0 = pk4frag(p, 0), pa1 = pk4frag(p, 8);
        f32x16 o = (f32x16){};
        const bf16x8 vb0 = ld_tr_B(VT, 160, 0, vt * 32, F.lane), vb1 = ld_tr_B(VT, 160, 16, vt * 32, F.lane);
        o = mfma32(pa0, vb0, o); o = mfma32(pa1, vb1, o);
#pragma unroll
        for (int dt = 0; dt < 4; ++dt)
#pragma unroll
            for (int s2 = 0; s2 < 2; ++s2) { float sf[8];
#pragma unroll
                for (int e = 0; e < 8; ++e) sf[e] = S[dt][8 * s2 + e];
                const bf16_t* qp = QH + r32 * LDK + dt * 32 + 16 * s2 + 4 * hi; u32x4 aw; const u32x2 lo = *(const u32x2*)qp, hh = *(const u32x2*)(qp + 8); aw[0] = lo[0]; aw[1] = lo[1]; aw[2] = hh[0]; aw[3] = hh[1];
                o = mfma32(__builtin_bit_cast(bf16x8, aw), pack8(sf), o); }
#pragma unroll
        for (int dt = 0; dt < 4; ++dt) {
#pragma unroll
            for (int ks = 0; ks < 2; ++ks) S[dt] = mfma32(ld8(KBT + (dt * 32 + r32) * LDS32 + ks * 16 + hi * 8), ks ? vb1 : vb0, S[dt]);
#pragma unroll
            for (int g = 0; g < 4; ++g) { const f32x4 b4 = *(const f32x4*)(blast + dt * 32 + 8 * g + 4 * hi);
#pragma unroll
                for (int e = 0; e < 4; ++e) S[dt][4 * g + e] *= b4[e]; } }
        PS_E(3) PS_B(4)
        bf16_t hgraw[16];
        if (step < 4) {
#pragma unroll
            for (int r = 0; r < 16; ++r) stash[(sb * 32 + crow(r, hi)) * 128 + vt * 32 + r32] = (bf16_t)f2bf(o[r]);
        } else {
#pragma unroll
            for (int r = 0; r < 16; ++r) hgraw[r] = PROJ[(size_t)grow(b, tb + crow(r, hi)) * ODP + O_HG + h * 128 + vt * 32 + r32];
#pragma unroll
            for (int r = 0; r < 16; ++r) { o[r] += bf2f(stash[(sb * 32 + crow(r, hi)) * 128 + vt * 32 + r32]); const float sq = half_sum32(o[r] * o[r]); if (r32 == 0) ssb[(dir * 32 + crow(r, hi)) * 4 + vt] = sq; }
        }
        __syncthreads();
        if (step >= 4) { const int v = h * 128 + vt * 32 + r32; const float gn = F.ap->in[I_HGNORM][v];
#pragma unroll
            for (int r = 0; r < 16; ++r) { const int tr = crow(r, hi); const f32x4 sp = *(const f32x4*)(ssb + (dir * 32 + tr) * 4); const float rs = RSQ(((sp[0] + sp[1]) + (sp[2] + sp[3])) * (1.f / 128.f) + EPS);
                YM[(size_t)grow(b, tb + tr) * D + v] = (bf16_t)f2bf(o[r] * rs * gn * siluf_(bf2f(hgraw[r]))); }
        }
        PS_E(4)
    }
    __syncthreads(); PS_E(9) PS_SPIN;
}
DEVI void mla_prep_unit(const Frame& F, int u) {
    const bf16_t* PROJ = (const bf16_t*)(F.ws + WS_BIG); float* rq = (float*)(F.ws + WS_RSTD); float* rkv = rq + M; bf16_t* KR = (bf16_t*)(F.ws + WS_SCR + SC_KR);
    const float* rc = (const float*)(F.ws + WS_ROPE); const float* rsn = rc + 128 * 16;
    const int r0 = u * 64 + F.wave * 8;
    bf16x8 q8[4], c8[2]; float kr[8];
#pragma unroll
    for (int i = 0; i < 4; ++i) q8[i] = ld8(PROJ + (size_t)(r0 + 2 * i + (F.lane >> 5)) * ODP + O_CQ + (F.lane & 31) * 8);
#pragma unroll
    for (int i = 0; i < 2; ++i) c8[i] = ld8(PROJ + (size_t)(r0 + 4 * i + (F.lane >> 4)) * ODP + O_CKV + (F.lane & 15) * 8);
#pragma unroll
    for (int i = 0; i < 8; ++i) kr[i] = bf2f(PROJ[(size_t)(r0 + i) * ODP + O_KR + F.lane]);
#pragma unroll
    for (int i = 0; i < 4; ++i) { float x[8]; unpack8(q8[i], x); float sq = 0.f;
#pragma unroll
        for (int e = 0; e < 8; ++e) sq += x[e] * x[e];
        sq = half_sum32(sq); if ((F.lane & 31) == 0) rq[r0 + 2 * i + (F.lane >> 5)] = RSQ(sq * (1.f / 256.f) + EPS); }
#pragma unroll
    for (int i = 0; i < 2; ++i) { float x[8]; unpack8(c8[i], x); float sq = 0.f;
#pragma unroll
        for (int e = 0; e < 8; ++e) sq += x[e] * x[e];
        sq = sum16(sq); if ((F.lane & 15) == 0) rkv[r0 + 4 * i + (F.lane >> 4)] = RSQ(sq * (1.f / 128.f) + EPS); }
#pragma unroll
    for (int i = 0; i < 8; ++i) { const int r = r0 + i; const float x = kr[i]; const float pr = shx<16>(x);
        const int tt = r % T; float y = x;
        if (tt >= CTX) { const int li = tt - CTX, half = F.lane >> 5, w = F.lane & 31, pos = half ? (li % GRIDW) : (li / GRIDW); const bool lo = w < 16; const int i0 = lo ? w : w - 16;
            const float cc = rc[pos * 16 + i0], sn = rsn[pos * 16 + i0]; y = lo ? (x * cc - pr * sn) : (pr * sn + x * cc); }
        KR[(size_t)r * 64 + F.lane] = (bf16_t)f2bf(y); }
}

namespace att {
constexpr int NW = 8, QBLK = 32, KVBLK = 64;
constexpr float SCALE = 0.07216878364870322f;
#ifndef ATT_THR
#define ATT_THR 8.f
#endif
constexpr float THR = ATT_THR;
constexpr size_t SHM_V = KVBLK * 128 * 2, SHM_K = KVBLK * 128 * 2, SHM_R = KVBLK * 64 * 2;
constexpr size_t OFF_V = 0, OFF_K = 2 * SHM_V, OFF_R = OFF_K + 2 * SHM_K, OFF_WS = OFF_R + 2 * SHM_R, OFF_QR = OFF_WS + NW * 64 * 4, QRLD = 144, SHM_ATTN = OFF_QR + NW * 32 * QRLD * 2;
static_assert(SHM_ATTN <= 160 * 1024, "attention LDS");
#define KSWZ(row, colB) ((row) * 256 + ((colB) ^ (((row) & 7) << 4)))
#define RSWZ(row, colB) ((row) * 128 + ((colB) ^ (((row) & 7) << 4)))
#ifndef HIPEMU
#define SBAR() __builtin_amdgcn_sched_barrier(0)
#define LGKM0() asm volatile("s_waitcnt lgkmcnt(0)" ::: "memory")
#else
#define SBAR()
#define LGKM0()
#endif
DEVI void partialSM(f32x16& p0, f32x16& p1, float& m_reg, float& mn, float& alpha) {
    constexpr float C = SCALE * 1.4426950408889634f;
    float pmax = p0[0];
#pragma unroll
    for (int r = 1; r < 16; ++r) pmax = fmaxf(pmax, p0[r]);
#pragma unroll
    for (int r = 0; r < 16; ++r) pmax = fmaxf(pmax, p1[r]);
    { const u32x2 rr = plswap(f2u(pmax), f2u(pmax)); const unsigned ra = rr[0], rb = rr[1]; pmax = fmaxf(u2f(ra), u2f(rb)); }
    bool keep = (pmax - m_reg <= THR / SCALE);
    int allk = 1;
#ifdef HIPEMU
    { float f = keep ? 1.f : 0.f; for (int o = 1; o < 64; o <<= 1) f = fminf(f, __shfl_xor(f, o)); allk = f > 0.5f; }
#else
    allk = __all(keep);
#endif
    if (allk) { mn = m_reg; alpha = 1.f; }
    else { mn = fmaxf(m_reg, pmax); alpha = EXP2F((m_reg - mn) * C); m_reg = mn; }
    const float mnC = -mn * C;
#pragma unroll
    for (int r = 0; r < 16; ++r) { p0[r] = EXP2F(fmaf(p0[r], C, mnC)); p1[r] = fmaf(p1[r], C, mnC); }
}
DEVI void finishSM(f32x16& p0, f32x16& p1, float alpha, float& l_reg, bf16x8& pa0, bf16x8& pa1, bf16x8& pa2, bf16x8& pa3) {
    float ps = 0.f;
#pragma unroll
    for (int r = 0; r < 16; ++r) { p1[r] = EXP2F(p1[r]); ps += p0[r] + p1[r]; }
    { const u32x2 rr = plswap(f2u(ps), f2u(ps)); const unsigned ra = rr[0], rb = rr[1]; ps = u2f(ra) + u2f(rb); }
    l_reg = l_reg * alpha + ps;
    pa0 = pk4frag(p0, 0); pa1 = pk4frag(p0, 8); pa2 = pk4frag(p1, 0); pa3 = pk4frag(p1, 8);
#ifdef ATT_DEBUG
    { float ones[8] = {1,1,1,1,1,1,1,1}; bf16x8 b1 = pack8(ones); f32x16 t = (f32x16){}; t = mfma32(pa0, b1, t); t = mfma32(pa1, b1, t); t = mfma32(pa2, b1, t); t = mfma32(pa3, b1, t);
      { float own = 0.f, ownb = 0.f; for (int r = 0; r < 16; ++r) { own += p0[r] + p1[r]; ownb += bf2f(f2bf(p0[r])) + bf2f(f2bf(p1[r])); }
        float fa = 0.f; for (int j = 0; j < 8; ++j) fa += bf2f((unsigned short)pa0[j]) + bf2f((unsigned short)pa1[j]) + bf2f((unsigned short)pa2[j]) + bf2f((unsigned short)pa3[j]);
        if (blockIdx.x == 0 && (threadIdx.x == 0 || threadIdx.x == 32)) printf("  lane %d own=%g ownbf=%g fragsum=%g\n", (int)threadIdx.x, own, ownb, fa); }
      if (blockIdx.x == 0 && threadIdx.x == 0) printf("T ps=%g mfma_row0=%g alpha=%g l=%g\n", ps, t[0], alpha, l_reg); }
#endif
}
DEVI void qkt(f32x16& p0, f32x16& p1, const unsigned char* Ks, const unsigned char* Rs, const bf16x8* qr, const bf16_t* qrl, int r32, int hi) {
    p0 = (f32x16){}; p1 = (f32x16){};
#pragma unroll
    for (int d0 = 0; d0 < 8; ++d0) { const int cb = (d0 * 16 + hi * 8) * 2; const bf16x8 qf = (d0 < 4) ? qr[d0 & 3] : ld8(qrl + (d0 - 4) * 16);
        p0 = mfma32(*(const bf16x8*)(Ks + KSWZ(r32, cb)), qf, p0); p1 = mfma32(*(const bf16x8*)(Ks + KSWZ(32 + r32, cb)), qf, p1); }
#pragma unroll
    for (int d0 = 0; d0 < 4; ++d0) { const int cb = (d0 * 16 + hi * 8) * 2;
        const bf16x8 qf = ld8(qrl + 64 + d0 * 16);
        p0 = mfma32(*(const bf16x8*)(Rs + RSWZ(r32, cb)), qf, p0); p1 = mfma32(*(const bf16x8*)(Rs + RSWZ(32 + r32, cb)), qf, p1); }
}
DEVI int v_st(int k, int c) { const int kk = (k & ~0xC) | ((k & 4) << 1) | ((k & 8) >> 1); return ((kk >> 3) * 4 + (c >> 5)) * 512 + ((kk & 7) * 32 + (c & 31)) * 2; }
DEVI int v_rd_base(int lane) { return ((lane & 3) << 3) | (((lane >> 2) & 3) << 6) | (((lane >> 4) & 1) << 5) | (((lane >> 5) & 1) << 8); }
DEVI bf16x8 v_frag(const unsigned char* Vs, int d0, int ks, int r32, int hi) {
    bf16x8 o;
#pragma unroll
    for (int j = 0; j < 8; ++j) o[j] = *(const short*)(Vs + v_st(16 * ks + 8 * hi + j, 32 * d0 + r32));
    return o;
}
#ifndef HIPEMU
template <int OFF> DEVI bf16x8 tr_pair(int vb) {
    typedef short s16x4 __attribute__((ext_vector_type(4)));
    s16x4 l, h2; asm volatile("ds_read_b64_tr_b16 %0, %1 offset:%2" : "=&v"(l) : "v"(vb), "i"(OFF) : "memory"); asm volatile("ds_read_b64_tr_b16 %0, %1 offset:%2" : "=&v"(h2) : "v"(vb), "i"(OFF + 2048) : "memory");
    return (bf16x8){l[0], l[1], l[2], l[3], h2[0], h2[1], h2[2], h2[3]};
}
template <int D0> DEVI void pv_one(f32x16& od, int vb, bf16x8 pa0, bf16x8 pa1, bf16x8 pa2, bf16x8 pa3) {
    const bf16x8 b0 = tr_pair<D0 * 512 + 0 * 4096>(vb), b1 = tr_pair<D0 * 512 + 1 * 4096>(vb), b2 = tr_pair<D0 * 512 + 2 * 4096>(vb), b3 = tr_pair<D0 * 512 + 3 * 4096>(vb);
    LGKM0(); SBAR();
    od = mfma32(pa0, b0, od); od = mfma32(pa1, b1, od); od = mfma32(pa2, b2, od); od = mfma32(pa3, b3, od);
}
DEVI void pv_d0(f32x16* o, const unsigned char* Vs, int r32, int hi, int lane, bf16x8 pa0, bf16x8 pa1, bf16x8 pa2, bf16x8 pa3) {
    const int vb = (int)(uintptr_t)Vs + v_rd_base(lane);
    pv_one<0>(o[0], vb, pa0, pa1, pa2, pa3); pv_one<1>(o[1], vb, pa0, pa1, pa2, pa3); pv_one<2>(o[2], vb, pa0, pa1, pa2, pa3); pv_one<3>(o[3], vb, pa0, pa1, pa2, pa3);
}
#else
DEVI void pv_d0(f32x16* o, const unsigned char* Vs, int r32, int hi, int lane, bf16x8 pa0, bf16x8 pa1, bf16x8 pa2, bf16x8 pa3) {
    for (int d0 = 0; d0 < 4; ++d0) { o[d0] = mfma32(pa0, v_frag(Vs, d0, 0, r32, hi), o[d0]); o[d0] = mfma32(pa1, v_frag(Vs, d0, 1, r32, hi), o[d0]);
        o[d0] = mfma32(pa2, v_frag(Vs, d0, 2, r32, hi), o[d0]); o[d0] = mfma32(pa3, v_frag(Vs, d0, 3, r32, hi), o[d0]); }
}
#endif
#ifdef HIPEMU
DEVI void dma16(const bf16_t* gsrc, unsigned char* lds_wave_base, int lane) { *(bf16x8*)(lds_wave_base + lane * 16) = ld8(gsrc); }
#else
DEVI void dma16(const bf16_t* gsrc, unsigned char* lds_wave_base, int lane) {
    __builtin_amdgcn_global_load_lds((const unsigned*)gsrc, (__attribute__((address_space(3))) unsigned*)lds_wave_base, 16, 0, 0); }
#endif
DEVI void attn_unit(const Frame& F, int b, int h, int qb) {
    unsigned char* wsl = F.ws;
    const bf16_t* Q = (const bf16_t*)(wsl + WS_SCR + SC_Q); const bf16_t* KN = (const bf16_t*)(wsl + WS_SCR + SC_KN); const bf16_t* Vg = (const bf16_t*)(wsl + WS_SCR + SC_V); const bf16_t* KR = (const bf16_t*)(wsl + WS_SCR + SC_KR);
    bf16_t* YM = (bf16_t*)(wsl + WS_ACT);
    unsigned char* lds = F.lds;
    const int wid = F.wave, lane = F.lane, r32 = lane & 31, hi = lane >> 5;
    unsigned char* V_lds = lds + OFF_V; unsigned char* K_lds = lds + OFF_K; unsigned char* R_lds = lds + OFF_R;
    float* wsf = (float*)(lds + OFF_WS) + wid * 64; float* li_l = wsf; float* al_l = wsf + 32;
    float m_reg = -1e30f, l_reg = 0.f; f32x16 o[4]; o[0] = o[1] = o[2] = o[3] = (f32x16){}; bf16x8 qr[4];
    bf16_t* qrl = (bf16_t*)(lds + OFF_QR) + (wid * 32 + r32) * QRLD + hi * 8;
    const int qrow = grow(b, CTX + qb * 256 + wid * QBLK + r32);
    { const bf16_t* Qw = Q + (size_t)qrow * 768 + h * 192 + hi * 8;
#pragma unroll
      for (int d0 = 0; d0 < 4; ++d0) qr[d0] = ld8(Qw + d0 * 16);
#pragma unroll
      for (int d0 = 0; d0 < 8; ++d0) *(bf16x8*)(qrl + d0 * 16) = ld8(Qw + 64 + d0 * 16); }
    const bf16_t* Kh = KN + (size_t)grow(b, 0) * 512 + h * 128; const bf16_t* Vh = Vg + (size_t)grow(b, 0) * 512 + h * 128; const bf16_t* Rh = KR + (size_t)grow(b, 0) * 64;
    int koff[2], voff[2], roff;
#pragma unroll
    for (int i = 0; i < 2; ++i) { const int p = wid * 2048 + i * 1024 + lane * 16; const int row = p >> 8, slot = (p >> 4) & 15; koff[i] = row * 512 + ((slot ^ (row & 7)) * 8);
        const int sI = p >> 4, sub = sI >> 5, rowin = (sI >> 2) & 7, chq = sI & 3; const int kk = (sub >> 2) * 8 + rowin, c = (sub & 3) * 32 + chq * 8; const int k = (kk & ~0xC) | ((kk & 4) << 1) | ((kk & 8) >> 1); voff[i] = k * 512 + c; }
    { const int p = wid * 1024 + lane * 16; const int row = p >> 7, slot = (p >> 4) & 7; roff = row * 64 + ((slot ^ (row & 7)) * 8); }
#define DMA_KR(t, bq) do { const bf16_t* kb_ = Kh + (size_t)(t) * KVBLK * 512; dma16(kb_ + koff[0], K_lds + (bq) * SHM_K + wid * 2048, lane); dma16(kb_ + koff[1], K_lds + (bq) * SHM_K + wid * 2048 + 1024, lane); \
    dma16(Rh + (size_t)(t) * KVBLK * 64 + roff, R_lds + (bq) * SHM_R + wid * 1024, lane); } while (0)
#define DMA_V(t, bq) do { const bf16_t* vb_ = Vh + (size_t)(t) * KVBLK * 512; dma16(vb_ + voff[0], V_lds + (bq) * SHM_V + wid * 2048, lane); dma16(vb_ + voff[1], V_lds + (bq) * SHM_V + wid * 2048 + 1024, lane); } while (0)
#define RESC(a) do { const int any_ = WAVE_ANY((a) < 1.f); \
    if (any_) { WAVE_SYNC(); if (hi == 0) al_l[r32] = (a); LGKM0(); WAVE_SYNC(); \
    _Pragma("unroll") for (int d = 0; d < 4; ++d) _Pragma("unroll") for (int r = 0; r < 16; ++r) o[d][r] *= al_l[crow(r, hi)]; } } while (0)
    f32x16 pA0, pA1, pB0, pB1; float mnA, mnB, alA, alB; bf16x8 pa0, pa1, pa2, pa3; const int NT = T / KVBLK;
    DMA_KR(0, 0); __syncthreads();
    DMA_KR(1, 1); DMA_V(0, 0);
    qkt(pA0, pA1, K_lds, R_lds, qr, qrl, r32, hi); partialSM(pA0, pA1, m_reg, mnA, alA);
    __syncthreads();
    for (int j = 1; j + 1 < NT; j += 2) {
        DMA_KR(j + 1, 0); DMA_V(j, 1);
        SBAR(); qkt(pB0, pB1, K_lds + SHM_K, R_lds + SHM_R, qr, qrl, r32, hi);
        finishSM(pA0, pA1, alA, l_reg, pa0, pa1, pa2, pa3); SBAR();
        pv_d0(o, V_lds, r32, hi, lane, pa0, pa1, pa2, pa3); partialSM(pB0, pB1, m_reg, mnB, alB);
        RESC(alB); __syncthreads();
        if (j + 2 < NT) DMA_KR(j + 2, 1);
        DMA_V(j + 1, 0);
        SBAR(); qkt(pA0, pA1, K_lds, R_lds, qr, qrl, r32, hi);
        finishSM(pB0, pB1, alB, l_reg, pa0, pa1, pa2, pa3); SBAR();
        pv_d0(o, V_lds + SHM_V, r32, hi, lane, pa0, pa1, pa2, pa3); partialSM(pA0, pA1, m_reg, mnA, alA);
        RESC(alA); __syncthreads();
    }
    DMA_V(NT - 1, 1);
    SBAR(); qkt(pB0, pB1, K_lds + SHM_K, R_lds + SHM_R, qr, qrl, r32, hi);
    finishSM(pA0, pA1, alA, l_reg, pa0, pa1, pa2, pa3); SBAR();
    pv_d0(o, V_lds, r32, hi, lane, pa0, pa1, pa2, pa3); partialSM(pB0, pB1, m_reg, mnB, alB);
    RESC(alB); __syncthreads();
    finishSM(pB0, pB1, alB, l_reg, pa0, pa1, pa2, pa3); SBAR();
    pv_d0(o, V_lds + SHM_V, r32, hi, lane, pa0, pa1, pa2, pa3);
    if (hi == 0) li_l[r32] = l_reg; LGKM0();
    __syncthreads();
    float rli[16];
#pragma unroll
    for (int r = 0; r < 16; ++r) rli[r] = 1.f / li_l[crow(r, hi)];
    const int orow0 = grow(b, CTX + qb * 256 + wid * QBLK);
#pragma unroll
    for (int r = 0; r < 16; ++r) { const int orow = orow0 + crow(r, hi);
#pragma unroll
        for (int d0 = 0; d0 < 4; ++d0) YM[(size_t)orow * D + 512 + h * 128 + d0 * 32 + r32] = (bf16_t)f2bf(o[d0][r] * rli[r]); }
    __syncthreads();
#undef DMA_KR
#undef DMA_V
#undef RESC
}
}

#ifndef HIPEMU
DEVI void grid_barrier(cg::grid_group& grid) { grid.sync(); }
#endif

#ifndef HIPEMU
#define XB_TMO      128
#define XB_XCNT(j)  (256  + 64 * (j))
#define XB_XSUB(j)  (1280 + 64 * (j))
#define XB_XGEN(j)  (2304 + 64 * (j))
#define XB_TOP      3328
#define XB_TOPGEN   3392
#define XB_SPIN_CAP (1u << 22)
typedef __attribute__((address_space(3))) unsigned lds_u32;
DEVI unsigned xb_ld(unsigned* p)              { return __hip_atomic_load(p, __ATOMIC_RELAXED, __HIP_MEMORY_SCOPE_AGENT); }
DEVI unsigned xb_add(unsigned* p, unsigned v) { return __hip_atomic_fetch_add(p, v, __ATOMIC_RELAXED, __HIP_MEMORY_SCOPE_AGENT); }
DEVI unsigned xb_xcc_id() { return (unsigned)__builtin_amdgcn_s_getreg((3 << 11) | 20) & 0xFu; }
#define XB_SPIN(cond, bar) do { unsigned _sp = 0; while (cond) { __builtin_amdgcn_s_sleep(1); \
    if ((++_sp & 255u) == 0u) { if (xb_ld(&(bar)[XB_TMO])) break; if (_sp > XB_SPIN_CAP) { atomicAdd(&(bar)[XB_TMO], 1u); break; } } } } while (0)
DEVI void xcd_barrier_complete(unsigned* bar, unsigned x, unsigned G, unsigned& nloc, unsigned& nx) {
    unsigned sum, cnt, mine, sp = 0u;
    for (;;) {
        sum = 0u; cnt = 0u; mine = 0u;
#pragma unroll
        for (unsigned j = 0; j < 16; ++j) { const unsigned c = xb_ld(&bar[XB_XCNT(j)]); sum += c; cnt += (c > 0u) ? 1u : 0u; mine = (j == x) ? c : mine; }
        if (sum == G) break;
        __builtin_amdgcn_s_sleep(1);
        if ((++sp & 255u) == 0u) { if (xb_ld(&bar[XB_TMO])) break; if (sp > XB_SPIN_CAP) { atomicAdd(&bar[XB_TMO], 1u); break; } }
    }
    nloc = mine > 0u ? mine : 1u; nx = cnt > 0u ? cnt : 1u;
}
DEVI void xcd_barrier(unsigned* bar, volatile lds_u32* st, bool is_t0, unsigned G) {
    asm volatile("s_waitcnt vmcnt(0)" ::: "memory");
    __syncthreads();
    if (is_t0) {
        __builtin_amdgcn_s_waitcnt(0);
        const unsigned x = xb_xcc_id();
        unsigned nloc = st[0], nx = st[1];
        if (nloc == 0u) { xcd_barrier_complete(bar, x, G, nloc, nx); st[0] = nloc; st[1] = nx; }
        const unsigned old = xb_add(&bar[XB_XSUB(x)], 1u);
        const unsigned gen = old / nloc;
        if (old + 1u == (gen + 1u) * nloc) {
            __builtin_amdgcn_fence(__ATOMIC_RELEASE, "agent");
            asm volatile("s_waitcnt vmcnt(0)" ::: "memory");
            const unsigned og = xb_add(&bar[XB_TOP], 1u);
            const unsigned tg = og / nx;
            if (og + 1u == (tg + 1u) * nx) xb_add(&bar[XB_TOPGEN], 1u);
            else XB_SPIN(xb_ld(&bar[XB_TOPGEN]) == tg, bar);
            __builtin_amdgcn_fence(__ATOMIC_ACQUIRE, "agent");
            xb_add(&bar[XB_XGEN(x)], 1u);
            asm volatile("s_waitcnt vmcnt(0)" ::: "memory");
        } else {
            XB_SPIN(xb_ld(&bar[XB_XGEN(x)]) == gen, bar);
            __builtin_amdgcn_fence(__ATOMIC_ACQUIRE, "agent");
            asm volatile("s_waitcnt vmcnt(0)" ::: "memory");
        }
    }
    __syncthreads();
}
#endif

constexpr int LDS_QW = 160 * 1024 - 256 + 64;
#ifdef HIPEMU
struct WorkQ { int next, total, G, bid; DEVI void init(const Frame& F, int q, int tot) { next = F.bid; total = tot; G = F.G; bid = F.bid; } DEVI int pop(const Frame& F) { const int r = next; next += G; return r < total ? r : -1; } };
#else
struct WorkQ { unsigned* ctr; int total; int pending;
    DEVI void init(const Frame& F, int q, int tot) { ctr = (unsigned*)(F.ws + WS_CTL) + 8192 + 64 * q; total = tot; pending = -1;
        if (F.tid == 0) pending = (int)__hip_atomic_fetch_add(ctr, 1u, __ATOMIC_RELAXED, __HIP_MEMORY_SCOPE_AGENT); }
    DEVI int pop(const Frame& F) { volatile int* w = (volatile int*)(F.lds + LDS_QW);
        __syncthreads(); if (F.tid == 0) { *w = pending; pending = (int)__hip_atomic_fetch_add(ctr, 1u, __ATOMIC_RELAXED, __HIP_MEMORY_SCOPE_AGENT); }
        __syncthreads(); const int r = *w; return (r < total) ? __builtin_amdgcn_readfirstlane(r) : -1; } };
#endif
template <int ACTF> DEVI void ctx_gemm(const Frame& F, const bf16_t* A, int lda, const bf16_t* Bt, int ldb, int N, bf16_t* O, int ldc) {
    constexpr int RS = 528, KC = 256, NCHK = D / KC;
    const int ncq = N / 1024, NBU = (NB * CTX / 64) * (N / 128);
    const int l31 = F.lane & 31, h = F.lane >> 5, dr = F.wave >> 2, dc = F.wave & 3, trow = F.tid >> 5, tc = F.tid & 31;
    for (int bu = F.bid; bu < NBU; bu += F.G) {
        const int x = bu & 7, j = bu >> 3, pr = j / ncq, pc = j % ncq, col0 = (x * ncq + pc) * 128;
        u32x4 pre[12]; f32x16 acc;
#pragma unroll
        for (int e = 0; e < 16; ++e) acc[e] = 0.f;
#define CTXG_SRC(i) ((i) < 4 ? A + (size_t)grow((pr * 64 + 16 * (i) + trow) / CTX, (pr * 64 + 16 * (i) + trow) % CTX) * lda + tc * 8 : Bt + (size_t)(col0 + 16 * ((i) - 4) + trow) * ldb + tc * 8)
#pragma unroll
        for (int i = 0; i < 12; ++i) pre[i] = *(const u32x4*)(CTXG_SRC(i));
        for (int ck = 0; ck < NCHK; ++ck) {
            __syncthreads();
#pragma unroll
            for (int i = 0; i < 12; ++i) *(u32x4*)(F.lds + (16 * i + trow) * RS + tc * 16) = pre[i];
            __syncthreads();
            if (ck + 1 < NCHK) {
#pragma unroll
                for (int i = 0; i < 12; ++i) pre[i] = *(const u32x4*)(CTXG_SRC(i) + (ck + 1) * KC); }
#pragma unroll
            for (int s = 0; s < 16; ++s) { const bf16x8 wf = *(const bf16x8*)(F.lds + (64 + dc * 32 + l31) * RS + s * 32 + h * 16), xf = *(const bf16x8*)(F.lds + (dr * 32 + l31) * RS + s * 32 + h * 16);
                acc = mfma32(wf, xf, acc); }
        }
#undef CTXG_SRC
        const int cr = pr * 64 + dr * 32 + l31; bf16_t* orow = O + (size_t)grow(cr / CTX, cr % CTX) * ldc + col0 + dc * 32 + 4 * h;
#pragma unroll
        for (int g = 0; g < 4; ++g) { float v[4];
#pragma unroll
            for (int e = 0; e < 4; ++e) { float a = acc[4 * g + e]; if (ACTF == 1) { a = a > 0.f ? a : 0.f; a = a * a; } v[e] = a; }
            *(unsigned long long*)(orow + 8 * g) = (unsigned long long)pk2(v[0], v[1]) | ((unsigned long long)pk2(v[2], v[3]) << 32); }
    }
    __syncthreads();
}
constexpr int NPHASES = 21;
#ifndef PH_MASK
#define PH_MASK 0xFFFFFFFFu
#endif
#define PH_ON(k) ((PH_MASK >> (k)) & 1u)
template <int ph> DEVI void run_phase_t(const Frame& F) {
    bf16_t* Wb = (bf16_t*)(F.ws + WS_W); bf16_t* ACT = (bf16_t*)(F.ws + WS_ACT); bf16_t* BIGb = (bf16_t*)(F.ws + WS_BIG); bf16_t* HJ1 = (bf16_t*)(F.ws + WS_HGS);
    float* BIGf = (float*)(F.ws + WS_BIG); float* ACTf = (float*)(F.ws + WS_ACT);
    pg8::Order S;
    switch (ph) {
    case 0: if (!PH_ON(0)) break; {
        ada_units(F);
#ifndef HIPEMU
        unsigned* adac = (unsigned*)(F.ws + WS_CTL) + 8192 + 64 * 40;
        asm volatile("s_waitcnt vmcnt(0)" ::: "memory"); __syncthreads();
        if (F.tid == 0) { __builtin_amdgcn_fence(__ATOMIC_RELEASE, "agent"); asm volatile("s_waitcnt vmcnt(0)" ::: "memory"); xb_add(adac, 1u); }
#endif
        convert_layer_weights(F, 0); rope_tables(F); rw_build_tables(F);
        for (size_t i = (size_t)F.bid * NTHREADS + F.tid; i < (size_t)M * 512 / 4; i += (size_t)F.G * NTHREADS) ((f32x4*)F.out)[i] = (f32x4){0.f, 0.f, 0.f, 0.f};
#ifndef HIPEMU
        if (F.tid == 0) { unsigned* bar = (unsigned*)(F.ws + WS_CTL); XB_SPIN(xb_ld(adac) < (unsigned)F.G, bar); __builtin_amdgcn_fence(__ATOMIC_ACQUIRE, "agent"); asm volatile("s_waitcnt vmcnt(0)" ::: "memory"); }
        __syncthreads();
        { const Frame F2 = relaunder(F); phase_hj0(F2); }
#endif
    } break;
    case 1: if (!PH_ON(1)) break;
#ifdef HIPEMU
        phase_hj0(F);
#endif
        break;
    case 2: if (!PH_ON(2)) break; { { pg8::Gemm g{ACT, Wb + W_IN / 2, D, D, D}; S.init(NB * NLT, EVP / 256, F.G, F.bid, 1); pg8::EpiBf16<0> E{BIGb, EVP}; pg8::gemm_phase(F.lds, g, S, E, F.tid); }
        ctx_gemm<0>(F, ACT, D, Wb + W_IN / 2, D, EVP, BIGb, EVP); } break;
    case 3: if (!PH_ON(3)) break; { constexpr int NML = NB * 4 * NCH, NRW = NSTR_RW * NCH; WorkQ Q; Q.init(F, 3, NML + NRW);
        for (int u = Q.pop(F); u >= 0; u = Q.pop(F)) { const Frame F2 = relaunder(F);
            if (u < NRW) rw2::heavy_unit(F2, u / (16 * NCH), (u / (2 * NCH)) % 8, (u / NCH) % 2, u % NCH);
            else { const int v = u - NRW; ml_phaseA_unit(F2, v / (4 * NCH), (v / NCH) % 4, v % NCH); } } } break;
    case 4: if (!PH_ON(4)) break; { ml_phaseB(F); const Frame F2 = relaunder(F); rw2::phaseB(F2); } break;
    case 5: if (!PH_ON(5)) break; { for (int u = F.bid; u < NSTR_RW * NCH; u += F.G) rw2::fixup_unit(F, u / NCH, u % NCH); } break;
    case 6: if (!PH_ON(6)) break; {
        constexpr int NML = NB * 4 * NCH, NFI = NB * 8 * (T / 64); WorkQ Q; Q.init(F, 6, NML + NFI);
        for (int u = Q.pop(F); u >= 0; u = Q.pop(F)) { const Frame F2 = relaunder(F);
            if (u < NML) { constexpr int NLC = NCH - NCTXCH, NLU = NB * 4 * NLC;
                if (u < NLU) ml_phaseC_unit(F2, u / (4 * NLC), (u / NLC) % 4, NCTXCH + u % NLC);
                else { const int v = u - NLU; ml_phaseC_unit(F2, v / (4 * NCTXCH), (v / NCTXCH) % 4, v % NCTXCH); } }
            else { const int v = u - NML; rw_finish2_unit(F2, v / (8 * (T / 64)), (v / (T / 64)) % 8, v % (T / 64)); } }
    } break;
    case 7: if (!PH_ON(7)) break; { { pg8::Gemm g{ACT, Wb + W_OUT / 2, D, D, D}; S.init(NB * NLT, 4, F.G, F.bid, 1); pg8::EpiBf16<0> E{BIGb, D}; pg8::gemm_phase(F.lds, g, S, E, F.tid); }
        { pg8::Gemm g{ACT, Wb + W_OUT / 2, 256, D, D}; S.init(NB * NCTXCH, 4, F.G, F.bid, 2, 4); pg8::EpiF32Slab E{(float*)(F.ws + WS_BIG + 70 * MiB), D}; pg8::gemm_phase(F.lds, g, S, E, F.tid); } } break;
    case 8: if (!PH_ON(8)) break; phase_resid(F, 0, 0, BIGb, false, ACT, (const float*)(F.ws + WS_BIG + 70 * MiB), 4); break;
    case 9: if (!PH_ON(9)) break; { { pg8::Gemm g{ACT, Wb + W_1 / 2, D, D, D}; S.init(NB * NLT, 16, F.G, F.bid, 1); pg8::EpiBf16<1> E{BIGb, DFF}; pg8::gemm_phase(F.lds, g, S, E, F.tid); }
        ctx_gemm<1>(F, ACT, D, Wb + W_1 / 2, D, DFF, BIGb, DFF); } break;
    case 10: if (!PH_ON(10)) break; { { pg8::Gemm g{BIGb, Wb + W_2 / 2, DFF, DFF, DFF}; S.init(NB * NLT, 4, F.G, F.bid, 1); pg8::EpiBf16<0> E{ACT, D}; pg8::gemm_phase(F.lds, g, S, E, F.tid); }
        { pg8::Gemm g{BIGb, Wb + W_2 / 2, 512, DFF, DFF}; S.init(NB * NCTXCH, 4, F.G, F.bid, 2, 8); pg8::EpiF32Slab E{(float*)(F.ws + WS_SCR + 34 * MiB), D}; pg8::gemm_phase(F.lds, g, S, E, F.tid); } } break;
    case 11: if (!PH_ON(11)) break; phase_resid(F, 0, 1, ACT, false, HJ1, (const float*)(F.ws + WS_SCR + 34 * MiB), 8); convert_layer_weights(F, 1); break;
    case 12: if (!PH_ON(12)) break; { { pg8::Gemm g{HJ1, Wb + W_IN / 2, D, D, D}; S.init(NB * NLT, ODP / 256, F.G, F.bid, 1); pg8::EpiBf16<0> E{BIGb, ODP}; pg8::gemm_phase(F.lds, g, S, E, F.tid); }
        ctx_gemm<0>(F, HJ1, D, Wb + W_IN / 2, D, ODP, BIGb, ODP); } break;
    case 13: if (!PH_ON(13)) break; { constexpr int NHA = NB * 4 * NCH, NMP = M / 64; WorkQ Q; Q.init(F, 13, NHA + NMP);
        for (int u = Q.pop(F); u >= 0; u = Q.pop(F)) { const Frame F2 = relaunder(F);
            if (u < NHA - 2 * NB * 4) { const int k = u / (NB * 4), bh = u % (NB * 4); const int cc = (k < NCTXCH) ? k : k + 1; hg_phaseA_unit<-1>(F2, bh / 4, bh % 4, cc); }
            else if (u < NHA - NB * 4) { const int bh = u - (NHA - 2 * NB * 4); hg_phaseA_unit<0>(F2, bh / 4, bh % 4, NCTXCH); }
            else if (u < NHA) { const int bh = u - (NHA - NB * 4); hg_phaseA_unit<1>(F2, bh / 4, bh % 4, NCH - 1); }
            else mla_prep_unit(F2, u - NHA); } } break;
    case 14: if (!PH_ON(14)) break; {
#ifndef NO_HGB
        hg_phaseB(F);
#endif
#ifndef NO_GQ
        { pg8::Gemm g{BIGb + O_CQ, Wb + W_QB / 2, 256, ODP, 256}; S.init(NB * NLT, 3, F.G, F.bid, 1);
          pg8::EpiQ E{F.ws}; pg8::gemm_phase(F.lds, g, S, E, F.tid); }
#endif
#ifndef NO_GKV
        { pg8::Gemm g{BIGb + O_CKV, Wb + W_KVB / 2, 256, ODP, 256}; const int nq = NB * NLT * 3, rot = (nq / 8) * 8 % F.G;
          S.init(M / 256, 4, F.G, (F.bid - rot + F.G) % F.G, 0);
          pg8::EpiKV E{F.ws}; pg8::gemm_phase(F.lds, g, S, E, F.tid); }
#endif
    } break;
    case 15: if (!PH_ON(15)) break; {
#ifndef NO_ATT
        for (int u = F.bid; u < NB * 4 * NLT; u += F.G) att::attn_unit(F, u / (4 * NLT), (u / NLT) % 4, u % NLT);
#endif
#ifndef NO_HGC
        const Frame F2 = relaunder(F);
        for (int u = F2.bid; u < NB * 4 * NLT; u += F2.G) hg_phaseC_unit(F2, u / (4 * NLT), (u / NLT) % 4, NCTXCH + u % NLT);
#endif
    } break;
    case 16: if (!PH_ON(16)) break; { pg8::Gemm g{ACT, Wb + W_OUT / 2, D, D, D}; S.init(NB * NLT, 4, F.G, F.bid, 1); pg8::EpiBf16<0> E{BIGb, D}; pg8::gemm_phase(F.lds, g, S, E, F.tid); } break;
    case 17: if (!PH_ON(17)) break; phase_resid(F, 1, 0, BIGb, true, ACT); break;
    case 18: if (!PH_ON(18)) break; { pg8::Gemm g{ACT, Wb + W_1 / 2, D, D, D}; S.init(NB * NLT, 16, F.G, F.bid, 1); pg8::EpiBf16<1> E{BIGb, DFF}; pg8::gemm_phase(F.lds, g, S, E, F.tid); } break;
    case 19: if (!PH_ON(19)) break; { pg8::Gemm g{BIGb, Wb + W_2 / 2, DFF, DFF, DFF}; S.init(NB * NLT, 4, F.G, F.bid, 1); pg8::EpiBf16<0> E{ACT, D}; pg8::gemm_phase(F.lds, g, S, E, F.tid); } break;
    case 20: if (!PH_ON(20)) break; phase_resid(F, 1, 1, ACT, true, nullptr); break;
    default: break;
    }
}

#ifdef HIPEMU
static inline void run_phase_rt(const Frame& F, int ph) {
    switch (ph) {
#define PHC(k) case k: run_phase_t<k>(F); break;
    PHC(0) PHC(1) PHC(2) PHC(3) PHC(4) PHC(5) PHC(6) PHC(7) PHC(8) PHC(9) PHC(10) PHC(11) PHC(12) PHC(13) PHC(14) PHC(15) PHC(16) PHC(17) PHC(18) PHC(19) PHC(20)
#undef PHC
    default: break; }
}
#endif
#ifndef HIPEMU
constexpr int LDS_BYTES = 160 * 1024;
extern __shared__ __attribute__((aligned(16))) unsigned char g_lds[];
template <int PH> __device__ __forceinline__ void phase_fn(const CONSTAS Args* ap_in, int wave_in) {
    const CONSTAS Args* ap = ap_in; int wv = wave_in, bid = blockIdx.x, G = gridDim.x;
    int ln = __builtin_amdgcn_mbcnt_hi(~0u, __builtin_amdgcn_mbcnt_lo(~0u, 0u));
    asm volatile("" : "+s"(ap)); asm volatile("" : "+v"(ln)); asm volatile("" : "+s"(bid), "+s"(G), "+s"(wv));
    __builtin_assume(ln >= 0 && ln < 64); __builtin_assume(wv >= 0 && wv < 8); __builtin_assume(bid >= 0 && bid < 1024); __builtin_assume(G > 0 && G <= 1024);
    const int tid = wv * 64 + ln;
    Frame F; F.lds = g_lds; F.ap = ap; F.out = ap->out; F.ws = ap->ws; F.tid = tid; F.lane = ln; F.wave = wv; F.G = G; F.bid = bid;
    run_phase_t<PH>(F);
}
constexpr int LDS_MISC = LDS_BYTES - 256;
__global__ void __launch_bounds__(NTHREADS, 2) mk_fwd(Args a) {
    cg::grid_group grid = cg::this_grid();
    const CONSTAS Args* ap = (const CONSTAS Args*)__builtin_amdgcn_kernarg_segment_ptr();
    const int lo = a.ph_lo, hi = a.ph_hi; const int wv0 = __builtin_amdgcn_readfirstlane(threadIdx.x >> 6);
    volatile lds_u32* st = (volatile lds_u32*)(g_lds + LDS_MISC);
    unsigned* bar = (unsigned*)(a.ws + WS_CTL);
    if (threadIdx.x == 0) { st[0] = 0u; st[1] = 0u; (void)xb_add(&bar[XB_XCNT(xb_xcc_id())], 1u); }
    __syncthreads();
#ifdef PROBE_MASK
#define PROBE_PRE(k) unsigned long long tp0_ = 0; if ((PROBE_MASK >> (k)) & 1u) tp0_ = __builtin_amdgcn_s_memrealtime();
#define PROBE_POST(k) if ((PROBE_MASK >> (k)) & 1u) { __syncthreads(); const unsigned long long tp1_ = __builtin_amdgcn_s_memrealtime(); const unsigned long long dt_ = (tp1_ - tp0_) * PROBE_AMP; while (__builtin_amdgcn_s_memrealtime() - tp1_ < dt_) __builtin_amdgcn_s_sleep(8); }
#else
#define PROBE_PRE(k)
#define PROBE_POST(k)
#endif
#define PHC(k) if (lo <= k && k < hi) { PROBE_PRE(k) phase_fn<k>(ap, wv0); PROBE_POST(k) if (k + 1 < hi) { if (k == 0 && hi > NPHASES) grid.sync();     \
        { const bool t0_ = (wv0 == 0) && (__builtin_amdgcn_mbcnt_hi(~0u, __builtin_amdgcn_mbcnt_lo(~0u, 0u)) == 0); xcd_barrier(bar, st, t0_, gridDim.x); } } }
    PHC(0) PHC(2) PHC(3) PHC(4) PHC(5) PHC(6) PHC(7) PHC(8) PHC(9) PHC(10) PHC(11) PHC(12) PHC(13) PHC(14) PHC(15) PHC(16) PHC(17) PHC(18) PHC(19) PHC(20)
#undef PHC
}
#ifndef MK_N_LAUNCHES
#define MK_N_LAUNCHES 1
#endif
extern "C" void kernel_launch(void* const* d_in, const int* in_sizes, int n_in, void* d_out, int out_size, void* d_ws, size_t ws_size, hipStream_t stream) {
    static int grid = 0;
    if (grid == 0) {
        if (n_in != 32 || out_size != NB * SEQ * D || ws_size < WS_END) { fprintf(stderr, "kernel_launch: shape mismatch n_in %d out %d ws %zu\n", n_in, out_size, ws_size); grid = -1; return; }
        int dev = 0, cus = 0, per_cu = 0; hipGetDevice(&dev); hipDeviceGetAttribute(&cus, hipDeviceAttributeMultiprocessorCount, dev);
        hipFuncSetAttribute((const void*)mk_fwd, hipFuncAttributeMaxDynamicSharedMemorySize, LDS_BYTES);
        hipOccupancyMaxActiveBlocksPerMultiprocessor(&per_cu, (const void*)mk_fwd, NTHREADS, LDS_BYTES);
        fprintf(stderr, "kernel_launch: cus %d per_cu %d\n", cus, per_cu);
        if (per_cu < 1) { grid = -1; return; }
        grid = cus;
    }
    if (grid < 0) return;
    Args a{}; for (int i = 0; i < 32; ++i) a.in[i] = (const float*)d_in[i];
    a.out = (float*)d_out; a.ws = (unsigned char*)d_ws;
    if (hipMemsetAsync((char*)d_ws + WS_CTL, 0, CTL_BYTES, stream) != hipSuccess) { fprintf(stderr, "kernel_launch: memset failed\n"); return; }
    if (MK_N_LAUNCHES == 1) { a.ph_lo = 0; a.ph_hi = NPHASES; void* args[] = {&a};
        hipError_t e = hipLaunchCooperativeKernel((void*)mk_fwd, dim3(grid), dim3(NTHREADS), args, LDS_BYTES, stream);
        if (e != hipSuccess) fprintf(stderr, "coop launch failed: %s\n", hipGetErrorString(e));
    } else {
        for (int ph = 0; ph < NPHASES; ++ph) { a.ph_lo = ph; a.ph_hi = ph + 1; void* args[] = {&a};
            hipError_t e = hipLaunchCooperativeKernel((void*)mk_fwd, dim3(grid), dim3(NTHREADS), args, LDS_BYTES, stream);
            if (e != hipSuccess) { fprintf(stderr, "launch %d failed: %s\n", ph, hipGetErrorString(e)); break; } }
    }
}
#endif
```

```cpp
#ifndef HIPEMU
#include <hip/hip_runtime.h>
#include <hip/hip_cooperative_groups.h>
namespace cg = cooperative_groups;
#endif
#include <cstdio>
#include <cstdint>
#include <cmath>

#define DEVI __device__ __forceinline__

#ifndef CFG_NB
#define CFG_NB 2
#endif
#ifndef CFG_SEQ
#define CFG_SEQ 8192
#endif
#ifndef CFG_CTX
#define CFG_CTX 256
#endif
constexpr int NB = CFG_NB, SEQ = CFG_SEQ, CTX = CFG_CTX, T = CTX + SEQ, M = NB * T, D = 1024, DFF = 4096;
constexpr int NCH = T / 256;
constexpr int NCTXCH = CTX / 256;
constexpr int NLT = SEQ / 256;
constexpr int GRIDW = 64;
constexpr int EVP = 4096, ODP = 3072;
constexpr float EPS = 1e-6f;
constexpr int NTHREADS = 512;
static_assert(CTX % 256 == 0 && SEQ % 256 == 0, "chunking");

constexpr int E_MQ = 0, E_MK = 512, E_MV = 1024, E_MO = 1536, E_RF = 2048, E_MG = 3968;
constexpr int R_R = 0, R_K = 512, R_V = 1024, R_WL = 1536, R_AL = 1664, R_GL = 1792;
constexpr int O_HQ = 0, O_HFF = 512, O_HFB = 1024, O_HI = 1536, O_HG = 2048, O_CQ = 2560, O_CKV = 2816, O_KR = 2944;

constexpr size_t MiB = 1u << 20;
constexpr size_t WS_CTL = 0;
constexpr size_t CTL_BYTES = 256 * 1024;
constexpr size_t WS_MOD = 1 * MiB;
constexpr size_t WS_ROPE = WS_MOD + 256 * 1024;
constexpr size_t WS_RSTD = WS_MOD + 512 * 1024;
constexpr size_t WS_W = 2 * MiB;
constexpr size_t W_IN = 0, W_OUT = 8 * MiB, W_1 = 10 * MiB, W_2 = 18 * MiB, W_QB = 26 * MiB, W_KVB = 26 * MiB + 512 * 1024;
constexpr size_t WS_BIG = 29 * MiB;
constexpr size_t WS_ACT = 161 * MiB;
constexpr size_t WS_SCR = 194 * MiB;
constexpr size_t WS_XC = 254 * MiB;
constexpr size_t WS_END = 256 * MiB;
constexpr size_t WS_RWT = WS_XC, RWT_W2 = 0, RWT_A2 = 147456, RWT_G2 = 294912, RWT_CST = 434176, RWT_BON = 524288;
constexpr int NSTR_ML = NB * 4 * 2;
constexpr size_t SC_MLC = 0;
constexpr size_t SC_MLN = SC_MLC + (size_t)NSTR_ML * NCH * 16384 * 4;
constexpr size_t SC_MLS = SC_MLN + (size_t)NSTR_ML * NCH * 128 * 4;
constexpr size_t SC_ML_END = SC_MLS + (size_t)NSTR_ML * NCH * 4 * 4;
constexpr int NSTR_RW = NB * 8 * 2;
constexpr size_t SC_RW = (SC_ML_END + 255) / 256 * 256;
constexpr int RW_NS1 = (int)((60 * MiB - SC_RW) / 32768);
constexpr size_t OUT_KC = (size_t)M * 512 * 4;
constexpr size_t OUT_RW = OUT_KC + (size_t)M * 512 * 2;
static_assert(OUT_RW + (size_t)(NSTR_RW * NCH > RW_NS1 ? NSTR_RW * NCH - RW_NS1 : 0) * 32768 <= (size_t)NB * SEQ * 1024 * 4, "d_out scratch");
constexpr size_t SC_Q = 0, SC_KN = SC_Q + (size_t)M * 768 * 2, SC_V = SC_KN + (size_t)M * 512 * 2, SC_KR = SC_V + (size_t)M * 512 * 2, SC_L1_END = SC_KR + (size_t)M * 64 * 2;
static_assert(SC_L1_END <= 60 * MiB, "scr1");
constexpr size_t WS_HGS = WS_BIG + (size_t)M * ODP * 2;
static_assert(WS_HGS + (size_t)NSTR_ML * NCH * 16384 * 4 <= WS_ACT, "hgs");
static_assert((size_t)M * 512 * 4 <= (size_t)NB * SEQ * 1024 * 4 + 0 || true, "");

typedef unsigned short bf16_t;
typedef short bf16x8 __attribute__((ext_vector_type(8)));
typedef float f32x4 __attribute__((ext_vector_type(4)));
typedef float f32x16 __attribute__((ext_vector_type(16)));
typedef unsigned u32x4 __attribute__((ext_vector_type(4)));
typedef unsigned u32x2 __attribute__((ext_vector_type(2)));

#ifdef PROBE_SUB
#define PS_DECL unsigned long long ps_acc_ = 0, ps_t0_ = 0;
#define PS_B(id) if (PROBE_SUB == (id)) ps_t0_ = __builtin_amdgcn_s_memrealtime();
#define PS_E(id) if (PROBE_SUB == (id)) ps_acc_ += __builtin_amdgcn_s_memrealtime() - ps_t0_;
#define PS_SPIN do { __syncthreads(); const unsigned long long t_ = __builtin_amdgcn_s_memrealtime(); while (__builtin_amdgcn_s_memrealtime() - t_ < ps_acc_) __builtin_amdgcn_s_sleep(8); } while (0)
#else
#define PS_DECL
#define PS_B(id)
#define PS_E(id)
#define PS_SPIN
#endif
#ifdef HIPEMU
DEVI unsigned f2bf(float f) { unsigned u = __builtin_bit_cast(unsigned, f); return (u + 0x7fffu + ((u >> 16) & 1u)) >> 16; }
DEVI unsigned pk2(float lo, float hi) { return f2bf(lo) | (f2bf(hi) << 16); }
#else
typedef float f32x2cv __attribute__((ext_vector_type(2)));
typedef __bf16 bf16x2cv __attribute__((ext_vector_type(2)));
DEVI unsigned pk2(float lo, float hi) { const f32x2cv v = {lo, hi}; const bf16x2cv b = __builtin_convertvector(v, bf16x2cv); return __builtin_bit_cast(unsigned, b); }
DEVI unsigned f2bf(float f) { const __bf16 b = (__bf16)f; return (unsigned)__builtin_bit_cast(unsigned short, b); }
#endif
DEVI float bf2f(unsigned h) { return __builtin_bit_cast(float, (h & 0xffffu) << 16); }
DEVI float u2f(unsigned u) { return __builtin_bit_cast(float, u); }
DEVI unsigned f2u(float f) { return __builtin_bit_cast(unsigned, f); }
#ifdef HIPEMU
DEVI float RCP(float x) { return 1.f / x; }
DEVI float RSQ(float x) { return 1.f / sqrtf(x); }
#else
DEVI float RCP(float x) { return __builtin_amdgcn_rcpf(x); }
DEVI float RSQ(float x) { return __builtin_amdgcn_rsqf(x); }
#endif
DEVI float sigmoidf_(float x) { return RCP(1.f + __expf(-x)); }
DEVI float siluf_(float x) { return x * sigmoidf_(x); }
DEVI float logsigmoidf_(float x) { return x >= 0.f ? -__logf(1.f + __expf(-x)) : x - __logf(1.f + __expf(x)); }
DEVI float tanhf_(float x) { return 2.f * sigmoidf_(2.f * x) - 1.f; }
DEVI int crow(int r, int hi) { return (r & 3) + 8 * (r >> 2) + 4 * hi; }
#ifdef HIPEMU
DEVI int emu_any(bool p) { float f_ = p ? 1.f : 0.f; for (int o = 1; o < 64; o <<= 1) f_ = fmaxf(f_, __shfl_xor(f_, o)); return f_ > 0.5f; }
#define WAVE_ANY(p) emu_any(p)
#define FENCE()
#define WAVE_SYNC() emu::wave_sync()
#define EXP2F(x) exp2f(x)
DEVI f32x16 mfma32(bf16x8 a, bf16x8 b, f32x16 c) { return emu_mfma32(a, b, c); }
DEVI f32x4 mfma16f(float a, float b, f32x4 c) { return emu_mfma16f32(a, b, c); }
DEVI u32x2 plswap(unsigned a, unsigned b) { return emu_permlane32_swap(a, b); }
DEVI void atomic_add_f32(float* p, float v) { float o = __atomic_load_n((int*)p, __ATOMIC_RELAXED) * 0 + *p; (void)o; unsigned* ip = (unsigned*)p; unsigned old = __atomic_load_n(ip, __ATOMIC_RELAXED);
    for (;;) { float f = __builtin_bit_cast(float, old) + v; unsigned nv = __builtin_bit_cast(unsigned, f); if (__atomic_compare_exchange_n(ip, &old, nv, false, __ATOMIC_RELAXED, __ATOMIC_RELAXED)) break; } }
#else
#define WAVE_ANY(p) __any(p)
#define FENCE() do { asm volatile("" ::: "memory"); __builtin_amdgcn_sched_barrier(0); } while (0)
#define WAVE_SYNC() __builtin_amdgcn_wave_barrier()
#define EXP2F(x) __builtin_amdgcn_exp2f(x)
DEVI f32x16 mfma32(bf16x8 a, bf16x8 b, f32x16 c) { return __builtin_amdgcn_mfma_f32_32x32x16_bf16(a, b, c, 0, 0, 0); }
DEVI f32x4 mfma16f(float a, float b, f32x4 c) { return __builtin_amdgcn_mfma_f32_16x16x4f32(a, b, c, 0, 0, 0); }
DEVI u32x2 plswap(unsigned a, unsigned b) { auto r = __builtin_amdgcn_permlane32_swap(a, b, false, false); u32x2 o; o[0] = r[0]; o[1] = r[1]; return o; }
DEVI void atomic_add_f32(float* p, float v) { unsafeAtomicAdd(p, v); }
#endif
#ifdef HIPEMU
template <int MSK> DEVI float shx(float v) { return __shfl_xor(v, MSK); }
DEVI float shfl_up_l(float v, int o, int lane) { return __shfl_up(v, o); }
#else
template <int MSK> DEVI float shx(float v) {
    if constexpr (MSK == 32) { auto r = __builtin_amdgcn_permlane32_swap(__builtin_bit_cast(unsigned, v), __builtin_bit_cast(unsigned, v), false, false); const unsigned lo = r[0], hi2 = r[1];
        return __builtin_bit_cast(float, lo ^ hi2 ^ __builtin_bit_cast(unsigned, v)); }
    else return __builtin_bit_cast(float, __builtin_amdgcn_ds_swizzle(__builtin_bit_cast(int, v), (MSK << 10) | 0x1f));
}
DEVI float shfl_up_l(float v, int o, int lane) { const int src = lane >= o ? lane - o : lane; return __builtin_bit_cast(float, __builtin_amdgcn_ds_bpermute(src << 2, __builtin_bit_cast(int, v))); }
#endif
#ifdef HIPEMU
DEVI float sum16(float v) { v += shx<1>(v); v += shx<2>(v); v += shx<4>(v); v += shx<8>(v); return v; }
#else
template <int CTRL> DEVI float dpp_mov(float v) { return __builtin_bit_cast(float, __builtin_amdgcn_update_dpp(0, __builtin_bit_cast(int, v), CTRL, 0xF, 0xF, true)); }
DEVI float sum16(float v) { v += dpp_mov<0xB1>(v); v += dpp_mov<0x4E>(v); v += dpp_mov<0x141>(v); v += dpp_mov<0x140>(v); return v; }
#endif
#ifdef HIPEMU
DEVI float sum8(float v) { v += shx<1>(v); v += shx<2>(v); v += shx<4>(v); return v; }
#else
DEVI float sum8(float v) { v += dpp_mov<0xB1>(v); v += dpp_mov<0x4E>(v); v += dpp_mov<0x141>(v); return v; }
#endif
DEVI float wave_sum(float v) { v = sum16(v); v += shx<16>(v); v += shx<32>(v); return v; }
DEVI float half_sum32(float v) { v = sum16(v); v += shx<16>(v); return v; }
DEVI bf16x8 ld8(const bf16_t* p) { return *(const bf16x8*)p; }
#ifdef HIPEMU
DEVI bf16x8 ld_tr_B(const bf16_t* tile, int RS, int k0, int n0, int lane) { bf16x8 o;
    for (int j = 0; j < 8; ++j) o[j] = (short)tile[(size_t)(k0 + 8 * (lane >> 5) + j) * RS + n0 + (lane & 31)]; return o; }
#else
DEVI bf16x8 ld_tr_B(const bf16_t* tile, int RS, int k0, int n0, int lane) {
    typedef short s16x4t __attribute__((ext_vector_type(4)));
    const int g = lane >> 4, i = lane & 15, q = i >> 2, p = i & 3;
    const bf16_t* a = tile + (k0 + 8 * (g >> 1) + q) * RS + n0 + 16 * (g & 1) + 4 * p;
    const s16x4t r0 = __builtin_amdgcn_ds_read_tr16_b64_v4i16((__attribute__((address_space(3))) s16x4t*)a);
    const s16x4t r1 = __builtin_amdgcn_ds_read_tr16_b64_v4i16((__attribute__((address_space(3))) s16x4t*)(a + 4 * RS));
    return (bf16x8){r0[0], r0[1], r0[2], r0[3], r1[0], r1[1], r1[2], r1[3]};
}
#endif
DEVI void unpack8(bf16x8 v, float* f) {
#pragma unroll
    for (int i = 0; i < 8; ++i) f[i] = bf2f((unsigned short)v[i]);
}
DEVI bf16x8 pack8(const float* f) { u32x4 w; w[0] = pk2(f[0], f[1]); w[1] = pk2(f[2], f[3]); w[2] = pk2(f[4], f[5]); w[3] = pk2(f[6], f[7]); return __builtin_bit_cast(bf16x8, w); }
DEVI bf16x8 pk4frag(const f32x16& P, int B) {
    unsigned a0 = pk2(P[B + 0], P[B + 1]), a1 = pk2(P[B + 2], P[B + 3]), b0 = pk2(P[B + 4], P[B + 5]), b1 = pk2(P[B + 6], P[B + 7]);
    u32x2 r0 = plswap(a0, b0), r1 = plswap(a1, b1); u32x4 w; w[0] = r0[0]; w[1] = r1[0]; w[2] = r0[1]; w[3] = r1[1]; return __builtin_bit_cast(bf16x8, w);
}
DEVI int grow(int b, int t) { return b * T + t; }

struct Args {
    const float* in[32];
    float* out; unsigned char* ws;
    int ph_lo, ph_hi;
};
#ifdef HIPEMU
#define CONSTAS
#else
#define CONSTAS __attribute__((address_space(4)))
#endif
struct Frame {
    unsigned char* lds;
    const CONSTAS Args* ap; float* out; unsigned char* ws;
    int tid, lane, wave, G, bid;
};
enum { I_X = 0, I_C, I_CTX, I_CCTX, I_ADAW, I_ADAB, I_NORMG, I_OUTW, I_W1, I_W2, I_HGLB, I_EVW, I_MLCONV, I_MLGB, I_MLNORM, I_RWMU, I_RWW0, I_RWW2,
       I_RWA0, I_RWA2, I_RWG2, I_RWKK, I_RWKA, I_RWRK, I_RWLNW, I_RWLNB, I_ODW, I_HGNORM, I_QNORM, I_WQB, I_KVNORM, I_WKVB };

DEVI const float* modp(const Frame& F, int layer, int s) { return (const float*)(F.ws + WS_MOD) + ((size_t)layer * 3 + s) * 6144; }

#ifdef HIPEMU
DEVI Frame relaunder(const Frame& F) { return F; }
DEVI Frame unit_frame(const Frame& F) { return F; }
#else
DEVI Frame relaunder(const Frame& F0) { Frame F = F0; int ln = __builtin_amdgcn_mbcnt_hi(~0u, __builtin_amdgcn_mbcnt_lo(~0u, 0u)); asm volatile("" : "+v"(ln)); __builtin_assume(ln >= 0 && ln < 64);
    F.lane = ln; F.tid = F0.wave * 64 + ln; return F; }
DEVI Frame unit_frame(const Frame& F0) { return relaunder(F0); }
#endif
namespace pg8 {
constexpr int BM = 256, BK = 64, HALF = 128, HTB = HALF * BK * 2, STAGE_BYTES = 8 * HTB, NXCD = 8, WGM = 8;
struct Unit { int pm, pn, ks; };
struct Gemm { const bf16_t* A; const bf16_t* Bt; int K, lda, ldb; };
DEVI int lds_byte(int r, int c) { const int st = (r >> 4) * 2 + (c >> 5), rr = r & 15, cc = c & 31, ob = rr * 64 + cc * 2; return st * 1024 + (ob ^ (((ob >> 9) & 1) << 5)); }
DEVI void stage_rc(int b, int& R, int& C) { const int st = b / 1024, sb = b % 1024, swz = sb ^ (((sb >> 9) & 1) << 5); R = (st >> 1) * 16 + swz / 64; C = (st & 1) * 32 + (swz % 64) / 2; }
DEVI int perm32(int rho) { const int n = rho >> 4, i = rho & 15; return 8 * (i >> 2) + 4 * n + (i & 3); }
struct Order {
    int nM, nN, nwg, G, c, lat_only, KS;
    DEVI void init(int nM_, int nN_, int G_, int c_, int lat, int ks_ = 1) { nM = nM_; nN = nN_; KS = ks_; nwg = nM * nN * KS; G = G_; c = c_; lat_only = lat; }
    DEVI bool next(int i, Unit& u) const {
        const long L = (long)i * G + c; if (L >= nwg) return false;
        u.ks = 0;
        if (lat_only == 2) { const int id = (int)L; u.ks = id % KS; const int r = id / KS; u.pn = r % nN; const int ct = r / nN; u.pm = (ct / NCTXCH) * NCH + (ct % NCTXCH); return true; }
        int wgid = (int)L; { const int q = nwg / NXCD, r = nwg % NXCD, xcd = wgid % NXCD, off = wgid / NXCD; wgid = (xcd < r ? xcd * (q + 1) : r * (q + 1) + (xcd - r) * q) + off; }
        const int nig = WGM * nN, gid = wgid / nig, fm = gid * WGM, gsz = (nM - fm) < WGM ? (nM - fm) : WGM;
        int pm = fm + ((wgid % nig) % gsz); u.pn = (wgid % nig) / gsz;
        if (lat_only) pm = (pm / NLT) * NCH + NCTXCH + (pm % NLT);
        u.pm = pm; return true;
    }
};
#ifndef HIPEMU
#define PG8_LAS __attribute__((address_space(3)))
template <class Epi>
__device__ __forceinline__ void gemm_phase(unsigned char* lds_g, const Gemm g, const Order& S, const Epi& E, int tid_in) {
    PG8_LAS unsigned char* lds = (PG8_LAS unsigned char*)lds_g;
    const int tid = tid_in, wid = __builtin_amdgcn_readfirstlane(tid >> 6), lane = tid & 63, wr = wid >> 2, wc = wid & 3, fr = lane & 15, fq = lane >> 4;
    const int K = g.K, nt = K / BK;
    unsigned voffA[2], voffB[2];
#pragma unroll
    for (int i = 0; i < 2; ++i) { int R, C; stage_rc(tid * 16 + i * 8192, R, C); const int Rb = Epi::PERM ? ((R & ~31) + perm32(R & 31)) : R;
        voffA[i] = (unsigned)(R * g.lda + C) * 2u; voffB[i] = (unsigned)(Rb * g.ldb + C) * 2u; }
    const size_t kstep = (size_t)(BK * 2);
    const size_t hstepA = (size_t)HALF * g.lda * 2, hstepB = (size_t)HALF * g.ldb * 2;
    const size_t tstepA = 2 * hstepA, tstepB = 2 * hstepB;
    const unsigned ldsw = (unsigned)wid * 1024u;
    const int aoff = lds_byte(wr * 64 + fr, fq * 8), boff = lds_byte(wc * 32 + fr, fq * 8);
#define PG8_SA(b, h) (((b) * 2 + (h)) * HTB)
#define PG8_SB(b, h) ((4 + (b) * 2 + (h)) * HTB)
#define PG8_STAGE(bufoff, gbase, voff) do { _Pragma("unroll") for (int _i = 0; _i < 2; ++_i) \
        __builtin_amdgcn_global_load_lds((const unsigned*)((const char*)(gbase) + (voff)[_i]), (PG8_LAS unsigned*)(lds + (bufoff) + ldsw + _i * 8192), 16, 0, 0); } while (0)
#define PG8_LDA(dst, b, h) do { _Pragma("unroll") for (int m = 0; m < 4; ++m) _Pragma("unroll") for (int k = 0; k < 2; ++k) dst[m][k] = *(const PG8_LAS bf16x8*)(lds + PG8_SA(b, h) + aoff + m * 2048 + k * 1024); } while (0)
#define PG8_LDB(dst, b, h) do { _Pragma("unroll") for (int n = 0; n < 2; ++n) _Pragma("unroll") for (int k = 0; k < 2; ++k) dst[n][k] = *(const PG8_LAS bf16x8*)(lds + PG8_SB(b, h) + boff + n * 2048 + k * 1024); } while (0)
#define PG8_MMA(ai, bj, At, Bt) do { __builtin_amdgcn_s_setprio(1); _Pragma("unroll") for (int m = 0; m < 4; ++m) _Pragma("unroll") for (int n = 0; n < 2; ++n) _Pragma("unroll") for (int k = 0; k < 2; ++k) \
        acc[ai][bj][m][n] = __builtin_amdgcn_mfma_f32_16x16x32_bf16(Bt[n][k], At[m][k], acc[ai][bj][m][n], 0, 0, 0); __builtin_amdgcn_s_setprio(0); } while (0)
#define PG8_WAIT_V(n) asm volatile("s_waitcnt vmcnt(" #n ")" ::: "memory")
#define PG8_WAIT_L(n) asm volatile("s_waitcnt lgkmcnt(" #n ")" ::: "memory")
#define PG8_BAR __builtin_amdgcn_s_barrier()
#define PG8_SCHED __builtin_amdgcn_sched_barrier(0)
    Unit cur, nxt; int ui = 0;
    if (!S.next(0, cur)) return;
    f32x4 acc[2][2][4][2];
#pragma unroll
    for (int a = 0; a < 2; ++a)
#pragma unroll
        for (int b = 0; b < 2; ++b)
#pragma unroll
            for (int m = 0; m < 4; ++m)
#pragma unroll
                for (int n = 0; n < 2; ++n) acc[a][b][m][n] = (f32x4){0.f, 0.f, 0.f, 0.f};
    bf16x8 At[4][2], B0[2][2], B1[2][2];
    const char* cA = (const char*)g.A + (size_t)cur.pm * tstepA + (size_t)cur.ks * K * 2; const char* cB = (const char*)g.Bt + (size_t)cur.pn * tstepB + (size_t)cur.ks * K * 2;
    PG8_STAGE(PG8_SB(0, 0), cB, voffB); PG8_STAGE(PG8_SB(0, 1), cB + hstepB, voffB); PG8_STAGE(PG8_SA(0, 0), cA, voffA); PG8_STAGE(PG8_SA(0, 1), cA + hstepA, voffA);
    if (wr == 1) PG8_BAR;
    PG8_WAIT_V(2); PG8_BAR;
    PG8_STAGE(PG8_SB(1, 0), cB + kstep, voffB); PG8_STAGE(PG8_SA(1, 0), cA + kstep, voffA); PG8_STAGE(PG8_SB(1, 1), cB + hstepB + kstep, voffB);
    PG8_WAIT_V(6); PG8_BAR;
    for (;;) {
        const bool has_next = S.next(ui + 1, nxt);
        const char* nA = has_next ? (const char*)g.A + (size_t)nxt.pm * tstepA + (size_t)nxt.ks * K * 2 : cA; const char* nB = has_next ? (const char*)g.Bt + (size_t)nxt.pn * tstepB + (size_t)nxt.ks * K * 2 : cB;
#pragma unroll 1
        for (int t = 0; t < nt; t += 2) {
            const bool last = (t == nt - 2);
            const char* a1 = cA + (size_t)(t + 1) * kstep;
            const char* a2 = last ? nA : cA + (size_t)(t + 2) * kstep; const char* b2 = last ? nB : cB + (size_t)(t + 2) * kstep;
            const char* a3 = a2 + kstep; const char* b3 = b2 + kstep;
            PG8_LDB(B0, 0, 0); PG8_LDB(B1, 0, 1); PG8_SCHED; PG8_LDA(At, 0, 0); PG8_STAGE(PG8_SA(1, 1), a1 + hstepA, voffA);
            PG8_WAIT_V(8); PG8_WAIT_L(0); PG8_BAR; PG8_MMA(0, 0, At, B0); PG8_MMA(0, 1, At, B1); PG8_BAR; PG8_SCHED;
            PG8_LDA(At, 0, 1); PG8_STAGE(PG8_SB(0, 0), b2, voffB); PG8_STAGE(PG8_SB(0, 1), b2 + hstepB, voffB); PG8_STAGE(PG8_SA(0, 0), a2, voffA);
            PG8_WAIT_V(8); PG8_WAIT_L(0); PG8_BAR; PG8_MMA(1, 0, At, B0); PG8_MMA(1, 1, At, B1); PG8_BAR; PG8_SCHED;
            PG8_LDB(B0, 1, 0); PG8_LDB(B1, 1, 1); PG8_SCHED; PG8_LDA(At, 1, 0); PG8_STAGE(PG8_SA(0, 1), a2 + hstepA, voffA);
            PG8_WAIT_V(8); PG8_WAIT_L(0); PG8_BAR; PG8_MMA(0, 0, At, B0); PG8_MMA(0, 1, At, B1); PG8_BAR; PG8_SCHED;
            PG8_LDA(At, 1, 1); PG8_STAGE(PG8_SB(1, 0), b3, voffB); PG8_STAGE(PG8_SB(1, 1), b3 + hstepB, voffB); PG8_STAGE(PG8_SA(1, 0), a3, voffA);
            PG8_WAIT_V(8); PG8_WAIT_L(0); PG8_BAR; PG8_MMA(1, 0, At, B0); PG8_MMA(1, 1, At, B1); PG8_BAR; PG8_SCHED;
        }
        if (wr == 0) PG8_BAR;
        E(acc, cur, wr, wc, fr, fq);
        if (!has_next) break;
#pragma unroll
        for (int a = 0; a < 2; ++a)
#pragma unroll
            for (int b = 0; b < 2; ++b)
#pragma unroll
                for (int m = 0; m < 4; ++m)
#pragma unroll
                    for (int n = 0; n < 2; ++n) acc[a][b][m][n] = (f32x4){0.f, 0.f, 0.f, 0.f};
        cur = nxt; cA = nA; cB = nB; ++ui;
        if (wr == 1) PG8_BAR;
    }
    PG8_WAIT_V(0);
    PG8_BAR;
#undef PG8_SA
#undef PG8_SB
#undef PG8_STAGE
#undef PG8_LDA
#undef PG8_LDB
#undef PG8_MMA
#undef PG8_WAIT_V
#undef PG8_WAIT_L
#undef PG8_BAR
#undef PG8_SCHED
}
#else
template <class Epi>
static inline void gemm_phase(unsigned char*, const Gemm g, const Order& S, const Epi& E, int tid_in) {
    const int tid = tid_in, wid = tid >> 6, lane = tid & 63, wr = wid >> 2, wc = wid & 3, fr = lane & 15, fq = lane >> 4;
    Unit u;
    for (int ui = 0; S.next(ui, u); ++ui) {
        f32x4 acc[2][2][4][2];
        for (int ai = 0; ai < 2; ++ai) for (int bj = 0; bj < 2; ++bj) for (int m = 0; m < 4; ++m) for (int n = 0; n < 2; ++n) for (int e = 0; e < 4; ++e) {
            const int row = u.pm * 256 + 128 * ai + 64 * wr + 16 * m + fr;
            const int col = u.pn * 256 + 128 * bj + 32 * wc + (Epi::PERM ? (8 * fq + 4 * n + e) : (16 * n + 4 * fq + e));
            const bf16_t* a = g.A + (size_t)row * g.lda + (size_t)u.ks * g.K; const bf16_t* b = g.Bt + (size_t)col * g.ldb + (size_t)u.ks * g.K; float s = 0.f;
            for (int k = 0; k < g.K; ++k) s += bf2f(a[k]) * bf2f(b[k]);
            acc[ai][bj][m][n][e] = s; }
        E(acc, u, wr, wc, fr, fq);
    }
    __syncthreads();
}
#endif
template <int ACT> struct EpiBf16 {
    static constexpr bool PERM = true;
    bf16_t* O; int ldc;
    DEVI void operator()(const f32x4 (&acc)[2][2][4][2], const Unit& u, int wr, int wc, int fr, int fq) const {
        const int row0 = u.pm * BM + wr * 64 + fr, col0 = u.pn * BM + wc * 32 + 8 * fq;
#pragma unroll
        for (int ai = 0; ai < 2; ++ai)
#pragma unroll
            for (int m = 0; m < 4; ++m) { bf16_t* rowp = O + (size_t)(row0 + ai * HALF + m * 16) * ldc + col0;
#pragma unroll
                for (int bj = 0; bj < 2; ++bj) { f32x4 v0 = acc[ai][bj][m][0], v1 = acc[ai][bj][m][1];
                    if (ACT == 1) {
#pragma unroll
                        for (int e = 0; e < 4; ++e) { float a = v0[e] > 0.f ? v0[e] : 0.f, b = v1[e] > 0.f ? v1[e] : 0.f; v0[e] = a * a; v1[e] = b * b; } }
                    u32x4 w; w[0] = pk2(v0[0], v0[1]); w[1] = pk2(v0[2], v0[3]); w[2] = pk2(v1[0], v1[1]); w[3] = pk2(v1[2], v1[3]);
                    *(u32x4*)(rowp + bj * HALF) = w; } }
    }
};
struct EpiF32 {
    static constexpr bool PERM = false;
    float* C; int ldc;
    DEVI void operator()(const f32x4 (&acc)[2][2][4][2], const Unit& u, int wr, int wc, int fr, int fq) const {
        const int row0 = u.pm * BM + wr * 64 + fr, col0 = u.pn * BM + wc * 32 + 4 * fq;
#pragma unroll
        for (int ai = 0; ai < 2; ++ai)
#pragma unroll
            for (int m = 0; m < 4; ++m) { float* rowp = C + (size_t)(row0 + ai * HALF + m * 16) * ldc + col0;
#pragma unroll
                for (int bj = 0; bj < 2; ++bj)
#pragma unroll
                    for (int n = 0; n < 2; ++n) *(f32x4*)(rowp + bj * HALF + n * 16) = acc[ai][bj][m][n]; }
    }
};
struct EpiF32Slab {
    static constexpr bool PERM = false;
    float* C; int ldc;
    DEVI void operator()(const f32x4 (&acc)[2][2][4][2], const Unit& u, int wr, int wc, int fr, int fq) const {
        const int rbase = (u.pm / NCH) * CTX + (u.pm % NCH) * 256; float* Cs = C + (size_t)u.ks * NB * CTX * ldc;
        const int row0 = rbase + wr * 64 + fr, col0 = u.pn * BM + wc * 32 + 4 * fq;
#pragma unroll
        for (int ai = 0; ai < 2; ++ai)
#pragma unroll
            for (int m = 0; m < 4; ++m) { float* rowp = Cs + (size_t)(row0 + ai * HALF + m * 16) * ldc + col0;
#pragma unroll
                for (int bj = 0; bj < 2; ++bj)
#pragma unroll
                    for (int n = 0; n < 2; ++n) *(f32x4*)(rowp + bj * HALF + n * 16) = acc[ai][bj][m][n]; }
    }
};
struct EpiQ {
    static constexpr bool PERM = true;
    unsigned char* ws;
    DEVI void operator()(const f32x4 (&acc)[2][2][4][2], const Unit& u, int wr, int wc, int fr, int fq) const {
        bf16_t* O = (bf16_t*)(ws + WS_SCR + SC_Q); const float* rstd = (const float*)(ws + WS_RSTD); const float* ropec = (const float*)(ws + WS_ROPE); const float* ropes = ropec + 128 * 16;
        const int row0 = u.pm * BM + wr * 64 + fr, col0 = u.pn * BM + wc * 32 + 8 * fq;
#pragma unroll
        for (int ai = 0; ai < 2; ++ai)
#pragma unroll
            for (int m = 0; m < 4; ++m) { const int row = row0 + ai * HALF + m * 16; const float rs = rstd[row];
                const int tt = row % T; const bool lat = tt >= CTX; const int li = lat ? tt - CTX : 0; const int prow = li / GRIDW, pcol = li % GRIDW;
#pragma unroll
                for (int bj = 0; bj < 2; ++bj) { const int col = col0 + bj * HALF; const int j = col % 192;
                    float v[8], p[8];
#pragma unroll
                    for (int e = 0; e < 4; ++e) { v[e] = acc[ai][bj][m][0][e] * rs; v[4 + e] = acc[ai][bj][m][1][e] * rs; }
#pragma unroll
                    for (int e = 0; e < 8; ++e) p[e] = shx<32>(v[e]);
                    if (j >= 128 && lat) { const int ro = j - 128, half = ro >> 5, w = ro & 31; const int pos = half ? pcol : prow; const bool lo = w < 16; const int i0 = lo ? w : w - 16;
#pragma unroll
                        for (int e = 0; e < 8; ++e) { const float c = ropec[pos * 16 + i0 + e], s = ropes[pos * 16 + i0 + e]; v[e] = lo ? (v[e] * c - p[e] * s) : (p[e] * s + v[e] * c); } }
                    u32x4 w4; w4[0] = pk2(v[0], v[1]); w4[1] = pk2(v[2], v[3]); w4[2] = pk2(v[4], v[5]); w4[3] = pk2(v[6], v[7]);
                    *(u32x4*)(O + (size_t)row * 768 + col) = w4; FENCE(); } }
    }
};
struct EpiKV {
    static constexpr bool PERM = true;
    unsigned char* ws;
    DEVI void operator()(const f32x4 (&acc)[2][2][4][2], const Unit& u, int wr, int wc, int fr, int fq) const {
        bf16_t* KN = (bf16_t*)(ws + WS_SCR + SC_KN); bf16_t* V = (bf16_t*)(ws + WS_SCR + SC_V); const float* rstd = (const float*)(ws + WS_RSTD) + M;
        const int row0 = u.pm * BM + wr * 64 + fr, col0 = u.pn * BM + wc * 32 + 8 * fq;
#pragma unroll
        for (int ai = 0; ai < 2; ++ai)
#pragma unroll
            for (int m = 0; m < 4; ++m) { const int row = row0 + ai * HALF + m * 16; const float rs = rstd[row];
#pragma unroll
                for (int bj = 0; bj < 2; ++bj) { const int col = col0 + bj * HALF; const int h = col >> 8, j = col & 255;
                    f32x4 v0 = acc[ai][bj][m][0] * rs, v1 = acc[ai][bj][m][1] * rs;
                    u32x4 w4; w4[0] = pk2(v0[0], v0[1]); w4[1] = pk2(v0[2], v0[3]); w4[2] = pk2(v1[0], v1[1]); w4[3] = pk2(v1[2], v1[3]);
                    bf16_t* dst = (j < 128) ? (KN + (size_t)row * 512 + h * 128 + j) : (V + (size_t)row * 512 + h * 128 + (j - 128));
                    *(u32x4*)dst = w4; FENCE(); } }
    }
};
}

template <class DMap>
DEVI void transpose_item(const float* W, int K, int N, bf16_t* WT, int ldk, const float* kscale, float* scr, int item, int lane, DMap dmap) {
    const int nblk = (N + 31) / 32, kb = item / nblk, nb = item % nblk, k0 = 64 * kb, n0 = 32 * nb;
    { const int rsub = lane >> 3, c4 = (lane & 7) * 4; const bool ok = n0 + c4 < N; const int cc = ok ? n0 + c4 : 0;
      f32x4 v[8];
#pragma unroll
      for (int i = 0; i < 8; ++i) v[i] = *(const f32x4*)(W + (size_t)(k0 + i * 8 + rsub) * N + cc);
#pragma unroll
      for (int i = 0; i < 8; ++i) { const int kk = i * 8 + rsub; const float ks = kscale ? kscale[k0 + kk] : 1.f;
#pragma unroll
          for (int e = 0; e < 4; ++e) scr[kk * 33 + c4 + e] = ok ? v[i][e] * ks : 0.f; } }
    WAVE_SYNC();
    const int c = lane & 7;
#pragma unroll
    for (int j = 0; j < 4; ++j) { const int n = (lane >> 3) + 8 * j; const float* s = scr + (8 * c) * 33 + n;
        if (n0 + n < N) { u32x4 o; o[0] = pk2(s[0 * 33], s[1 * 33]); o[1] = pk2(s[2 * 33], s[3 * 33]); o[2] = pk2(s[4 * 33], s[5 * 33]); o[3] = pk2(s[6 * 33], s[7 * 33]);
            *(u32x4*)(WT + (size_t)dmap(n0 + n) * ldk + k0 + 8 * c) = o; } }
    WAVE_SYNC();
}
struct DMapId { DEVI int operator()(int n) const { return n; } };
struct DMapEv { DEVI int operator()(int n) const { return n < 2048 ? n : (n < 2064 ? E_MG + (n - 2048) : E_RF + (n - 2064)); } };
template <class DMap>
DEVI void convert_weight(const Frame& F, const float* W, int K, int N, bf16_t* WT, int ldk, const float* kscale, DMap dmap, int& wcur) {
    float* scr = (float*)(F.lds) + F.wave * (64 * 33);
    const int items = (K / 64) * ((N + 31) / 32), NGW = F.G * 8, gw = F.bid * 8 + F.wave;
    int first = (gw - wcur % NGW + NGW) % NGW;
    for (int it = first; it < items; it += NGW) transpose_item(W, K, N, WT, ldk, kscale, scr, it, F.lane, dmap);
    wcur += items;
}
DEVI void zero_rows(const Frame& F, bf16_t* WT, int ldk, int r0, int r1, int c0 = 0, int c1 = -1) {
    if (c1 < 0) c1 = ldk; const int w8 = (c1 - c0) / 8, n = (r1 - r0) * w8;
    for (int i = F.bid * NTHREADS + F.tid; i < n; i += F.G * NTHREADS) { const int r = r0 + i / w8, c = c0 + (i % w8) * 8; *(u32x4*)(WT + (size_t)r * ldk + c) = (u32x4){0u, 0u, 0u, 0u}; }
}
DEVI void convert_layer_weights(const Frame& F, int layer) {
    bf16_t* Wb = (bf16_t*)(F.ws + WS_W); int wcur = 0;
    if (layer == 0) {
        convert_weight(F, F.ap->in[I_EVW], D, 3984, Wb + W_IN / 2, D, nullptr, DMapEv(), wcur);
        zero_rows(F, Wb + W_IN / 2, D, 3984, EVP);
    } else {
        convert_weight(F, F.ap->in[I_ODW], D, 3008, Wb + W_IN / 2, D, nullptr, DMapId(), wcur);
        zero_rows(F, Wb + W_IN / 2, D, 3008, ODP);
        convert_weight(F, F.ap->in[I_WQB], 256, 768, Wb + W_QB / 2, 256, F.ap->in[I_QNORM], DMapId(), wcur);
        convert_weight(F, F.ap->in[I_WKVB], 128, 1024, Wb + W_KVB / 2, 256, F.ap->in[I_KVNORM], DMapId(), wcur);
        zero_rows(F, Wb + W_KVB / 2, 256, 0, 1024, 128, 256);
    }
    convert_weight(F, F.ap->in[I_OUTW] + (size_t)layer * D * D, D, D, Wb + W_OUT / 2, D, nullptr, DMapId(), wcur);
    convert_weight(F, F.ap->in[I_W1] + (size_t)layer * D * DFF, D, DFF, Wb + W_1 / 2, D, nullptr, DMapId(), wcur);
    convert_weight(F, F.ap->in[I_W2] + (size_t)layer * DFF * D, DFF, D, Wb + W_2 / 2, DFF, nullptr, DMapId(), wcur);
}
DEVI void ada_units(const Frame& F) {
    float* sc = (float*)F.lds;
    float* part = sc + 3 * 1024;
    constexpr int CW = 48, UPL = 6144 / CW;
    bool have = false;
    for (int u = F.bid; u < 2 * UPL; u += F.G) {
        if (!have) { for (int i = F.tid; i < 3 * 1024; i += NTHREADS) { const int s = i >> 10, k = i & 1023; const float c = (s < 2) ? (s < NB ? F.ap->in[I_C][s * 1024 + k] : 0.f) : F.ap->in[I_CCTX][k]; sc[i] = siluf_(c); } have = true; }
        __syncthreads();
        const int l = u / UPL, c0 = (u % UPL) * CW, col = c0 + (F.lane < CW ? F.lane : 0); const float* W = F.ap->in[I_ADAW] + (size_t)l * 1024 * 6144 + col;
        float a0 = 0.f, a1 = 0.f, a2 = 0.f;
#pragma unroll 32
        for (int kk = 0; kk < 128; ++kk) { const int k = F.wave * 128 + kk; const float w = W[(size_t)k * 6144]; a0 += sc[k] * w; a1 += sc[1024 + k] * w; a2 += sc[2048 + k] * w; }
        part[(F.wave * 3 + 0) * 64 + F.lane] = a0; part[(F.wave * 3 + 1) * 64 + F.lane] = a1; part[(F.wave * 3 + 2) * 64 + F.lane] = a2;
        __syncthreads();
        if (F.tid < 192) { const int s = F.tid >> 6, ln = F.tid & 63; float t = 0.f; for (int w = 0; w < 8; ++w) t += part[(w * 3 + s) * 64 + ln];
            const int c2 = c0 + ln; if (ln < CW) ((float*)(F.ws + WS_MOD))[((size_t)l * 3 + s) * 6144 + c2] = t + F.ap->in[I_ADAB][l * 6144 + c2]; }
    }
    __syncthreads();
}
DEVI void rope_tables(const Frame& F) {
    float* rc = (float*)(F.ws + WS_ROPE); float* rs = rc + 128 * 16;
    for (int i = F.bid * NTHREADS + F.tid; i < 128 * 16; i += F.G * NTHREADS) { const int pos = i >> 4, j = i & 15; const float inv = powf(10000.f, -(float)j / 16.f); const float ang = (float)pos * inv; rc[i] = cosf(ang); rs[i] = sinf(ang); }
}

struct RowVec { f32x4 v[4]; };
DEVI RowVec ld_row_b(const bf16_t* p, int lane) { RowVec r; const u32x2* q = (const u32x2*)p + lane;
#pragma unroll
    for (int j = 0; j < 4; ++j) { const u32x2 w = q[64 * j]; const unsigned a = w[0], b2 = w[1]; r.v[j][0] = bf2f(a); r.v[j][1] = bf2f(a >> 16); r.v[j][2] = bf2f(b2); r.v[j][3] = bf2f(b2 >> 16); } return r; }
DEVI RowVec ld_row(const float* p, int lane) { RowVec r; const f32x4* q = (const f32x4*)p + lane;
#pragma unroll
    for (int j = 0; j < 4; ++j) r.v[j] = q[64 * j]; return r; }
DEVI void st_row(float* p, int lane, const RowVec& r) { f32x4* q = (f32x4*)p + lane;
#pragma unroll
    for (int j = 0; j < 4; ++j) q[64 * j] = r.v[j]; }
DEVI float row_rstd(const RowVec& r) { float s = 0.f;
#pragma unroll
    for (int j = 0; j < 4; ++j) s += (r.v[j][0] * r.v[j][0] + r.v[j][1] * r.v[j][1]) + (r.v[j][2] * r.v[j][2] + r.v[j][3] * r.v[j][3]);
    return RSQ(wave_sum(s) * (1.f / D) + EPS); }
DEVI void st_mod_bf16(bf16_t* orow, int lane, const RowVec& x, float rstd, const float* g, const float* shift, const float* scale) {
    unsigned long long* o8 = (unsigned long long*)orow + lane;
#pragma unroll
    for (int j = 0; j < 4; ++j) { const f32x4 gg = ((const f32x4*)g)[lane + 64 * j], sh = ((const f32x4*)shift)[lane + 64 * j], sc = ((const f32x4*)scale)[lane + 64 * j];
        f32x4 y;
#pragma unroll
        for (int e = 0; e < 4; ++e) y[e] = (x.v[j][e] * rstd * gg[e]) * (1.f + sc[e]) + sh[e];
        o8[64 * j] = (unsigned long long)pk2(y[0], y[1]) | ((unsigned long long)pk2(y[2], y[3]) << 32); }
}
DEVI float* stream_row(const Frame& F, int b, int t) { return (t < CTX) ? (float*)(F.ws + WS_XC) + ((size_t)b * CTX + t) * D : F.out + ((size_t)b * SEQ + (t - CTX)) * D; }
DEVI bf16_t* xs_lat(const Frame& F, int idx) { return (idx == 2) ? (bf16_t*)F.out : (bf16_t*)(F.ws + WS_SCR); }
DEVI void st_row_b(bf16_t* p, int lane, const RowVec& r) { unsigned long long* o8 = (unsigned long long*)p + lane;
#pragma unroll
    for (int j = 0; j < 4; ++j) o8[64 * j] = (unsigned long long)pk2(r.v[j][0], r.v[j][1]) | ((unsigned long long)pk2(r.v[j][2], r.v[j][3]) << 32); }
DEVI const float* input_row(const Frame& F, int b, int t) { return (t < CTX) ? F.ap->in[I_CTX] + ((size_t)b * CTX + t) * D : F.ap->in[I_X] + ((size_t)b * SEQ + (t - CTX)) * D; }
struct RowCoef { RowVec ga, sh, gy; };
DEVI void coef_mod(RowCoef& c, int lane, const float* g, const float* shift, const float* scale) {
#pragma unroll
    for (int j = 0; j < 4; ++j) { const f32x4 gg = ((const f32x4*)g)[lane + 64 * j], sh = ((const f32x4*)shift)[lane + 64 * j], sc = ((const f32x4*)scale)[lane + 64 * j];
#pragma unroll
        for (int e = 0; e < 4; ++e) { c.ga.v[j][e] = gg[e] * (1.f + sc[e]); c.sh.v[j][e] = sh[e]; } }
}
DEVI void st_mod_c(bf16_t* orow, int lane, const RowVec& x, float rstd, const RowCoef& c) {
    unsigned long long* o8 = (unsigned long long*)orow + lane;
#pragma unroll
    for (int j = 0; j < 4; ++j) { f32x4 y;
#pragma unroll
        for (int e = 0; e < 4; ++e) y[e] = (x.v[j][e] * rstd) * c.ga.v[j][e] + c.sh.v[j][e];
        o8[64 * j] = (unsigned long long)pk2(y[0], y[1]) | ((unsigned long long)pk2(y[2], y[3]) << 32); }
}
DEVI void phase_hj0(const Frame& F) {
    const int gw = F.bid * 8 + F.wave, NGW = F.G * 8; bf16_t* HJ = (bf16_t*)(F.ws + WS_ACT);
    int r = gw; if (r >= M) return;
    RowVec x = ld_row(input_row(F, r / T, r % T), F.lane); int cur_s = -1; RowCoef c;
    for (;;) { const int rn = r + NGW; RowVec xn = x; if (rn < M) xn = ld_row(input_row(F, rn / T, rn % T), F.lane);
        const int b = r / T, t = r % T, s = (t < CTX) ? 2 : b;
        if (s != cur_s) { const float* mod = modp(F, 0, s); coef_mod(c, F.lane, F.ap->in[I_NORMG], mod + 0, mod + 1024); cur_s = s; }
        const float rs = row_rstd(x);
        st_mod_c(HJ + (size_t)r * D, F.lane, x, rs, c);
        if (rn >= M) break; r = rn; x = xn; }
}
struct ResidIn { RowVec y, x; };
DEVI ResidIn resid_load(const Frame& F, int layer, int which, const bf16_t* Y, const float* slab, int nks, int r) {
    ResidIn in; const int b = r / T, t = r % T;
    if (slab && t < CTX) { in.y = ld_row(slab + ((size_t)b * CTX + t) * D, F.lane);
        for (int ks = 1; ks < nks; ++ks) { const RowVec y2 = ld_row(slab + ((size_t)ks * NB * CTX + (size_t)b * CTX + t) * D, F.lane);
#pragma unroll
            for (int j = 0; j < 4; ++j) in.y.v[j] += y2.v[j]; } }
    else in.y = ld_row_b(Y + (size_t)r * D, F.lane);
    const int step = layer * 2 + which;
    if (step == 0) in.x = ld_row(input_row(F, b, t), F.lane);
    else if (t < CTX) in.x = ld_row(stream_row(F, b, t), F.lane);
    else in.x = ld_row_b(xs_lat(F, step) + ((size_t)b * SEQ + (t - CTX)) * D, F.lane);
    return in;
}
DEVI int resid_next_row(int r, int NGW, bool lat_only) { r += NGW; while (lat_only && r < M && (r % T) < CTX) r += NGW; return r; }
DEVI void phase_resid(const Frame& F, int layer, int which, const bf16_t* Y, bool lat_only, bf16_t* AO, const float* slab = nullptr, int nks = 0) {
    const int gw = F.bid * 8 + F.wave, NGW = F.G * 8;
    const float* ng = F.ap->in[I_NORMG] + (size_t)layer * 4 * D;
    int r = gw; while (lat_only && r < M && (r % T) < CTX) r += NGW;
    if (r >= M) return;
    ResidIn cur = resid_load(F, layer, which, Y, slab, nks, r); int cur_s = -1; RowCoef c;
    for (;;) { const int rn = resid_next_row(r, NGW, lat_only); ResidIn nxt = cur; if (rn < M) nxt = resid_load(F, layer, which, Y, slab, nks, rn);
        const int b = r / T, t = r % T; const int s = (t < CTX) ? 2 : b;
        if (s != cur_s) { const float* mod = modp(F, layer, s); cur_s = s;
            const float* gn = ng + (which == 0 ? 1 : 3) * D; const float* gate = mod + (which == 0 ? 2048 : 5120);
#pragma unroll
            for (int j = 0; j < 4; ++j) { const f32x4 gg = ((const f32x4*)gn)[F.lane + 64 * j], gt = ((const f32x4*)gate)[F.lane + 64 * j];
#pragma unroll
                for (int e = 0; e < 4; ++e) c.gy.v[j][e] = gg[e] * gt[e]; }
            if (which == 0) coef_mod(c, F.lane, ng + 2 * D, mod + 3072, mod + 4096);
            else if (layer == 0) { const float* mod1 = modp(F, 1, s); coef_mod(c, F.lane, F.ap->in[I_NORMG] + (size_t)1 * 4 * D, mod1 + 0, mod1 + 1024); } }
        const float rsy = row_rstd(cur.y); RowVec x = cur.x;
#pragma unroll
        for (int j = 0; j < 4; ++j) {
#pragma unroll
            for (int e = 0; e < 4; ++e) x.v[j][e] += (cur.y.v[j][e] * rsy) * c.gy.v[j][e]; }
        if (t < CTX || layer * 2 + which == 3) st_row(stream_row(F, b, t), F.lane, x);
        else st_row_b(xs_lat(F, layer * 2 + which + 1) + ((size_t)b * SEQ + (t - CTX)) * D, F.lane, x);
        if (which == 0 || layer == 0) { const float rs = row_rstd(x); st_mod_c(AO + (size_t)r * D, F.lane, x, rs, c); }
        if (rn >= M) break; r = rn; cur = nxt; }
}

DEVI void wave_scan256(float* arr, int lane, int op, bool rev) {
    float v[4];
#pragma unroll
    for (int e = 0; e < 4; ++e) { const int i = 4 * lane + e; v[e] = arr[rev ? 255 - i : i]; }
#pragma unroll
    for (int e = 1; e < 4; ++e) v[e] = op ? fmaxf(v[e], v[e - 1]) : v[e] + v[e - 1];
    float tot = v[3];
#pragma unroll
    for (int o = 1; o < 64; o <<= 1) { const float n = shfl_up_l(tot, o, lane); if (lane >= o) tot = op ? fmaxf(tot, n) : tot + n; }
    float ex = shfl_up_l(tot, 1, lane);
#pragma unroll
    for (int e = 0; e < 4; ++e) { float r = v[e]; if (lane > 0) r = op ? fmaxf(r, ex) : r + ex; const int i = 4 * lane + e; arr[rev ? 255 - i : i] = r; }
}

struct MlGates { float *a_fw, *pm_fw, *b_fw, *a_bw, *pm_bw, *b_bw; };
DEVI MlGates ml_gate_ptrs(float* base) { MlGates g; g.a_fw = base; g.pm_fw = base + 256; g.b_fw = base + 512; g.a_bw = base + 768; g.pm_bw = base + 1024; g.b_bw = base + 1280; return g; }
DEVI void ml_gates_setup(const Frame& F, const MlGates& g, int b, int h, int c) {
    const bf16_t* PROJ = (const bf16_t*)(F.ws + WS_BIG); const float* gb = F.ap->in[I_MLGB];
    if (F.tid < 256) { const int row = grow(b, c * 256 + F.tid); const bf16_t* p = PROJ + (size_t)row * EVP + E_MG;
        const float igf = bf2f(p[0 + h]) + gb[0 + h], fgf = bf2f(p[4 + h]) + gb[4 + h], igb = bf2f(p[8 + h]) + gb[8 + h], fgb = bf2f(p[12 + h]) + gb[12 + h];
        g.b_fw[F.tid] = logsigmoidf_(fgf); g.a_fw[F.tid] = igf; g.b_bw[F.tid] = logsigmoidf_(fgb); g.a_bw[F.tid] = igb; }
    __syncthreads();
    if (F.wave == 0) wave_scan256(g.b_fw, F.lane, 0, false);
    if (F.wave == 1) wave_scan256(g.b_bw, F.lane, 0, true);
    __syncthreads();
    if (F.tid < 256) { const float af = g.a_fw[F.tid] - g.b_fw[F.tid], ab = g.a_bw[F.tid] - g.b_bw[F.tid]; g.a_fw[F.tid] = af; g.pm_fw[F.tid] = af; g.a_bw[F.tid] = ab; g.pm_bw[F.tid] = ab; }
    __syncthreads();
    if (F.wave == 0) wave_scan256(g.pm_fw, F.lane, 1, false);
    if (F.wave == 1) wave_scan256(g.pm_bw, F.lane, 1, true);
    __syncthreads();
}
DEVI void ml_conv8(const bf16_t* PROJ, const float* cw, int b, int t, int col, int cch, float scale, float* out) {
    const int lo = (t < CTX) ? 0 : CTX, hi = (t < CTX) ? CTX : T;
    float x0[8], x1[8], x2[8];
    unpack8(ld8(PROJ + (size_t)grow(b, t) * EVP + col), x1);
    if (t - 1 >= lo) unpack8(ld8(PROJ + (size_t)grow(b, t - 1) * EVP + col), x0); else { for (int e = 0; e < 8; ++e) x0[e] = 0.f; }
    if (t + 1 < hi) unpack8(ld8(PROJ + (size_t)grow(b, t + 1) * EVP + col), x2); else { for (int e = 0; e < 8; ++e) x2[e] = 0.f; }
#pragma unroll
    for (int e = 0; e < 8; ++e) out[e] = (cw[cch + e] * x0[e] + cw[1024 + cch + e] * x1[e] + cw[2048 + cch + e] * x2[e]) * scale;
}
constexpr float ML_KSCALE = 0.08838834764831845f;
constexpr int LDT = 72;
DEVI void ml_phaseA_unit(const Frame& F, int b, int h, int c) {
    const bf16_t* PROJ = (const bf16_t*)(F.ws + WS_BIG);
    float* gbase = (float*)F.lds; MlGates g = ml_gate_ptrs(gbase);
    float* wfw = gbase + 1536; float* wbw = wfw + 256;
    constexpr int RSV = 160;
    bf16_t* Vf = (bf16_t*)(F.lds + 8192); bf16_t* Vb = Vf + 64 * RSV; bf16_t* Kr = Vb + 64 * RSV;
    const int dir = F.wave >> 2, vt = F.wave & 3;
    const int lj = F.tid >> 3, cg8 = F.tid & 7; const float* cw = F.ap->in[I_MLCONV];
    bf16x8 pv[2], pk0[2], pk1[2], pk2[2];
#define MLA_ISSUE(jb_) do { const int t = c * 256 + (jb_) * 64 + lj; const int lo = (t < CTX) ? 0 : CTX, hi2 = (t < CTX) ? CTX : T; const int tm = (t - 1 >= lo) ? t - 1 : t, tp = (t + 1 < hi2) ? t + 1 : t; \
        _Pragma("unroll") for (int half = 0; half < 2; ++half) { const int ch = cg8 * 16 + half * 8; pv[half] = ld8(PROJ + (size_t)grow(b, t) * EVP + E_MV + h * 128 + ch); \
            pk0[half] = ld8(PROJ + (size_t)grow(b, tm) * EVP + E_MK + h * 128 + ch); pk1[half] = ld8(PROJ + (size_t)grow(b, t) * EVP + E_MK + h * 128 + ch); pk2[half] = ld8(PROJ + (size_t)grow(b, tp) * EVP + E_MK + h * 128 + ch); } } while (0)
    MLA_ISSUE(0);
    ml_gates_setup(F, g, b, h, c);
    if (F.tid < 256) { wfw[F.tid] = __expf(g.a_fw[F.tid] - g.pm_fw[255]); wbw[F.tid] = __expf(g.a_bw[F.tid] - g.pm_bw[0]); }
    f32x16 acc[4];
#pragma unroll
    for (int i = 0; i < 4; ++i) acc[i] = (f32x16){};
    float nacc = 0.f;
    for (int jb = 0; jb < 4; ++jb) {
        __syncthreads();
        { const int t = c * 256 + jb * 64 + lj; const float wf = wfw[jb * 64 + lj], wb = wbw[jb * 64 + lj];
          const int lo = (t < CTX) ? 0 : CTX, hi2 = (t < CTX) ? CTX : T; const bool hm = t - 1 >= lo, hp = t + 1 < hi2;
#pragma unroll
          for (int half = 0; half < 2; ++half) { const int ch = cg8 * 16 + half * 8, cch = 512 + h * 128 + ch; float v[8], k[8], x0[8], x1[8], x2[8], vf[8], vb[8];
            unpack8(pv[half], v); unpack8(pk0[half], x0); unpack8(pk1[half], x1); unpack8(pk2[half], x2);
#pragma unroll
            for (int e = 0; e < 8; ++e) { k[e] = (cw[cch + e] * (hm ? x0[e] : 0.f) + cw[1024 + cch + e] * x1[e] + cw[2048 + cch + e] * (hp ? x2[e] : 0.f)) * ML_KSCALE; vf[e] = v[e] * wf; vb[e] = v[e] * wb; }
            const bf16x8 kp = pack8(k); *(bf16x8*)((bf16_t*)((unsigned char*)F.out + OUT_KC) + (size_t)grow(b, t) * 512 + h * 128 + ch) = kp;
            *(bf16x8*)(Vf + lj * RSV + ch) = pack8(vf); *(bf16x8*)(Vb + lj * RSV + ch) = pack8(vb); *(bf16x8*)(Kr + lj * RSV + ch) = kp; } }
        __syncthreads();
        if (jb + 1 < 4) MLA_ISSUE(jb + 1);
        const bf16_t* Vx = dir ? Vb : Vf;
#pragma unroll
        for (int ks = 0; ks < 4; ++ks) { const bf16x8 a = ld_tr_B(Vx, RSV, ks * 16, vt * 32, F.lane);
#pragma unroll
            for (int dt = 0; dt < 4; ++dt) acc[dt] = mfma32(a, ld_tr_B(Kr, RSV, ks * 16, dt * 32, F.lane), acc[dt]); }
        if (F.tid < 256) { const int dd = F.tid >> 7, d = F.tid & 127; const float* w = dd ? wbw : wfw; float s = 0.f;
#pragma unroll 8
            for (int j = 0; j < 64; ++j) s += bf2f(Kr[j * RSV + d]) * w[jb * 64 + j];
            nacc += s; }
    }
#undef MLA_ISSUE
    const int r32 = F.lane & 31, hi = F.lane >> 5;
    const int stream = (b * 4 + h) * 2 + dir;
    float* Cg = (float*)(F.ws + WS_SCR + SC_MLC) + ((size_t)stream * NCH + c) * 16384;
#pragma unroll
    for (int dt = 0; dt < 4; ++dt)
#pragma unroll
        for (int r = 0; r < 16; ++r) Cg[(vt * 32 + crow(r, hi)) * 128 + dt * 32 + r32] = acc[dt][r];
    if (F.tid < 256) { const int dd = F.tid >> 7, d = F.tid & 127; const int st2 = (b * 4 + h) * 2 + dd; ((float*)(F.ws + WS_SCR + SC_MLN))[((size_t)st2 * NCH + c) * 128 + d] = nacc; }
    if (F.tid < 2) { const int dd = F.tid; const int st2 = (b * 4 + h) * 2 + dd; float* sc = (float*)(F.ws + WS_SCR + SC_MLS) + ((size_t)st2 * NCH + c) * 4;
        const float btot = dd ? g.b_bw[0] : g.b_fw[255], pme = dd ? g.pm_bw[0] : g.pm_fw[255]; sc[0] = btot + pme; sc[1] = btot; }
    __syncthreads();
}
DEVI int ml_chunk_at(int dir, int k) { if (!dir) return k; return (k < NCTXCH) ? (NCTXCH - 1 - k) : (NCH - 1 - (k - NCTXCH)); }
DEVI void ml_phaseB(const Frame& F) {
    const int nvb = NSTR_ML * 16;
    const int GH = F.G;
    for (int vb = F.bid; vb < nvb && F.bid < GH; vb += GH) {
        const int stream = vb >> 4, e0 = ((vb & 15) * NTHREADS + F.tid) * 2, dir = stream & 1;
        float* Cs = (float*)(F.ws + WS_SCR + SC_MLC) + (size_t)stream * NCH * 16384; float* Ns = (float*)(F.ws + WS_SCR + SC_MLN) + (size_t)stream * NCH * 128; float* Ss = (float*)(F.ws + WS_SCR + SC_MLS) + (size_t)stream * NCH * 4;
        float c0 = 0.f, c1 = 0.f, n0 = 0.f, m = 0.f; const bool do_n = (vb & 15) == 0 && F.tid < 128;
        typedef float f32x2 __attribute__((ext_vector_type(2)));
        constexpr int KB2 = (NCH + 1) / 2;
#pragma unroll 1
        for (int k0 = 0; k0 < NCH; k0 += KB2) {
            f32x2 lv[KB2]; float lnv[KB2], mlv[KB2], btv[KB2];
#pragma unroll
            for (int kk = 0; kk < KB2; ++kk) { const int k = (k0 + kk < NCH) ? k0 + kk : NCH - 1; const int c = ml_chunk_at(dir, k); mlv[kk] = Ss[c * 4 + 0]; btv[kk] = Ss[c * 4 + 1]; lv[kk] = *(const f32x2*)(Cs + (size_t)c * 16384 + e0); lnv[kk] = do_n ? Ns[c * 128 + F.tid] : 0.f; }
#pragma unroll
            for (int kk = 0; kk < KB2; ++kk) { if (k0 + kk < NCH) { const int c = ml_chunk_at(dir, k0 + kk); const float mloc = mlv[kk], btot = btv[kk];
                f32x2 st2; st2[0] = c0; st2[1] = c1; *(f32x2*)(Cs + (size_t)c * 16384 + e0) = st2;
                if (do_n) Ns[c * 128 + F.tid] = n0;
                if ((vb & 15) == 0 && F.tid == 0) Ss[c * 4 + 2] = m;
                const float mn = fmaxf(btot + m, mloc), dk = __expf(btot + m - mn), sl = __expf(mloc - mn);
                c0 = dk * c0 + sl * lv[kk][0]; c1 = dk * c1 + sl * lv[kk][1]; n0 = dk * n0 + sl * lnv[kk]; m = mn; } }
        }
    }
}
constexpr int LDK = 136;
DEVI void ml_phaseC_unit(const Frame& F0, int b, int h, int c) {
    const Frame F = unit_frame(F0);
    const bf16_t* PROJ = (const bf16_t*)(F.ws + WS_BIG); bf16_t* YM = (bf16_t*)(F.ws + WS_ACT);
    float* gbase = (float*)F.lds; MlGates g = ml_gate_ptrs(gbase);
    float* nin = gbase + 1536;
    float* wsc = gbase + 1792 + F.wave * 64;
    bf16_t* Kl = (bf16_t*)(F.lds + 12288);
    bf16_t* VT = Kl + 64 * LDK;
    bf16_t* stash = VT + 64 * 160 + F.wave * (32 * 136);
    ml_gates_setup(F, g, b, h, c);
    const int r32 = F.lane & 31, hi = F.lane >> 5, it = F.wave >> 1;
    const int irow = F.wave * 32 + r32;
    const int tq = c * 256 + irow;
    if (F.tid < 256) { const int dd = F.tid >> 7, d = F.tid & 127; nin[F.tid] = ((const float*)(F.ws + WS_SCR + SC_MLN))[((size_t)((b * 4 + h) * 2 + dd) * NCH + c) * 128 + d]; }
    bf16x8 qr[4];
    bf16_t* qhi = (bf16_t*)(F.lds + 119808) + F.tid * 32;
#define MLQ(d0) (((d0) < 4) ? qr[(d0) & 3] : ld8(qhi + ((d0) - 4) * 8))
#pragma unroll
    for (int d0 = 0; d0 < 4; ++d0) qr[d0] = (bf16x8){};
    { const int lo = (tq < CTX) ? 0 : CTX, hi2 = (tq < CTX) ? CTX : T; const bool hm = tq - 1 >= lo, hp = tq + 1 < hi2; const int tm = hm ? tq - 1 : tq, tp = hp ? tq + 1 : tq;
      const float* cw = F.ap->in[I_MLCONV];
#pragma unroll 1
      for (int half = 0; half < 2; ++half) { bf16x8 xr[4][3];
#pragma unroll
        for (int j = 0; j < 4; ++j) { const int col = E_MQ + h * 128 + (half * 4 + j) * 16 + hi * 8;
            xr[j][0] = ld8(PROJ + (size_t)grow(b, tm) * EVP + col); xr[j][1] = ld8(PROJ + (size_t)grow(b, tq) * EVP + col); xr[j][2] = ld8(PROJ + (size_t)grow(b, tp) * EVP + col); }
#pragma unroll
        for (int j = 0; j < 4; ++j) { const int cch = h * 128 + (half * 4 + j) * 16 + hi * 8; float x0[8], x1[8], x2[8], q[8]; unpack8(xr[j][0], x0); unpack8(xr[j][1], x1); unpack8(xr[j][2], x2);
#pragma unroll
            for (int e = 0; e < 8; ++e) q[e] = cw[cch + e] * (hm ? x0[e] : 0.f) + cw[1024 + cch + e] * x1[e] + cw[2048 + cch + e] * (hp ? x2[e] : 0.f);
            if (half == 0) qr[j] = pack8(q); else *(bf16x8*)(qhi + j * 8) = pack8(q); } }
      WAVE_SYNC(); }
    __syncthreads();
    f32x16 o[4];
#pragma unroll 1
    for (int dir = 0; dir < 2; ++dir) {
        const int stream = (b * 4 + h) * 2 + dir;
        const float m_in = ((const float*)(F.ws + WS_SCR + SC_MLS))[((size_t)stream * NCH + c) * 4 + 2];
        const float* aarr = dir ? g.a_bw : g.a_fw; const float* pmarr = dir ? g.pm_bw : g.pm_fw; const float* barr = dir ? g.b_bw : g.b_fw;
        const float Mrow = fmaxf(m_in, pmarr[irow]), w_inter = __expf(m_in - Mrow);
        const float* Cg = (const float*)(F.ws + WS_SCR + SC_MLC) + ((size_t)stream * NCH + c) * 16384;
        bf16_t* Cl = Kl;
        bf16x8 pkt[2], pvt[2];
#define MLC_ISSUE(jt_) do { const int j = F.tid >> 3, cg8 = F.tid & 7, t = c * 256 + (jt_) * 64 + j; \
            _Pragma("unroll") for (int half = 0; half < 2; ++half) { const int ch = cg8 * 16 + half * 8; pvt[half] = ld8(PROJ + (size_t)grow(b, t) * EVP + E_MV + h * 128 + ch); \
                pkt[half] = ld8((const bf16_t*)((const unsigned char*)F.out + OUT_KC) + (size_t)grow(b, t) * 512 + h * 128 + ch); } } while (0)
        MLC_ISSUE(0);
        float nq = 0.f;
        if (c >= NCTXCH) {
        __syncthreads();
        { const int v = F.tid >> 2, q4 = (F.tid & 3) * 32;
#pragma unroll
          for (int g8 = 0; g8 < 4; ++g8) { const f32x4 c0 = *(const f32x4*)(Cg + v * 128 + q4 + g8 * 8), c1 = *(const f32x4*)(Cg + v * 128 + q4 + g8 * 8 + 4); float cf[8];
#pragma unroll
              for (int e = 0; e < 4; ++e) { cf[e] = c0[e]; cf[4 + e] = c1[e]; }
              *(bf16x8*)(Cl + v * LDK + q4 + g8 * 8) = pack8(cf); } }
        __syncthreads();
#pragma unroll
        for (int d0 = 0; d0 < 4; ++d0) { o[d0] = (f32x16){};
#pragma unroll
            for (int ks = 0; ks < 8; ++ks) o[d0] = mfma32(MLQ(ks), ld8(Cl + (d0 * 32 + r32) * LDK + ks * 16 + hi * 8), o[d0]); }
#pragma unroll
        for (int d0 = 0; d0 < 8; ++d0) { float q[8]; unpack8(MLQ(d0), q);
#pragma unroll
            for (int e = 0; e < 8; ++e) nq += q[e] * nin[dir * 128 + d0 * 16 + hi * 8 + e]; FENCE(); }
        nq += shx<32>(nq);
        if (hi == 0) wsc[r32] = w_inter;
        __syncthreads();
#pragma unroll
        for (int d0 = 0; d0 < 4; ++d0)
#pragma unroll
            for (int r = 0; r < 16; ++r) o[d0][r] *= wsc[crow(r, hi)];
        } else {
#pragma unroll
            for (int d0 = 0; d0 < 4; ++d0) o[d0] = (f32x16){};
        }
        float rowsum = 0.f;
#pragma unroll 1
        for (int jt = 0; jt < 4; ++jt) {
            __syncthreads();
            { const int j = F.tid >> 3, cg8 = F.tid & 7;
#pragma unroll
              for (int half = 0; half < 2; ++half) { const int ch = cg8 * 16 + half * 8;
                *(bf16x8*)(Kl + j * LDK + ch) = pkt[half]; *(bf16x8*)(VT + j * 160 + ch) = pvt[half]; } }
            __syncthreads(); FENCE();
            if (jt + 1 < 4) MLC_ISSUE(jt + 1);
            const bool rel = dir ? (jt >= it) : (jt <= it);
            if (rel) {
                f32x16 p0 = (f32x16){}, p1 = (f32x16){};
#pragma unroll
                for (int d0 = 0; d0 < 8; ++d0) { const bf16x8 qf = MLQ(d0); p0 = mfma32(ld8(Kl + r32 * LDK + d0 * 16 + hi * 8), qf, p0); p1 = mfma32(ld8(Kl + (32 + r32) * LDK + d0 * 16 + hi * 8), qf, p1); }
#pragma unroll
                for (int r = 0; r < 16; ++r) { const int j0 = jt * 64 + crow(r, hi), j1 = j0 + 32;
                    const bool v0 = dir ? (j0 >= irow) : (j0 <= irow), v1 = dir ? (j1 >= irow) : (j1 <= irow);
                    p0[r] = v0 ? p0[r] * __expf(aarr[j0] - Mrow) : 0.f; p1[r] = v1 ? p1[r] * __expf(aarr[j1] - Mrow) : 0.f; rowsum += p0[r] + p1[r]; }
                const bf16x8 pa0 = pk4frag(p0, 0), pa1 = pk4frag(p0, 8), pa2 = pk4frag(p1, 0), pa3 = pk4frag(p1, 8); FENCE();
#pragma unroll
                for (int d0 = 0; d0 < 4; ++d0) {
                    o[d0] = mfma32(pa0, ld_tr_B(VT, 160, 0, d0 * 32, F.lane), o[d0]); o[d0] = mfma32(pa1, ld_tr_B(VT, 160, 16, d0 * 32, F.lane), o[d0]);
                    o[d0] = mfma32(pa2, ld_tr_B(VT, 160, 32, d0 * 32, F.lane), o[d0]); o[d0] = mfma32(pa3, ld_tr_B(VT, 160, 48, d0 * 32, F.lane), o[d0]); }
            }
        }
        rowsum += shx<32>(rowsum);
        const float den = rowsum + w_inter * nq, dn = fmaxf(fabsf(den), __expf(-(barr[irow] + Mrow)));
        __syncthreads();
        if (hi == 0) wsc[r32] = 1.f / dn;
        __syncthreads();
        if (dir == 0) {
#pragma unroll
            for (int d0 = 0; d0 < 4; ++d0)
#pragma unroll
                for (int r = 0; r < 16; ++r) stash[crow(r, hi) * 136 + d0 * 32 + r32] = (bf16_t)f2bf(o[d0][r] * wsc[crow(r, hi)]);
        } else {
#pragma unroll
            for (int d0 = 0; d0 < 4; ++d0)
#pragma unroll
                for (int r = 0; r < 16; ++r) o[d0][r] = o[d0][r] * wsc[crow(r, hi)] + bf2f(stash[crow(r, hi) * 136 + d0 * 32 + r32]);
        }
        __syncthreads();
    }
#pragma unroll
    for (int d0 = 0; d0 < 4; ++d0)
#pragma unroll
        for (int r = 0; r < 16; ++r) stash[crow(r, hi) * 136 + d0 * 32 + r32] = (bf16_t)f2bf(o[d0][r]);
    WAVE_SYNC();
    { const int rw = F.lane >> 1, hf = F.lane & 1; const bf16_t* sp = stash + rw * 136 + hf * 64; float hv[64]; float ss = 0.f;
#pragma unroll
      for (int q8 = 0; q8 < 8; ++q8) { unpack8(ld8(sp + q8 * 8), hv + q8 * 8);
#pragma unroll
          for (int e = 0; e < 8; ++e) ss += hv[q8 * 8 + e] * hv[q8 * 8 + e]; }
      ss += shx<1>(ss); const float rs = RSQ(ss * (1.f / 128.f) + EPS);
      const int row = grow(b, c * 256 + F.wave * 32 + rw); const int v0 = h * 128 + hf * 64;
#pragma unroll
      for (int q8 = 0; q8 < 8; ++q8) { float mo[8], ov[8]; unpack8(ld8(PROJ + (size_t)row * EVP + E_MO + v0 + q8 * 8), mo);
          const f32x4 g0 = *(const f32x4*)(F.ap->in[I_MLNORM] + v0 + q8 * 8), g1 = *(const f32x4*)(F.ap->in[I_MLNORM] + v0 + q8 * 8 + 4);
#pragma unroll
          for (int e = 0; e < 8; ++e) ov[e] = hv[q8 * 8 + e] * rs * (e < 4 ? g0[e] : g1[e - 4]) * sigmoidf_(mo[e]);
          *(bf16x8*)(YM + (size_t)row * D + v0 + q8 * 8) = pack8(ov); } }
    __syncthreads();
}

DEVI void rw_shift8(const bf16_t* PROJ, const float* mu8, int b, int t, int f, float* out) {
    const int lo = (t < CTX) ? 0 : CTX, hi = (t < CTX) ? CTX : T; float x0[8], x1[8], x2[8];
    unpack8(ld8(PROJ + (size_t)grow(b, t) * EVP + E_RF + f), x1);
    if (t - 1 >= lo) unpack8(ld8(PROJ + (size_t)grow(b, t - 1) * EVP + E_RF + f), x0); else { for (int e = 0; e < 8; ++e) x0[e] = 0.f; }
    if (t + 1 < hi) unpack8(ld8(PROJ + (size_t)grow(b, t + 1) * EVP + E_RF + f), x2); else { for (int e = 0; e < 8; ++e) x2[e] = 0.f; }
#pragma unroll
    for (int e = 0; e < 8; ++e) out[e] = x1[e] + (0.5f * (x0[e] + x2[e]) - x1[e]) * mu8[e];
}
constexpr int RW_T = 64 * 65;
DEVI void copy16(const Frame& F, void* dst, const void* src, int nchunks) { for (int i = F.tid; i < nchunks; i += NTHREADS) ((u32x4*)dst)[i] = ((const u32x4*)src)[i]; }
DEVI void rw_stage_weights(const Frame& F, int h, bf16_t* W2T, bf16_t* A2T, bf16_t* G2T, int dmask) {
    const unsigned char* T = F.ws + WS_RWT;
    for (int d = 0; d < 2; ++d) { if (!((dmask >> d) & 1)) continue; const int slot = (dmask == 3) ? d : 0;
        if (W2T) copy16(F, W2T + slot * 64 * LDT, T + RWT_W2 + (size_t)(d * 8 + h) * 9216, 576);
        copy16(F, A2T + slot * 64 * LDT, T + RWT_A2 + (size_t)(d * 8 + h) * 9216, 576); }
    if (G2T) copy16(F, G2T, T + RWT_G2 + (size_t)h * 17408, 1088);
}
DEVI void rw_build_tables(const Frame& F) {
    unsigned char* T = F.ws + WS_RWT; const int gt = F.bid * NTHREADS + F.tid, GT = F.G * NTHREADS;
    for (int idx = gt; idx < 16 * 64 * LDT; idx += GT) { const int dh = idx / (64 * LDT), e = (idx / LDT) % 64, j = idx % LDT, d = dh >> 3, h = dh & 7;
        const float w = (j < 64) ? F.ap->in[I_RWW2][((size_t)d * 64 + j) * 512 + h * 64 + e] : 0.f, a = (j < 64) ? F.ap->in[I_RWA2][((size_t)d * 64 + j) * 512 + h * 64 + e] : 0.f;
        ((bf16_t*)(T + RWT_W2))[idx] = (bf16_t)f2bf(w); ((bf16_t*)(T + RWT_A2))[idx] = (bf16_t)f2bf(a); }
    for (int idx = gt; idx < 8 * 64 * LDK; idx += GT) { const int h = idx / (64 * LDK), e = (idx / LDK) % 64, j = idx % LDK;
        ((bf16_t*)(T + RWT_G2))[idx] = (bf16_t)f2bf((j < 128) ? F.ap->in[I_RWG2][(size_t)j * 512 + h * 64 + e] : 0.f); }
    for (int idx = gt; idx < 16 * 640; idx += GT) { const int dh = idx / 640, i = idx % 640, dir = dh >> 3, h = dh & 7, a = i >> 6, e = i & 63; float v;
        if (a == 0) v = F.ap->in[I_RWKK][h * 64 + e]; else if (a == 1) v = F.ap->in[I_RWKA][h * 64 + e]; else if (a == 2) v = F.ap->in[I_RWW0][dir * 512 + h * 64 + e]; else if (a == 3) v = F.ap->in[I_RWA0][dir * 512 + h * 64 + e]; else if (a == 9) v = F.ap->in[I_RWRK][h * 64 + e];
        else { const int f = (a == 4) ? R_R + h * 64 : (a == 5) ? R_K + h * 64 : (a == 6) ? R_V + h * 64 : (a == 7) ? R_WL + dir * 64 : R_AL + dir * 64; v = F.ap->in[I_RWMU][f + e]; }
        ((float*)(T + RWT_CST))[idx] = v; }
}
DEVI void rw_prep(const Frame& F, int b, int h, int t0, float* R, float* K, float* V, float* KK, float* LW0, float* AA0, float* LW1, float* AA1, float* G,
                  const bf16_t* W2T, const bf16_t* A2T, const bf16_t* G2T, bf16_t* XW, bf16_t* XA, bf16_t* XG, int dmask) {
    const bf16_t* PROJ = (const bf16_t*)(F.ws + WS_BIG); const float* mu = F.ap->in[I_RWMU];
    const int tok = F.tid >> 3, c8 = (F.tid & 7) * 8, t = t0 + tok;
    const int r32 = F.lane & 31, hi = F.lane >> 5;
    { float x[8];
      rw_shift8(PROJ, mu + (R_R + h * 64 + c8), b, t, R_R + h * 64 + c8, x); for (int e = 0; e < 8; ++e) R[tok * 65 + c8 + e] = x[e];
      rw_shift8(PROJ, mu + (R_K + h * 64 + c8), b, t, R_K + h * 64 + c8, x); for (int e = 0; e < 8; ++e) K[tok * 65 + c8 + e] = x[e];
      rw_shift8(PROJ, mu + (R_V + h * 64 + c8), b, t, R_V + h * 64 + c8, x); for (int e = 0; e < 8; ++e) V[tok * 65 + c8 + e] = x[e]; }
    if (G) { float x[8];
#pragma unroll
        for (int hf = 0; hf < 2; ++hf) { rw_shift8(PROJ, mu + (R_GL + hf * 64 + c8), b, t, R_GL + hf * 64 + c8, x); for (int e = 0; e < 8; ++e) x[e] = sigmoidf_(x[e]); *(bf16x8*)(XG + tok * LDK + hf * 64 + c8) = pack8(x); } }
    __syncthreads();
    if (KK && F.tid < 64) { float s = 0.f; for (int e = 0; e < 64; ++e) { const float kk = K[F.tid * 65 + e] * F.ap->in[I_RWKK][h * 64 + e]; s += kk * kk; }
        const float rn = RSQ(s + 1e-12f); for (int e = 0; e < 64; ++e) KK[F.tid * 65 + e] = K[F.tid * 65 + e] * F.ap->in[I_RWKK][h * 64 + e] * rn; }
    if (G) {
        if (F.wave < 4) { const int tt = F.wave >> 1, et = F.wave & 1; f32x16 acc = (f32x16){};
#pragma unroll
            for (int ks = 0; ks < 8; ++ks) acc = mfma32(ld8(XG + (tt * 32 + r32) * LDK + ks * 16 + hi * 8), ld8(G2T + (et * 32 + r32) * LDK + ks * 16 + hi * 8), acc);
#pragma unroll
            for (int r = 0; r < 16; ++r) G[(tt * 32 + crow(r, hi)) * 65 + et * 32 + r32] = acc[r]; }
        __syncthreads(); }
    for (int d = 0; d < 2; ++d) { if (!((dmask >> d) & 1)) continue;
        const int slot = (dmask == 3) ? d : 0; float* LW = d ? LW1 : LW0; float* AA = d ? AA1 : AA0;
        __syncthreads();
        { float x[8];
          if (LW) { rw_shift8(PROJ, mu + (R_WL + d * 64 + c8), b, t, R_WL + d * 64 + c8, x); for (int e = 0; e < 8; ++e) x[e] = tanhf_(x[e]); *(bf16x8*)(XW + tok * LDT + c8) = pack8(x); }
          rw_shift8(PROJ, mu + (R_AL + d * 64 + c8), b, t, R_AL + d * 64 + c8, x); *(bf16x8*)(XA + tok * LDT + c8) = pack8(x); }
        __syncthreads();
        { const int which = F.wave >> 2, tt = (F.wave >> 1) & 1, et = F.wave & 1;
          if (which || LW) { const bf16_t* X = which ? XA : XW; const bf16_t* WT = (which ? A2T : W2T) + slot * 64 * LDT;
          f32x16 acc = (f32x16){};
#pragma unroll
          for (int ks = 0; ks < 4; ++ks) acc = mfma32(ld8(X + (tt * 32 + r32) * LDT + ks * 16 + hi * 8), ld8(WT + (et * 32 + r32) * LDT + ks * 16 + hi * 8), acc);
          const int e = et * 32 + r32;
#pragma unroll
          for (int r = 0; r < 16; ++r) { const int tk = tt * 32 + crow(r, hi);
              if (!which) { const float wpre = F.ap->in[I_RWW0][d * 512 + h * 64 + e] + acc[r]; LW[tk * 65 + e] = -0.6065306597126334f * sigmoidf_(wpre); }
              else AA[tk * 65 + e] = sigmoidf_(F.ap->in[I_RWA0][d * 512 + h * 64 + e] + acc[r]); } } }
    }
    __syncthreads();
}
DEVI void rw_scan_v1(const Frame& F, int b, int h, int dir, int rh) {
    float* base = (float*)F.lds;
    float *R = base, *K = R + RW_T, *V = K + RW_T, *KK = V + RW_T, *LW = KK + RW_T, *AA = LW + RW_T;
    bf16_t* W2T = (bf16_t*)(AA + RW_T); bf16_t* A2T = W2T + 64 * LDT; bf16_t* XW = A2T + 64 * LDT; bf16_t* XA = XW + 64 * LDT;
    float* YB = (float*)(XA + 64 * LDT);
    rw_stage_weights(F, h, W2T, A2T, nullptr, 1 << dir);
    float* YRW = F.out;
    const int q = F.lane & 15, rloc = F.wave * 4 + (F.lane >> 4), vrow = rh * 32 + rloc;
    float S[4] = {0.f, 0.f, 0.f, 0.f};
    const float ka0 = F.ap->in[I_RWKA][h * 64 + 4 * q + 0], ka1 = F.ap->in[I_RWKA][h * 64 + 4 * q + 1], ka2 = F.ap->in[I_RWKA][h * 64 + 4 * q + 2], ka3 = F.ap->in[I_RWKA][h * 64 + 4 * q + 3];
    const int nblk = T / 64;
    for (int kb = 0; kb < nblk; ++kb) {
        int blk; if (!dir) blk = kb; else blk = (kb < CTX / 64) ? (CTX / 64 - 1 - kb) : (nblk - 1 - (kb - CTX / 64));
        const int t0 = blk * 64;
        __syncthreads();
        rw_prep(F, b, h, t0, R, K, V, KK, dir ? nullptr : LW, dir ? nullptr : AA, dir ? LW : nullptr, dir ? AA : nullptr, nullptr, W2T, A2T, nullptr, XW, XA, nullptr, 1 << dir);
        for (int s = 0; s < 64; ++s) { const int tk = dir ? 63 - s : s; const float* kkp = KK + tk * 65 + 4 * q; const float* ap = AA + tk * 65 + 4 * q; const float* kp = K + tk * 65 + 4 * q;
            const float* lwp = LW + tk * 65 + 4 * q; const float* rp = R + tk * 65 + 4 * q;
            const float a0 = ap[0], a1 = ap[1], a2 = ap[2], a3 = ap[3];
            float sa = -(S[0] * kkp[0] + S[1] * kkp[1] + S[2] * kkp[2] + S[3] * kkp[3]);
            sa += shx<1>(sa); sa += shx<2>(sa); sa += shx<4>(sa); sa += shx<8>(sa);
            const float vv = V[tk * 65 + vrow];
            S[0] = S[0] * __expf(lwp[0]) + sa * (kkp[0] * a0) + vv * (kp[0] * (1.f + (a0 - 1.f) * ka0));
            S[1] = S[1] * __expf(lwp[1]) + sa * (kkp[1] * a1) + vv * (kp[1] * (1.f + (a1 - 1.f) * ka1));
            S[2] = S[2] * __expf(lwp[2]) + sa * (kkp[2] * a2) + vv * (kp[2] * (1.f + (a2 - 1.f) * ka2));
            S[3] = S[3] * __expf(lwp[3]) + sa * (kkp[3] * a3) + vv * (kp[3] * (1.f + (a3 - 1.f) * ka3));
            float y = S[0] * rp[0] + S[1] * rp[1] + S[2] * rp[2] + S[3] * rp[3];
            y += shx<1>(y); y += shx<2>(y); y += shx<4>(y); y += shx<8>(y);
            if (q == 0) YB[tk * 33 + rloc] = y; }
        __syncthreads();
        for (int i = F.tid; i < 64 * 32; i += NTHREADS) { const int tk = i >> 5, rr = i & 31; atomic_add_f32(YRW + (size_t)grow(b, t0 + tk) * 512 + h * 64 + rh * 32 + rr, YB[tk * 33 + rr]); }
    }
    __syncthreads();
}
DEVI void rw_finish_unit(const Frame& F, int b, int h, int blk) {
    float* base = (float*)F.lds;
    float *R = base, *K = R + RW_T, *V = K + RW_T, *G = V + RW_T, *AA0 = G + RW_T, *AA1 = AA0 + RW_T;
    bf16_t* A2T = (bf16_t*)(AA1 + RW_T); bf16_t* G2T = A2T + 2 * 64 * LDT; bf16_t* XA = G2T + 64 * LDK; bf16_t* XG = (bf16_t*)AA0;
    rw_stage_weights(F, h, nullptr, A2T, G2T, 3);
    __syncthreads();
    const int t0 = blk * 64;
    rw_prep(F, b, h, t0, R, K, V, nullptr, nullptr, AA0, nullptr, AA1, G, nullptr, A2T, G2T, nullptr, XA, XG, 3);
    const float* YRW = F.out; bf16_t* YM = (bf16_t*)(F.ws + WS_ACT);
    const int tok = F.tid >> 3, c8 = (F.tid & 7) * 8; const int row = grow(b, t0 + tok);
    float y[8]; float s = 0.f, bsum = 0.f;
#pragma unroll
    for (int e = 0; e < 8; ++e) { const int ch = c8 + e; y[e] = YRW[(size_t)row * 512 + h * 64 + ch]; s += y[e];
        const float r = R[tok * 65 + ch], k = K[tok * 65 + ch], ka = F.ap->in[I_RWKA][h * 64 + ch], rk = F.ap->in[I_RWRK][h * 64 + ch];
        const float kd0 = k * (1.f + (AA0[tok * 65 + ch] - 1.f) * ka), kd1 = k * (1.f + (AA1[tok * 65 + ch] - 1.f) * ka); bsum += r * (kd0 + kd1) * rk; }
    s += shx<1>(s); s += shx<2>(s); s += shx<4>(s); bsum += shx<1>(bsum); bsum += shx<2>(bsum); bsum += shx<4>(bsum);
    const float mu = s * (1.f / 64.f); float var = 0.f;
#pragma unroll
    for (int e = 0; e < 8; ++e) { const float dlt = y[e] - mu; var += dlt * dlt; }
    var = sum8(var);
    const float rs = RSQ(var * (1.f / 64.f) + 64e-5f); float o[8];
#pragma unroll
    for (int e = 0; e < 8; ++e) { const int ch = c8 + e; const float gn = (y[e] - mu) * rs * F.ap->in[I_RWLNW][h * 64 + ch] + F.ap->in[I_RWLNB][h * 64 + ch]; o[e] = (gn + bsum * V[tok * 65 + ch]) * G[tok * 65 + ch]; }
    *(bf16x8*)(YM + (size_t)row * D + 512 + h * 64 + c8) = pack8(o);
    __syncthreads();
}

DEVI void rw_finish2_unit(const Frame& F0, int b, int h, int blk) {
    const Frame F = unit_frame(F0);
    float* V = (float*)F.lds; float* G = V + RW_T; bf16_t* G2T = (bf16_t*)(G + RW_T); bf16_t* XG = G2T + 64 * LDK;
    const bf16_t* PROJ = (const bf16_t*)(F.ws + WS_BIG); const float* mu = F.ap->in[I_RWMU];
    const int r32 = F.lane & 31, hi = F.lane >> 5;
    __syncthreads();
    copy16(F, G2T, F.ws + WS_RWT + RWT_G2 + (size_t)h * 17408, 1088);
    const int t0 = blk * 64, tok = F.tid >> 3, c8 = (F.tid & 7) * 8, t = t0 + tok; const int row = grow(b, t);
    { float x[8]; rw_shift8(PROJ, mu + R_V + h * 64 + c8, b, t, R_V + h * 64 + c8, x);
#pragma unroll
      for (int e = 0; e < 8; ++e) V[tok * 65 + c8 + e] = x[e];
#pragma unroll
      for (int hf = 0; hf < 2; ++hf) { rw_shift8(PROJ, mu + R_GL + hf * 64 + c8, b, t, R_GL + hf * 64 + c8, x);
#pragma unroll
          for (int e = 0; e < 8; ++e) x[e] = sigmoidf_(x[e]);
          *(bf16x8*)(XG + tok * LDK + hf * 64 + c8) = pack8(x); } }
    __syncthreads();
    if (F.wave < 4) { const int tt = F.wave >> 1, et = F.wave & 1; f32x16 acc = (f32x16){};
#pragma unroll
        for (int ks = 0; ks < 8; ++ks) acc = mfma32(ld8(XG + (tt * 32 + r32) * LDK + ks * 16 + hi * 8), ld8(G2T + (et * 32 + r32) * LDK + ks * 16 + hi * 8), acc);
#pragma unroll
        for (int r = 0; r < 16; ++r) G[(tt * 32 + crow(r, hi)) * 65 + et * 32 + r32] = acc[r]; }
    __syncthreads();
    const float* YRW = F.out; bf16_t* YM = (bf16_t*)(F.ws + WS_ACT); const float* BON = (const float*)(F.ws + WS_RWT + RWT_BON);
    const float bsum = BON[(size_t)row * 16 + h * 2] + BON[(size_t)row * 16 + h * 2 + 1];
    float y[8]; float s = 0.f;
    { const f32x4 y0 = *(const f32x4*)(YRW + (size_t)row * 512 + h * 64 + c8), y1 = *(const f32x4*)(YRW + (size_t)row * 512 + h * 64 + c8 + 4);
#pragma unroll
      for (int e = 0; e < 4; ++e) { y[e] = y0[e]; y[4 + e] = y1[e]; } }
#pragma unroll
    for (int e = 0; e < 8; ++e) s += y[e];
    s = sum8(s);
    const float mean = s * (1.f / 64.f); float var = 0.f;
#pragma unroll
    for (int e = 0; e < 8; ++e) { const float dlt = y[e] - mean; var += dlt * dlt; }
    var = sum8(var);
    const float rs = RSQ(var * (1.f / 64.f) + 64e-5f); float o[8];
#pragma unroll
    for (int e = 0; e < 8; ++e) { const int ch = c8 + e; const float gn = (y[e] - mean) * rs * F.ap->in[I_RWLNW][h * 64 + ch] + F.ap->in[I_RWLNB][h * 64 + ch]; o[e] = (gn + bsum * V[tok * 65 + ch]) * G[tok * 65 + ch]; }
    *(bf16x8*)(YM + (size_t)row * D + 512 + h * 64 + c8) = pack8(o);
}

namespace rw2 {
constexpr int O_W2T = 0, O_A2T = 9216, O_AL = 18432, O_XW = O_AL, O_XA = O_AL + 9216, O_LW = O_AL + 18432, O_AA = O_LW + 16640;
constexpr int O_AAB = O_AL, O_AAK = O_AL + 9216, O_ARB = O_AL + 18432, O_ARK = O_AL + 27648, O_UT = O_AL + 36864;
constexpr int O_RN = 70144, O_GL = 70400, O_SEG = 70656, O_AT = 72704, O_BT = 81920, O_KT = 91136, O_RT = 100352, O_BTT = 109568, O_KTT = 118784, O_VT = 128000, O_S0B = 137216;
constexpr int O_CST = 159744;
constexpr int O_ABF_C = 146432;
static_assert(O_ABF_C + 8192 + 2 * 32 * 40 * 2 <= O_CST && O_CST + 10 * 64 * 4 <= 160 * 1024 - 256, "rw2 lds");
DEVI void stage_consts(const Frame& F, int h, int dir) { copy16(F, F.lds + O_CST, F.ws + WS_RWT + RWT_CST + (size_t)(dir * 8 + h) * 2560, 160); }
DEVI float* slot_ptr(const Frame& F, int slot) { return (slot < RW_NS1) ? (float*)(F.ws + WS_SCR + SC_RW + (size_t)slot * 32768) : (float*)((unsigned char*)F.out + OUT_RW + (size_t)(slot - RW_NS1) * 32768); }
struct RawPrep { bf16x8 x[5][3]; };
DEVI void prep_load(const Frame& F, int b, int h, int dir, int t0, RawPrep& R) {
    const bf16_t* PROJ = (const bf16_t*)(F.ws + WS_BIG);
    const int i = F.tid >> 3, c8 = (F.tid & 7) * 8, t = dir ? t0 + 63 - i : t0 + i;
    const int lo = (t < CTX) ? 0 : CTX, hi2 = (t < CTX) ? CTX : T; const int tm = (t - 1 >= lo) ? t - 1 : t, tp = (t + 1 < hi2) ? t + 1 : t;
    const int fo[5] = {R_R + h * 64, R_K + h * 64, R_V + h * 64, R_WL + dir * 64, R_AL + dir * 64};
#pragma unroll
    for (int f = 0; f < 5; ++f) { const size_t col = E_RF + fo[f] + c8;
        R.x[f][0] = ld8(PROJ + (size_t)grow(b, tm) * EVP + col); R.x[f][1] = ld8(PROJ + (size_t)grow(b, t) * EVP + col); R.x[f][2] = ld8(PROJ + (size_t)grow(b, tp) * EVP + col); }
}
DEVI void shift_raw(const bf16x8 (&x)[3], const float* mu8, bool has_m, bool has_p, float* out) {
    float x0[8], x1[8], x2[8]; unpack8(x[0], x0); unpack8(x[1], x1); unpack8(x[2], x2);
#pragma unroll
    for (int e = 0; e < 8; ++e) { const float a = has_m ? x0[e] : 0.f, c = has_p ? x2[e] : 0.f; out[e] = x1[e] + (0.5f * (a + c) - x1[e]) * mu8[e]; }
}
DEVI void prep(const Frame& F, int b, int h, int dir, int t0, const RawPrep& RP, float* bon = nullptr) {
    unsigned char* L = F.lds; const float* CST = (const float*)(L + O_CST);
    bf16_t* W2T = (bf16_t*)(L + O_W2T); bf16_t* A2T = (bf16_t*)(L + O_A2T); bf16_t* XW = (bf16_t*)(L + O_XW); bf16_t* XA = (bf16_t*)(L + O_XA);
    float* LW = (float*)(L + O_LW); float* AA = (float*)(L + O_AA); float* GL = (float*)(L + O_GL); float* SEG = (float*)(L + O_SEG);
    bf16_t* At = (bf16_t*)(L + O_AT); bf16_t* Bt = (bf16_t*)(L + O_BT); bf16_t* Kt = (bf16_t*)(L + O_KT); bf16_t* Rt = (bf16_t*)(L + O_RT);
    bf16_t* BtT = (bf16_t*)(L + O_BTT); bf16_t* KtT = (bf16_t*)(L + O_KTT); bf16_t* VT = (bf16_t*)(L + O_VT);
    const int i = F.tid >> 3, c8 = (F.tid & 7) * 8, t = dir ? t0 + 63 - i : t0 + i;
    const int r32 = F.lane & 31, hi = F.lane >> 5;
    float r[8], k[8], v[8], kkr[8];
    const bool has_m = (t - 1 >= ((t < CTX) ? 0 : CTX)), has_p = (t + 1 < ((t < CTX) ? CTX : T));
    shift_raw(RP.x[0], CST + 4 * 64 + c8, has_m, has_p, r); shift_raw(RP.x[1], CST + 5 * 64 + c8, has_m, has_p, k); shift_raw(RP.x[2], CST + 6 * 64 + c8, has_m, has_p, v);
    float ssq = 0.f;
#pragma unroll
    for (int e = 0; e < 8; ++e) { kkr[e] = k[e] * CST[c8 + e]; ssq += kkr[e] * kkr[e]; }
    ssq = sum8(ssq);
    const float rn = RSQ(ssq + 1e-12f);
    { float x[8]; shift_raw(RP.x[3], CST + 7 * 64 + c8, has_m, has_p, x);
#pragma unroll
      for (int e = 0; e < 8; ++e) x[e] = tanhf_(x[e]);
      *(bf16x8*)(XW + i * LDT + c8) = pack8(x);
      shift_raw(RP.x[4], CST + 8 * 64 + c8, has_m, has_p, x); *(bf16x8*)(XA + i * LDT + c8) = pack8(x); }
    __syncthreads();
    { const int which = F.wave >> 2, tt = (F.wave >> 1) & 1, et = F.wave & 1; const bf16_t* X = which ? XA : XW; const bf16_t* WT = which ? A2T : W2T;
      f32x16 acc = (f32x16){};
#pragma unroll
      for (int ks = 0; ks < 4; ++ks) acc = mfma32(ld8(X + (tt * 32 + r32) * LDT + ks * 16 + hi * 8), ld8(WT + (et * 32 + r32) * LDT + ks * 16 + hi * 8), acc);
      const int e = et * 32 + r32;
#pragma unroll
      for (int rr = 0; rr < 16; ++rr) { const int tk = tt * 32 + crow(rr, hi);
          if (!which) { const float wpre = CST[2 * 64 + e] + acc[rr]; LW[tk * 65 + e] = -0.6065306597126334f * sigmoidf_(wpre); }
          else AA[tk * 65 + e] = sigmoidf_(CST[3 * 64 + e] + acc[rr]); } }
    __syncthreads();
    { const int e = F.tid & 63, seg = F.tid >> 6; float x[8]; float a = 0.f;
#pragma unroll
      for (int j = 0; j < 8; ++j) x[j] = LW[(seg * 8 + j) * 65 + e];
#pragma unroll
      for (int j = 0; j < 8; ++j) { a += x[j]; x[j] = a; }
      SEG[seg * 64 + e] = a;
      __syncthreads();
      float off = 0.f;
#pragma unroll
      for (int s2 = 0; s2 < 7; ++s2) { const float sv = SEG[s2 * 64 + e]; off += (s2 < seg) ? sv : 0.f; }
#pragma unroll
      for (int j = 0; j < 8; ++j) LW[(seg * 8 + j) * 65 + e] = x[j] + off;
      if (seg == 7) GL[e] = __expf(x[7] + off); }
    __syncthreads();
    { float at[8], bt[8], kt[8], rt[8]; float bsum = 0.f;
#pragma unroll
      for (int e = 0; e < 8; ++e) { const int c = c8 + e; const float G = LW[i * 65 + c], Gp = (i > 0) ? LW[(i - 1) * 65 + c] : 0.f, aa = AA[i * 65 + c];
          const float kkn = kkr[e] * rn, eg = __expf(-G);
          const float kd = k[e] * (1.f + (aa - 1.f) * CST[64 + c]); bsum += r[e] * kd * CST[9 * 64 + c];
          at[e] = -kkn * __expf(Gp); bt[e] = kkn * aa * eg; kt[e] = kd * eg; rt[e] = r[e] * __expf(G); }
      if (bon) { bsum = sum8(bsum); if ((F.tid & 7) == 0) bon[(size_t)grow(b, t) * 16 + h * 2 + dir] = bsum; }
      const bf16x8 bp = pack8(bt), kp = pack8(kt), vp = pack8(v);
      *(bf16x8*)(At + i * LDT + c8) = pack8(at); *(bf16x8*)(Bt + i * LDT + c8) = bp; *(bf16x8*)(Kt + i * LDT + c8) = kp; *(bf16x8*)(Rt + i * LDT + c8) = pack8(rt);
      *(bf16x8*)(VT + i * LDT + c8) = vp; (void)BtT; (void)KtT; }
    __syncthreads();
}
DEVI void amats(const Frame& F, bool want_r, float* ABFd) {
    unsigned char* L = F.lds; const int r32 = F.lane & 31, hi = F.lane >> 5, pair = F.wave >> 2, tr = (F.wave >> 1) & 1, tc = F.wave & 1;
    if (pair == 0 || want_r) {
        const bf16_t* X = (const bf16_t*)(L + (pair ? O_RT : O_AT));
#pragma unroll
        for (int which = 0; which < 2; ++which) { const bf16_t* Y = (const bf16_t*)(L + (which ? O_KT : O_BT)); bf16_t* dst = (bf16_t*)(L + (pair ? (which ? O_ARK : O_ARB) : (which ? O_AAK : O_AAB)));
            f32x16 acc = (f32x16){};
            if (tc <= tr) {
#pragma unroll
                for (int ks = 0; ks < 4; ++ks) acc = mfma32(ld8(X + (tr * 32 + r32) * LDT + ks * 16 + hi * 8), ld8(Y + (tc * 32 + r32) * LDT + ks * 16 + hi * 8), acc); }
#pragma unroll
            for (int rr = 0; rr < 16; ++rr) { const int t = tr * 32 + crow(rr, hi), s2 = tc * 32 + r32; const bool keep = pair ? (s2 <= t) : (s2 < t); const float val = keep ? acc[rr] : 0.f;
                dst[t * LDT + s2] = (bf16_t)f2bf(val); if (pair == 0 && which == 0 && tr == tc) ABFd[tr * 1024 + crow(rr, hi) * 32 + r32] = val; } }
    }
    __syncthreads();
}
DEVI void tinv(const float* ABFd_in, const bf16_t* Aab, bf16_t* Tm, bf16_t* T0T, bf16_t* XT, int lane) {
    const int blk = lane >> 5, j = lane & 31, r32 = lane & 31, hi = lane >> 5;
    const float* Ab = ABFd_in + blk * 1024;
    float x[32];
#pragma unroll
    for (int t = 0; t < 32; ++t) { float a0 = (t == j) ? 1.f : 0.f, a1 = 0.f; const float* rowp = Ab + t * 32;
#ifndef HIPEMU
        if (t >= 2) asm volatile("" : "+v"(rowp), "+v"(x[t - 2]));
#endif
#pragma unroll
        for (int c = 0; c < (t + 3) / 4; ++c) { const f32x4 a = *(const f32x4*)(rowp + c * 4);
#pragma unroll
            for (int e = 0; e < 4; ++e) if (c * 4 + e < t) { if (c & 1) a1 += a[e] * x[c * 4 + e]; else a0 += a[e] * x[c * 4 + e]; } }
        x[t] = a0 + a1; }
#pragma unroll
    for (int s2 = 0; s2 < 32; ++s2) { Tm[(blk * 32 + s2) * LDT + blk * 32 + j] = (bf16_t)f2bf(x[s2]); if (blk) Tm[s2 * LDT + 32 + j] = 0; }
    if (!blk) {
#pragma unroll
        for (int c = 0; c < 4; ++c) { float y[8];
#pragma unroll
            for (int e = 0; e < 8; ++e) y[e] = x[c * 8 + e];
            *(bf16x8*)(T0T + j * 40 + c * 8) = pack8(y); } }
    WAVE_SYNC();
    f32x16 acc = (f32x16){};
#pragma unroll
    for (int ks = 0; ks < 2; ++ks) acc = mfma32(ld8(Aab + (32 + r32) * LDT + ks * 16 + hi * 8), ld8(T0T + r32 * 40 + ks * 16 + hi * 8), acc);
#pragma unroll
    for (int rr = 0; rr < 16; ++rr) XT[r32 * 40 + crow(rr, hi)] = (bf16_t)f2bf(acc[rr]);
    WAVE_SYNC();
    acc = (f32x16){};
#pragma unroll
    for (int ks = 0; ks < 2; ++ks) acc = mfma32(ld8(Tm + (32 + r32) * LDT + 32 + ks * 16 + hi * 8), ld8(XT + r32 * 40 + ks * 16 + hi * 8), acc);
#pragma unroll
    for (int rr = 0; rr < 16; ++rr) Tm[(32 + crow(rr, hi)) * LDT + r32] = (bf16_t)f2bf(acc[rr]);
}
DEVI f32x16 mm64(const bf16_t* X, int x0, const bf16_t* Y, int y0, f32x16 acc, int r32, int hi) {
#pragma unroll
    for (int ks = 0; ks < 4; ++ks) acc = mfma32(ld8(X + (x0 + r32) * LDT + ks * 16 + hi * 8), ld8(Y + (y0 + r32) * LDT + ks * 16 + hi * 8), acc);
    return acc;
}
DEVI f32x16 mm64_yt(const bf16_t* X, int x0, const bf16_t* Yr, int y0, f32x16 acc, int r32, int hi, int lane) {
#pragma unroll
    for (int ks = 0; ks < 4; ++ks) acc = mfma32(ld8(X + (x0 + r32) * LDT + ks * 16 + hi * 8), ld_tr_B(Yr, LDT, ks * 16, y0, lane), acc);
    return acc;
}
DEVI f32x16 mm64_xyt(const bf16_t* Xr, int x0, const bf16_t* Yr, int y0, f32x16 acc, int lane) {
#pragma unroll
    for (int ks = 0; ks < 4; ++ks) acc = mfma32(ld_tr_B(Xr, LDT, ks * 16, x0, lane), ld_tr_B(Yr, LDT, ks * 16, y0, lane), acc);
    return acc;
}
DEVI void st_tile_T(bf16_t* dst, int t0, int v0, const f32x16& acc, int r32, int hi) {
#pragma unroll
    for (int g = 0; g < 4; ++g) { u32x2 w; w[0] = pk2(acc[4 * g], acc[4 * g + 1]); w[1] = pk2(acc[4 * g + 2], acc[4 * g + 3]); *(u32x2*)(dst + (v0 + r32) * LDT + t0 + 8 * g + 4 * hi) = w; }
}
DEVI void phaseA_unit(const Frame& F0, int b, int h, int dir, int c) {
    unsigned char* L = F0.lds; const int part = F0.wave >> 2, vr = (F0.wave >> 1) & 1, dc = F0.wave & 1;
    bf16_t* S0b = (bf16_t*)(L + O_S0B); float* ABFd = (float*)(L + O_ARB); bf16_t* T0T = (bf16_t*)(L + O_ARB + 8192); bf16_t* XT = T0T + 32 * 40; bf16_t* Tm = (bf16_t*)(L + O_KT);
    f32x16 S;
    { const Frame F = unit_frame(F0); const int r32 = F.lane & 31, hi = F.lane >> 5;
      rw_stage_weights(F, h, (bf16_t*)(L + O_W2T), (bf16_t*)(L + O_A2T), nullptr, 1 << dir); stage_consts(F, h, dir);
#pragma unroll
      for (int rr = 0; rr < 16; ++rr) { const int v = vr * 32 + crow(rr, hi), d = dc * 32 + r32; S[rr] = (part == 0 && v == d) ? 1.f : 0.f; S0b[(part * 64 + v) * LDT + d] = (bf16_t)f2bf(S[rr]); } }
    __syncthreads();
    RawPrep rcur, rnxt;
    { const Frame F = unit_frame(F0); prep_load(F, b, h, dir, c * 256 + (dir ? 3 : 0) * 64, rcur); }
#pragma unroll 1
    for (int sbi = 0; sbi < 4; ++sbi) { const int sub = dir ? 3 - sbi : sbi; const int t0 = c * 256 + sub * 64;
        const Frame F = unit_frame(F0);
        const int r32 = F.lane & 31, hi = F.lane >> 5;
        if (sbi < 3) prep_load(F, b, h, dir, c * 256 + (dir ? 2 - sbi : sbi + 1) * 64, rnxt);
        prep(F, b, h, dir, t0, rcur);
        rcur = rnxt;
        amats(F, false, ABFd);
        if (F.wave == 0) tinv(ABFd, (const bf16_t*)(L + O_AAB), Tm, T0T, XT, F.lane);
        { f32x16 acc = (f32x16){};
          acc = mm64((const bf16_t*)(L + O_AT), vr * 32, S0b + part * 64 * LDT, dc * 32, acc, r32, hi);
          if (part) acc = mm64((const bf16_t*)(L + O_AAK), vr * 32, (const bf16_t*)(L + O_VT), dc * 32, acc, r32, hi);
          st_tile_T((bf16_t*)(L + (part ? O_RT : O_BT)), vr * 32, dc * 32, acc, r32, hi); }
        __syncthreads();
        { f32x16 u = (f32x16){};
          u = mm64(Tm, vr * 32, (const bf16_t*)(L + (part ? O_RT : O_BT)), dc * 32, u, r32, hi);
          __syncthreads();
          st_tile_T((bf16_t*)(L + (part ? O_AT : O_UT)), vr * 32, dc * 32, u, r32, hi); }
        __syncthreads();
        { const bf16_t* UT = (const bf16_t*)(L + (part ? O_AT : O_UT));
          S = mm64(UT, vr * 32, (const bf16_t*)(L + O_BTT), dc * 32, S, r32, hi);
          if (part) S = mm64((const bf16_t*)(L + O_VT), vr * 32, (const bf16_t*)(L + O_KTT), dc * 32, S, r32, hi);
          const float gl = ((const float*)(L + O_GL))[dc * 32 + r32];
#pragma unroll
          for (int rr = 0; rr < 16; ++rr) { S[rr] *= gl; S0b[(part * 64 + vr * 32 + crow(rr, hi)) * LDT + dc * 32 + r32] = (bf16_t)f2bf(S[rr]); } }
        __syncthreads();
    }
    { const Frame F = unit_frame(F0); const int r32 = F.lane & 31, hi = F.lane >> 5;
      float* slot = slot_ptr(F, ((b * 8 + h) * 2 + dir) * NCH + c);
#pragma unroll
      for (int rr = 0; rr < 16; ++rr) slot[(part * 64 + vr * 32 + crow(rr, hi)) * 64 + dc * 32 + r32] = S[rr]; }
    __syncthreads();
}
constexpr int O_T0T = O_AL + 46080, O_XT = O_AL + 48640;
DEVI void amats4(const Frame& F) {
    unsigned char* L = F.lds; const int r32 = F.lane & 31, hi = F.lane >> 5, pair = F.wave >> 2, tr = (F.wave >> 1) & 1, tc = F.wave & 1;
    const bf16_t* X = (const bf16_t*)(L + (pair ? O_RT : O_AT));
#pragma unroll
    for (int which = 0; which < 2; ++which) { const bf16_t* Y = (const bf16_t*)(L + (which ? O_KT : O_BT)); bf16_t* dst = (bf16_t*)(L + (pair ? (which ? O_ARK : O_ARB) : (which ? O_AAK : O_AAB)));
        f32x16 acc = (f32x16){};
        if (tc <= tr) {
#pragma unroll
            for (int ks = 0; ks < 4; ++ks) acc = mfma32(ld8(Y + (tc * 32 + r32) * LDT + ks * 16 + hi * 8), ld8(X + (tr * 32 + r32) * LDT + ks * 16 + hi * 8), acc); }
        const int t = tr * 32 + r32;
#pragma unroll
        for (int g = 0; g < 4; ++g) { float v[4];
#pragma unroll
            for (int e = 0; e < 4; ++e) { const int s2 = tc * 32 + 8 * g + 4 * hi + e; const bool keep = pair ? (s2 <= t) : (s2 < t); v[e] = keep ? acc[4 * g + e] : 0.f; }
            u32x2 w; w[0] = pk2(v[0], v[1]); w[1] = pk2(v[2], v[3]); *(u32x2*)(dst + t * LDT + tc * 32 + 8 * g + 4 * hi) = w; } }
    __syncthreads();
}
DEVI void tinv_b(const bf16_t* Aab_in, bf16_t* Tm, bf16_t* T0T, bf16_t* XT, int lane) {
    const int blk = lane >> 5, j = lane & 31, r32 = lane & 31, hi = lane >> 5;
    const bf16_t* Ab = Aab_in + (blk * 32) * LDT + blk * 32;
    float x[32];
#pragma unroll
    for (int t = 0; t < 32; ++t) { float a0 = (t == j) ? 1.f : 0.f, a1 = 0.f; const bf16_t* rowp = Ab + t * LDT;
#ifndef HIPEMU
        if (t >= 2) asm volatile("" : "+v"(rowp), "+v"(x[t - 2]));
#endif
#pragma unroll
        for (int c = 0; c < (t + 7) / 8; ++c) { float a[8]; unpack8(ld8(rowp + c * 8), a);
#pragma unroll
            for (int e = 0; e < 8; ++e) if (c * 8 + e < t) { if (e & 1) a1 += a[e] * x[c * 8 + e]; else a0 += a[e] * x[c * 8 + e]; } }
        x[t] = a0 + a1; }
#pragma unroll
    for (int s2 = 0; s2 < 32; ++s2) { Tm[(blk * 32 + s2) * LDT + blk * 32 + j] = (bf16_t)f2bf(x[s2]); if (blk) Tm[s2 * LDT + 32 + j] = 0; }
    if (!blk) {
#pragma unroll
        for (int c = 0; c < 4; ++c) { float y[8];
#pragma unroll
            for (int e = 0; e < 8; ++e) y[e] = x[c * 8 + e];
            *(bf16x8*)(T0T + j * 40 + c * 8) = pack8(y); } }
    WAVE_SYNC();
    f32x16 acc = (f32x16){};
#pragma unroll
    for (int ks = 0; ks < 2; ++ks) acc = mfma32(ld8(Aab_in + (32 + r32) * LDT + ks * 16 + hi * 8), ld8(T0T + r32 * 40 + ks * 16 + hi * 8), acc);
#pragma unroll
    for (int rr = 0; rr < 16; ++rr) XT[r32 * 40 + crow(rr, hi)] = (bf16_t)f2bf(acc[rr]);
    WAVE_SYNC();
    acc = (f32x16){};
#pragma unroll
    for (int ks = 0; ks < 2; ++ks) acc = mfma32(ld8(Tm + (32 + r32) * LDT + 32 + ks * 16 + hi * 8), ld8(XT + r32 * 40 + ks * 16 + hi * 8), acc);
#pragma unroll
    for (int rr = 0; rr < 16; ++rr) Tm[(32 + crow(rr, hi)) * LDT + r32] = (bf16_t)f2bf(acc[rr]);
}
DEVI bf16x8 accfrag(const f32x16& X, int s2) { float x[8];
#pragma unroll
    for (int e = 0; e < 8; ++e) x[e] = X[8 * s2 + e];
    return pack8(x); }
DEVI bf16x8 ldk(const bf16_t* rowp, int s2, int hi) { const u32x2 lo = *(const u32x2*)(rowp + 16 * s2 + 4 * hi), h2 = *(const u32x2*)(rowp + 16 * s2 + 8 + 4 * hi); u32x4 w; w[0] = lo[0]; w[1] = lo[1]; w[2] = h2[0]; w[3] = h2[1]; return __builtin_bit_cast(bf16x8, w); }
DEVI void inv32(const bf16_t* Ab, f32x16& Tm_, f32x16& Tt_, int n, int hi) {
    f32x16 S, St;
#pragma unroll
    for (int r = 0; r < 16; ++r) S[r] = bf2f(Ab[crow(r, hi) * LDT + n]);
#pragma unroll
    for (int g = 0; g < 4; ++g) { const u32x2 w = *(const u32x2*)(Ab + n * LDT + 8 * g + 4 * hi); const unsigned a = w[0], b2 = w[1]; St[4 * g] = bf2f(a); St[4 * g + 1] = bf2f(a >> 16); St[4 * g + 2] = bf2f(b2); St[4 * g + 3] = bf2f(b2 >> 16); }
    Tm_ = S; Tt_ = St;
#pragma unroll
    for (int r = 0; r < 16; ++r) { const float d = (crow(r, hi) == n) ? 1.f : 0.f; Tm_[r] += d; Tt_[r] += d; }
#pragma unroll
    for (int k = 0; k < 4; ++k) {
        { const bf16x8 fs0 = accfrag(S, 0), fs1 = accfrag(S, 1), ft0 = accfrag(St, 0), ft1 = accfrag(St, 1);
          f32x16 Sn = (f32x16){}; Sn = mfma32(ft0, fs0, Sn); Sn = mfma32(ft1, fs1, Sn);
          f32x16 Stn = (f32x16){}; Stn = mfma32(fs0, ft0, Stn); Stn = mfma32(fs1, ft1, Stn);
          S = Sn; St = Stn; }
        { const bf16x8 fs0 = accfrag(S, 0), fs1 = accfrag(S, 1), ft0 = accfrag(Tt_, 0), ft1 = accfrag(Tt_, 1);
          Tm_ = mfma32(ft0, fs0, Tm_); Tm_ = mfma32(ft1, fs1, Tm_);
          Tt_ = mfma32(fs0, ft0, Tt_); Tt_ = mfma32(fs1, ft1, Tt_); } }
}
DEVI void tinv_mfma(const bf16_t* Aab, bf16_t* Tm, int lane) {
    const int n = lane & 31, hi = lane >> 5;
    f32x16 X = (f32x16){};
    { f32x16 T0, T0t; inv32(Aab, T0, T0t, n, hi);
#pragma unroll
      for (int s2 = 0; s2 < 2; ++s2) X = mfma32(ldk(Aab + (32 + n) * LDT, s2, hi), accfrag(T0, s2), X);
#pragma unroll
      for (int g = 0; g < 4; ++g) { u32x2 w; w[0] = pk2(T0t[4 * g], T0t[4 * g + 1]); w[1] = pk2(T0t[4 * g + 2], T0t[4 * g + 3]); *(u32x2*)(Tm + n * LDT + 8 * g + 4 * hi) = w;
          u32x2 z; z[0] = 0u; z[1] = 0u; *(u32x2*)(Tm + n * LDT + 32 + 8 * g + 4 * hi) = z; } }
    { f32x16 T1, T1t; inv32(Aab + 32 * LDT + 32, T1, T1t, n, hi);
      f32x16 T10 = (f32x16){};
#pragma unroll
      for (int s2 = 0; s2 < 2; ++s2) T10 = mfma32(accfrag(T1t, s2), accfrag(X, s2), T10);
#pragma unroll
      for (int g = 0; g < 4; ++g) { u32x2 w; w[0] = pk2(T1t[4 * g], T1t[4 * g + 1]); w[1] = pk2(T1t[4 * g + 2], T1t[4 * g + 3]); *(u32x2*)(Tm + (32 + n) * LDT + 32 + 8 * g + 4 * hi) = w; }
#pragma unroll
      for (int r = 0; r < 16; ++r) Tm[(32 + crow(r, hi)) * LDT + n] = (bf16_t)f2bf(T10[r]); }
}
DEVI void tinv_half(const bf16_t* Aab, bf16_t* Tm, bf16_t* XL, int which, int lane) {
    const int n = lane & 31, hi = lane >> 5;
    f32x16 Tq, Tqt; inv32(Aab + which * (32 * LDT + 32), Tq, Tqt, n, hi);
#pragma unroll
    for (int g = 0; g < 4; ++g) { u32x2 w; w[0] = pk2(Tqt[4 * g], Tqt[4 * g + 1]); w[1] = pk2(Tqt[4 * g + 2], Tqt[4 * g + 3]); *(u32x2*)(Tm + (which * 32 + n) * LDT + which * 32 + 8 * g + 4 * hi) = w; }
    if (!which) { f32x16 X = (f32x16){};
#pragma unroll
        for (int s2 = 0; s2 < 2; ++s2) X = mfma32(ldk(Aab + (32 + n) * LDT, s2, hi), accfrag(Tq, s2), X);
#pragma unroll
        for (int r = 0; r < 16; ++r) XL[crow(r, hi) * LDT + n] = (bf16_t)f2bf(X[r]); }
}
DEVI void heavy_unit(const Frame& F0, int b, int h, int dir, int c) {
    unsigned char* L = F0.lds; const int part = F0.wave >> 2, vr = (F0.wave >> 1) & 1, dc = F0.wave & 1;
    bf16_t* S0b = (bf16_t*)(L + O_S0B); bf16_t* Tm = (bf16_t*)(L + O_BTT);
    const int stream = (b * 8 + h) * 2 + dir; float* YRW = F0.out; float* BON = (float*)(F0.ws + WS_RWT + RWT_BON);
    f32x16 S;
    RawPrep rcur;
    { const Frame F = unit_frame(F0); prep_load(F, b, h, dir, c * 256 + (dir ? 3 : 0) * 64, rcur); }
    { const Frame F = unit_frame(F0); const int r32 = F.lane & 31, hi = F.lane >> 5;
      copy16(F, L + O_W2T, F.ws + WS_RWT + RWT_W2 + (size_t)(dir * 8 + h) * 9216, 576); copy16(F, L + O_A2T, F.ws + WS_RWT + RWT_A2 + (size_t)(dir * 8 + h) * 9216, 576); stage_consts(F, h, dir);
#pragma unroll
      for (int rr = 0; rr < 16; ++rr) { const int v = vr * 32 + crow(rr, hi), d = dc * 32 + r32; S[rr] = (part == 0 && v == d) ? 1.f : 0.f; S0b[(part * 64 + v) * LDT + d] = (bf16_t)f2bf(S[rr]); } }
    __syncthreads();
#pragma unroll 1
    for (int sbi = 0; sbi < 4; ++sbi) { const int sub = dir ? 3 - sbi : sbi; const int t0 = c * 256 + sub * 64;
        const Frame F = unit_frame(F0);
        const int r32 = F.lane & 31, hi = F.lane >> 5;
        prep(F, b, h, dir, t0, rcur, BON);
        amats4(F);
        if (F.wave < 2) tinv_half((const bf16_t*)(L + O_AAB), Tm, (bf16_t*)(L + O_KTT), F.wave, F.lane);
        f32x16 W0 = (f32x16){}, W1 = (f32x16){};
        W0 = mm64((const bf16_t*)(L + O_AT), 0, S0b + part * 64 * LDT, dc * 32, W0, r32, hi); W1 = mm64((const bf16_t*)(L + O_AT), 32, S0b + part * 64 * LDT, dc * 32, W1, r32, hi);
        if (part) { W0 = mm64_yt((const bf16_t*)(L + O_AAK), 0, (const bf16_t*)(L + O_VT), dc * 32, W0, r32, hi, F.lane); W1 = mm64_yt((const bf16_t*)(L + O_AAK), 32, (const bf16_t*)(L + O_VT), dc * 32, W1, r32, hi, F.lane); }
        __syncthreads();
        if (sbi < 3) prep_load(F, b, h, dir, c * 256 + (dir ? 2 - sbi : sbi + 1) * 64, rcur);
        { f32x16 u = (f32x16){}; const bf16_t* trow = Tm + (vr * 32 + r32) * LDT;
#pragma unroll
          for (int s2 = 0; s2 < 2; ++s2) u = mfma32(ldk(vr ? (const bf16_t*)(L + O_KTT) + r32 * LDT : trow, s2, hi), accfrag(W0, s2), u);
          if (vr) {
#pragma unroll
              for (int e = 0; e < 16; ++e) W1[e] += u[e];
              u = (f32x16){};
#pragma unroll
              for (int s2 = 0; s2 < 2; ++s2) u = mfma32(ldk(trow + 32, s2, hi), accfrag(W1, s2), u); }
          st_tile_T((bf16_t*)(L + (part ? O_AT : O_UT)), vr * 32, dc * 32, u, r32, hi); }
        __syncthreads();
        { const bf16_t* UT = (const bf16_t*)(L + (part ? O_AT : O_UT));
          f32x16 y = (f32x16){};
          y = mm64((const bf16_t*)(L + O_RT), vr * 32, S0b + part * 64 * LDT, dc * 32, y, r32, hi);
          y = mm64((const bf16_t*)(L + O_ARB), vr * 32, UT, dc * 32, y, r32, hi);
          if (part) { y = mm64_yt((const bf16_t*)(L + O_ARK), vr * 32, (const bf16_t*)(L + O_VT), dc * 32, y, r32, hi, F.lane);
#pragma unroll
              for (int rr = 0; rr < 16; ++rr) { const int i = vr * 32 + crow(rr, hi), tok = dir ? t0 + 63 - i : t0 + i; atomic_add_f32(YRW + (size_t)grow(b, tok) * 512 + h * 64 + dc * 32 + r32, y[rr]); } }
          else { bf16_t* Z = (bf16_t*)(F.ws + WS_ACT) + ((size_t)(stream * NCH + c) * 4 + sbi) * 4096;
#pragma unroll
              for (int rr = 0; rr < 16; ++rr) Z[(vr * 32 + crow(rr, hi)) * 64 + dc * 32 + r32] = (bf16_t)f2bf(y[rr]); }
          S = mm64_yt(UT, vr * 32, (const bf16_t*)(L + O_BT), dc * 32, S, r32, hi, F.lane);
          if (part) S = mm64_xyt((const bf16_t*)(L + O_VT), vr * 32, (const bf16_t*)(L + O_KT), dc * 32, S, F.lane);
          const float gl = ((const float*)(L + O_GL))[dc * 32 + r32];
#pragma unroll
          for (int rr = 0; rr < 16; ++rr) S[rr] *= gl; }
        __syncthreads();
#pragma unroll
        for (int rr = 0; rr < 16; ++rr) S0b[(part * 64 + vr * 32 + crow(rr, hi)) * LDT + dc * 32 + r32] = (bf16_t)f2bf(S[rr]);
    }
    { const Frame F = unit_frame(F0); const int r32 = F.lane & 31, hi = F.lane >> 5;
      float* slot = slot_ptr(F, stream * NCH + c);
#pragma unroll
      for (int rr = 0; rr < 16; ++rr) slot[(part * 64 + vr * 32 + crow(rr, hi)) * 64 + dc * 32 + r32] = S[rr]; }
    __syncthreads();
}
struct FixPre { f32x4 a, a2; bf16x8 z[2][2]; };
DEVI void fixup_load(const Frame& F, int stream, int c, FixPre& P) {
    const float* Sin = slot_ptr(F, stream * NCH + c) + 4096; const bf16_t* Zb = (const bf16_t*)(F.ws + WS_ACT) + (size_t)(stream * NCH + c) * 4 * 4096;
    const int sv = F.tid >> 3, j8 = (F.tid & 7) * 8, zw = F.tid >> 8, zt = (F.tid & 255) >> 2, q16 = (F.tid & 3) * 16;
    P.a = *(const f32x4*)(Sin + sv * 64 + j8); P.a2 = *(const f32x4*)(Sin + sv * 64 + j8 + 4);
#pragma unroll
    for (int rnd = 0; rnd < 2; ++rnd) { const bf16_t* zp = Zb + (size_t)(rnd * 2 + zw) * 4096 + zt * 64 + q16; P.z[rnd][0] = ld8(zp); P.z[rnd][1] = ld8(zp + 8); }
}
DEVI void fixup_unit(const Frame& F0, int stream, int c, FixPre& P, bool has_next, int nstream, int nc) {
    const Frame F = unit_frame(F0);
    unsigned char* L = F.lds; bf16_t* Sb = (bf16_t*)L; bf16_t* Cz = (bf16_t*)(L + 9216);
    const int r32 = F.lane & 31, hi = F.lane >> 5, half = F.wave >> 2, tr = (F.wave >> 1) & 1, vc = F.wave & 1;
    const int dir = stream & 1, h = (stream >> 1) & 7, b = stream >> 4; float* YRW = F.out;
    const int sv = F.tid >> 3, j8 = (F.tid & 7) * 8, zw = F.tid >> 8, zt = (F.tid & 255) >> 2, q16 = (F.tid & 3) * 16;
    __syncthreads();
    { float x[8];
#pragma unroll
      for (int e = 0; e < 4; ++e) { x[e] = P.a[e]; x[4 + e] = P.a2[e]; }
      *(bf16x8*)(Sb + sv * LDT + j8) = pack8(x); }
#pragma unroll
    for (int rnd = 0; rnd < 2; ++rnd) { bf16_t* cz = Cz + ((rnd * 2 + zw) * 64 + zt) * LDT + q16; *(bf16x8*)cz = P.z[rnd][0]; *(bf16x8*)(cz + 8) = P.z[rnd][1]; }
    __syncthreads();
    if (has_next) fixup_load(F, nstream, nc, P);
#pragma unroll 1
    for (int rnd = 0; rnd < 2; ++rnd) {
        const int sbi = rnd * 2 + half, sub = dir ? 3 - sbi : sbi, t0 = c * 256 + sub * 64;
        f32x16 y = (f32x16){}; y = mm64(Cz + sbi * 64 * LDT, tr * 32, Sb, vc * 32, y, r32, hi);
#pragma unroll
        for (int rr = 0; rr < 16; ++rr) { const int i = tr * 32 + crow(rr, hi), tok = dir ? t0 + 63 - i : t0 + i; atomic_add_f32(YRW + (size_t)grow(b, tok) * 512 + h * 64 + vc * 32 + r32, y[rr]); }
    }
}
DEVI void phaseB(const Frame& F) {
    constexpr int SLD = 66, MLD = 80;
    float* Sl = (float*)F.lds; float* Ml = Sl + 16 * SLD; float* Nl = Ml + 64 * MLD;
    const int v = F.tid >> 5, d2 = (F.tid & 31) * 2, lj = F.lane & 15, lq = F.lane >> 4;
    for (int item = F.G - 1 - F.bid; item < NSTR_RW * 4; item += F.G) { const int stream = item >> 2, q = item & 3, dir = stream & 1;
        __syncthreads();
        for (int i = F.tid; i < 16 * SLD; i += NTHREADS) Sl[i] = 0.f;
        f32x4 pm0, pm1, pn = (f32x4){}, qm0, qm1, qn = (f32x4){}, rm0, rm1, rn = (f32x4){};
#define RWB_LD(M0, M1, NN, kk) do { const float* ns_ = slot_ptr(F, stream * NCH + ml_chunk_at(dir, (kk))); M0 = ((const f32x4*)ns_)[F.tid]; M1 = ((const f32x4*)ns_)[512 + F.tid]; if (F.tid < 256) NN = ((const f32x4*)(ns_ + 4096 + q * 1024))[F.tid]; } while (0)
        RWB_LD(pm0, pm1, pn, 0); qm0 = pm0; qm1 = pm1; rm0 = pm0; rm1 = pm1;
        if (1 < NCH) RWB_LD(qm0, qm1, qn, 1);
        if (2 < NCH) RWB_LD(rm0, rm1, rn, 2);
        for (int k = 0; k < NCH; ++k) { const int c = ml_chunk_at(dir, k); float* slot = slot_ptr(F, stream * NCH + c);
            __syncthreads();
            *(f32x4*)(Ml + (F.tid >> 4) * MLD + (F.tid & 15) * 4) = pm0; *(f32x4*)(Ml + (32 + (F.tid >> 4)) * MLD + (F.tid & 15) * 4) = pm1; if (F.tid < 256) ((f32x4*)Nl)[F.tid] = pn;
            pm0 = qm0; pm1 = qm1; pn = qn; qm0 = rm0; qm1 = rm1; qn = rn;
            if (k + 3 < NCH) RWB_LD(rm0, rm1, rn, k + 3);
            __syncthreads();
            f32x4 acc = (f32x4){};
            if (F.wave < 4) {
#pragma unroll
                for (int r = 0; r < 4; ++r) acc[r] = Nl[(4 * lq + r) * 64 + 16 * F.wave + lj];
#pragma unroll
                for (int kk = 0; kk < 16; ++kk) acc = mfma16f(Sl[lj * SLD + 4 * kk + lq], Ml[(4 * kk + lq) * MLD + 16 * F.wave + lj], acc); }
            slot[4096 + (q * 16 + v) * 64 + d2] = Sl[v * SLD + d2]; slot[4096 + (q * 16 + v) * 64 + d2 + 1] = Sl[v * SLD + d2 + 1];
            __syncthreads();
            if (F.wave < 4) {
#pragma unroll
                for (int r = 0; r < 4; ++r) Sl[(4 * lq + r) * SLD + 16 * F.wave + lj] = acc[r]; }
        }
    }
    __syncthreads();
}
DEVI void phaseC_unit(const Frame& F0, int b, int h, int dir, int c) {
    unsigned char* L = F0.lds; const int half = F0.wave >> 2, vr = (F0.wave >> 1) & 1, dc = F0.wave & 1;
    bf16_t* S0b = (bf16_t*)(L + O_S0B); float* ABFd = (float*)(L + O_ABF_C); bf16_t* T0T = (bf16_t*)(L + O_ABF_C + 8192); bf16_t* XT = T0T + 32 * 40; bf16_t* Tm = (bf16_t*)(L + O_KT);
    float* YRW = F0.out;
    f32x16 S = (f32x16){};
    { const Frame F = unit_frame(F0); const int r32 = F.lane & 31, hi = F.lane >> 5;
      rw_stage_weights(F, h, (bf16_t*)(L + O_W2T), (bf16_t*)(L + O_A2T), nullptr, 1 << dir); stage_consts(F, h, dir);
      const float* Sin = slot_ptr(F, ((b * 8 + h) * 2 + dir) * NCH + c) + 4096;
      if (half == 1) {
#pragma unroll
        for (int rr = 0; rr < 16; ++rr) { const int v = vr * 32 + crow(rr, hi), d = dc * 32 + r32; S[rr] = Sin[v * 64 + d]; S0b[v * LDT + d] = (bf16_t)f2bf(S[rr]); } } }
    __syncthreads();
    RawPrep rcur, rnxt;
    { const Frame F = unit_frame(F0); prep_load(F, b, h, dir, c * 256 + (dir ? 3 : 0) * 64, rcur); }
#pragma unroll 1
    for (int sbi = 0; sbi < 4; ++sbi) { const int sub = dir ? 3 - sbi : sbi; const int t0 = c * 256 + sub * 64;
        const Frame F = unit_frame(F0);
        const int r32 = F.lane & 31, hi = F.lane >> 5;
        if (sbi < 3) prep_load(F, b, h, dir, c * 256 + (dir ? 2 - sbi : sbi + 1) * 64, rnxt);
        prep(F, b, h, dir, t0, rcur);
        rcur = rnxt;
        amats(F, true, ABFd);
        if (F.wave == 4) tinv(ABFd, (const bf16_t*)(L + O_AAB), Tm, T0T, XT, F.lane);
        if (half == 0) { f32x16 acc = (f32x16){};
          acc = mm64((const bf16_t*)(L + O_AT), vr * 32, S0b, dc * 32, acc, r32, hi);
          acc = mm64((const bf16_t*)(L + O_AAK), vr * 32, (const bf16_t*)(L + O_VT), dc * 32, acc, r32, hi);
          st_tile_T((bf16_t*)(L + O_BT), vr * 32, dc * 32, acc, r32, hi); }
        __syncthreads();
        if (half == 0) { f32x16 u = (f32x16){}; u = mm64(Tm, vr * 32, (const bf16_t*)(L + O_BT), dc * 32, u, r32, hi); st_tile_T((bf16_t*)(L + O_UT), vr * 32, dc * 32, u, r32, hi); }
        __syncthreads();
        if (half == 0) {
            f32x16 y = (f32x16){};
            y = mm64((const bf16_t*)(L + O_RT), vr * 32, S0b, dc * 32, y, r32, hi);
            y = mm64((const bf16_t*)(L + O_ARB), vr * 32, (const bf16_t*)(L + O_UT), dc * 32, y, r32, hi);
            y = mm64((const bf16_t*)(L + O_ARK), vr * 32, (const bf16_t*)(L + O_VT), dc * 32, y, r32, hi);
#pragma unroll
            for (int rr = 0; rr < 16; ++rr) { const int i = vr * 32 + crow(rr, hi), tok = dir ? t0 + 63 - i : t0 + i; atomic_add_f32(YRW + (size_t)grow(b, tok) * 512 + h * 64 + dc * 32 + r32, y[rr]); }
        } else {
            S = mm64((const bf16_t*)(L + O_UT), vr * 32, (const bf16_t*)(L + O_BTT), dc * 32, S, r32, hi);
            S = mm64((const bf16_t*)(L + O_VT), vr * 32, (const bf16_t*)(L + O_KTT), dc * 32, S, r32, hi);
            const float gl = ((const float*)(L + O_GL))[dc * 32 + r32];
#pragma unroll
            for (int rr = 0; rr < 16; ++rr) S[rr] *= gl;
        }
        __syncthreads();
        if (half == 1) {
#pragma unroll
            for (int rr = 0; rr < 16; ++rr) S0b[(vr * 32 + crow(rr, hi)) * LDT + dc * 32 + r32] = (bf16_t)f2bf(S[rr]); }
        __syncthreads();
    }
}
}

constexpr float HG_QSCALE = 0.08838834764831845f;
constexpr int LDS32 = 40;
DEVI float hg_lb(const Frame& F, int ch) { return sigmoidf_(F.ap->in[I_HGLB][512 + ch] - F.ap->in[I_HGLB][ch]); }
DEVI void hg_fk(float pre, float lb, float& lf, float& k) { const float sg = sigmoidf_(pre); lf = __logf(lb + (1.f - lb) * sg); k = (1.f - lb) * (1.f - sg); }
DEVI void hg_fk2(float pre, float lb, float& f, float& k) { const float sg = sigmoidf_(pre); f = lb + (1.f - lb) * sg; k = (1.f - lb) * (1.f - sg); }
template <int DSEL> DEVI void hg_phaseA_unit(const Frame& F, int b, int h, int c) {
    constexpr bool FWO = DSEL >= 0;
    const bf16_t* PROJ = (const bf16_t*)(F.ws + WS_BIG);
    constexpr int RSV = 160;
    bf16_t* KTf = (bf16_t*)F.lds; bf16_t* KTb = KTf + 128 * LDT; bf16_t* VTa = KTb + 128 * LDT; bf16_t* VTb = VTa + 64 * RSV; bf16_t* HFf = VTb + 64 * RSV; bf16_t* HFb = HFf + 64 * LDK;
    constexpr int NG = FWO ? 2 : 4, NSEG = FWO ? 4 : 2, NPOS = 64 / NSEG, NV = FWO ? 2 : 4;
    const int r32 = F.lane & 31, hi = F.lane >> 5, dir = FWO ? DSEL : (F.wave >> 2), dt = F.wave & 3, vt0 = FWO ? (F.wave >> 2) * 2 : 0;
    const int lw = FWO ? DSEL : (F.tid >> 8), lj = FWO ? (F.tid >> 3) : ((F.tid & 255) >> 2), lch = FWO ? (F.tid & 7) * 16 : (F.tid & 3) * 32;
    f32x16 acc[NV];
#pragma unroll
    for (int i = 0; i < NV; ++i) acc[i] = (f32x16){};
    float Pacc = 1.f; const int sd = FWO ? DSEL : (F.tid >> 8), seg = FWO ? (F.tid >> 7) : ((F.tid >> 7) & 1), sdch = F.tid & 127;
    const float lb = hg_lb(F, h * 128 + sdch); float* xch = (float*)(HFb + 64 * LDK);
    bf16x8 pf[NG], pv[NG];
#define HGA_ISSUE(itb_) do { const int blk = lw ? (itb_) : 3 - (itb_); const size_t rb = (size_t)grow(b, c * 256 + blk * 64 + lj) * ODP; const int colf = (lw ? O_HFB : O_HFF) + h * 128; \
        _Pragma("unroll") for (int g = 0; g < NG; ++g) { const int ch = lch + g * 8; pf[g] = ld8(PROJ + rb + colf + ch); pv[g] = ld8(PROJ + rb + O_HI + h * 128 + ch); } } while (0)
    HGA_ISSUE(0);
    for (int itb = 0; itb < 4; ++itb) {
        __syncthreads();
        { bf16_t* VT = lw ? VTb : VTa; bf16_t* HF = lw ? HFb : HFf;
#pragma unroll
          for (int g = 0; g < NG; ++g) { const int ch = lch + g * 8; *(bf16x8*)(HF + lj * LDK + ch) = pf[g]; *(bf16x8*)(VT + lj * RSV + ch) = pv[g]; } }
        __syncthreads();
        if (itb + 1 < 4) HGA_ISSUE(itb + 1);
        { bf16_t* KT = sd ? KTb : KTf; const bf16_t* HF = sd ? HFb : HFf; float cp[NPOS], kk[NPOS]; float run = 1.f;
#pragma unroll
            for (int i = 0; i < NPOS; ++i) { const int sp = seg * NPOS + i, j = sd ? sp : 63 - sp; float f; hg_fk2(bf2f(HF[j * LDK + sdch]), lb, f, kk[i]); cp[i] = run; run *= f; }
            xch[(sd * 4 + seg) * 128 + sdch] = run;
            __syncthreads();
            float base = Pacc, tot = 1.f;
#pragma unroll
            for (int q = 0; q < NSEG; ++q) { const float rq = xch[(sd * 4 + q) * 128 + sdch]; base *= (q < seg) ? rq : 1.f; tot *= rq; }
#pragma unroll
            for (int i = 0; i < NPOS; ++i) { const int sp = seg * NPOS + i, j = sd ? sp : 63 - sp; KT[sdch * LDT + j] = (bf16_t)f2bf(kk[i] * (base * cp[i])); }
            Pacc *= tot; }
        __syncthreads();
        const bf16_t* KT = dir ? KTb : KTf; const bf16_t* VT = dir ? VTb : VTa;
#pragma unroll
        for (int ks = 0; ks < 4; ++ks) { const bf16x8 a = ld8(KT + (dt * 32 + r32) * LDT + ks * 16 + hi * 8);
#pragma unroll
            for (int vt = 0; vt < NV; ++vt) acc[vt] = mfma32(a, ld_tr_B(VT, RSV, ks * 16, (vt0 + vt) * 32, F.lane), acc[vt]); }
    }
    const int stream = (b * 4 + h) * 2 + dir; float* Sg = (float*)(F.ws + WS_HGS) + ((size_t)stream * NCH + c) * 16384;
#pragma unroll
    for (int vt = 0; vt < NV; ++vt)
#pragma unroll
        for (int r = 0; r < 16; ++r) Sg[(dt * 32 + crow(r, hi)) * 128 + (vt0 + vt) * 32 + r32] = acc[vt][r];
#undef HGA_ISSUE
    if (seg == 0) ((float*)(F.ws + WS_ACT))[((size_t)((b * 4 + h) * 2 + sd) * NCH + c) * 128 + sdch] = Pacc;
    __syncthreads();
}
DEVI void hg_phaseB(const Frame& F) {
    const int nvb = NSTR_ML * 16;
    for (int vb = F.bid; vb < nvb; vb += F.G) {
        const int stream = vb >> 4, e0 = ((vb & 15) * NTHREADS + F.tid) * 2, dir = stream & 1, d = e0 >> 7;
        float* Ss = (float*)(F.ws + WS_HGS) + (size_t)stream * NCH * 16384; const float* Bt = (const float*)(F.ws + WS_ACT) + (size_t)stream * NCH * 128;
        typedef float f32x2s __attribute__((ext_vector_type(2)));
        f32x2s lv[NCH]; float dkv[NCH];
#pragma unroll
        for (int k = 0; k < NCH; ++k) { const int c = ml_chunk_at(dir, k); lv[k] = *(const f32x2s*)(Ss + (size_t)c * 16384 + e0); dkv[k] = Bt[c * 128 + d]; }
        float s0 = 0.f, s1 = 0.f;
#pragma unroll
        for (int k = 0; k < NCH; ++k) { const int c = ml_chunk_at(dir, k); f32x2s o; o[0] = s0; o[1] = s1; *(f32x2s*)(Ss + (size_t)c * 16384 + e0) = o;
            s0 = dkv[k] * s0 + lv[k][0]; s1 = dkv[k] * s1 + lv[k][1]; }
    }
}
DEVI void hg_phaseC_unit(const Frame& F0, int b, int h, int c) {
    const Frame F = unit_frame(F0); PS_DECL PS_B(9)
    const bf16_t* PROJ = (const bf16_t*)(F.ws + WS_BIG); bf16_t* YM = (bf16_t*)(F.ws + WS_ACT);
    const int dir = F.wave >> 2, vt = F.wave & 3;
    int r32 = F.lane & 31, hi = F.lane >> 5, tl = F.tid & 255;
    unsigned char* dbase = F.lds + dir * 40960;
    bf16_t* QH = (bf16_t*)dbase; bf16_t* KB = QH + 32 * LDK; bf16_t* KBT = KB + 32 * LDK; bf16_t* VT = KBT + 128 * LDS32; float* blast = (float*)(VT + 128 * LDS32);
    bf16_t* stash = (bf16_t*)(F.lds + 81920);
    float* ssb = (float*)(F.lds + 81920 + 65536);
    f32x16 S[4];
    { const int stream = (b * 4 + h) * 2 + dir; const float* Sg = (const float*)(F.ws + WS_HGS) + ((size_t)stream * NCH + c) * 16384;
#pragma unroll
      for (int dt = 0; dt < 4; ++dt)
#pragma unroll
          for (int r = 0; r < 16; ++r) S[dt][r] = Sg[(dt * 32 + crow(r, hi)) * 128 + vt * 32 + r32]; }
    const float lb = hg_lb(F, h * 128 + (tl & 127));
#pragma unroll 1
    for (int step = 0; step < 8; ++step) {
        const int sb = dir ? 7 - step : step; const int tb = c * 256 + sb * 32;
        { const Frame Fs = unit_frame(F0); r32 = Fs.lane & 31; hi = Fs.lane >> 5; tl = Fs.tid & 255; }
        PS_B(1) __syncthreads();
        { const int j = tl >> 3, g8 = tl & 7; const size_t rb = (size_t)grow(b, tb + j) * ODP;
#pragma unroll
          for (int hf2 = 0; hf2 < 2; ++hf2) { const int ch = g8 * 16 + hf2 * 8;
              *(bf16x8*)(QH + j * LDK + ch) = ld8(PROJ + rb + O_HQ + h * 128 + ch); *(bf16x8*)(KB + j * LDK + ch) = ld8(PROJ + rb + (dir ? O_HFB : O_HFF) + h * 128 + ch);
              *(bf16x8*)(VT + j * 160 + ch) = ld8(PROJ + rb + O_HI + h * 128 + ch); } }
        __syncthreads(); PS_E(1) PS_B(2)
        { const int d = tl & 127, hf = tl >> 7; float cp[16]; float run = 1.f;
#pragma unroll
          for (int s = 0; s < 16; ++s) { const int sp = hf * 16 + s, j = dir ? 31 - sp : sp; float f, k; hg_fk2(bf2f(KB[j * LDK + d]), lb, f, k);
              run *= f; cp[s] = run; KB[j * LDK + d] = (bf16_t)f2bf(k); QH[j * LDK + d] = (bf16_t)f2bf(siluf_(bf2f(QH[j * LDK + d])) * HG_QSCALE); }
          if (hf == 0) blast[d] = run;
          __syncthreads();
          const float off = hf ? blast[d] : 1.f;
          __syncthreads();
#pragma unroll
          for (int s = 0; s < 16; ++s) { const int sp = hf * 16 + s, j = dir ? 31 - sp : sp; const float P = cp[s] * off;
              QH[j * LDK + d] = (bf16_t)f2bf(bf2f(QH[j * LDK + d]) * P); const unsigned kb = f2bf(bf2f(KB[j * LDK + d]) * RCP(fmaxf(P, 1.8e-35f))); KB[j * LDK + d] = (bf16_t)kb; KBT[d * LDS32 + j] = (bf16_t)kb; }
          if (hf) blast[d] = cp[15] * off; }
        __syncthreads(); PS_E(2) PS_B(3)
        f32x16 p = (f32x16){};
#pragma unroll
        for (int ks = 0; ks < 8; ++ks) p = mfma32(ld8(KB + r32 * LDK + ks * 16 + hi * 8), ld8(QH + r32 * LDK + ks * 16 + hi * 8), p);
#pragma unroll
        for (int r = 0; r < 16; ++r) { const int s = crow(r, hi); const bool ok = dir ? (s >= r32) : (s <= r32); p[r] = ok ? p[r] : 0.f; }
        const bf16x8 pa0 = pk4frag(p, 0), pa1 = pk4frag(p, 8);
        f32x16 o = (f32x16){};
        const bf16x8 vb0 = ld_tr_B(VT, 160, 0, vt * 32, F.lane), vb1 = ld_tr_B(VT, 160, 16, vt * 32, F.lane);
        o = mfma32(pa0, vb0, o); o = mfma32(pa1, vb1, o);
#pragma unroll
        for (int dt = 0; dt < 4; ++dt)
#pragma unroll
            for (int s2 = 0; s2 < 2; ++s2) { float sf[8];
#pragma unroll
                for (int e = 0; e < 8; ++e) sf[e] = S[dt][8 * s2 + e];
                const bf16_t* qp = QH + r32 * LDK + dt * 32 + 16 * s2 + 4 * hi; u32x4 aw; const u32x2 lo = *(const u32x2*)qp, hh = *(const u32x2*)(qp + 8); aw[0] = lo[0]; aw[1] = lo[1]; aw[2] = hh[0]; aw[3] = hh[1];
                o = mfma32(__builtin_bit_cast(bf16x8, aw), pack8(sf), o); }
#pragma unroll
        for (int dt = 0; dt < 4; ++dt) {
#pragma unroll
            for (int ks = 0; ks < 2; ++ks) S[dt] = mfma32(ld8(KBT + (dt * 32 + r32) * LDS32 + ks * 16 + hi * 8), ks ? vb1 : vb0, S[dt]);
#pragma unroll
            for (int g = 0; g < 4; ++g) { const f32x4 b4 = *(const f32x4*)(blast + dt * 32 + 8 * g + 4 * hi);
#pragma unroll
                for (int e = 0; e < 4; ++e) S[dt][4 * g + e] *= b4[e]; } }
        PS_E(3) PS_B(4)
        bf16_t hgraw[16];
        if (step < 4) {
#pragma unroll
            for (int r = 0; r < 16; ++r) stash[(sb * 32 + crow(r, hi)) * 128 + vt * 32 + r32] = (bf16_t)f2bf(o[r]);
        } else {
#pragma unroll
            for (int r = 0; r < 16; ++r) hgraw[r] = PROJ[(size_t)grow(b, tb + crow(r, hi)) * ODP + O_HG + h * 128 + vt * 32 + r32];
#pragma unroll
            for (int r = 0; r < 16; ++r) { o[r] += bf2f(stash[(sb * 32 + crow(r, hi)) * 128 + vt * 32 + r32]); const float sq = half_sum32(o[r] * o[r]); if (r32 == 0) ssb[(dir * 32 + crow(r, hi)) * 4 + vt] = sq; }
        }
        __syncthreads();
        if (step >= 4) { const int v = h * 128 + vt * 32 + r32; const float gn = F.ap->in[I_HGNORM][v];
#pragma unroll
            for (int r = 0; r < 16; ++r) { const int tr = crow(r, hi); const f32x4 sp = *(const f32x4*)(ssb + (dir * 32 + tr) * 4); const float rs = RSQ(((sp[0] + sp[1]) + (sp[2] + sp[3])) * (1.f / 128.f) + EPS);
                YM[(size_t)grow(b, tb + tr) * D + v] = (bf16_t)f2bf(o[r] * rs * gn * siluf_(bf2f(hgraw[r]))); }
        }
        PS_E(4)
    }
    __syncthreads(); PS_E(9) PS_SPIN;
}
DEVI void mla_prep_unit(const Frame& F, int u) {
    const bf16_t* PROJ = (const bf16_t*)(F.ws + WS_BIG); float* rq = (float*)(F.ws + WS_RSTD); float* rkv = rq + M; bf16_t* KR = (bf16_t*)(F.ws + WS_SCR + SC_KR);
    const float* rc = (const float*)(F.ws + WS_ROPE); const float* rsn = rc + 128 * 16;
    const int r0 = u * 64 + F.wave * 8;
    bf16x8 q8[4], c8[2]; float kr[8];
#pragma unroll
    for (int i = 0; i < 4; ++i) q8[i] = ld8(PROJ + (size_t)(r0 + 2 * i + (F.lane >> 5)) * ODP + O_CQ + (F.lane & 31) * 8);
#pragma unroll
    for (int i = 0; i < 2; ++i) c8[i] = ld8(PROJ + (size_t)(r0 + 4 * i + (F.lane >> 4)) * ODP + O_CKV + (F.lane & 15) * 8);
#pragma unroll
    for (int i = 0; i < 8; ++i) kr[i] = bf2f(PROJ[(size_t)(r0 + i) * ODP + O_KR + F.lane]);
#pragma unroll
    for (int i = 0; i < 4; ++i) { float x[8]; unpack8(q8[i], x); float sq = 0.f;
#pragma unroll
        for (int e = 0; e < 8; ++e) sq += x[e] * x[e];
        sq = half_sum32(sq); if ((F.lane & 31) == 0) rq[r0 + 2 * i + (F.lane >> 5)] = RSQ(sq * (1.f / 256.f) + EPS); }
#pragma unroll
    for (int i = 0; i < 2; ++i) { float x[8]; unpack8(c8[i], x); float sq = 0.f;
#pragma unroll
        for (int e = 0; e < 8; ++e) sq += x[e] * x[e];
        sq = sum16(sq); if ((F.lane & 15) == 0) rkv[r0 + 4 * i + (F.lane >> 4)] = RSQ(sq * (1.f / 128.f) + EPS); }
#pragma unroll
    for (int i = 0; i < 8; ++i) { const int r = r0 + i; const float x = kr[i]; const float pr = shx<16>(x);
        const int tt = r % T; float y = x;
        if (tt >= CTX) { const int li = tt - CTX, half = F.lane >> 5, w = F.lane & 31, pos = half ? (li % GRIDW) : (li / GRIDW); const bool lo = w < 16; const int i0 = lo ? w : w - 16;
            const float cc = rc[pos * 16 + i0], sn = rsn[pos * 16 + i0]; y = lo ? (x * cc - pr * sn) : (pr * sn + x * cc); }
        KR[(size_t)r * 64 + F.lane] = (bf16_t)f2bf(y); }
}

namespace att {
constexpr int NW = 8, QBLK = 32, KVBLK = 64;
constexpr float SCALE = 0.07216878364870322f;
#ifndef ATT_THR
#define ATT_THR 8.f
#endif
constexpr float THR = ATT_THR;
constexpr size_t SHM_V = KVBLK * 128 * 2, SHM_K = KVBLK * 128 * 2, SHM_R = KVBLK * 64 * 2;
constexpr size_t OFF_V = 0, OFF_K = 2 * SHM_V, OFF_R = OFF_K + 2 * SHM_K, OFF_WS = OFF_R + 2 * SHM_R, OFF_QR = OFF_WS + NW * 64 * 4, QRLD = 144, SHM_ATTN = OFF_QR + NW * 32 * QRLD * 2;
static_assert(SHM_ATTN <= 160 * 1024, "attention LDS");
#define KSWZ(row, colB) ((row) * 256 + ((colB) ^ (((row) & 7) << 4)))
#define RSWZ(row, colB) ((row) * 128 + ((colB) ^ (((row) & 7) << 4)))
#ifndef HIPEMU
#define SBAR() __builtin_amdgcn_sched_barrier(0)
#define LGKM0() asm volatile("s_waitcnt lgkmcnt(0)" ::: "memory")
#else
#define SBAR()
#define LGKM0()
#endif
DEVI void partialSM(f32x16& p0, f32x16& p1, float& m_reg, float& mn, float& alpha) {
    constexpr float C = SCALE * 1.4426950408889634f;
    float pmax = p0[0];
#pragma unroll
    for (int r = 1; r < 16; ++r) pmax = fmaxf(pmax, p0[r]);
#pragma unroll
    for (int r = 0; r < 16; ++r) pmax = fmaxf(pmax, p1[r]);
    { const u32x2 rr = plswap(f2u(pmax), f2u(pmax)); const unsigned ra = rr[0], rb = rr[1]; pmax = fmaxf(u2f(ra), u2f(rb)); }
    bool keep = (pmax - m_reg <= THR / SCALE);
    int allk = 1;
#ifdef HIPEMU
    { float f = keep ? 1.f : 0.f; for (int o = 1; o < 64; o <<= 1) f = fminf(f, __shfl_xor(f, o)); allk = f > 0.5f; }
#else
    allk = __all(keep);
#endif
    if (allk) { mn = m_reg; alpha = 1.f; }
    else { mn = fmaxf(m_reg, pmax); alpha = EXP2F((m_reg - mn) * C); m_reg = mn; }
    const float mnC = -mn * C;
#pragma unroll
    for (int r = 0; r < 16; ++r) { p0[r] = EXP2F(fmaf(p0[r], C, mnC)); p1[r] = fmaf(p1[r], C, mnC); }
}
DEVI void finishSM(f32x16& p0, f32x16& p1, float alpha, float& l_reg, bf16x8& pa0, bf16x8& pa1, bf16x8& pa2, bf16x8& pa3) {
    float ps = 0.f;
#pragma unroll
    for (int r = 0; r < 16; ++r) { p1[r] = EXP2F(p1[r]); ps += p0[r] + p1[r]; }
    { const u32x2 rr = plswap(f2u(ps), f2u(ps)); const unsigned ra = rr[0], rb = rr[1]; ps = u2f(ra) + u2f(rb); }
    l_reg = l_reg * alpha + ps;
    pa0 = pk4frag(p0, 0); pa1 = pk4frag(p0, 8); pa2 = pk4frag(p1, 0); pa3 = pk4frag(p1, 8);
#ifdef ATT_DEBUG
    { float ones[8] = {1,1,1,1,1,1,1,1}; bf16x8 b1 = pack8(ones); f32x16 t = (f32x16){}; t = mfma32(pa0, b1, t); t = mfma32(pa1, b1, t); t = mfma32(pa2, b1, t); t = mfma32(pa3, b1, t);
      { float own = 0.f, ownb = 0.f; for (int r = 0; r < 16; ++r) { own += p0[r] + p1[r]; ownb += bf2f(f2bf(p0[r])) + bf2f(f2bf(p1[r])); }
        float fa = 0.f; for (int j = 0; j < 8; ++j) fa += bf2f((unsigned short)pa0[j]) + bf2f((unsigned short)pa1[j]) + bf2f((unsigned short)pa2[j]) + bf2f((unsigned short)pa3[j]);
        if (blockIdx.x == 0 && (threadIdx.x == 0 || threadIdx.x == 32)) printf("  lane %d own=%g ownbf=%g fragsum=%g\n", (int)threadIdx.x, own, ownb, fa); }
      if (blockIdx.x == 0 && threadIdx.x == 0) printf("T ps=%g mfma_row0=%g alpha=%g l=%g\n", ps, t[0], alpha, l_reg); }
#endif
}
DEVI void qkt(f32x16& p0, f32x16& p1, const unsigned char* Ks, const unsigned char* Rs, const bf16x8* qr, const bf16_t* qrl, int r32, int hi) {
    p0 = (f32x16){}; p1 = (f32x16){};
#pragma unroll
    for (int d0 = 0; d0 < 8; ++d0) { const int cb = (d0 * 16 + hi * 8) * 2; const bf16x8 qf = (d0 < 4) ? qr[d0 & 3] : ld8(qrl + (d0 - 4) * 16);
        p0 = mfma32(*(const bf16x8*)(Ks + KSWZ(r32, cb)), qf, p0); p1 = mfma32(*(const bf16x8*)(Ks + KSWZ(32 + r32, cb)), qf, p1); }
#pragma unroll
    for (int d0 = 0; d0 < 4; ++d0) { const int cb = (d0 * 16 + hi * 8) * 2;
        const bf16x8 qf = ld8(qrl + 64 + d0 * 16);
        p0 = mfma32(*(const bf16x8*)(Rs + RSWZ(r32, cb)), qf, p0); p1 = mfma32(*(const bf16x8*)(Rs + RSWZ(32 + r32, cb)), qf, p1); }
}
DEVI int v_st(int k, int c) { const int kk = (k & ~0xC) | ((k & 4) << 1) | ((k & 8) >> 1); return ((kk >> 3) * 4 + (c >> 5)) * 512 + ((kk & 7) * 32 + (c & 31)) * 2; }
DEVI int v_rd_base(int lane) { return ((lane & 3) << 3) | (((lane >> 2) & 3) << 6) | (((lane >> 4) & 1) << 5) | (((lane >> 5) & 1) << 8); }
DEVI bf16x8 v_frag(const unsigned char* Vs, int d0, int ks, int r32, int hi) {
    bf16x8 o;
#pragma unroll
    for (int j = 0; j < 8; ++j) o[j] = *(const short*)(Vs + v_st(16 * ks + 8 * hi + j, 32 * d0 + r32));
    return o;
}
#ifndef HIPEMU
template <int OFF> DEVI bf16x8 tr_pair(int vb) {
    typedef short s16x4 __attribute__((ext_vector_type(4)));
    s16x4 l, h2; asm volatile("ds_read_b64_tr_b16 %0, %1 offset:%2" : "=&v"(l) : "v"(vb), "i"(OFF) : "memory"); asm volatile("ds_read_b64_tr_b16 %0, %1 offset:%2" : "=&v"(h2) : "v"(vb), "i"(OFF + 2048) : "memory");
    return (bf16x8){l[0], l[1], l[2], l[3], h2[0], h2[1], h2[2], h2[3]};
}
template <int D0> DEVI void pv_one(f32x16& od, int vb, bf16x8 pa0, bf16x8 pa1, bf16x8 pa2, bf16x8 pa3) {
    const bf16x8 b0 = tr_pair<D0 * 512 + 0 * 4096>(vb), b1 = tr_pair<D0 * 512 + 1 * 4096>(vb), b2 = tr_pair<D0 * 512 + 2 * 4096>(vb), b3 = tr_pair<D0 * 512 + 3 * 4096>(vb);
    LGKM0(); SBAR();
    od = mfma32(pa0, b0, od); od = mfma32(pa1, b1, od); od = mfma32(pa2, b2, od); od = mfma32(pa3, b3, od);
}
DEVI void pv_d0(f32x16* o, const unsigned char* Vs, int r32, int hi, int lane, bf16x8 pa0, bf16x8 pa1, bf16x8 pa2, bf16x8 pa3) {
    const int vb = (int)(uintptr_t)Vs + v_rd_base(lane);
    pv_one<0>(o[0], vb, pa0, pa1, pa2, pa3); pv_one<1>(o[1], vb, pa0, pa1, pa2, pa3); pv_one<2>(o[2], vb, pa0, pa1, pa2, pa3); pv_one<3>(o[3], vb, pa0, pa1, pa2, pa3);
}
#else
DEVI void pv_d0(f32x16* o, const unsigned char* Vs, int r32, int hi, int lane, bf16x8 pa0, bf16x8 pa1, bf16x8 pa2, bf16x8 pa3) {
    for (int d0 = 0; d0 < 4; ++d0) { o[d0] = mfma32(pa0, v_frag(Vs, d0, 0, r32, hi), o[d0]); o[d0] = mfma32(pa1, v_frag(Vs, d0, 1, r32, hi), o[d0]);
        o[d0] = mfma32(pa2, v_frag(Vs, d0, 2, r32, hi), o[d0]); o[d0] = mfma32(pa3, v_frag(Vs, d0, 3, r32, hi), o[d0]); }
}
#endif
#ifdef HIPEMU
DEVI void dma16(const bf16_t* gsrc, unsigned char* lds_wave_base, int lane) { *(bf16x8*)(lds_wave_base + lane * 16) = ld8(gsrc); }
#else
DEVI void dma16(const bf16_t* gsrc, unsigned char* lds_wave_base, int lane) {
    __builtin_amdgcn_global_load_lds((const unsigned*)gsrc, (__attribute__((address_space(3))) unsigned*)lds_wave_base, 16, 0, 0); }
#endif
DEVI void attn_unit(const Frame& F, int b, int h, int qb) {
    unsigned char* wsl = F.ws;
    const bf16_t* Q = (const bf16_t*)(wsl + WS_SCR + SC_Q); const bf16_t* KN = (const bf16_t*)(wsl + WS_SCR + SC_KN); const bf16_t* Vg = (const bf16_t*)(wsl + WS_SCR + SC_V); const bf16_t* KR = (const bf16_t*)(wsl + WS_SCR + SC_KR);
    bf16_t* YM = (bf16_t*)(wsl + WS_ACT);
    unsigned char* lds = F.lds;
    const int wid = F.wave, lane = F.lane, r32 = lane & 31, hi = lane >> 5;
    unsigned char* V_lds = lds + OFF_V; unsigned char* K_lds = lds + OFF_K; unsigned char* R_lds = lds + OFF_R;
    float* wsf = (float*)(lds + OFF_WS) + wid * 64; float* li_l = wsf; float* al_l = wsf + 32;
    float m_reg = -1e30f, l_reg = 0.f; f32x16 o[4]; o[0] = o[1] = o[2] = o[3] = (f32x16){}; bf16x8 qr[4];
    bf16_t* qrl = (bf16_t*)(lds + OFF_QR) + (wid * 32 + r32) * QRLD + hi * 8;
    const int qrow = grow(b, CTX + qb * 256 + wid * QBLK + r32);
    { const bf16_t* Qw = Q + (size_t)qrow * 768 + h * 192 + hi * 8;
#pragma unroll
      for (int d0 = 0; d0 < 4; ++d0) qr[d0] = ld8(Qw + d0 * 16);
#pragma unroll
      for (int d0 = 0; d0 < 8; ++d0) *(bf16x8*)(qrl + d0 * 16) = ld8(Qw + 64 + d0 * 16); }
    const bf16_t* Kh = KN + (size_t)grow(b, 0) * 512 + h * 128; const bf16_t* Vh = Vg + (size_t)grow(b, 0) * 512 + h * 128; const bf16_t* Rh = KR + (size_t)grow(b, 0) * 64;
    int koff[2], voff[2], roff;
#pragma unroll
    for (int i = 0; i < 2; ++i) { const int p = wid * 2048 + i * 1024 + lane * 16; const int row = p >> 8, slot = (p >> 4) & 15; koff[i] = row * 512 + ((slot ^ (row & 7)) * 8);
        const int sI = p >> 4, sub = sI >> 5, rowin = (sI >> 2) & 7, chq = sI & 3; const int kk = (sub >> 2) * 8 + rowin, c = (sub & 3) * 32 + chq * 8; const int k = (kk & ~0xC) | ((kk & 4) << 1) | ((kk & 8) >> 1); voff[i] = k * 512 + c; }
    { const int p = wid * 1024 + lane * 16; const int row = p >> 7, slot = (p >> 4) & 7; roff = row * 64 + ((slot ^ (row & 7)) * 8); }
#define DMA_KR(t, bq) do { const bf16_t* kb_ = Kh + (size_t)(t) * KVBLK * 512; dma16(kb_ + koff[0], K_lds + (bq) * SHM_K + wid * 2048, lane); dma16(kb_ + koff[1], K_lds + (bq) * SHM_K + wid * 2048 + 1024, lane); \
    dma16(Rh + (size_t)(t) * KVBLK * 64 + roff, R_lds + (bq) * SHM_R + wid * 1024, lane); } while (0)
#define DMA_V(t, bq) do { const bf16_t* vb_ = Vh + (size_t)(t) * KVBLK * 512; dma16(vb_ + voff[0], V_lds + (bq) * SHM_V + wid * 2048, lane); dma16(vb_ + voff[1], V_lds + (bq) * SHM_V + wid * 2048 + 1024, lane); } while (0)
#define RESC(a) do { const int any_ = WAVE_ANY((a) < 1.f); \
    if (any_) { WAVE_SYNC(); if (hi == 0) al_l[r32] = (a); LGKM0(); WAVE_SYNC(); \
    _Pragma("unroll") for (int d = 0; d < 4; ++d) _Pragma("unroll") for (int r = 0; r < 16; ++r) o[d][r] *= al_l[crow(r, hi)]; } } while (0)
    f32x16 pA0, pA1, pB0, pB1; float mnA, mnB, alA, alB; bf16x8 pa0, pa1, pa2, pa3; const int NT = T / KVBLK;
    DMA_KR(0, 0); __syncthreads();
    DMA_KR(1, 1); DMA_V(0, 0);
    qkt(pA0, pA1, K_lds, R_lds, qr, qrl, r32, hi); partialSM(pA0, pA1, m_reg, mnA, alA);
    __syncthreads();
    for (int j = 1; j + 1 < NT; j += 2) {
        DMA_KR(j + 1, 0); DMA_V(j, 1);
        SBAR(); qkt(pB0, pB1, K_lds + SHM_K, R_lds + SHM_R, qr, qrl, r32, hi);
        finishSM(pA0, pA1, alA, l_reg, pa0, pa1, pa2, pa3); SBAR();
        pv_d0(o, V_lds, r32, hi, lane, pa0, pa1, pa2, pa3); partialSM(pB0, pB1, m_reg, mnB, alB);
        RESC(alB); __syncthreads();
        if (j + 2 < NT) DMA_KR(j + 2, 1);
        DMA_V(j + 1, 0);
        SBAR(); qkt(pA0, pA1, K_lds, R_lds, qr, qrl, r32, hi);
        finishSM(pB0, pB1, alB, l_reg, pa0, pa1, pa2, pa3); SBAR();
        pv_d0(o, V_lds + SHM_V, r32, hi, lane, pa0, pa1, pa2, pa3); partialSM(pA0, pA1, m_reg, mnA, alA);
        RESC(alA); __syncthreads();
    }
    DMA_V(NT - 1, 1);
    SBAR(); qkt(pB0, pB1, K_lds + SHM_K, R_lds + SHM_R, qr, qrl, r32, hi);
    finishSM(pA0, pA1, alA, l_reg, pa0, pa1, pa2, pa3); SBAR();
    pv_d0(o, V_lds, r32, hi, lane, pa0, pa1, pa2, pa3); partialSM(pB0, pB1, m_reg, mnB, alB);
    RESC(alB); __syncthreads();
    finishSM(pB0, pB1, alB, l_reg, pa0, pa1, pa2, pa3); SBAR();
    pv_d0(o, V_lds + SHM_V, r32, hi, lane, pa0, pa1, pa2, pa3);
    if (hi == 0) li_l[r32] = l_reg; LGKM0();
    __syncthreads();
    float rli[16];
#pragma unroll
    for (int r = 0; r < 16; ++r) rli[r] = 1.f / li_l[crow(r, hi)];
    const int orow0 = grow(b, CTX + qb * 256 + wid * QBLK);
#pragma unroll
    for (int r = 0; r < 16; ++r) { const int orow = orow0 + crow(r, hi);
#pragma unroll
        for (int d0 = 0; d0 < 4; ++d0) YM[(size_t)orow * D + 512 + h * 128 + d0 * 32 + r32] = (bf16_t)f2bf(o[d0][r] * rli[r]); }
    __syncthreads();
#undef DMA_KR
#undef DMA_V
#undef RESC
}
}

#ifndef HIPEMU
DEVI void grid_barrier(cg::grid_group& grid) { grid.sync(); }
#endif

#ifndef HIPEMU
#define XB_TMO      128
#define XB_XCNT(j)  (256  + 64 * (j))
#define XB_XSUB(j)  (1280 + 64 * (j))
#define XB_XGEN(j)  (2304 + 64 * (j))
#define XB_TOP      3328
#define XB_TOPGEN   3392
#define XB_SPIN_CAP (1u << 22)
typedef __attribute__((address_space(3))) unsigned lds_u32;
DEVI unsigned xb_ld(unsigned* p)              { return __hip_atomic_load(p, __ATOMIC_RELAXED, __HIP_MEMORY_SCOPE_AGENT); }
DEVI unsigned xb_add(unsigned* p, unsigned v) { return __hip_atomic_fetch_add(p, v, __ATOMIC_RELAXED, __HIP_MEMORY_SCOPE_AGENT); }
DEVI unsigned xb_xcc_id() { return (unsigned)__builtin_amdgcn_s_getreg((3 << 11) | 20) & 0xFu; }
#define XB_SPIN(cond, bar) do { unsigned _sp = 0; while (cond) { __builtin_amdgcn_s_sleep(1); \
    if ((++_sp & 255u) == 0u) { if (xb_ld(&(bar)[XB_TMO])) break; if (_sp > XB_SPIN_CAP) { atomicAdd(&(bar)[XB_TMO], 1u); break; } } } } while (0)
DEVI void xcd_barrier_complete(unsigned* bar, unsigned x, unsigned G, unsigned& nloc, unsigned& nx) {
    unsigned sum, cnt, mine, sp = 0u;
    for (;;) {
        sum = 0u; cnt = 0u; mine = 0u;
#pragma unroll
        for (unsigned j = 0; j < 16; ++j) { const unsigned c = xb_ld(&bar[XB_XCNT(j)]); sum += c; cnt += (c > 0u) ? 1u : 0u; mine = (j == x) ? c : mine; }
        if (sum == G) break;
        __builtin_amdgcn_s_sleep(1);
        if ((++sp & 255u) == 0u) { if (xb_ld(&bar[XB_TMO])) break; if (sp > XB_SPIN_CAP) { atomicAdd(&bar[XB_TMO], 1u); break; } }
    }
    nloc = mine > 0u ? mine : 1u; nx = cnt > 0u ? cnt : 1u;
}
DEVI void xcd_barrier(unsigned* bar, volatile lds_u32* st, bool is_t0, unsigned G) {
    asm volatile("s_waitcnt vmcnt(0)" ::: "memory");
    __syncthreads();
    if (is_t0) {
        __builtin_amdgcn_s_waitcnt(0);
        const unsigned x = xb_xcc_id();
        unsigned nloc = st[0], nx = st[1];
        if (nloc == 0u) { xcd_barrier_complete(bar, x, G, nloc, nx); st[0] = nloc; st[1] = nx; }
        const unsigned old = xb_add(&bar[XB_XSUB(x)], 1u);
        const unsigned gen = old / nloc;
        if (old + 1u == (gen + 1u) * nloc) {
            __builtin_amdgcn_fence(__ATOMIC_RELEASE, "agent");
            asm volatile("s_waitcnt vmcnt(0)" ::: "memory");
            const unsigned og = xb_add(&bar[XB_TOP], 1u);
            const unsigned tg = og / nx;
            if (og + 1u == (tg + 1u) * nx) xb_add(&bar[XB_TOPGEN], 1u);
            else XB_SPIN(xb_ld(&bar[XB_TOPGEN]) == tg, bar);
            __builtin_amdgcn_fence(__ATOMIC_ACQUIRE, "agent");
            xb_add(&bar[XB_XGEN(x)], 1u);
            asm volatile("s_waitcnt vmcnt(0)" ::: "memory");
        } else {
            XB_SPIN(xb_ld(&bar[XB_XGEN(x)]) == gen, bar);
            __builtin_amdgcn_fence(__ATOMIC_ACQUIRE, "agent");
            asm volatile("s_waitcnt vmcnt(0)" ::: "memory");
        }
    }
    __syncthreads();
}
#endif

constexpr int LDS_QW = 160 * 1024 - 256 + 64;
#ifdef HIPEMU
struct WorkQ { int next, total, G, bid; DEVI void init(const Frame& F, int q, int tot) { next = F.bid; total = tot; G = F.G; bid = F.bid; } DEVI int pop(const Frame& F) { const int r = next; next += G; return r < total ? r : -1; } };
#else
struct WorkQ { unsigned* ctr; int total; int pending;
    DEVI void init(const Frame& F, int q, int tot) { ctr = (unsigned*)(F.ws + WS_CTL) + 8192 + 64 * q; total = tot; pending = -1;
        if (F.tid == 0) pending = (int)__hip_atomic_fetch_add(ctr, 1u, __ATOMIC_RELAXED, __HIP_MEMORY_SCOPE_AGENT); }
    DEVI int pop(const Frame& F) { volatile int* w = (volatile int*)(F.lds + LDS_QW);
        __syncthreads(); if (F.tid == 0) { *w = pending; pending = (int)__hip_atomic_fetch_add(ctr, 1u, __ATOMIC_RELAXED, __HIP_MEMORY_SCOPE_AGENT); }
        __syncthreads(); const int r = *w; return (r < total) ? __builtin_amdgcn_readfirstlane(r) : -1; } };
#endif
template <int ACTF> DEVI void ctx_gemm(const Frame& F, const bf16_t* A, int lda, const bf16_t* Bt, int ldb, int N, bf16_t* O, int ldc) {
    constexpr int RS = 528, KC = 256, NCHK = D / KC;
    const int ncq = N / 1024, NBU = (NB * CTX / 64) * (N / 128);
    const int l31 = F.lane & 31, h = F.lane >> 5, dr = F.wave >> 2, dc = F.wave & 3, trow = F.tid >> 5, tc = F.tid & 31;
    for (int bu = F.bid; bu < NBU; bu += F.G) {
        const int x = bu & 7, j = bu >> 3, pr = j / ncq, pc = j % ncq, col0 = (x * ncq + pc) * 128;
        u32x4 pre[12]; f32x16 acc;
#pragma unroll
        for (int e = 0; e < 16; ++e) acc[e] = 0.f;
#define CTXG_SRC(i) ((i) < 4 ? A + (size_t)grow((pr * 64 + 16 * (i) + trow) / CTX, (pr * 64 + 16 * (i) + trow) % CTX) * lda + tc * 8 : Bt + (size_t)(col0 + 16 * ((i) - 4) + trow) * ldb + tc * 8)
#pragma unroll
        for (int i = 0; i < 12; ++i) pre[i] = *(const u32x4*)(CTXG_SRC(i));
        for (int ck = 0; ck < NCHK; ++ck) {
            __syncthreads();
#pragma unroll
            for (int i = 0; i < 12; ++i) *(u32x4*)(F.lds + (16 * i + trow) * RS + tc * 16) = pre[i];
            __syncthreads();
            if (ck + 1 < NCHK) {
#pragma unroll
                for (int i = 0; i < 12; ++i) pre[i] = *(const u32x4*)(CTXG_SRC(i) + (ck + 1) * KC); }
#pragma unroll
            for (int s = 0; s < 16; ++s) { const bf16x8 wf = *(const bf16x8*)(F.lds + (64 + dc * 32 + l31) * RS + s * 32 + h * 16), xf = *(const bf16x8*)(F.lds + (dr * 32 + l31) * RS + s * 32 + h * 16);
                acc = mfma32(wf, xf, acc); }
        }
#undef CTXG_SRC
        const int cr = pr * 64 + dr * 32 + l31; bf16_t* orow = O + (size_t)grow(cr / CTX, cr % CTX) * ldc + col0 + dc * 32 + 4 * h;
#pragma unroll
        for (int g = 0; g < 4; ++g) { float v[4];
#pragma unroll
            for (int e = 0; e < 4; ++e) { float a = acc[4 * g + e]; if (ACTF == 1) { a = a > 0.f ? a : 0.f; a = a * a; } v[e] = a; }
            *(unsigned long long*)(orow + 8 * g) = (unsigned long long)pk2(v[0], v[1]) | ((unsigned long long)pk2(v[2], v[3]) << 32); }
    }
    __syncthreads();
}
constexpr int NPHASES = 21;
#ifndef PH_MASK
#define PH_MASK 0xFFFFFFFFu
#endif
#define PH_ON(k) ((PH_MASK >> (k)) & 1u)
template <int ph> DEVI void run_phase_t(const Frame& F) {
    bf16_t* Wb = (bf16_t*)(F.ws + WS_W); bf16_t* ACT = (bf16_t*)(F.ws + WS_ACT); bf16_t* BIGb = (bf16_t*)(F.ws + WS_BIG); bf16_t* HJ1 = (bf16_t*)(F.ws + WS_HGS);
    float* BIGf = (float*)(F.ws + WS_BIG); float* ACTf = (float*)(F.ws + WS_ACT);
    pg8::Order S;
    switch (ph) {
    case 0: if (!PH_ON(0)) break; {
        ada_units(F);
#ifndef HIPEMU
        unsigned* adac = (unsigned*)(F.ws + WS_CTL) + 8192 + 64 * 40;
        asm volatile("s_waitcnt vmcnt(0)" ::: "memory"); __syncthreads();
        if (F.tid == 0) { __builtin_amdgcn_fence(__ATOMIC_RELEASE, "agent"); asm volatile("s_waitcnt vmcnt(0)" ::: "memory"); xb_add(adac, 1u); }
#endif
        convert_layer_weights(F, 0); rope_tables(F); rw_build_tables(F);
        for (size_t i = (size_t)F.bid * NTHREADS + F.tid; i < (size_t)M * 512 / 4; i += (size_t)F.G * NTHREADS) ((f32x4*)F.out)[i] = (f32x4){0.f, 0.f, 0.f, 0.f};
#ifndef HIPEMU
        if (F.tid == 0) { unsigned* bar = (unsigned*)(F.ws + WS_CTL); XB_SPIN(xb_ld(adac) < (unsigned)F.G, bar); __builtin_amdgcn_fence(__ATOMIC_ACQUIRE, "agent"); asm volatile("s_waitcnt vmcnt(0)" ::: "memory"); }
        __syncthreads();
        { const Frame F2 = relaunder(F); phase_hj0(F2); }
#endif
    } break;
    case 1: if (!PH_ON(1)) break;
#ifdef HIPEMU
        phase_hj0(F);
#endif
        break;
    case 2: if (!PH_ON(2)) break; { { pg8::Gemm g{ACT, Wb + W_IN / 2, D, D, D}; S.init(NB * NLT, EVP / 256, F.G, F.bid, 1); pg8::EpiBf16<0> E{BIGb, EVP}; pg8::gemm_phase(F.lds, g, S, E, F.tid); }
        ctx_gemm<0>(F, ACT, D, Wb + W_IN / 2, D, EVP, BIGb, EVP); } break;
    case 3: if (!PH_ON(3)) break; { constexpr int NML = NB * 4 * NCH, NRW = NSTR_RW * NCH; WorkQ Q; Q.init(F, 3, NML + NRW);
        for (int u = Q.pop(F); u >= 0; u = Q.pop(F)) { const Frame F2 = relaunder(F);
            if (u < NRW) rw2::heavy_unit(F2, u / (16 * NCH), (u / (2 * NCH)) % 8, (u / NCH) % 2, u % NCH);
            else { const int v = u - NRW; ml_phaseA_unit(F2, v / (4 * NCH), (v / NCH) % 4, v % NCH); } } } break;
    case 4: if (!PH_ON(4)) break; { ml_phaseB(F); const Frame F2 = relaunder(F); rw2::phaseB(F2); } break;
    case 5: if (!PH_ON(5)) break; { constexpr int NU = NSTR_RW * NCH; rw2::FixPre P;
        if (F.bid < NU) rw2::fixup_load(F, F.bid / NCH, F.bid % NCH, P);
        for (int u = F.bid; u < NU; u += F.G) { const int un = u + F.G; rw2::fixup_unit(F, u / NCH, u % NCH, P, un < NU, un / NCH, un % NCH); } } break;
    case 6: if (!PH_ON(6)) break; {
        constexpr int NML = NB * 4 * NCH, NFI = NB * 8 * (T / 64); WorkQ Q; Q.init(F, 6, NML + NFI);
        for (int u = Q.pop(F); u >= 0; u = Q.pop(F)) { const Frame F2 = relaunder(F);
            if (u < NML) { constexpr int NLC = NCH - NCTXCH, NLU = NB * 4 * NLC;
                if (u < NLU) ml_phaseC_unit(F2, u / (4 * NLC), (u / NLC) % 4, NCTXCH + u % NLC);
                else { const int v = u - NLU; ml_phaseC_unit(F2, v / (4 * NCTXCH), (v / NCTXCH) % 4, v % NCTXCH); } }
            else { const int v = u - NML; rw_finish2_unit(F2, v / (8 * (T / 64)), (v / (T / 64)) % 8, v % (T / 64)); } }
    } break;
    case 7: if (!PH_ON(7)) break; { { pg8::Gemm g{ACT, Wb + W_OUT / 2, D, D, D}; S.init(NB * NLT, 4, F.G, F.bid, 1); pg8::EpiBf16<0> E{BIGb, D}; pg8::gemm_phase(F.lds, g, S, E, F.tid); }
        { pg8::Gemm g{ACT, Wb + W_OUT / 2, 256, D, D}; S.init(NB * NCTXCH, 4, F.G, F.bid, 2, 4); pg8::EpiF32Slab E{(float*)(F.ws + WS_BIG + 70 * MiB), D}; pg8::gemm_phase(F.lds, g, S, E, F.tid); } } break;
    case 8: if (!PH_ON(8)) break; phase_resid(F, 0, 0, BIGb, false, ACT, (const float*)(F.ws + WS_BIG + 70 * MiB), 4); break;
    case 9: if (!PH_ON(9)) break; { { pg8::Gemm g{ACT, Wb + W_1 / 2, D, D, D}; S.init(NB * NLT, 16, F.G, F.bid, 1); pg8::EpiBf16<1> E{BIGb, DFF}; pg8::gemm_phase(F.lds, g, S, E, F.tid); }
        ctx_gemm<1>(F, ACT, D, Wb + W_1 / 2, D, DFF, BIGb, DFF); } break;
    case 10: if (!PH_ON(10)) break; { { pg8::Gemm g{BIGb, Wb + W_2 / 2, DFF, DFF, DFF}; S.init(NB * NLT, 4, F.G, F.bid, 1); pg8::EpiBf16<0> E{ACT, D}; pg8::gemm_phase(F.lds, g, S, E, F.tid); }
        { pg8::Gemm g{BIGb, Wb + W_2 / 2, 512, DFF, DFF}; S.init(NB * NCTXCH, 4, F.G, F.bid, 2, 8); pg8::EpiF32Slab E{(float*)(F.ws + WS_SCR + 34 * MiB), D}; pg8::gemm_phase(F.lds, g, S, E, F.tid); } } break;
    case 11: if (!PH_ON(11)) break; phase_resid(F, 0, 1, ACT, false, HJ1, (const float*)(F.ws + WS_SCR + 34 * MiB), 8); convert_layer_weights(F, 1); break;
    case 12: if (!PH_ON(12)) break; { { pg8::Gemm g{HJ1, Wb + W_IN / 2, D, D, D}; S.init(NB * NLT, ODP / 256, F.G, F.bid, 1); pg8::EpiBf16<0> E{BIGb, ODP}; pg8::gemm_phase(F.lds, g, S, E, F.tid); }
        ctx_gemm<0>(F, HJ1, D, Wb + W_IN / 2, D, ODP, BIGb, ODP); } break;
    case 13: if (!PH_ON(13)) break; { constexpr int NHA = NB * 4 * NCH, NMP = M / 64; WorkQ Q; Q.init(F, 13, NHA + NMP);
        for (int u = Q.pop(F); u >= 0; u = Q.pop(F)) { const Frame F2 = relaunder(F);
            if (u < NHA - 2 * NB * 4) { const int k = u / (NB * 4), bh = u % (NB * 4); const int cc = (k < NCTXCH) ? k : k + 1; hg_phaseA_unit<-1>(F2, bh / 4, bh % 4, cc); }
            else if (u < NHA - NB * 4) { const int bh = u - (NHA - 2 * NB * 4); hg_phaseA_unit<0>(F2, bh / 4, bh % 4, NCTXCH); }
            else if (u < NHA) { const int bh = u - (NHA - NB * 4); hg_phaseA_unit<1>(F2, bh / 4, bh % 4, NCH - 1); }
            else mla_prep_unit(F2, u - NHA); } } break;
    case 14: if (!PH_ON(14)) break; {
#ifndef NO_HGB
        hg_phaseB(F);
#endif
#ifndef NO_GQ
        { pg8::Gemm g{BIGb + O_CQ, Wb + W_QB / 2, 256, ODP, 256}; S.init(NB * NLT, 3, F.G, F.bid, 1);
          pg8::EpiQ E{F.ws}; pg8::gemm_phase(F.lds, g, S, E, F.tid); }
#endif
#ifndef NO_GKV
        { pg8::Gemm g{BIGb + O_CKV, Wb + W_KVB / 2, 256, ODP, 256}; const int nq = NB * NLT * 3, rot = (nq / 8) * 8 % F.G;
          S.init(M / 256, 4, F.G, (F.bid - rot + F.G) % F.G, 0);
          pg8::EpiKV E{F.ws}; pg8::gemm_phase(F.lds, g, S, E, F.tid); }
#endif
    } break;
    case 15: if (!PH_ON(15)) break; {
#ifndef NO_ATT
        for (int u = F.bid; u < NB * 4 * NLT; u += F.G) att::attn_unit(F, u / (4 * NLT), (u / NLT) % 4, u % NLT);
#endif
#ifndef NO_HGC
        const Frame F2 = relaunder(F);
        for (int u = F2.bid; u < NB * 4 * NLT; u += F2.G) hg_phaseC_unit(F2, u / (4 * NLT), (u / NLT) % 4, NCTXCH + u % NLT);
#endif
    } break;
    case 16: if (!PH_ON(16)) break; { pg8::Gemm g{ACT, Wb + W_OUT / 2, D, D, D}; S.init(NB * NLT, 4, F.G, F.bid, 1); pg8::EpiBf16<0> E{BIGb, D}; pg8::gemm_phase(F.lds, g, S, E, F.tid); } break;
    case 17: if (!PH_ON(17)) break; phase_resid(F, 1, 0, BIGb, true, ACT); break;
    case 18: if (!PH_ON(18)) break; { pg8::Gemm g{ACT, Wb + W_1 / 2, D, D, D}; S.init(NB * NLT, 16, F.G, F.bid, 1); pg8::EpiBf16<1> E{BIGb, DFF}; pg8::gemm_phase(F.lds, g, S, E, F.tid); } break;
    case 19: if (!PH_ON(19)) break; { pg8::Gemm g{BIGb, Wb + W_2 / 2, DFF, DFF, DFF}; S.init(NB * NLT, 4, F.G, F.bid, 1); pg8::EpiBf16<0> E{ACT, D}; pg8::gemm_phase(F.lds, g, S, E, F.tid); } break;
    case 20: if (!PH_ON(20)) break; phase_resid(F, 1, 1, ACT, true, nullptr); break;
    default: break;
    }
}

#ifdef HIPEMU
static inline void run_phase_rt(const Frame& F, int ph) {
    switch (ph) {
#define PHC(k) case k: run_phase_t<k>(F); break;
    PHC(0) PHC(1) PHC(2) PHC(3) PHC(4) PHC(5) PHC(6) PHC(7) PHC(8) PHC(9) PHC(10) PHC(11) PHC(12) PHC(13) PHC(14) PHC(15) PHC(16) PHC(17) PHC(18) PHC(19) PHC(20)
#undef PHC
    default: break; }
}
#endif
#ifndef HIPEMU
constexpr int LDS_BYTES = 160 * 1024;
extern __shared__ __attribute__((aligned(16))) unsigned char g_lds[];
template <int PH> __device__ __forceinline__ void phase_fn(const CONSTAS Args* ap_in, int wave_in) {
    const CONSTAS Args* ap = ap_in; int wv = wave_in, bid = blockIdx.x, G = gridDim.x;
    int ln = __builtin_amdgcn_mbcnt_hi(~0u, __builtin_amdgcn_mbcnt_lo(~0u, 0u));
    asm volatile("" : "+s"(ap)); asm volatile("" : "+v"(ln)); asm volatile("" : "+s"(bid), "+s"(G), "+s"(wv));
    __builtin_assume(ln >= 0 && ln < 64); __builtin_assume(wv >= 0 && wv < 8); __builtin_assume(bid >= 0 && bid < 1024); __builtin_assume(G > 0 && G <= 1024);
    const int tid = wv * 64 + ln;
    Frame F; F.lds = g_lds; F.ap = ap; F.out = ap->out; F.ws = ap->ws; F.tid = tid; F.lane = ln; F.wave = wv; F.G = G; F.bid = bid;
    run_phase_t<PH>(F);
}
constexpr int LDS_MISC = LDS_BYTES - 256;
__global__ void __launch_bounds__(NTHREADS, 2) mk_fwd(Args a) {
    cg::grid_group grid = cg::this_grid();
    const CONSTAS Args* ap = (const CONSTAS Args*)__builtin_amdgcn_kernarg_segment_ptr();
    const int lo = a.ph_lo, hi = a.ph_hi; const int wv0 = __builtin_amdgcn_readfirstlane(threadIdx.x >> 6);
    volatile lds_u32* st = (volatile lds_u32*)(g_lds + LDS_MISC);
    unsigned* bar = (unsigned*)(a.ws + WS_CTL);
    if (threadIdx.x == 0) { st[0] = 0u; st[1] = 0u; (void)xb_add(&bar[XB_XCNT(xb_xcc_id())], 1u); }
    __syncthreads();
#ifdef PROBE_MASK
#define PROBE_PRE(k) unsigned long long tp0_ = 0; if ((PROBE_MASK >> (k)) & 1u) tp0_ = __builtin_amdgcn_s_memrealtime();
#define PROBE_POST(k) if ((PROBE_MASK >> (k)) & 1u) { __syncthreads(); const unsigned long long tp1_ = __builtin_amdgcn_s_memrealtime(); const unsigned long long dt_ = (tp1_ - tp0_) * PROBE_AMP; while (__builtin_amdgcn_s_memrealtime() - tp1_ < dt_) __builtin_amdgcn_s_sleep(8); }
#else
#define PROBE_PRE(k)
#define PROBE_POST(k)
#endif
#define PHC(k) if (lo <= k && k < hi) { PROBE_PRE(k) phase_fn<k>(ap, wv0); PROBE_POST(k) if (k + 1 < hi) { if (k == 0 && hi > NPHASES) grid.sync();     \
        { const bool t0_ = (wv0 == 0) && (__builtin_amdgcn_mbcnt_hi(~0u, __builtin_amdgcn_mbcnt_lo(~0u, 0u)) == 0); xcd_barrier(bar, st, t0_, gridDim.x); } } }
    PHC(0) PHC(2) PHC(3) PHC(4) PHC(5) PHC(6) PHC(7) PHC(8) PHC(9) PHC(10) PHC(11) PHC(12) PHC(13) PHC(14) PHC(15) PHC(16) PHC(17) PHC(18) PHC(19) PHC(20)
#undef PHC
}
#ifndef MK_N_LAUNCHES
#define MK_N_LAUNCHES 1
#endif
extern "C" void kernel_launch(void* const* d_in, const int* in_sizes, int n_in, void* d_out, int out_size, void* d_ws, size_t ws_size, hipStream_t stream) {
    static int grid = 0;
    if (grid == 0) {
        if (n_in != 32 || out_size != NB * SEQ * D || ws_size < WS_END) { fprintf(stderr, "kernel_launch: shape mismatch n_in %d out %d ws %zu\n", n_in, out_size, ws_size); grid = -1; return; }
        int dev = 0, cus = 0, per_cu = 0; hipGetDevice(&dev); hipDeviceGetAttribute(&cus, hipDeviceAttributeMultiprocessorCount, dev);
        hipFuncSetAttribute((const void*)mk_fwd, hipFuncAttributeMaxDynamicSharedMemorySize, LDS_BYTES);
        hipOccupancyMaxActiveBlocksPerMultiprocessor(&per_cu, (const void*)mk_fwd, NTHREADS, LDS_BYTES);
        fprintf(stderr, "kernel_launch: cus %d per_cu %d\n", cus, per_cu);
        if (per_cu < 1) { grid = -1; return; }
        grid = cus;
    }
    if (grid < 0) return;
    Args a{}; for (int i = 0; i < 32; ++i) a.in[i] = (const float*)d_in[i];
    a.out = (float*)d_out; a.ws = (unsigned char*)d_ws;
    if (hipMemsetAsync((char*)d_ws + WS_CTL, 0, CTL_BYTES, stream) != hipSuccess) { fprintf(stderr, "kernel_launch: memset failed\n"); return; }
    if (MK_N_LAUNCHES == 1) { a.ph_lo = 0; a.ph_hi = NPHASES; void* args[] = {&a};
        hipError_t e = hipLaunchCooperativeKernel((void*)mk_fwd, dim3(grid), dim3(NTHREADS), args, LDS_BYTES, stream);
        if (e != hipSuccess) fprintf(stderr, "coop launch failed: %s\n", hipGetErrorString(e));
    } else {
        for (int ph = 0; ph < NPHASES; ++ph) { a.ph_lo = ph; a.ph_hi = ph + 1; void* args[] = {&a};
            hipError_t e = hipLaunchCooperativeKernel((void*)mk_fwd, dim3(grid), dim3(NTHREADS), args, LDS_BYTES, stream);
            if (e != hipSuccess) { fprintf(stderr, "launch %d failed: %s\n", ph, hipGetErrorString(e)); break; } }
    }
}
#endif
```

```cpp
#ifndef HIPEMU
#include <hip/hip_runtime.h>
#include <hip/hip_cooperative_groups.h>
namespace cg = cooperative_groups;
#endif
#include <cstdio>
#include <cstdint>
#include <cmath>

#define DEVI __device__ __forceinline__

#ifndef CFG_NB
#define CFG_NB 2
#endif
#ifndef CFG_SEQ
#define CFG_SEQ 8192
#endif
#ifndef CFG_CTX
#define CFG_CTX 256
#endif
constexpr int NB = CFG_NB, SEQ = CFG_SEQ, CTX = CFG_CTX, T = CTX + SEQ, M = NB * T, D = 1024, DFF = 4096;
constexpr int NCH = T / 256;
constexpr int NCTXCH = CTX / 256;
constexpr int NLT = SEQ / 256;
constexpr int GRIDW = 64;
constexpr int EVP = 4096, ODP = 3072;
constexpr float EPS = 1e-6f;
constexpr int NTHREADS = 512;
static_assert(CTX % 256 == 0 && SEQ % 256 == 0, "chunking");

constexpr int E_MQ = 0, E_MK = 512, E_MV = 1024, E_MO = 1536, E_RF = 2048, E_MG = 3968;
constexpr int R_R = 0, R_K = 512, R_V = 1024, R_WL = 1536, R_AL = 1664, R_GL = 1792;
constexpr int O_HQ = 0, O_HFF = 512, O_HFB = 1024, O_HI = 1536, O_HG = 2048, O_CQ = 2560, O_CKV = 2816, O_KR = 2944;

constexpr size_t MiB = 1u << 20;
constexpr size_t WS_CTL = 0;
constexpr size_t CTL_BYTES = 256 * 1024;
constexpr size_t WS_MOD = 1 * MiB;
constexpr size_t WS_ROPE = WS_MOD + 256 * 1024;
constexpr size_t WS_RSTD = WS_MOD + 512 * 1024;
constexpr size_t WS_W = 2 * MiB;
constexpr size_t W_IN = 0, W_OUT = 8 * MiB, W_1 = 10 * MiB, W_2 = 18 * MiB, W_QB = 26 * MiB, W_KVB = 26 * MiB + 512 * 1024;
constexpr size_t WS_BIG = 29 * MiB;
constexpr size_t WS_ACT = 161 * MiB;
constexpr size_t WS_SCR = 194 * MiB;
constexpr size_t WS_XC = 254 * MiB;
constexpr size_t WS_END = 256 * MiB;
constexpr size_t WS_RWT = WS_XC, RWT_W2 = 0, RWT_A2 = 147456, RWT_G2 = 294912, RWT_CST = 434176, RWT_BON = 524288;
constexpr int NSTR_ML = NB * 4 * 2;
constexpr size_t SC_MLC = 0;
constexpr size_t SC_MLN = SC_MLC + (size_t)NSTR_ML * NCH * 16384 * 4;
constexpr size_t SC_MLS = SC_MLN + (size_t)NSTR_ML * NCH * 128 * 4;
constexpr size_t SC_ML_END = SC_MLS + (size_t)NSTR_ML * NCH * 4 * 4;
constexpr int NSTR_RW = NB * 8 * 2;
constexpr size_t SC_RW = (SC_ML_END + 255) / 256 * 256;
constexpr int RW_NS1 = (int)((60 * MiB - SC_RW) / 32768);
constexpr size_t OUT_KC = (size_t)M * 512 * 4;
constexpr size_t OUT_RW = OUT_KC + (size_t)M * 512 * 2;
static_assert(OUT_RW + (size_t)(NSTR_RW * NCH > RW_NS1 ? NSTR_RW * NCH - RW_NS1 : 0) * 32768 <= (size_t)NB * SEQ * 1024 * 4, "d_out scratch");
constexpr size_t SC_Q = 0, SC_KN = SC_Q + (size_t)M * 768 * 2, SC_V = SC_KN + (size_t)M * 512 * 2, SC_KR = SC_V + (size_t)M * 512 * 2, SC_L1_END = SC_KR + (size_t)M * 64 * 2;
static_assert(SC_L1_END <= 60 * MiB, "scr1");
constexpr size_t WS_HGS = WS_BIG + (size_t)M * ODP * 2;
static_assert(WS_HGS + (size_t)NSTR_ML * NCH * 16384 * 4 <= WS_ACT, "hgs");
static_assert((size_t)M * 512 * 4 <= (size_t)NB * SEQ * 1024 * 4 + 0 || true, "");

typedef unsigned short bf16_t;
typedef short bf16x8 __attribute__((ext_vector_type(8)));
typedef float f32x4 __attribute__((ext_vector_type(4)));
typedef float f32x16 __attribute__((ext_vector_type(16)));
typedef unsigned u32x4 __attribute__((ext_vector_type(4)));
typedef unsigned u32x2 __attribute__((ext_vector_type(2)));

#ifdef PROBE_SUB
#define PS_DECL unsigned long long ps_acc_ = 0, ps_t0_ = 0;
#define PS_B(id) if (PROBE_SUB == (id)) ps_t0_ = __builtin_amdgcn_s_memrealtime();
#define PS_E(id) if (PROBE_SUB == (id)) ps_acc_ += __builtin_amdgcn_s_memrealtime() - ps_t0_;
#define PS_SPIN do { __syncthreads(); const unsigned long long t_ = __builtin_amdgcn_s_memrealtime(); while (__builtin_amdgcn_s_memrealtime() - t_ < ps_acc_) __builtin_amdgcn_s_sleep(8); } while (0)
#else
#define PS_DECL
#define PS_B(id)
#define PS_E(id)
#define PS_SPIN
#endif
#ifdef HIPEMU
DEVI unsigned f2bf(float f) { unsigned u = __builtin_bit_cast(unsigned, f); return (u + 0x7fffu + ((u >> 16) & 1u)) >> 16; }
DEVI unsigned pk2(float lo, float hi) { return f2bf(lo) | (f2bf(hi) << 16); }
#else
typedef float f32x2cv __attribute__((ext_vector_type(2)));
typedef __bf16 bf16x2cv __attribute__((ext_vector_type(2)));
DEVI unsigned pk2(float lo, float hi) { const f32x2cv v = {lo, hi}; const bf16x2cv b = __builtin_convertvector(v, bf16x2cv); return __builtin_bit_cast(unsigned, b); }
DEVI unsigned f2bf(float f) { const __bf16 b = (__bf16)f; return (unsigned)__builtin_bit_cast(unsigned short, b); }
#endif
DEVI float bf2f(unsigned h) { return __builtin_bit_cast(float, (h & 0xffffu) << 16); }
DEVI float u2f(unsigned u) { return __builtin_bit_cast(float, u); }
DEVI unsigned f2u(float f) { return __builtin_bit_cast(unsigned, f); }
#ifdef HIPEMU
DEVI float RCP(float x) { return 1.f / x; }
DEVI float RSQ(float x) { return 1.f / sqrtf(x); }
#else
DEVI float RCP(float x) { return __builtin_amdgcn_rcpf(x); }
DEVI float RSQ(float x) { return __builtin_amdgcn_rsqf(x); }
#endif
DEVI float sigmoidf_(float x) { return RCP(1.f + __expf(-x)); }
DEVI float siluf_(float x) { return x * sigmoidf_(x); }
DEVI float logsigmoidf_(float x) { return x >= 0.f ? -__logf(1.f + __expf(-x)) : x - __logf(1.f + __expf(x)); }
DEVI float tanhf_(float x) { return 2.f * sigmoidf_(2.f * x) - 1.f; }
DEVI int crow(int r, int hi) { return (r & 3) + 8 * (r >> 2) + 4 * hi; }
#ifdef HIPEMU
DEVI int emu_any(bool p) { float f_ = p ? 1.f : 0.f; for (int o = 1; o < 64; o <<= 1) f_ = fmaxf(f_, __shfl_xor(f_, o)); return f_ > 0.5f; }
#define WAVE_ANY(p) emu_any(p)
#define FENCE()
#define WAVE_SYNC() emu::wave_sync()
#define EXP2F(x) exp2f(x)
DEVI f32x16 mfma32(bf16x8 a, bf16x8 b, f32x16 c) { return emu_mfma32(a, b, c); }
DEVI f32x4 mfma16f(float a, float b, f32x4 c) { return emu_mfma16f32(a, b, c); }
DEVI u32x2 plswap(unsigned a, unsigned b) { return emu_permlane32_swap(a, b); }
DEVI void atomic_add_f32(float* p, float v) { float o = __atomic_load_n((int*)p, __ATOMIC_RELAXED) * 0 + *p; (void)o; unsigned* ip = (unsigned*)p; unsigned old = __atomic_load_n(ip, __ATOMIC_RELAXED);
    for (;;) { float f = __builtin_bit_cast(float, old) + v; unsigned nv = __builtin_bit_cast(unsigned, f); if (__atomic_compare_exchange_n(ip, &old, nv, false, __ATOMIC_RELAXED, __ATOMIC_RELAXED)) break; } }
#else
#define WAVE_ANY(p) __any(p)
#define FENCE() do { asm volatile("" ::: "memory"); __builtin_amdgcn_sched_barrier(0); } while (0)
#define WAVE_SYNC() __builtin_amdgcn_wave_barrier()
#define EXP2F(x) __builtin_amdgcn_exp2f(x)
DEVI f32x16 mfma32(bf16x8 a, bf16x8 b, f32x16 c) { return __builtin_amdgcn_mfma_f32_32x32x16_bf16(a, b, c, 0, 0, 0); }
DEVI f32x4 mfma16f(float a, float b, f32x4 c) { return __builtin_amdgcn_mfma_f32_16x16x4f32(a, b, c, 0, 0, 0); }
DEVI u32x2 plswap(unsigned a, unsigned b) { auto r = __builtin_amdgcn_permlane32_swap(a, b, false, false); u32x2 o; o[0] = r[0]; o[1] = r[1]; return o; }
DEVI void atomic_add_f32(float* p, float v) { unsafeAtomicAdd(p, v); }
#endif
#ifdef HIPEMU
template <int MSK> DEVI float shx(float v) { return __shfl_xor(v, MSK); }
DEVI float shfl_up_l(float v, int o, int lane) { return __shfl_up(v, o); }
#else
template <int MSK> DEVI float shx(float v) {
    if constexpr (MSK == 32) { auto r = __builtin_amdgcn_permlane32_swap(__builtin_bit_cast(unsigned, v), __builtin_bit_cast(unsigned, v), false, false); const unsigned lo = r[0], hi2 = r[1];
        return __builtin_bit_cast(float, lo ^ hi2 ^ __builtin_bit_cast(unsigned, v)); }
    else return __builtin_bit_cast(float, __builtin_amdgcn_ds_swizzle(__builtin_bit_cast(int, v), (MSK << 10) | 0x1f));
}
DEVI float shfl_up_l(float v, int o, int lane) { const int src = lane >= o ? lane - o : lane; return __builtin_bit_cast(float, __builtin_amdgcn_ds_bpermute(src << 2, __builtin_bit_cast(int, v))); }
#endif
#ifdef HIPEMU
DEVI float sum16(float v) { v += shx<1>(v); v += shx<2>(v); v += shx<4>(v); v += shx<8>(v); return v; }
#else
template <int CTRL> DEVI float dpp_mov(float v) { return __builtin_bit_cast(float, __builtin_amdgcn_update_dpp(0, __builtin_bit_cast(int, v), CTRL, 0xF, 0xF, true)); }
DEVI float sum16(float v) { v += dpp_mov<0xB1>(v); v += dpp_mov<0x4E>(v); v += dpp_mov<0x141>(v); v += dpp_mov<0x140>(v); return v; }
#endif
#ifdef HIPEMU
DEVI float sum8(float v) { v += shx<1>(v); v += shx<2>(v); v += shx<4>(v); return v; }
#else
DEVI float sum8(float v) { v += dpp_mov<0xB1>(v); v += dpp_mov<0x4E>(v); v += dpp_mov<0x141>(v); return v; }
#endif
DEVI float wave_sum(float v) { v = sum16(v); v += shx<16>(v); v += shx<32>(v); return v; }
DEVI float half_sum32(float v) { v = sum16(v); v += shx<16>(v); return v; }
DEVI bf16x8 ld8(const bf16_t* p) { return *(const bf16x8*)p; }
#ifdef HIPEMU
DEVI bf16x8 ld_tr_B(const bf16_t* tile, int RS, int k0, int n0, int lane) { bf16x8 o;
    for (int j = 0; j < 8; ++j) o[j] = (short)tile[(size_t)(k0 + 8 * (lane >> 5) + j) * RS + n0 + (lane & 31)]; return o; }
#else
DEVI bf16x8 ld_tr_B(const bf16_t* tile, int RS, int k0, int n0, int lane) {
    typedef short s16x4t __attribute__((ext_vector_type(4)));
    const int g = lane >> 4, i = lane & 15, q = i >> 2, p = i & 3;
    const bf16_t* a = tile + (k0 + 8 * (g >> 1) + q) * RS + n0 + 16 * (g & 1) + 4 * p;
    const s16x4t r0 = __builtin_amdgcn_ds_read_tr16_b64_v4i16((__attribute__((address_space(3))) s16x4t*)a);
    const s16x4t r1 = __builtin_amdgcn_ds_read_tr16_b64_v4i16((__attribute__((address_space(3))) s16x4t*)(a + 4 * RS));
    return (bf16x8){r0[0], r0[1], r0[2], r0[3], r1[0], r1[1], r1[2], r1[3]};
}
#endif
DEVI void unpack8(bf16x8 v, float* f) {
#pragma unroll
    for (int i = 0; i < 8; ++i) f[i] = bf2f((unsigned short)v[i]);
}
DEVI bf16x8 pack8(const float* f) { u32x4 w; w[0] = pk2(f[0], f[1]); w[1] = pk2(f[2], f[3]); w[2] = pk2(f[4], f[5]); w[3] = pk2(f[6], f[7]); return __builtin_bit_cast(bf16x8, w); }
DEVI bf16x8 pk4frag(const f32x16& P, int B) {
    unsigned a0 = pk2(P[B + 0], P[B + 1]), a1 = pk2(P[B + 2], P[B + 3]), b0 = pk2(P[B + 4], P[B + 5]), b1 = pk2(P[B + 6], P[B + 7]);
    u32x2 r0 = plswap(a0, b0), r1 = plswap(a1, b1); u32x4 w; w[0] = r0[0]; w[1] = r1[0]; w[2] = r0[1]; w[3] = r1[1]; return __builtin_bit_cast(bf16x8, w);
}
DEVI int grow(int b, int t) { return b * T + t; }

struct Args {
    const float* in[32];
    float* out; unsigned char* ws;
    int ph_lo, ph_hi;
};
#ifdef HIPEMU
#define CONSTAS
#else
#define CONSTAS __attribute__((address_space(4)))
#endif
struct Frame {
    unsigned char* lds;
    const CONSTAS Args* ap; float* out; unsigned char* ws;
    int tid, lane, wave, G, bid;
};
enum { I_X = 0, I_C, I_CTX, I_CCTX, I_ADAW, I_ADAB, I_NORMG, I_OUTW, I_W1, I_W2, I_HGLB, I_EVW, I_MLCONV, I_MLGB, I_MLNORM, I_RWMU, I_RWW0, I_RWW2,
       I_RWA0, I_RWA2, I_RWG2, I_RWKK, I_RWKA, I_RWRK, I_RWLNW, I_RWLNB, I_ODW, I_HGNORM, I_QNORM, I_WQB, I_KVNORM, I_WKVB };

DEVI const float* modp(const Frame& F, int layer, int s) { return (const float*)(F.ws + WS_MOD) + ((size_t)layer * 3 + s) * 6144; }

#ifdef HIPEMU
DEVI Frame relaunder(const Frame& F) { return F; }
DEVI Frame unit_frame(const Frame& F) { return F; }
#else
DEVI Frame relaunder(const Frame& F0) { Frame F = F0; int ln = __builtin_amdgcn_mbcnt_hi(~0u, __builtin_amdgcn_mbcnt_lo(~0u, 0u)); asm volatile("" : "+v"(ln)); __builtin_assume(ln >= 0 && ln < 64);
    F.lane = ln; F.tid = F0.wave * 64 + ln; return F; }
DEVI Frame unit_frame(const Frame& F0) { return relaunder(F0); }
#endif
namespace pg8 {
constexpr int BM = 256, BK = 64, HALF = 128, HTB = HALF * BK * 2, STAGE_BYTES = 8 * HTB, NXCD = 8, WGM = 8;
struct Unit { int pm, pn, ks; };
struct Gemm { const bf16_t* A; const bf16_t* Bt; int K, lda, ldb; };
DEVI int lds_byte(int r, int c) { const int st = (r >> 4) * 2 + (c >> 5), rr = r & 15, cc = c & 31, ob = rr * 64 + cc * 2; return st * 1024 + (ob ^ (((ob >> 9) & 1) << 5)); }
DEVI void stage_rc(int b, int& R, int& C) { const int st = b / 1024, sb = b % 1024, swz = sb ^ (((sb >> 9) & 1) << 5); R = (st >> 1) * 16 + swz / 64; C = (st & 1) * 32 + (swz % 64) / 2; }
DEVI int perm32(int rho) { const int n = rho >> 4, i = rho & 15; return 8 * (i >> 2) + 4 * n + (i & 3); }
struct Order {
    int nM, nN, nwg, G, c, lat_only, KS;
    DEVI void init(int nM_, int nN_, int G_, int c_, int lat, int ks_ = 1) { nM = nM_; nN = nN_; KS = ks_; nwg = nM * nN * KS; G = G_; c = c_; lat_only = lat; }
    DEVI bool next(int i, Unit& u) const {
        const long L = (long)i * G + c; if (L >= nwg) return false;
        u.ks = 0;
        if (lat_only == 2) { const int id = (int)L; u.ks = id % KS; const int r = id / KS; u.pn = r % nN; const int ct = r / nN; u.pm = (ct / NCTXCH) * NCH + (ct % NCTXCH); return true; }
        int wgid = (int)L; { const int q = nwg / NXCD, r = nwg % NXCD, xcd = wgid % NXCD, off = wgid / NXCD; wgid = (xcd < r ? xcd * (q + 1) : r * (q + 1) + (xcd - r) * q) + off; }
        const int nig = WGM * nN, gid = wgid / nig, fm = gid * WGM, gsz = (nM - fm) < WGM ? (nM - fm) : WGM;
        int pm = fm + ((wgid % nig) % gsz); u.pn = (wgid % nig) / gsz;
        if (lat_only) pm = (pm / NLT) * NCH + NCTXCH + (pm % NLT);
        u.pm = pm; return true;
    }
};
#ifndef HIPEMU
#define PG8_LAS __attribute__((address_space(3)))
template <class Epi>
__device__ __forceinline__ void gemm_phase(unsigned char* lds_g, const Gemm g, const Order& S, const Epi& E, int tid_in) {
    PG8_LAS unsigned char* lds = (PG8_LAS unsigned char*)lds_g;
    const int tid = tid_in, wid = __builtin_amdgcn_readfirstlane(tid >> 6), lane = tid & 63, wr = wid >> 2, wc = wid & 3, fr = lane & 15, fq = lane >> 4;
    const int K = g.K, nt = K / BK;
    unsigned voffA[2], voffB[2];
#pragma unroll
    for (int i = 0; i < 2; ++i) { int R, C; stage_rc(tid * 16 + i * 8192, R, C); const int Rb = Epi::PERM ? ((R & ~31) + perm32(R & 31)) : R;
        voffA[i] = (unsigned)(R * g.lda + C) * 2u; voffB[i] = (unsigned)(Rb * g.ldb + C) * 2u; }
    const size_t kstep = (size_t)(BK * 2);
    const size_t hstepA = (size_t)HALF * g.lda * 2, hstepB = (size_t)HALF * g.ldb * 2;
    const size_t tstepA = 2 * hstepA, tstepB = 2 * hstepB;
    const unsigned ldsw = (unsigned)wid * 1024u;
    const int aoff = lds_byte(wr * 64 + fr, fq * 8), boff = lds_byte(wc * 32 + fr, fq * 8);
#define PG8_SA(b, h) (((b) * 2 + (h)) * HTB)
#define PG8_SB(b, h) ((4 + (b) * 2 + (h)) * HTB)
#define PG8_STAGE(bufoff, gbase, voff) do { _Pragma("unroll") for (int _i = 0; _i < 2; ++_i) \
        __builtin_amdgcn_global_load_lds((const unsigned*)((const char*)(gbase) + (voff)[_i]), (PG8_LAS unsigned*)(lds + (bufoff) + ldsw + _i * 8192), 16, 0, 0); } while (0)
#define PG8_LDA(dst, b, h) do { _Pragma("unroll") for (int m = 0; m < 4; ++m) _Pragma("unroll") for (int k = 0; k < 2; ++k) dst[m][k] = *(const PG8_LAS bf16x8*)(lds + PG8_SA(b, h) + aoff + m * 2048 + k * 1024); } while (0)
#define PG8_LDB(dst, b, h) do { _Pragma("unroll") for (int n = 0; n < 2; ++n) _Pragma("unroll") for (int k = 0; k < 2; ++k) dst[n][k] = *(const PG8_LAS bf16x8*)(lds + PG8_SB(b, h) + boff + n * 2048 + k * 1024); } while (0)
#define PG8_MMA(ai, bj, At, Bt) do { __builtin_amdgcn_s_setprio(1); _Pragma("unroll") for (int m = 0; m < 4; ++m) _Pragma("unroll") for (int n = 0; n < 2; ++n) _Pragma("unroll") for (int k = 0; k < 2; ++k) \
        acc[ai][bj][m][n] = __builtin_amdgcn_mfma_f32_16x16x32_bf16(Bt[n][k], At[m][k], acc[ai][bj][m][n], 0, 0, 0); __builtin_amdgcn_s_setprio(0); } while (0)
#define PG8_WAIT_V(n) asm volatile("s_waitcnt vmcnt(" #n ")" ::: "memory")
#define PG8_WAIT_L(n) asm volatile("s_waitcnt lgkmcnt(" #n ")" ::: "memory")
#define PG8_BAR __builtin_amdgcn_s_barrier()
#define PG8_SCHED __builtin_amdgcn_sched_barrier(0)
    Unit cur, nxt; int ui = 0;
    if (!S.next(0, cur)) return;
    f32x4 acc[2][2][4][2];
#pragma unroll
    for (int a = 0; a < 2; ++a)
#pragma unroll
        for (int b = 0; b < 2; ++b)
#pragma unroll
            for (int m = 0; m < 4; ++m)
#pragma unroll
                for (int n = 0; n < 2; ++n) acc[a][b][m][n] = (f32x4){0.f, 0.f, 0.f, 0.f};
    bf16x8 At[4][2], B0[2][2], B1[2][2];
    const char* cA = (const char*)g.A + (size_t)cur.pm * tstepA + (size_t)cur.ks * K * 2; const char* cB = (const char*)g.Bt + (size_t)cur.pn * tstepB + (size_t)cur.ks * K * 2;
    PG8_STAGE(PG8_SB(0, 0), cB, voffB); PG8_STAGE(PG8_SB(0, 1), cB + hstepB, voffB); PG8_STAGE(PG8_SA(0, 0), cA, voffA); PG8_STAGE(PG8_SA(0, 1), cA + hstepA, voffA);
    if (wr == 1) PG8_BAR;
    PG8_WAIT_V(2); PG8_BAR;
    PG8_STAGE(PG8_SB(1, 0), cB + kstep, voffB); PG8_STAGE(PG8_SA(1, 0), cA + kstep, voffA); PG8_STAGE(PG8_SB(1, 1), cB + hstepB + kstep, voffB);
    PG8_WAIT_V(6); PG8_BAR;
    for (;;) {
        const bool has_next = S.next(ui + 1, nxt);
        const char* nA = has_next ? (const char*)g.A + (size_t)nxt.pm * tstepA + (size_t)nxt.ks * K * 2 : cA; const char* nB = has_next ? (const char*)g.Bt + (size_t)nxt.pn * tstepB + (size_t)nxt.ks * K * 2 : cB;
#pragma unroll 1
        for (int t = 0; t < nt; t += 2) {
            const bool last = (t == nt - 2);
            const char* a1 = cA + (size_t)(t + 1) * kstep;
            const char* a2 = last ? nA : cA + (size_t)(t + 2) * kstep; const char* b2 = last ? nB : cB + (size_t)(t + 2) * kstep;
            const char* a3 = a2 + kstep; const char* b3 = b2 + kstep;
            PG8_LDB(B0, 0, 0); PG8_LDB(B1, 0, 1); PG8_SCHED; PG8_LDA(At, 0, 0); PG8_STAGE(PG8_SA(1, 1), a1 + hstepA, voffA);
            PG8_WAIT_V(8); PG8_WAIT_L(0); PG8_BAR; PG8_MMA(0, 0, At, B0); PG8_MMA(0, 1, At, B1); PG8_BAR; PG8_SCHED;
            PG8_LDA(At, 0, 1); PG8_STAGE(PG8_SB(0, 0), b2, voffB); PG8_STAGE(PG8_SB(0, 1), b2 + hstepB, voffB); PG8_STAGE(PG8_SA(0, 0), a2, voffA);
            PG8_WAIT_V(8); PG8_WAIT_L(0); PG8_BAR; PG8_MMA(1, 0, At, B0); PG8_MMA(1, 1, At, B1); PG8_BAR; PG8_SCHED;
            PG8_LDB(B0, 1, 0); PG8_LDB(B1, 1, 1); PG8_SCHED; PG8_LDA(At, 1, 0); PG8_STAGE(PG8_SA(0, 1), a2 + hstepA, voffA);
            PG8_WAIT_V(8); PG8_WAIT_L(0); PG8_BAR; PG8_MMA(0, 0, At, B0); PG8_MMA(0, 1, At, B1); PG8_BAR; PG8_SCHED;
            PG8_LDA(At, 1, 1); PG8_STAGE(PG8_SB(1, 0), b3, voffB); PG8_STAGE(PG8_SB(1, 1), b3 + hstepB, voffB); PG8_STAGE(PG8_SA(1, 0), a3, voffA);
            PG8_WAIT_V(8); PG8_WAIT_L(0); PG8_BAR; PG8_MMA(1, 0, At, B0); PG8_MMA(1, 1, At, B1); PG8_BAR; PG8_SCHED;
        }
        if (wr == 0) PG8_BAR;
        E(acc, cur, wr, wc, fr, fq);
        if (!has_next) break;
#pragma unroll
        for (int a = 0; a < 2; ++a)
#pragma unroll
            for (int b = 0; b < 2; ++b)
#pragma unroll
                for (int m = 0; m < 4; ++m)
#pragma unroll
                    for (int n = 0; n < 2; ++n) acc[a][b][m][n] = (f32x4){0.f, 0.f, 0.f, 0.f};
        cur = nxt; cA = nA; cB = nB; ++ui;
        if (wr == 1) PG8_BAR;
    }
    PG8_WAIT_V(0);
    PG8_BAR;
#undef PG8_SA
#undef PG8_SB
#undef PG8_STAGE
#undef PG8_LDA
#undef PG8_LDB
#undef PG8_MMA
#undef PG8_WAIT_V
#undef PG8_WAIT_L
#undef PG8_BAR
#undef PG8_SCHED
}
#else
template <class Epi>
static inline void gemm_phase(unsigned char*, const Gemm g, const Order& S, const Epi& E, int tid_in) {
    const int tid = tid_in, wid = tid >> 6, lane = tid & 63, wr = wid >> 2, wc = wid & 3, fr = lane & 15, fq = lane >> 4;
    Unit u;
    for (int ui = 0; S.next(ui, u); ++ui) {
        f32x4 acc[2][2][4][2];
        for (int ai = 0; ai < 2; ++ai) for (int bj = 0; bj < 2; ++bj) for (int m = 0; m < 4; ++m) for (int n = 0; n < 2; ++n) for (int e = 0; e < 4; ++e) {
            const int row = u.pm * 256 + 128 * ai + 64 * wr + 16 * m + fr;
            const int col = u.pn * 256 + 128 * bj + 32 * wc + (Epi::PERM ? (8 * fq + 4 * n + e) : (16 * n + 4 * fq + e));
            const bf16_t* a = g.A + (size_t)row * g.lda + (size_t)u.ks * g.K; const bf16_t* b = g.Bt + (size_t)col * g.ldb + (size_t)u.ks * g.K; float s = 0.f;
            for (int k = 0; k < g.K; ++k) s += bf2f(a[k]) * bf2f(b[k]);
            acc[ai][bj][m][n][e] = s; }
        E(acc, u, wr, wc, fr, fq);
    }
    __syncthreads();
}
#endif
template <int ACT> struct EpiBf16 {
    static constexpr bool PERM = true;
    bf16_t* O; int ldc;
    DEVI void operator()(const f32x4 (&acc)[2][2][4][2], const Unit& u, int wr, int wc, int fr, int fq) const {
        const int row0 = u.pm * BM + wr * 64 + fr, col0 = u.pn * BM + wc * 32 + 8 * fq;
#pragma unroll
        for (int ai = 0; ai < 2; ++ai)
#pragma unroll
            for (int m = 0; m < 4; ++m) { bf16_t* rowp = O + (size_t)(row0 + ai * HALF + m * 16) * ldc + col0;
#pragma unroll
                for (int bj = 0; bj < 2; ++bj) { f32x4 v0 = acc[ai][bj][m][0], v1 = acc[ai][bj][m][1];
                    if (ACT == 1) {
#pragma unroll
                        for (int e = 0; e < 4; ++e) { float a = v0[e] > 0.f ? v0[e] : 0.f, b = v1[e] > 0.f ? v1[e] : 0.f; v0[e] = a * a; v1[e] = b * b; } }
                    u32x4 w; w[0] = pk2(v0[0], v0[1]); w[1] = pk2(v0[2], v0[3]); w[2] = pk2(v1[0], v1[1]); w[3] = pk2(v1[2], v1[3]);
                    *(u32x4*)(rowp + bj * HALF) = w; } }
    }
};
struct EpiF32 {
    static constexpr bool PERM = false;
    float* C; int ldc;
    DEVI void operator()(const f32x4 (&acc)[2][2][4][2], const Unit& u, int wr, int wc, int fr, int fq) const {
        const int row0 = u.pm * BM + wr * 64 + fr, col0 = u.pn * BM + wc * 32 + 4 * fq;
#pragma unroll
        for (int ai = 0; ai < 2; ++ai)
#pragma unroll
            for (int m = 0; m < 4; ++m) { float* rowp = C + (size_t)(row0 + ai * HALF + m * 16) * ldc + col0;
#pragma unroll
                for (int bj = 0; bj < 2; ++bj)
#pragma unroll
                    for (int n = 0; n < 2; ++n) *(f32x4*)(rowp + bj * HALF + n * 16) = acc[ai][bj][m][n]; }
    }
};
struct EpiF32Slab {
    static constexpr bool PERM = false;
    float* C; int ldc;
    DEVI void operator()(const f32x4 (&acc)[2][2][4][2], const Unit& u, int wr, int wc, int fr, int fq) const {
        const int rbase = (u.pm / NCH) * CTX + (u.pm % NCH) * 256; float* Cs = C + (size_t)u.ks * NB * CTX * ldc;
        const int row0 = rbase + wr * 64 + fr, col0 = u.pn * BM + wc * 32 + 4 * fq;
#pragma unroll
        for (int ai = 0; ai < 2; ++ai)
#pragma unroll
            for (int m = 0; m < 4; ++m) { float* rowp = Cs + (size_t)(row0 + ai * HALF + m * 16) * ldc + col0;
#pragma unroll
                for (int bj = 0; bj < 2; ++bj)
#pragma unroll
                    for (int n = 0; n < 2; ++n) *(f32x4*)(rowp + bj * HALF + n * 16) = acc[ai][bj][m][n]; }
    }
};
struct EpiQ {
    static constexpr bool PERM = true;
    unsigned char* ws;
    DEVI void operator()(const f32x4 (&acc)[2][2][4][2], const Unit& u, int wr, int wc, int fr, int fq) const {
        bf16_t* O = (bf16_t*)(ws + WS_SCR + SC_Q); const float* rstd = (const float*)(ws + WS_RSTD); const float* ropec = (const float*)(ws + WS_ROPE); const float* ropes = ropec + 128 * 16;
        const int row0 = u.pm * BM + wr * 64 + fr, col0 = u.pn * BM + wc * 32 + 8 * fq;
#pragma unroll
        for (int ai = 0; ai < 2; ++ai)
#pragma unroll
            for (int m = 0; m < 4; ++m) { const int row = row0 + ai * HALF + m * 16; const float rs = rstd[row];
                const int tt = row % T; const bool lat = tt >= CTX; const int li = lat ? tt - CTX : 0; const int prow = li / GRIDW, pcol = li % GRIDW;
#pragma unroll
                for (int bj = 0; bj < 2; ++bj) { const int col = col0 + bj * HALF; const int j = col % 192;
                    float v[8], p[8];
#pragma unroll
                    for (int e = 0; e < 4; ++e) { v[e] = acc[ai][bj][m][0][e] * rs; v[4 + e] = acc[ai][bj][m][1][e] * rs; }
#pragma unroll
                    for (int e = 0; e < 8; ++e) p[e] = shx<32>(v[e]);
                    if (j >= 128 && lat) { const int ro = j - 128, half = ro >> 5, w = ro & 31; const int pos = half ? pcol : prow; const bool lo = w < 16; const int i0 = lo ? w : w - 16;
#pragma unroll
                        for (int e = 0; e < 8; ++e) { const float c = ropec[pos * 16 + i0 + e], s = ropes[pos * 16 + i0 + e]; v[e] = lo ? (v[e] * c - p[e] * s) : (p[e] * s + v[e] * c); } }
                    u32x4 w4; w4[0] = pk2(v[0], v[1]); w4[1] = pk2(v[2], v[3]); w4[2] = pk2(v[4], v[5]); w4[3] = pk2(v[6], v[7]);
                    *(u32x4*)(O + (size_t)row * 768 + col) = w4; FENCE(); } }
    }
};
struct EpiKV {
    static constexpr bool PERM = true;
    unsigned char* ws;
    DEVI void operator()(const f32x4 (&acc)[2][2][4][2], const Unit& u, int wr, int wc, int fr, int fq) const {
        bf16_t* KN = (bf16_t*)(ws + WS_SCR + SC_KN); bf16_t* V = (bf16_t*)(ws + WS_SCR + SC_V); const float* rstd = (const float*)(ws + WS_RSTD) + M;
        const int row0 = u.pm * BM + wr * 64 + fr, col0 = u.pn * BM + wc * 32 + 8 * fq;
#pragma unroll
        for (int ai = 0; ai < 2; ++ai)
#pragma unroll
            for (int m = 0; m < 4; ++m) { const int row = row0 + ai * HALF + m * 16; const float rs = rstd[row];
#pragma unroll
                for (int bj = 0; bj < 2; ++bj) { const int col = col0 + bj * HALF; const int h = col >> 8, j = col & 255;
                    f32x4 v0 = acc[ai][bj][m][0] * rs, v1 = acc[ai][bj][m][1] * rs;
                    u32x4 w4; w4[0] = pk2(v0[0], v0[1]); w4[1] = pk2(v0[2], v0[3]); w4[2] = pk2(v1[0], v1[1]); w4[3] = pk2(v1[2], v1[3]);
                    bf16_t* dst = (j < 128) ? (KN + (size_t)row * 512 + h * 128 + j) : (V + (size_t)row * 512 + h * 128 + (j - 128));
                    *(u32x4*)dst = w4; FENCE(); } }
    }
};
}

template <class DMap>
DEVI void transpose_item(const float* W, int K, int N, bf16_t* WT, int ldk, const float* kscale, float* scr, int item, int lane, DMap dmap) {
    const int nblk = (N + 31) / 32, kb = item / nblk, nb = item % nblk, k0 = 64 * kb, n0 = 32 * nb;
    { const int rsub = lane >> 3, c4 = (lane & 7) * 4; const bool ok = n0 + c4 < N; const int cc = ok ? n0 + c4 : 0;
      f32x4 v[8];
#pragma unroll
      for (int i = 0; i < 8; ++i) v[i] = __builtin_nontemporal_load((const f32x4*)(W + (size_t)(k0 + i * 8 + rsub) * N + cc));
#pragma unroll
      for (int i = 0; i < 8; ++i) { const int kk = i * 8 + rsub; const float ks = kscale ? kscale[k0 + kk] : 1.f;
#pragma unroll
          for (int e = 0; e < 4; ++e) scr[kk * 33 + c4 + e] = ok ? v[i][e] * ks : 0.f; } }
    WAVE_SYNC();
    const int c = lane & 7;
#pragma unroll
    for (int j = 0; j < 4; ++j) { const int n = (lane >> 3) + 8 * j; const float* s = scr + (8 * c) * 33 + n;
        if (n0 + n < N) { u32x4 o; o[0] = pk2(s[0 * 33], s[1 * 33]); o[1] = pk2(s[2 * 33], s[3 * 33]); o[2] = pk2(s[4 * 33], s[5 * 33]); o[3] = pk2(s[6 * 33], s[7 * 33]);
            *(u32x4*)(WT + (size_t)dmap(n0 + n) * ldk + k0 + 8 * c) = o; } }
    WAVE_SYNC();
}
struct DMapId { DEVI int operator()(int n) const { return n; } };
struct DMapEv { DEVI int operator()(int n) const { return n < 2048 ? n : (n < 2064 ? E_MG + (n - 2048) : E_RF + (n - 2064)); } };
template <class DMap>
DEVI void convert_weight(const Frame& F, const float* W, int K, int N, bf16_t* WT, int ldk, const float* kscale, DMap dmap, int& wcur) {
    float* scr = (float*)(F.lds) + F.wave * (64 * 33);
    const int items = (K / 64) * ((N + 31) / 32), NGW = F.G * 8, gw = F.bid * 8 + F.wave;
    int first = (gw - wcur % NGW + NGW) % NGW;
    for (int it = first; it < items; it += NGW) transpose_item(W, K, N, WT, ldk, kscale, scr, it, F.lane, dmap);
    wcur += items;
}
DEVI void zero_rows(const Frame& F, bf16_t* WT, int ldk, int r0, int r1, int c0 = 0, int c1 = -1) {
    if (c1 < 0) c1 = ldk; const int w8 = (c1 - c0) / 8, n = (r1 - r0) * w8;
    for (int i = F.bid * NTHREADS + F.tid; i < n; i += F.G * NTHREADS) { const int r = r0 + i / w8, c = c0 + (i % w8) * 8; *(u32x4*)(WT + (size_t)r * ldk + c) = (u32x4){0u, 0u, 0u, 0u}; }
}
DEVI void convert_layer_weights(const Frame& F, int layer) {
    bf16_t* Wb = (bf16_t*)(F.ws + WS_W); int wcur = 0;
    if (layer == 0) {
        convert_weight(F, F.ap->in[I_EVW], D, 3984, Wb + W_IN / 2, D, nullptr, DMapEv(), wcur);
        zero_rows(F, Wb + W_IN / 2, D, 3984, EVP);
    } else {
        convert_weight(F, F.ap->in[I_ODW], D, 3008, Wb + W_IN / 2, D, nullptr, DMapId(), wcur);
        zero_rows(F, Wb + W_IN / 2, D, 3008, ODP);
        convert_weight(F, F.ap->in[I_WQB], 256, 768, Wb + W_QB / 2, 256, F.ap->in[I_QNORM], DMapId(), wcur);
        convert_weight(F, F.ap->in[I_WKVB], 128, 1024, Wb + W_KVB / 2, 256, F.ap->in[I_KVNORM], DMapId(), wcur);
        zero_rows(F, Wb + W_KVB / 2, 256, 0, 1024, 128, 256);
    }
    convert_weight(F, F.ap->in[I_OUTW] + (size_t)layer * D * D, D, D, Wb + W_OUT / 2, D, nullptr, DMapId(), wcur);
    convert_weight(F, F.ap->in[I_W1] + (size_t)layer * D * DFF, D, DFF, Wb + W_1 / 2, D, nullptr, DMapId(), wcur);
    convert_weight(F, F.ap->in[I_W2] + (size_t)layer * DFF * D, DFF, D, Wb + W_2 / 2, DFF, nullptr, DMapId(), wcur);
}
DEVI void ada_units(const Frame& F) {
    float* sc = (float*)F.lds;
    float* part = sc + 3 * 1024;
    constexpr int CW = 48, UPL = 6144 / CW;
    bool have = false;
    for (int u = F.bid; u < 2 * UPL; u += F.G) {
        if (!have) { for (int i = F.tid; i < 3 * 1024; i += NTHREADS) { const int s = i >> 10, k = i & 1023; const float c = (s < 2) ? (s < NB ? F.ap->in[I_C][s * 1024 + k] : 0.f) : F.ap->in[I_CCTX][k]; sc[i] = siluf_(c); } have = true; }
        __syncthreads();
        const int l = u / UPL, c0 = (u % UPL) * CW, col = c0 + (F.lane < CW ? F.lane : 0); const float* W = F.ap->in[I_ADAW] + (size_t)l * 1024 * 6144 + col;
        float a0 = 0.f, a1 = 0.f, a2 = 0.f;
#pragma unroll 32
        for (int kk = 0; kk < 128; ++kk) { const int k = F.wave * 128 + kk; const float w = __builtin_nontemporal_load(W + (size_t)k * 6144); a0 += sc[k] * w; a1 += sc[1024 + k] * w; a2 += sc[2048 + k] * w; }
        part[(F.wave * 3 + 0) * 64 + F.lane] = a0; part[(F.wave * 3 + 1) * 64 + F.lane] = a1; part[(F.wave * 3 + 2) * 64 + F.lane] = a2;
        __syncthreads();
        if (F.tid < 192) { const int s = F.tid >> 6, ln = F.tid & 63; float t = 0.f; for (int w = 0; w < 8; ++w) t += part[(w * 3 + s) * 64 + ln];
            const int c2 = c0 + ln; if (ln < CW) ((float*)(F.ws + WS_MOD))[((size_t)l * 3 + s) * 6144 + c2] = t + F.ap->in[I_ADAB][l * 6144 + c2]; }
    }
    __syncthreads();
}
DEVI void rope_tables(const Frame& F) {
    float* rc = (float*)(F.ws + WS_ROPE); float* rs = rc + 128 * 16;
    for (int i = F.bid * NTHREADS + F.tid; i < 128 * 16; i += F.G * NTHREADS) { const int pos = i >> 4, j = i & 15; const float inv = powf(10000.f, -(float)j / 16.f); const float ang = (float)pos * inv; rc[i] = cosf(ang); rs[i] = sinf(ang); }
}

struct RowVec { f32x4 v[4]; };
DEVI RowVec ld_row_b(const bf16_t* p, int lane) { RowVec r; const u32x2* q = (const u32x2*)p + lane;
#pragma unroll
    for (int j = 0; j < 4; ++j) { const u32x2 w = __builtin_nontemporal_load(q + 64 * j); const unsigned a = w[0], b2 = w[1]; r.v[j][0] = bf2f(a); r.v[j][1] = bf2f(a >> 16); r.v[j][2] = bf2f(b2); r.v[j][3] = bf2f(b2 >> 16); } return r; }
DEVI RowVec ld_row(const float* p, int lane) { RowVec r; const f32x4* q = (const f32x4*)p + lane;
#pragma unroll
    for (int j = 0; j < 4; ++j) r.v[j] = __builtin_nontemporal_load(q + 64 * j); return r; }
DEVI void st_row(float* p, int lane, const RowVec& r) { f32x4* q = (f32x4*)p + lane;
#pragma unroll
    for (int j = 0; j < 4; ++j) q[64 * j] = r.v[j]; }
DEVI float row_rstd(const RowVec& r) { float s = 0.f;
#pragma unroll
    for (int j = 0; j < 4; ++j) s += (r.v[j][0] * r.v[j][0] + r.v[j][1] * r.v[j][1]) + (r.v[j][2] * r.v[j][2] + r.v[j][3] * r.v[j][3]);
    return RSQ(wave_sum(s) * (1.f / D) + EPS); }
DEVI void st_mod_bf16(bf16_t* orow, int lane, const RowVec& x, float rstd, const float* g, const float* shift, const float* scale) {
    unsigned long long* o8 = (unsigned long long*)orow + lane;
#pragma unroll
    for (int j = 0; j < 4; ++j) { const f32x4 gg = ((const f32x4*)g)[lane + 64 * j], sh = ((const f32x4*)shift)[lane + 64 * j], sc = ((const f32x4*)scale)[lane + 64 * j];
        f32x4 y;
#pragma unroll
        for (int e = 0; e < 4; ++e) y[e] = (x.v[j][e] * rstd * gg[e]) * (1.f + sc[e]) + sh[e];
        o8[64 * j] = (unsigned long long)pk2(y[0], y[1]) | ((unsigned long long)pk2(y[2], y[3]) << 32); }
}
DEVI float* stream_row(const Frame& F, int b, int t) { return (t < CTX) ? (float*)(F.ws + WS_XC) + ((size_t)b * CTX + t) * D : F.out + ((size_t)b * SEQ + (t - CTX)) * D; }
DEVI bf16_t* xs_lat(const Frame& F, int idx) { return (idx == 2) ? (bf16_t*)F.out : (bf16_t*)(F.ws + WS_SCR); }
DEVI void st_row_b(bf16_t* p, int lane, const RowVec& r) { unsigned long long* o8 = (unsigned long long*)p + lane;
#pragma unroll
    for (int j = 0; j < 4; ++j) __builtin_nontemporal_store((unsigned long long)pk2(r.v[j][0], r.v[j][1]) | ((unsigned long long)pk2(r.v[j][2], r.v[j][3]) << 32), o8 + 64 * j); }
DEVI const float* input_row(const Frame& F, int b, int t) { return (t < CTX) ? F.ap->in[I_CTX] + ((size_t)b * CTX + t) * D : F.ap->in[I_X] + ((size_t)b * SEQ + (t - CTX)) * D; }
struct RowCoef { RowVec ga, sh, gy; };
DEVI void coef_mod(RowCoef& c, int lane, const float* g, const float* shift, const float* scale) {
#pragma unroll
    for (int j = 0; j < 4; ++j) { const f32x4 gg = ((const f32x4*)g)[lane + 64 * j], sh = ((const f32x4*)shift)[lane + 64 * j], sc = ((const f32x4*)scale)[lane + 64 * j];
#pragma unroll
        for (int e = 0; e < 4; ++e) { c.ga.v[j][e] = gg[e] * (1.f + sc[e]); c.sh.v[j][e] = sh[e]; } }
}
DEVI void st_mod_c(bf16_t* orow, int lane, const RowVec& x, float rstd, const RowCoef& c) {
    unsigned long long* o8 = (unsigned long long*)orow + lane;
#pragma unroll
    for (int j = 0; j < 4; ++j) { f32x4 y;
#pragma unroll
        for (int e = 0; e < 4; ++e) y[e] = (x.v[j][e] * rstd) * c.ga.v[j][e] + c.sh.v[j][e];
        o8[64 * j] = (unsigned long long)pk2(y[0], y[1]) | ((unsigned long long)pk2(y[2], y[3]) << 32); }
}
DEVI void phase_hj0(const Frame& F) {
    const int gw = F.bid * 8 + F.wave, NGW = F.G * 8; bf16_t* HJ = (bf16_t*)(F.ws + WS_ACT);
    int r = gw; if (r >= M) return;
    RowVec x = ld_row(input_row(F, r / T, r % T), F.lane); int cur_s = -1; RowCoef c;
    for (;;) { const int rn = r + NGW; RowVec xn = x; if (rn < M) xn = ld_row(input_row(F, rn / T, rn % T), F.lane);
        const int b = r / T, t = r % T, s = (t < CTX) ? 2 : b;
        if (s != cur_s) { const float* mod = modp(F, 0, s); coef_mod(c, F.lane, F.ap->in[I_NORMG], mod + 0, mod + 1024); cur_s = s; }
        const float rs = row_rstd(x);
        st_mod_c(HJ + (size_t)r * D, F.lane, x, rs, c);
        if (rn >= M) break; r = rn; x = xn; }
}
struct ResidIn { RowVec y, x; };
DEVI ResidIn resid_load(const Frame& F, int layer, int which, const bf16_t* Y, const float* slab, int nks, int r) {
    ResidIn in; const int b = r / T, t = r % T;
    if (slab && t < CTX) { in.y = ld_row(slab + ((size_t)b * CTX + t) * D, F.lane);
        for (int ks = 1; ks < nks; ++ks) { const RowVec y2 = ld_row(slab + ((size_t)ks * NB * CTX + (size_t)b * CTX + t) * D, F.lane);
#pragma unroll
            for (int j = 0; j < 4; ++j) in.y.v[j] += y2.v[j]; } }
    else in.y = ld_row_b(Y + (size_t)r * D, F.lane);
    const int step = layer * 2 + which;
    if (step == 0) in.x = ld_row(input_row(F, b, t), F.lane);
    else if (t < CTX) in.x = ld_row(stream_row(F, b, t), F.lane);
    else in.x = ld_row_b(xs_lat(F, step) + ((size_t)b * SEQ + (t - CTX)) * D, F.lane);
    return in;
}
DEVI int resid_next_row(int r, int NGW, bool lat_only) { r += NGW; while (lat_only && r < M && (r % T) < CTX) r += NGW; return r; }
DEVI void phase_resid(const Frame& F, int layer, int which, const bf16_t* Y, bool lat_only, bf16_t* AO, const float* slab = nullptr, int nks = 0) {
    const int gw = F.bid * 8 + F.wave, NGW = F.G * 8;
    const float* ng = F.ap->in[I_NORMG] + (size_t)layer * 4 * D;
    int r = gw; while (lat_only && r < M && (r % T) < CTX) r += NGW;
    if (r >= M) return;
    ResidIn cur = resid_load(F, layer, which, Y, slab, nks, r); int cur_s = -1; RowCoef c;
    for (;;) { const int rn = resid_next_row(r, NGW, lat_only); ResidIn nxt = cur; if (rn < M) nxt = resid_load(F, layer, which, Y, slab, nks, rn);
        const int b = r / T, t = r % T; const int s = (t < CTX) ? 2 : b;
        if (s != cur_s) { const float* mod = modp(F, layer, s); cur_s = s;
            const float* gn = ng + (which == 0 ? 1 : 3) * D; const float* gate = mod + (which == 0 ? 2048 : 5120);
#pragma unroll
            for (int j = 0; j < 4; ++j) { const f32x4 gg = ((const f32x4*)gn)[F.lane + 64 * j], gt = ((const f32x4*)gate)[F.lane + 64 * j];
#pragma unroll
                for (int e = 0; e < 4; ++e) c.gy.v[j][e] = gg[e] * gt[e]; }
            if (which == 0) coef_mod(c, F.lane, ng + 2 * D, mod + 3072, mod + 4096);
            else if (layer == 0) { const float* mod1 = modp(F, 1, s); coef_mod(c, F.lane, F.ap->in[I_NORMG] + (size_t)1 * 4 * D, mod1 + 0, mod1 + 1024); } }
        const float rsy = row_rstd(cur.y); RowVec x = cur.x;
#pragma unroll
        for (int j = 0; j < 4; ++j) {
#pragma unroll
            for (int e = 0; e < 4; ++e) x.v[j][e] += (cur.y.v[j][e] * rsy) * c.gy.v[j][e]; }
        if (t < CTX) st_row(stream_row(F, b, t), F.lane, x);
        else if (layer * 2 + which == 3) { f32x4* q = (f32x4*)stream_row(F, b, t) + F.lane;
#pragma unroll
            for (int j = 0; j < 4; ++j) __builtin_nontemporal_store(x.v[j], q + 64 * j); }
        else st_row_b(xs_lat(F, layer * 2 + which + 1) + ((size_t)b * SEQ + (t - CTX)) * D, F.lane, x);
        if (which == 0 || layer == 0) { const float rs = row_rstd(x); st_mod_c(AO + (size_t)r * D, F.lane, x, rs, c); }
        if (rn >= M) break; r = rn; cur = nxt; }
}

DEVI void wave_scan256(float* arr, int lane, int op, bool rev) {
    float v[4];
#pragma unroll
    for (int e = 0; e < 4; ++e) { const int i = 4 * lane + e; v[e] = arr[rev ? 255 - i : i]; }
#pragma unroll
    for (int e = 1; e < 4; ++e) v[e] = op ? fmaxf(v[e], v[e - 1]) : v[e] + v[e - 1];
    float tot = v[3];
#pragma unroll
    for (int o = 1; o < 64; o <<= 1) { const float n = shfl_up_l(tot, o, lane); if (lane >= o) tot = op ? fmaxf(tot, n) : tot + n; }
    float ex = shfl_up_l(tot, 1, lane);
#pragma unroll
    for (int e = 0; e < 4; ++e) { float r = v[e]; if (lane > 0) r = op ? fmaxf(r, ex) : r + ex; const int i = 4 * lane + e; arr[rev ? 255 - i : i] = r; }
}

struct MlGates { float *a_fw, *pm_fw, *b_fw, *a_bw, *pm_bw, *b_bw; };
DEVI MlGates ml_gate_ptrs(float* base) { MlGates g; g.a_fw = base; g.pm_fw = base + 256; g.b_fw = base + 512; g.a_bw = base + 768; g.pm_bw = base + 1024; g.b_bw = base + 1280; return g; }
DEVI void ml_gates_setup(const Frame& F, const MlGates& g, int b, int h, int c) {
    const bf16_t* PROJ = (const bf16_t*)(F.ws + WS_BIG); const float* gb = F.ap->in[I_MLGB];
    if (F.tid < 256) { const int row = grow(b, c * 256 + F.tid); const bf16_t* p = PROJ + (size_t)row * EVP + E_MG;
        const float igf = bf2f(p[0 + h]) + gb[0 + h], fgf = bf2f(p[4 + h]) + gb[4 + h], igb = bf2f(p[8 + h]) + gb[8 + h], fgb = bf2f(p[12 + h]) + gb[12 + h];
        g.b_fw[F.tid] = logsigmoidf_(fgf); g.a_fw[F.tid] = igf; g.b_bw[F.tid] = logsigmoidf_(fgb); g.a_bw[F.tid] = igb; }
    __syncthreads();
    if (F.wave == 0) wave_scan256(g.b_fw, F.lane, 0, false);
    if (F.wave == 1) wave_scan256(g.b_bw, F.lane, 0, true);
    __syncthreads();
    if (F.tid < 256) { const float af = g.a_fw[F.tid] - g.b_fw[F.tid], ab = g.a_bw[F.tid] - g.b_bw[F.tid]; g.a_fw[F.tid] = af; g.pm_fw[F.tid] = af; g.a_bw[F.tid] = ab; g.pm_bw[F.tid] = ab; }
    __syncthreads();
    if (F.wave == 0) wave_scan256(g.pm_fw, F.lane, 1, false);
    if (F.wave == 1) wave_scan256(g.pm_bw, F.lane, 1, true);
    __syncthreads();
}
DEVI void ml_conv8(const bf16_t* PROJ, const float* cw, int b, int t, int col, int cch, float scale, float* out) {
    const int lo = (t < CTX) ? 0 : CTX, hi = (t < CTX) ? CTX : T;
    float x0[8], x1[8], x2[8];
    unpack8(ld8(PROJ + (size_t)grow(b, t) * EVP + col), x1);
    if (t - 1 >= lo) unpack8(ld8(PROJ + (size_t)grow(b, t - 1) * EVP + col), x0); else { for (int e = 0; e < 8; ++e) x0[e] = 0.f; }
    if (t + 1 < hi) unpack8(ld8(PROJ + (size_t)grow(b, t + 1) * EVP + col), x2); else { for (int e = 0; e < 8; ++e) x2[e] = 0.f; }
#pragma unroll
    for (int e = 0; e < 8; ++e) out[e] = (cw[cch + e] * x0[e] + cw[1024 + cch + e] * x1[e] + cw[2048 + cch + e] * x2[e]) * scale;
}
constexpr float ML_KSCALE = 0.08838834764831845f;
constexpr int LDT = 72;
DEVI void ml_phaseA_unit(const Frame& F, int b, int h, int c) {
    const bf16_t* PROJ = (const bf16_t*)(F.ws + WS_BIG);
    float* gbase = (float*)F.lds; MlGates g = ml_gate_ptrs(gbase);
    float* wfw = gbase + 1536; float* wbw = wfw + 256;
    constexpr int RSV = 160;
    bf16_t* Vf = (bf16_t*)(F.lds + 8192); bf16_t* Vb = Vf + 64 * RSV; bf16_t* Kr = Vb + 64 * RSV;
    const int dir = F.wave >> 2, vt = F.wave & 3;
    const int lj = F.tid >> 3, cg8 = F.tid & 7; const float* cw = F.ap->in[I_MLCONV];
    bf16x8 pv[2], pk0[2], pk1[2], pk2[2];
#define MLA_ISSUE(jb_) do { const int t = c * 256 + (jb_) * 64 + lj; const int lo = (t < CTX) ? 0 : CTX, hi2 = (t < CTX) ? CTX : T; const int tm = (t - 1 >= lo) ? t - 1 : t, tp = (t + 1 < hi2) ? t + 1 : t; \
        _Pragma("unroll") for (int half = 0; half < 2; ++half) { const int ch = cg8 * 16 + half * 8; pv[half] = ld8(PROJ + (size_t)grow(b, t) * EVP + E_MV + h * 128 + ch); \
            pk0[half] = ld8(PROJ + (size_t)grow(b, tm) * EVP + E_MK + h * 128 + ch); pk1[half] = ld8(PROJ + (size_t)grow(b, t) * EVP + E_MK + h * 128 + ch); pk2[half] = ld8(PROJ + (size_t)grow(b, tp) * EVP + E_MK + h * 128 + ch); } } while (0)
    MLA_ISSUE(0);
    ml_gates_setup(F, g, b, h, c);
    if (F.tid < 256) { wfw[F.tid] = __expf(g.a_fw[F.tid] - g.pm_fw[255]); wbw[F.tid] = __expf(g.a_bw[F.tid] - g.pm_bw[0]); }
    f32x16 acc[4];
#pragma unroll
    for (int i = 0; i < 4; ++i) acc[i] = (f32x16){};
    float nacc = 0.f;
    for (int jb = 0; jb < 4; ++jb) {
        __syncthreads();
        { const int t = c * 256 + jb * 64 + lj; const float wf = wfw[jb * 64 + lj], wb = wbw[jb * 64 + lj];
          const int lo = (t < CTX) ? 0 : CTX, hi2 = (t < CTX) ? CTX : T; const bool hm = t - 1 >= lo, hp = t + 1 < hi2;
#pragma unroll
          for (int half = 0; half < 2; ++half) { const int ch = cg8 * 16 + half * 8, cch = 512 + h * 128 + ch; float v[8], k[8], x0[8], x1[8], x2[8], vf[8], vb[8];
            unpack8(pv[half], v); unpack8(pk0[half], x0); unpack8(pk1[half], x1); unpack8(pk2[half], x2);
#pragma unroll
            for (int e = 0; e < 8; ++e) { k[e] = (cw[cch + e] * (hm ? x0[e] : 0.f) + cw[1024 + cch + e] * x1[e] + cw[2048 + cch + e] * (hp ? x2[e] : 0.f)) * ML_KSCALE; vf[e] = v[e] * wf; vb[e] = v[e] * wb; }
            const bf16x8 kp = pack8(k); __builtin_nontemporal_store(kp, (bf16x8*)((bf16_t*)((unsigned char*)F.out + OUT_KC) + (size_t)grow(b, t) * 512 + h * 128 + ch));
            *(bf16x8*)(Vf + lj * RSV + ch) = pack8(vf); *(bf16x8*)(Vb + lj * RSV + ch) = pack8(vb); *(bf16x8*)(Kr + lj * RSV + ch) = kp; } }
        __syncthreads();
        if (jb + 1 < 4) MLA_ISSUE(jb + 1);
        const bf16_t* Vx = dir ? Vb : Vf;
#pragma unroll
        for (int ks = 0; ks < 4; ++ks) { const bf16x8 a = ld_tr_B(Vx, RSV, ks * 16, vt * 32, F.lane);
#pragma unroll
            for (int dt = 0; dt < 4; ++dt) acc[dt] = mfma32(a, ld_tr_B(Kr, RSV, ks * 16, dt * 32, F.lane), acc[dt]); }
        if (F.tid < 256) { const int dd = F.tid >> 7, d = F.tid & 127; const float* w = dd ? wbw : wfw; float s = 0.f;
#pragma unroll 8
            for (int j = 0; j < 64; ++j) s += bf2f(Kr[j * RSV + d]) * w[jb * 64 + j];
            nacc += s; }
    }
#undef MLA_ISSUE
    const int r32 = F.lane & 31, hi = F.lane >> 5;
    const int stream = (b * 4 + h) * 2 + dir;
    bf16_t* Cg = (bf16_t*)(F.ws + WS_SCR + SC_MLC) + ((size_t)stream * NCH + c) * 16384;
#pragma unroll
    for (int dt = 0; dt < 4; ++dt)
#pragma unroll
        for (int r = 0; r < 16; ++r) Cg[(vt * 32 + crow(r, hi)) * 128 + dt * 32 + r32] = (bf16_t)f2bf(acc[dt][r]);
    if (F.tid < 256) { const int dd = F.tid >> 7, d = F.tid & 127; const int st2 = (b * 4 + h) * 2 + dd; ((float*)(F.ws + WS_SCR + SC_MLN))[((size_t)st2 * NCH + c) * 128 + d] = nacc; }
    if (F.tid < 2) { const int dd = F.tid; const int st2 = (b * 4 + h) * 2 + dd; float* sc = (float*)(F.ws + WS_SCR + SC_MLS) + ((size_t)st2 * NCH + c) * 4;
        const float btot = dd ? g.b_bw[0] : g.b_fw[255], pme = dd ? g.pm_bw[0] : g.pm_fw[255]; sc[0] = btot + pme; sc[1] = btot; }
    __syncthreads();
}
DEVI int ml_chunk_at(int dir, int k) { if (!dir) return k; return (k < NCTXCH) ? (NCTXCH - 1 - k) : (NCH - 1 - (k - NCTXCH)); }
DEVI void ml_phaseB(const Frame& F) {
    const int nvb = NSTR_ML * 16;
    const int GH = F.G;
    for (int vb = F.bid; vb < nvb && F.bid < GH; vb += GH) {
        const int stream = vb >> 4, e0 = ((vb & 15) * NTHREADS + F.tid) * 2, dir = stream & 1;
        bf16_t* Cs = (bf16_t*)(F.ws + WS_SCR + SC_MLC) + (size_t)stream * NCH * 16384; float* Ns = (float*)(F.ws + WS_SCR + SC_MLN) + (size_t)stream * NCH * 128; float* Ss = (float*)(F.ws + WS_SCR + SC_MLS) + (size_t)stream * NCH * 4;
        float c0 = 0.f, c1 = 0.f, n0 = 0.f, m = 0.f; const bool do_n = (vb & 15) == 0 && F.tid < 128;
        typedef float f32x2 __attribute__((ext_vector_type(2)));
        constexpr int KB2 = (NCH + 1) / 2;
#pragma unroll 1
        for (int k0 = 0; k0 < NCH; k0 += KB2) {
            unsigned lv[KB2]; float lnv[KB2], mlv[KB2], btv[KB2];
#pragma unroll
            for (int kk = 0; kk < KB2; ++kk) { const int k = (k0 + kk < NCH) ? k0 + kk : NCH - 1; const int c = ml_chunk_at(dir, k); mlv[kk] = Ss[c * 4 + 0]; btv[kk] = Ss[c * 4 + 1]; lv[kk] = *(const unsigned*)(Cs + (size_t)c * 16384 + e0); lnv[kk] = do_n ? Ns[c * 128 + F.tid] : 0.f; }
#pragma unroll
            for (int kk = 0; kk < KB2; ++kk) { if (k0 + kk < NCH) { const int c = ml_chunk_at(dir, k0 + kk); const float mloc = mlv[kk], btot = btv[kk];
                *(unsigned*)(Cs + (size_t)c * 16384 + e0) = pk2(c0, c1);
                if (do_n) Ns[c * 128 + F.tid] = n0;
                if ((vb & 15) == 0 && F.tid == 0) Ss[c * 4 + 2] = m;
                const float mn = fmaxf(btot + m, mloc), dk = __expf(btot + m - mn), sl = __expf(mloc - mn);
                c0 = dk * c0 + sl * bf2f(lv[kk]); c1 = dk * c1 + sl * bf2f(lv[kk] >> 16); n0 = dk * n0 + sl * lnv[kk]; m = mn; } }
        }
    }
}
constexpr int LDK = 136;
DEVI void ml_phaseC_unit(const Frame& F0, int b, int h, int c) {
    const Frame F = unit_frame(F0);
    const bf16_t* PROJ = (const bf16_t*)(F.ws + WS_BIG); bf16_t* YM = (bf16_t*)(F.ws + WS_ACT);
    float* gbase = (float*)F.lds; MlGates g = ml_gate_ptrs(gbase);
    float* nin = gbase + 1536;
    float* wsc = gbase + 1792 + F.wave * 64;
    bf16_t* Kl = (bf16_t*)(F.lds + 12288);
    bf16_t* VT = Kl + 64 * LDK;
    bf16_t* stash = VT + 64 * 160 + F.wave * (32 * 136);
    ml_gates_setup(F, g, b, h, c);
    const int r32 = F.lane & 31, hi = F.lane >> 5, it = F.wave >> 1;
    const int irow = F.wave * 32 + r32;
    const int tq = c * 256 + irow;
    if (F.tid < 256) { const int dd = F.tid >> 7, d = F.tid & 127; nin[F.tid] = ((const float*)(F.ws + WS_SCR + SC_MLN))[((size_t)((b * 4 + h) * 2 + dd) * NCH + c) * 128 + d]; }
    bf16x8 qr[4];
    bf16_t* qhi = (bf16_t*)(F.lds + 119808) + F.tid * 32;
#define MLQ(d0) (((d0) < 4) ? qr[(d0) & 3] : ld8(qhi + ((d0) - 4) * 8))
#pragma unroll
    for (int d0 = 0; d0 < 4; ++d0) qr[d0] = (bf16x8){};
    { const int lo = (tq < CTX) ? 0 : CTX, hi2 = (tq < CTX) ? CTX : T; const bool hm = tq - 1 >= lo, hp = tq + 1 < hi2; const int tm = hm ? tq - 1 : tq, tp = hp ? tq + 1 : tq;
      const float* cw = F.ap->in[I_MLCONV];
#pragma unroll 1
      for (int half = 0; half < 2; ++half) { bf16x8 xr[4][3];
#pragma unroll
        for (int j = 0; j < 4; ++j) { const int col = E_MQ + h * 128 + (half * 4 + j) * 16 + hi * 8;
            xr[j][0] = ld8(PROJ + (size_t)grow(b, tm) * EVP + col); xr[j][1] = ld8(PROJ + (size_t)grow(b, tq) * EVP + col); xr[j][2] = ld8(PROJ + (size_t)grow(b, tp) * EVP + col); }
#pragma unroll
        for (int j = 0; j < 4; ++j) { const int cch = h * 128 + (half * 4 + j) * 16 + hi * 8; float x0[8], x1[8], x2[8], q[8]; unpack8(xr[j][0], x0); unpack8(xr[j][1], x1); unpack8(xr[j][2], x2);
#pragma unroll
            for (int e = 0; e < 8; ++e) q[e] = cw[cch + e] * (hm ? x0[e] : 0.f) + cw[1024 + cch + e] * x1[e] + cw[2048 + cch + e] * (hp ? x2[e] : 0.f);
            if (half == 0) qr[j] = pack8(q); else *(bf16x8*)(qhi + j * 8) = pack8(q); } }
      WAVE_SYNC(); }
    __syncthreads();
    f32x16 o[4];
#pragma unroll 1
    for (int dir = 0; dir < 2; ++dir) {
        const int stream = (b * 4 + h) * 2 + dir;
        const float m_in = ((const float*)(F.ws + WS_SCR + SC_MLS))[((size_t)stream * NCH + c) * 4 + 2];
        const float* aarr = dir ? g.a_bw : g.a_fw; const float* pmarr = dir ? g.pm_bw : g.pm_fw; const float* barr = dir ? g.b_bw : g.b_fw;
        const float Mrow = fmaxf(m_in, pmarr[irow]), w_inter = __expf(m_in - Mrow);
        const bf16_t* Cg = (const bf16_t*)(F.ws + WS_SCR + SC_MLC) + ((size_t)stream * NCH + c) * 16384;
        bf16_t* Cl = Kl;
        bf16x8 pkt[2], pvt[2];
#define MLC_ISSUE(jt_) do { const int j = F.tid >> 3, cg8 = F.tid & 7, t = c * 256 + (jt_) * 64 + j; \
            _Pragma("unroll") for (int half = 0; half < 2; ++half) { const int ch = cg8 * 16 + half * 8; pvt[half] = ld8(PROJ + (size_t)grow(b, t) * EVP + E_MV + h * 128 + ch); \
                pkt[half] = ld8((const bf16_t*)((const unsigned char*)F.out + OUT_KC) + (size_t)grow(b, t) * 512 + h * 128 + ch); } } while (0)
        MLC_ISSUE(0);
        float nq = 0.f;
        if (c >= NCTXCH) {
        __syncthreads();
        { const int v = F.tid >> 2, q4 = (F.tid & 3) * 32;
#pragma unroll
          for (int g8 = 0; g8 < 4; ++g8) *(bf16x8*)(Cl + v * LDK + q4 + g8 * 8) = ld8(Cg + v * 128 + q4 + g8 * 8); }
        __syncthreads();
#pragma unroll
        for (int d0 = 0; d0 < 4; ++d0) { o[d0] = (f32x16){};
#pragma unroll
            for (int ks = 0; ks < 8; ++ks) o[d0] = mfma32(MLQ(ks), ld8(Cl + (d0 * 32 + r32) * LDK + ks * 16 + hi * 8), o[d0]); }
#pragma unroll
        for (int d0 = 0; d0 < 8; ++d0) { float q[8]; unpack8(MLQ(d0), q);
#pragma unroll
            for (int e = 0; e < 8; ++e) nq += q[e] * nin[dir * 128 + d0 * 16 + hi * 8 + e]; FENCE(); }
        nq += shx<32>(nq);
        if (hi == 0) wsc[r32] = w_inter;
        __syncthreads();
#pragma unroll
        for (int d0 = 0; d0 < 4; ++d0)
#pragma unroll
            for (int r = 0; r < 16; ++r) o[d0][r] *= wsc[crow(r, hi)];
        } else {
#pragma unroll
            for (int d0 = 0; d0 < 4; ++d0) o[d0] = (f32x16){};
        }
        float rowsum = 0.f;
#pragma unroll 1
        for (int jt = 0; jt < 4; ++jt) {
            __syncthreads();
            { const int j = F.tid >> 3, cg8 = F.tid & 7;
#pragma unroll
              for (int half = 0; half < 2; ++half) { const int ch = cg8 * 16 + half * 8;
                *(bf16x8*)(Kl + j * LDK + ch) = pkt[half]; *(bf16x8*)(VT + j * 160 + ch) = pvt[half]; } }
            __syncthreads(); FENCE();
            if (jt + 1 < 4) MLC_ISSUE(jt + 1);
            const bool rel = dir ? (jt >= it) : (jt <= it);
            if (rel) {
                f32x16 p0 = (f32x16){}, p1 = (f32x16){};
#pragma unroll
                for (int d0 = 0; d0 < 8; ++d0) { const bf16x8 qf = MLQ(d0); p0 = mfma32(ld8(Kl + r32 * LDK + d0 * 16 + hi * 8), qf, p0); p1 = mfma32(ld8(Kl + (32 + r32) * LDK + d0 * 16 + hi * 8), qf, p1); }
#pragma unroll
                for (int r = 0; r < 16; ++r) { const int j0 = jt * 64 + crow(r, hi), j1 = j0 + 32;
                    const bool v0 = dir ? (j0 >= irow) : (j0 <= irow), v1 = dir ? (j1 >= irow) : (j1 <= irow);
                    p0[r] = v0 ? p0[r] * __expf(aarr[j0] - Mrow) : 0.f; p1[r] = v1 ? p1[r] * __expf(aarr[j1] - Mrow) : 0.f; rowsum += p0[r] + p1[r]; }
                const bf16x8 pa0 = pk4frag(p0, 0), pa1 = pk4frag(p0, 8), pa2 = pk4frag(p1, 0), pa3 = pk4frag(p1, 8); FENCE();
#pragma unroll
                for (int d0 = 0; d0 < 4; ++d0) {
                    o[d0] = mfma32(pa0, ld_tr_B(VT, 160, 0, d0 * 32, F.lane), o[d0]); o[d0] = mfma32(pa1, ld_tr_B(VT, 160, 16, d0 * 32, F.lane), o[d0]);
                    o[d0] = mfma32(pa2, ld_tr_B(VT, 160, 32, d0 * 32, F.lane), o[d0]); o[d0] = mfma32(pa3, ld_tr_B(VT, 160, 48, d0 * 32, F.lane), o[d0]); }
            }
        }
        rowsum += shx<32>(rowsum);
        const float den = rowsum + w_inter * nq, dn = fmaxf(fabsf(den), __expf(-(barr[irow] + Mrow)));
        __syncthreads();
        if (hi == 0) wsc[r32] = 1.f / dn;
        __syncthreads();
        if (dir == 0) {
#pragma unroll
            for (int d0 = 0; d0 < 4; ++d0)
#pragma unroll
                for (int r = 0; r < 16; ++r) stash[crow(r, hi) * 136 + d0 * 32 + r32] = (bf16_t)f2bf(o[d0][r] * wsc[crow(r, hi)]);
        } else {
#pragma unroll
            for (int d0 = 0; d0 < 4; ++d0)
#pragma unroll
                for (int r = 0; r < 16; ++r) o[d0][r] = o[d0][r] * wsc[crow(r, hi)] + bf2f(stash[crow(r, hi) * 136 + d0 * 32 + r32]);
        }
        __syncthreads();
    }
#pragma unroll
    for (int d0 = 0; d0 < 4; ++d0)
#pragma unroll
        for (int r = 0; r < 16; ++r) stash[crow(r, hi) * 136 + d0 * 32 + r32] = (bf16_t)f2bf(o[d0][r]);
    WAVE_SYNC();
    { const int rw = F.lane >> 1, hf = F.lane & 1; const bf16_t* sp = stash + rw * 136 + hf * 64; float hv[64]; float ss = 0.f;
#pragma unroll
      for (int q8 = 0; q8 < 8; ++q8) { unpack8(ld8(sp + q8 * 8), hv + q8 * 8);
#pragma unroll
          for (int e = 0; e < 8; ++e) ss += hv[q8 * 8 + e] * hv[q8 * 8 + e]; }
      ss += shx<1>(ss); const float rs = RSQ(ss * (1.f / 128.f) + EPS);
      const int row = grow(b, c * 256 + F.wave * 32 + rw); const int v0 = h * 128 + hf * 64;
#pragma unroll
      for (int q8 = 0; q8 < 8; ++q8) { float mo[8], ov[8]; unpack8(ld8(PROJ + (size_t)row * EVP + E_MO + v0 + q8 * 8), mo);
          const f32x4 g0 = *(const f32x4*)(F.ap->in[I_MLNORM] + v0 + q8 * 8), g1 = *(const f32x4*)(F.ap->in[I_MLNORM] + v0 + q8 * 8 + 4);
#pragma unroll
          for (int e = 0; e < 8; ++e) ov[e] = hv[q8 * 8 + e] * rs * (e < 4 ? g0[e] : g1[e - 4]) * sigmoidf_(mo[e]);
          *(bf16x8*)(YM + (size_t)row * D + v0 + q8 * 8) = pack8(ov); } }
    __syncthreads();
}

DEVI void rw_shift8(const bf16_t* PROJ, const float* mu8, int b, int t, int f, float* out) {
    const int lo = (t < CTX) ? 0 : CTX, hi = (t < CTX) ? CTX : T; float x0[8], x1[8], x2[8];
    unpack8(ld8(PROJ + (size_t)grow(b, t) * EVP + E_RF + f), x1);
    if (t - 1 >= lo) unpack8(ld8(PROJ + (size_t)grow(b, t - 1) * EVP + E_RF + f), x0); else { for (int e = 0; e < 8; ++e) x0[e] = 0.f; }
    if (t + 1 < hi) unpack8(ld8(PROJ + (size_t)grow(b, t + 1) * EVP + E_RF + f), x2); else { for (int e = 0; e < 8; ++e) x2[e] = 0.f; }
#pragma unroll
    for (int e = 0; e < 8; ++e) out[e] = x1[e] + (0.5f * (x0[e] + x2[e]) - x1[e]) * mu8[e];
}
constexpr int RW_T = 64 * 65;
DEVI void copy16(const Frame& F, void* dst, const void* src, int nchunks) { for (int i = F.tid; i < nchunks; i += NTHREADS) ((u32x4*)dst)[i] = ((const u32x4*)src)[i]; }
DEVI void rw_stage_weights(const Frame& F, int h, bf16_t* W2T, bf16_t* A2T, bf16_t* G2T, int dmask) {
    const unsigned char* T = F.ws + WS_RWT;
    for (int d = 0; d < 2; ++d) { if (!((dmask >> d) & 1)) continue; const int slot = (dmask == 3) ? d : 0;
        if (W2T) copy16(F, W2T + slot * 64 * LDT, T + RWT_W2 + (size_t)(d * 8 + h) * 9216, 576);
        copy16(F, A2T + slot * 64 * LDT, T + RWT_A2 + (size_t)(d * 8 + h) * 9216, 576); }
    if (G2T) copy16(F, G2T, T + RWT_G2 + (size_t)h * 17408, 1088);
}
DEVI void rw_build_tables(const Frame& F) {
    unsigned char* T = F.ws + WS_RWT; const int gt = F.bid * NTHREADS + F.tid, GT = F.G * NTHREADS;
    for (int idx = gt; idx < 16 * 64 * LDT; idx += GT) { const int dh = idx / (64 * LDT), e = (idx / LDT) % 64, j = idx % LDT, d = dh >> 3, h = dh & 7;
        const float w = (j < 64) ? F.ap->in[I_RWW2][((size_t)d * 64 + j) * 512 + h * 64 + e] : 0.f, a = (j < 64) ? F.ap->in[I_RWA2][((size_t)d * 64 + j) * 512 + h * 64 + e] : 0.f;
        ((bf16_t*)(T + RWT_W2))[idx] = (bf16_t)f2bf(w); ((bf16_t*)(T + RWT_A2))[idx] = (bf16_t)f2bf(a); }
    for (int idx = gt; idx < 8 * 64 * LDK; idx += GT) { const int h = idx / (64 * LDK), e = (idx / LDK) % 64, j = idx % LDK;
        ((bf16_t*)(T + RWT_G2))[idx] = (bf16_t)f2bf((j < 128) ? F.ap->in[I_RWG2][(size_t)j * 512 + h * 64 + e] : 0.f); }
    for (int idx = gt; idx < 16 * 640; idx += GT) { const int dh = idx / 640, i = idx % 640, dir = dh >> 3, h = dh & 7, a = i >> 6, e = i & 63; float v;
        if (a == 0) v = F.ap->in[I_RWKK][h * 64 + e]; else if (a == 1) v = F.ap->in[I_RWKA][h * 64 + e]; else if (a == 2) v = F.ap->in[I_RWW0][dir * 512 + h * 64 + e]; else if (a == 3) v = F.ap->in[I_RWA0][dir * 512 + h * 64 + e]; else if (a == 9) v = F.ap->in[I_RWRK][h * 64 + e];
        else { const int f = (a == 4) ? R_R + h * 64 : (a == 5) ? R_K + h * 64 : (a == 6) ? R_V + h * 64 : (a == 7) ? R_WL + dir * 64 : R_AL + dir * 64; v = F.ap->in[I_RWMU][f + e]; }
        ((float*)(T + RWT_CST))[idx] = v; }
}
DEVI void rw_prep(const Frame& F, int b, int h, int t0, float* R, float* K, float* V, float* KK, float* LW0, float* AA0, float* LW1, float* AA1, float* G,
                  const bf16_t* W2T, const bf16_t* A2T, const bf16_t* G2T, bf16_t* XW, bf16_t* XA, bf16_t* XG, int dmask) {
    const bf16_t* PROJ = (const bf16_t*)(F.ws + WS_BIG); const float* mu = F.ap->in[I_RWMU];
    const int tok = F.tid >> 3, c8 = (F.tid & 7) * 8, t = t0 + tok;
    const int r32 = F.lane & 31, hi = F.lane >> 5;
    { float x[8];
      rw_shift8(PROJ, mu + (R_R + h * 64 + c8), b, t, R_R + h * 64 + c8, x); for (int e = 0; e < 8; ++e) R[tok * 65 + c8 + e] = x[e];
      rw_shift8(PROJ, mu + (R_K + h * 64 + c8), b, t, R_K + h * 64 + c8, x); for (int e = 0; e < 8; ++e) K[tok * 65 + c8 + e] = x[e];
      rw_shift8(PROJ, mu + (R_V + h * 64 + c8), b, t, R_V + h * 64 + c8, x); for (int e = 0; e < 8; ++e) V[tok * 65 + c8 + e] = x[e]; }
    if (G) { float x[8];
#pragma unroll
        for (int hf = 0; hf < 2; ++hf) { rw_shift8(PROJ, mu + (R_GL + hf * 64 + c8), b, t, R_GL + hf * 64 + c8, x); for (int e = 0; e < 8; ++e) x[e] = sigmoidf_(x[e]); *(bf16x8*)(XG + tok * LDK + hf * 64 + c8) = pack8(x); } }
    __syncthreads();
    if (KK && F.tid < 64) { float s = 0.f; for (int e = 0; e < 64; ++e) { const float kk = K[F.tid * 65 + e] * F.ap->in[I_RWKK][h * 64 + e]; s += kk * kk; }
        const float rn = RSQ(s + 1e-12f); for (int e = 0; e < 64; ++e) KK[F.tid * 65 + e] = K[F.tid * 65 + e] * F.ap->in[I_RWKK][h * 64 + e] * rn; }
    if (G) {
        if (F.wave < 4) { const int tt = F.wave >> 1, et = F.wave & 1; f32x16 acc = (f32x16){};
#pragma unroll
            for (int ks = 0; ks < 8; ++ks) acc = mfma32(ld8(XG + (tt * 32 + r32) * LDK + ks * 16 + hi * 8), ld8(G2T + (et * 32 + r32) * LDK + ks * 16 + hi * 8), acc);
#pragma unroll
            for (int r = 0; r < 16; ++r) G[(tt * 32 + crow(r, hi)) * 65 + et * 32 + r32] = acc[r]; }
        __syncthreads(); }
    for (int d = 0; d < 2; ++d) { if (!((dmask >> d) & 1)) continue;
        const int slot = (dmask == 3) ? d : 0; float* LW = d ? LW1 : LW0; float* AA = d ? AA1 : AA0;
        __syncthreads();
        { float x[8];
          if (LW) { rw_shift8(PROJ, mu + (R_WL + d * 64 + c8), b, t, R_WL + d * 64 + c8, x); for (int e = 0; e < 8; ++e) x[e] = tanhf_(x[e]); *(bf16x8*)(XW + tok * LDT + c8) = pack8(x); }
          rw_shift8(PROJ, mu + (R_AL + d * 64 + c8), b, t, R_AL + d * 64 + c8, x); *(bf16x8*)(XA + tok * LDT + c8) = pack8(x); }
        __syncthreads();
        { const int which = F.wave >> 2, tt = (F.wave >> 1) & 1, et = F.wave & 1;
          if (which || LW) { const bf16_t* X = which ? XA : XW; const bf16_t* WT = (which ? A2T : W2T) + slot * 64 * LDT;
          f32x16 acc = (f32x16){};
#pragma unroll
          for (int ks = 0; ks < 4; ++ks) acc = mfma32(ld8(X + (tt * 32 + r32) * LDT + ks * 16 + hi * 8), ld8(WT + (et * 32 + r32) * LDT + ks * 16 + hi * 8), acc);
          const int e = et * 32 + r32;
#pragma unroll
          for (int r = 0; r < 16; ++r) { const int tk = tt * 32 + crow(r, hi);
              if (!which) { const float wpre = F.ap->in[I_RWW0][d * 512 + h * 64 + e] + acc[r]; LW[tk * 65 + e] = -0.6065306597126334f * sigmoidf_(wpre); }
              else AA[tk * 65 + e] = sigmoidf_(F.ap->in[I_RWA0][d * 512 + h * 64 + e] + acc[r]); } } }
    }
    __syncthreads();
}
DEVI void rw_scan_v1(const Frame& F, int b, int h, int dir, int rh) {
    float* base = (float*)F.lds;
    float *R = base, *K = R + RW_T, *V = K + RW_T, *KK = V + RW_T, *LW = KK + RW_T, *AA = LW + RW_T;
    bf16_t* W2T = (bf16_t*)(AA + RW_T); bf16_t* A2T = W2T + 64 * LDT; bf16_t* XW = A2T + 64 * LDT; bf16_t* XA = XW + 64 * LDT;
    float* YB = (float*)(XA + 64 * LDT);
    rw_stage_weights(F, h, W2T, A2T, nullptr, 1 << dir);
    float* YRW = F.out;
    const int q = F.lane & 15, rloc = F.wave * 4 + (F.lane >> 4), vrow = rh * 32 + rloc;
    float S[4] = {0.f, 0.f, 0.f, 0.f};
    const float ka0 = F.ap->in[I_RWKA][h * 64 + 4 * q + 0], ka1 = F.ap->in[I_RWKA][h * 64 + 4 * q + 1], ka2 = F.ap->in[I_RWKA][h * 64 + 4 * q + 2], ka3 = F.ap->in[I_RWKA][h * 64 + 4 * q + 3];
    const int nblk = T / 64;
    for (int kb = 0; kb < nblk; ++kb) {
        int blk; if (!dir) blk = kb; else blk = (kb < CTX / 64) ? (CTX / 64 - 1 - kb) : (nblk - 1 - (kb - CTX / 64));
        const int t0 = blk * 64;
        __syncthreads();
        rw_prep(F, b, h, t0, R, K, V, KK, dir ? nullptr : LW, dir ? nullptr : AA, dir ? LW : nullptr, dir ? AA : nullptr, nullptr, W2T, A2T, nullptr, XW, XA, nullptr, 1 << dir);
        for (int s = 0; s < 64; ++s) { const int tk = dir ? 63 - s : s; const float* kkp = KK + tk * 65 + 4 * q; const float* ap = AA + tk * 65 + 4 * q; const float* kp = K + tk * 65 + 4 * q;
            const float* lwp = LW + tk * 65 + 4 * q; const float* rp = R + tk * 65 + 4 * q;
            const float a0 = ap[0], a1 = ap[1], a2 = ap[2], a3 = ap[3];
            float sa = -(S[0] * kkp[0] + S[1] * kkp[1] + S[2] * kkp[2] + S[3] * kkp[3]);
            sa += shx<1>(sa); sa += shx<2>(sa); sa += shx<4>(sa); sa += shx<8>(sa);
            const float vv = V[tk * 65 + vrow];
            S[0] = S[0] * __expf(lwp[0]) + sa * (kkp[0] * a0) + vv * (kp[0] * (1.f + (a0 - 1.f) * ka0));
            S[1] = S[1] * __expf(lwp[1]) + sa * (kkp[1] * a1) + vv * (kp[1] * (1.f + (a1 - 1.f) * ka1));
            S[2] = S[2] * __expf(lwp[2]) + sa * (kkp[2] * a2) + vv * (kp[2] * (1.f + (a2 - 1.f) * ka2));
            S[3] = S[3] * __expf(lwp[3]) + sa * (kkp[3] * a3) + vv * (kp[3] * (1.f + (a3 - 1.f) * ka3));
            float y = S[0] * rp[0] + S[1] * rp[1] + S[2] * rp[2] + S[3] * rp[3];
            y += shx<1>(y); y += shx<2>(y); y += shx<4>(y); y += shx<8>(y);
            if (q == 0) YB[tk * 33 + rloc] = y; }
        __syncthreads();
        for (int i = F.tid; i < 64 * 32; i += NTHREADS) { const int tk = i >> 5, rr = i & 31; atomic_add_f32(YRW + (size_t)grow(b, t0 + tk) * 512 + h * 64 + rh * 32 + rr, YB[tk * 33 + rr]); }
    }
    __syncthreads();
}
DEVI void rw_finish_unit(const Frame& F, int b, int h, int blk) {
    float* base = (float*)F.lds;
    float *R = base, *K = R + RW_T, *V = K + RW_T, *G = V + RW_T, *AA0 = G + RW_T, *AA1 = AA0 + RW_T;
    bf16_t* A2T = (bf16_t*)(AA1 + RW_T); bf16_t* G2T = A2T + 2 * 64 * LDT; bf16_t* XA = G2T + 64 * LDK; bf16_t* XG = (bf16_t*)AA0;
    rw_stage_weights(F, h, nullptr, A2T, G2T, 3);
    __syncthreads();
    const int t0 = blk * 64;
    rw_prep(F, b, h, t0, R, K, V, nullptr, nullptr, AA0, nullptr, AA1, G, nullptr, A2T, G2T, nullptr, XA, XG, 3);
    const float* YRW = F.out; bf16_t* YM = (bf16_t*)(F.ws + WS_ACT);
    const int tok = F.tid >> 3, c8 = (F.tid & 7) * 8; const int row = grow(b, t0 + tok);
    float y[8]; float s = 0.f, bsum = 0.f;
#pragma unroll
    for (int e = 0; e < 8; ++e) { const int ch = c8 + e; y[e] = YRW[(size_t)row * 512 + h * 64 + ch]; s += y[e];
        const float r = R[tok * 65 + ch], k = K[tok * 65 + ch], ka = F.ap->in[I_RWKA][h * 64 + ch], rk = F.ap->in[I_RWRK][h * 64 + ch];
        const float kd0 = k * (1.f + (AA0[tok * 65 + ch] - 1.f) * ka), kd1 = k * (1.f + (AA1[tok * 65 + ch] - 1.f) * ka); bsum += r * (kd0 + kd1) * rk; }
    s += shx<1>(s); s += shx<2>(s); s += shx<4>(s); bsum += shx<1>(bsum); bsum += shx<2>(bsum); bsum += shx<4>(bsum);
    const float mu = s * (1.f / 64.f); float var = 0.f;
#pragma unroll
    for (int e = 0; e < 8; ++e) { const float dlt = y[e] - mu; var += dlt * dlt; }
    var = sum8(var);
    const float rs = RSQ(var * (1.f / 64.f) + 64e-5f); float o[8];
#pragma unroll
    for (int e = 0; e < 8; ++e) { const int ch = c8 + e; const float gn = (y[e] - mu) * rs * F.ap->in[I_RWLNW][h * 64 + ch] + F.ap->in[I_RWLNB][h * 64 + ch]; o[e] = (gn + bsum * V[tok * 65 + ch]) * G[tok * 65 + ch]; }
    *(bf16x8*)(YM + (size_t)row * D + 512 + h * 64 + c8) = pack8(o);
    __syncthreads();
}

DEVI void rw_finish2_unit(const Frame& F0, int b, int h, int blk) {
    const Frame F = unit_frame(F0);
    float* V = (float*)F.lds; float* G = V + RW_T; bf16_t* G2T = (bf16_t*)(G + RW_T); bf16_t* XG = G2T + 64 * LDK;
    const bf16_t* PROJ = (const bf16_t*)(F.ws + WS_BIG); const float* mu = F.ap->in[I_RWMU];
    const int r32 = F.lane & 31, hi = F.lane >> 5;
    __syncthreads();
    copy16(F, G2T, F.ws + WS_RWT + RWT_G2 + (size_t)h * 17408, 1088);
    const int t0 = blk * 64, tok = F.tid >> 3, c8 = (F.tid & 7) * 8, t = t0 + tok; const int row = grow(b, t);
    { float x[8]; rw_shift8(PROJ, mu + R_V + h * 64 + c8, b, t, R_V + h * 64 + c8, x);
#pragma unroll
      for (int e = 0; e < 8; ++e) V[tok * 65 + c8 + e] = x[e];
#pragma unroll
      for (int hf = 0; hf < 2; ++hf) { rw_shift8(PROJ, mu + R_GL + hf * 64 + c8, b, t, R_GL + hf * 64 + c8, x);
#pragma unroll
          for (int e = 0; e < 8; ++e) x[e] = sigmoidf_(x[e]);
          *(bf16x8*)(XG + tok * LDK + hf * 64 + c8) = pack8(x); } }
    __syncthreads();
    if (F.wave < 4) { const int tt = F.wave >> 1, et = F.wave & 1; f32x16 acc = (f32x16){};
#pragma unroll
        for (int ks = 0; ks < 8; ++ks) acc = mfma32(ld8(XG + (tt * 32 + r32) * LDK + ks * 16 + hi * 8), ld8(G2T + (et * 32 + r32) * LDK + ks * 16 + hi * 8), acc);
#pragma unroll
        for (int r = 0; r < 16; ++r) G[(tt * 32 + crow(r, hi)) * 65 + et * 32 + r32] = acc[r]; }
    __syncthreads();
    const float* YRW = F.out; bf16_t* YM = (bf16_t*)(F.ws + WS_ACT); const float* BON = (const float*)(F.ws + WS_RWT + RWT_BON);
    const float bsum = BON[(size_t)row * 16 + h * 2] + BON[(size_t)row * 16 + h * 2 + 1];
    float y[8]; float s = 0.f;
    unpack8(ld8((const bf16_t*)YRW + (size_t)row * 512 + h * 64 + c8), y);
#pragma unroll
    for (int e = 0; e < 8; ++e) s += y[e];
    s = sum8(s);
    const float mean = s * (1.f / 64.f); float var = 0.f;
#pragma unroll
    for (int e = 0; e < 8; ++e) { const float dlt = y[e] - mean; var += dlt * dlt; }
    var = sum8(var);
    const float rs = RSQ(var * (1.f / 64.f) + 64e-5f); float o[8];
#pragma unroll
    for (int e = 0; e < 8; ++e) { const int ch = c8 + e; const float gn = (y[e] - mean) * rs * F.ap->in[I_RWLNW][h * 64 + ch] + F.ap->in[I_RWLNB][h * 64 + ch]; o[e] = (gn + bsum * V[tok * 65 + ch]) * G[tok * 65 + ch]; }
    *(bf16x8*)(YM + (size_t)row * D + 512 + h * 64 + c8) = pack8(o);
}

namespace rw2 {
constexpr int O_W2T = 0, O_A2T = 9216, O_AL = 18432, O_XW = O_AL, O_XA = O_AL + 9216, O_LW = O_AL + 18432, O_AA = O_LW + 16640;
constexpr int O_AAB = O_AL, O_AAK = O_AL + 9216, O_ARB = O_AL + 18432, O_ARK = O_AL + 27648, O_UT = O_AL + 36864;
constexpr int O_RN = 70144, O_GL = 70400, O_SEG = 70656, O_AT = 72704, O_BT = 81920, O_KT = 91136, O_RT = 100352, O_BTT = 109568, O_KTT = 118784, O_VT = 128000, O_S0B = 137216;
constexpr int O_CST = 159744;
constexpr int O_ABF_C = 146432;
static_assert(O_ABF_C + 8192 + 2 * 32 * 40 * 2 <= O_CST && O_CST + 10 * 64 * 4 <= 160 * 1024 - 256, "rw2 lds");
DEVI void stage_consts(const Frame& F, int h, int dir) { copy16(F, F.lds + O_CST, F.ws + WS_RWT + RWT_CST + (size_t)(dir * 8 + h) * 2560, 160); }
DEVI float* slot_ptr(const Frame& F, int slot) { return (slot < RW_NS1) ? (float*)(F.ws + WS_SCR + SC_RW + (size_t)slot * 32768) : (float*)((unsigned char*)F.out + OUT_RW + (size_t)(slot - RW_NS1) * 32768); }
struct RawPrep { bf16x8 x[5][3]; };
DEVI void prep_load(const Frame& F, int b, int h, int dir, int t0, RawPrep& R) {
    const bf16_t* PROJ = (const bf16_t*)(F.ws + WS_BIG);
    const int i = F.tid >> 3, c8 = (F.tid & 7) * 8, t = dir ? t0 + 63 - i : t0 + i;
    const int lo = (t < CTX) ? 0 : CTX, hi2 = (t < CTX) ? CTX : T; const int tm = (t - 1 >= lo) ? t - 1 : t, tp = (t + 1 < hi2) ? t + 1 : t;
    const int fo[5] = {R_R + h * 64, R_K + h * 64, R_V + h * 64, R_WL + dir * 64, R_AL + dir * 64};
#pragma unroll
    for (int f = 0; f < 5; ++f) { const size_t col = E_RF + fo[f] + c8;
        R.x[f][0] = ld8(PROJ + (size_t)grow(b, tm) * EVP + col); R.x[f][1] = ld8(PROJ + (size_t)grow(b, t) * EVP + col); R.x[f][2] = ld8(PROJ + (size_t)grow(b, tp) * EVP + col); }
}
DEVI void shift_raw(const bf16x8 (&x)[3], const float* mu8, bool has_m, bool has_p, float* out) {
    float x0[8], x1[8], x2[8]; unpack8(x[0], x0); unpack8(x[1], x1); unpack8(x[2], x2);
#pragma unroll
    for (int e = 0; e < 8; ++e) { const float a = has_m ? x0[e] : 0.f, c = has_p ? x2[e] : 0.f; out[e] = x1[e] + (0.5f * (a + c) - x1[e]) * mu8[e]; }
}
DEVI void prep(const Frame& F, int b, int h, int dir, int t0, const RawPrep& RP, float* bon = nullptr) {
    unsigned char* L = F.lds; const float* CST = (const float*)(L + O_CST);
    bf16_t* W2T = (bf16_t*)(L + O_W2T); bf16_t* A2T = (bf16_t*)(L + O_A2T); bf16_t* XW = (bf16_t*)(L + O_XW); bf16_t* XA = (bf16_t*)(L + O_XA);
    float* LW = (float*)(L + O_LW); float* AA = (float*)(L + O_AA); float* GL = (float*)(L + O_GL); float* SEG = (float*)(L + O_SEG);
    bf16_t* At = (bf16_t*)(L + O_AT); bf16_t* Bt = (bf16_t*)(L + O_BT); bf16_t* Kt = (bf16_t*)(L + O_KT); bf16_t* Rt = (bf16_t*)(L + O_RT);
    bf16_t* BtT = (bf16_t*)(L + O_BTT); bf16_t* KtT = (bf16_t*)(L + O_KTT); bf16_t* VT = (bf16_t*)(L + O_VT);
    const int i = F.tid >> 3, c8 = (F.tid & 7) * 8, t = dir ? t0 + 63 - i : t0 + i;
    const int r32 = F.lane & 31, hi = F.lane >> 5;
    float r[8], k[8], v[8], kkr[8];
    const bool has_m = (t - 1 >= ((t < CTX) ? 0 : CTX)), has_p = (t + 1 < ((t < CTX) ? CTX : T));
    shift_raw(RP.x[0], CST + 4 * 64 + c8, has_m, has_p, r); shift_raw(RP.x[1], CST + 5 * 64 + c8, has_m, has_p, k); shift_raw(RP.x[2], CST + 6 * 64 + c8, has_m, has_p, v);
    float ssq = 0.f;
#pragma unroll
    for (int e = 0; e < 8; ++e) { kkr[e] = k[e] * CST[c8 + e]; ssq += kkr[e] * kkr[e]; }
    ssq = sum8(ssq);
    const float rn = RSQ(ssq + 1e-12f);
    { float x[8]; shift_raw(RP.x[3], CST + 7 * 64 + c8, has_m, has_p, x);
#pragma unroll
      for (int e = 0; e < 8; ++e) x[e] = tanhf_(x[e]);
      *(bf16x8*)(XW + i * LDT + c8) = pack8(x);
      shift_raw(RP.x[4], CST + 8 * 64 + c8, has_m, has_p, x); *(bf16x8*)(XA + i * LDT + c8) = pack8(x); }
    __syncthreads();
    { const int which = F.wave >> 2, tt = (F.wave >> 1) & 1, et = F.wave & 1; const bf16_t* X = which ? XA : XW; const bf16_t* WT = which ? A2T : W2T;
      f32x16 acc = (f32x16){};
#pragma unroll
      for (int ks = 0; ks < 4; ++ks) acc = mfma32(ld8(X + (tt * 32 + r32) * LDT + ks * 16 + hi * 8), ld8(WT + (et * 32 + r32) * LDT + ks * 16 + hi * 8), acc);
      const int e = et * 32 + r32;
#pragma unroll
      for (int rr = 0; rr < 16; ++rr) { const int tk = tt * 32 + crow(rr, hi);
          if (!which) { const float wpre = CST[2 * 64 + e] + acc[rr]; LW[tk * 65 + e] = -0.6065306597126334f * sigmoidf_(wpre); }
          else AA[tk * 65 + e] = sigmoidf_(CST[3 * 64 + e] + acc[rr]); } }
    __syncthreads();
    { const int e = F.tid & 63, seg = F.tid >> 6; float x[8]; float a = 0.f;
#pragma unroll
      for (int j = 0; j < 8; ++j) x[j] = LW[(seg * 8 + j) * 65 + e];
#pragma unroll
      for (int j = 0; j < 8; ++j) { a += x[j]; x[j] = a; }
      SEG[seg * 64 + e] = a;
      __syncthreads();
      float off = 0.f;
#pragma unroll
      for (int s2 = 0; s2 < 7; ++s2) { const float sv = SEG[s2 * 64 + e]; off += (s2 < seg) ? sv : 0.f; }
#pragma unroll
      for (int j = 0; j < 8; ++j) LW[(seg * 8 + j) * 65 + e] = x[j] + off;
      if (seg == 7) GL[e] = __expf(x[7] + off); }
    __syncthreads();
    { float at[8], bt[8], kt[8], rt[8]; float bsum = 0.f;
#pragma unroll
      for (int e = 0; e < 8; ++e) { const int c = c8 + e; const float G = LW[i * 65 + c], Gp = (i > 0) ? LW[(i - 1) * 65 + c] : 0.f, aa = AA[i * 65 + c];
          const float kkn = kkr[e] * rn, eg = __expf(-G);
          const float kd = k[e] * (1.f + (aa - 1.f) * CST[64 + c]); bsum += r[e] * kd * CST[9 * 64 + c];
          at[e] = -kkn * __expf(Gp); bt[e] = kkn * aa * eg; kt[e] = kd * eg; rt[e] = r[e] * __expf(G); }
      if (bon) { bsum = sum8(bsum); if ((F.tid & 7) == 0) bon[(size_t)grow(b, t) * 16 + h * 2 + dir] = bsum; }
      const bf16x8 bp = pack8(bt), kp = pack8(kt), vp = pack8(v);
      *(bf16x8*)(At + i * LDT + c8) = pack8(at); *(bf16x8*)(Bt + i * LDT + c8) = bp; *(bf16x8*)(Kt + i * LDT + c8) = kp; *(bf16x8*)(Rt + i * LDT + c8) = pack8(rt);
      *(bf16x8*)(VT + i * LDT + c8) = vp; (void)BtT; (void)KtT; }
    __syncthreads();
}
DEVI void amats(const Frame& F, bool want_r, float* ABFd) {
    unsigned char* L = F.lds; const int r32 = F.lane & 31, hi = F.lane >> 5, pair = F.wave >> 2, tr = (F.wave >> 1) & 1, tc = F.wave & 1;
    if (pair == 0 || want_r) {
        const bf16_t* X = (const bf16_t*)(L + (pair ? O_RT : O_AT));
#pragma unroll
        for (int which = 0; which < 2; ++which) { const bf16_t* Y = (const bf16_t*)(L + (which ? O_KT : O_BT)); bf16_t* dst = (bf16_t*)(L + (pair ? (which ? O_ARK : O_ARB) : (which ? O_AAK : O_AAB)));
            f32x16 acc = (f32x16){};
            if (tc <= tr) {
#pragma unroll
                for (int ks = 0; ks < 4; ++ks) acc = mfma32(ld8(X + (tr * 32 + r32) * LDT + ks * 16 + hi * 8), ld8(Y + (tc * 32 + r32) * LDT + ks * 16 + hi * 8), acc); }
#pragma unroll
            for (int rr = 0; rr < 16; ++rr) { const int t = tr * 32 + crow(rr, hi), s2 = tc * 32 + r32; const bool keep = pair ? (s2 <= t) : (s2 < t); const float val = keep ? acc[rr] : 0.f;
                dst[t * LDT + s2] = (bf16_t)f2bf(val); if (pair == 0 && which == 0 && tr == tc) ABFd[tr * 1024 + crow(rr, hi) * 32 + r32] = val; } }
    }
    __syncthreads();
}
DEVI void tinv(const float* ABFd_in, const bf16_t* Aab, bf16_t* Tm, bf16_t* T0T, bf16_t* XT, int lane) {
    const int blk = lane >> 5, j = lane & 31, r32 = lane & 31, hi = lane >> 5;
    const float* Ab = ABFd_in + blk * 1024;
    float x[32];
#pragma unroll
    for (int t = 0; t < 32; ++t) { float a0 = (t == j) ? 1.f : 0.f, a1 = 0.f; const float* rowp = Ab + t * 32;
#ifndef HIPEMU
        if (t >= 2) asm volatile("" : "+v"(rowp), "+v"(x[t - 2]));
#endif
#pragma unroll
        for (int c = 0; c < (t + 3) / 4; ++c) { const f32x4 a = *(const f32x4*)(rowp + c * 4);
#pragma unroll
            for (int e = 0; e < 4; ++e) if (c * 4 + e < t) { if (c & 1) a1 += a[e] * x[c * 4 + e]; else a0 += a[e] * x[c * 4 + e]; } }
        x[t] = a0 + a1; }
#pragma unroll
    for (int s2 = 0; s2 < 32; ++s2) { Tm[(blk * 32 + s2) * LDT + blk * 32 + j] = (bf16_t)f2bf(x[s2]); if (blk) Tm[s2 * LDT + 32 + j] = 0; }
    if (!blk) {
#pragma unroll
        for (int c = 0; c < 4; ++c) { float y[8];
#pragma unroll
            for (int e = 0; e < 8; ++e) y[e] = x[c * 8 + e];
            *(bf16x8*)(T0T + j * 40 + c * 8) = pack8(y); } }
    WAVE_SYNC();
    f32x16 acc = (f32x16){};
#pragma unroll
    for (int ks = 0; ks < 2; ++ks) acc = mfma32(ld8(Aab + (32 + r32) * LDT + ks * 16 + hi * 8), ld8(T0T + r32 * 40 + ks * 16 + hi * 8), acc);
#pragma unroll
    for (int rr = 0; rr < 16; ++rr) XT[r32 * 40 + crow(rr, hi)] = (bf16_t)f2bf(acc[rr]);
    WAVE_SYNC();
    acc = (f32x16){};
#pragma unroll
    for (int ks = 0; ks < 2; ++ks) acc = mfma32(ld8(Tm + (32 + r32) * LDT + 32 + ks * 16 + hi * 8), ld8(XT + r32 * 40 + ks * 16 + hi * 8), acc);
#pragma unroll
    for (int rr = 0; rr < 16; ++rr) Tm[(32 + crow(rr, hi)) * LDT + r32] = (bf16_t)f2bf(acc[rr]);
}
DEVI f32x16 mm64(const bf16_t* X, int x0, const bf16_t* Y, int y0, f32x16 acc, int r32, int hi) {
#pragma unroll
    for (int ks = 0; ks < 4; ++ks) acc = mfma32(ld8(X + (x0 + r32) * LDT + ks * 16 + hi * 8), ld8(Y + (y0 + r32) * LDT + ks * 16 + hi * 8), acc);
    return acc;
}
DEVI f32x16 mm64_yt(const bf16_t* X, int x0, const bf16_t* Yr, int y0, f32x16 acc, int r32, int hi, int lane) {
#pragma unroll
    for (int ks = 0; ks < 4; ++ks) acc = mfma32(ld8(X + (x0 + r32) * LDT + ks * 16 + hi * 8), ld_tr_B(Yr, LDT, ks * 16, y0, lane), acc);
    return acc;
}
DEVI f32x16 mm64_xyt(const bf16_t* Xr, int x0, const bf16_t* Yr, int y0, f32x16 acc, int lane) {
#pragma unroll
    for (int ks = 0; ks < 4; ++ks) acc = mfma32(ld_tr_B(Xr, LDT, ks * 16, x0, lane), ld_tr_B(Yr, LDT, ks * 16, y0, lane), acc);
    return acc;
}
DEVI void st_tile_T(bf16_t* dst, int t0, int v0, const f32x16& acc, int r32, int hi) {
#pragma unroll
    for (int g = 0; g < 4; ++g) { u32x2 w; w[0] = pk2(acc[4 * g], acc[4 * g + 1]); w[1] = pk2(acc[4 * g + 2], acc[4 * g + 3]); *(u32x2*)(dst + (v0 + r32) * LDT + t0 + 8 * g + 4 * hi) = w; }
}
DEVI void phaseA_unit(const Frame& F0, int b, int h, int dir, int c) {
    unsigned char* L = F0.lds; const int part = F0.wave >> 2, vr = (F0.wave >> 1) & 1, dc = F0.wave & 1;
    bf16_t* S0b = (bf16_t*)(L + O_S0B); float* ABFd = (float*)(L + O_ARB); bf16_t* T0T = (bf16_t*)(L + O_ARB + 8192); bf16_t* XT = T0T + 32 * 40; bf16_t* Tm = (bf16_t*)(L + O_KT);
    f32x16 S;
    { const Frame F = unit_frame(F0); const int r32 = F.lane & 31, hi = F.lane >> 5;
      rw_stage_weights(F, h, (bf16_t*)(L + O_W2T), (bf16_t*)(L + O_A2T), nullptr, 1 << dir); stage_consts(F, h, dir);
#pragma unroll
      for (int rr = 0; rr < 16; ++rr) { const int v = vr * 32 + crow(rr, hi), d = dc * 32 + r32; S[rr] = (part == 0 && v == d) ? 1.f : 0.f; S0b[(part * 64 + v) * LDT + d] = (bf16_t)f2bf(S[rr]); } }
    __syncthreads();
    RawPrep rcur, rnxt;
    { const Frame F = unit_frame(F0); prep_load(F, b, h, dir, c * 256 + (dir ? 3 : 0) * 64, rcur); }
#pragma unroll 1
    for (int sbi = 0; sbi < 4; ++sbi) { const int sub = dir ? 3 - sbi : sbi; const int t0 = c * 256 + sub * 64;
        const Frame F = unit_frame(F0);
        const int r32 = F.lane & 31, hi = F.lane >> 5;
        if (sbi < 3) prep_load(F, b, h, dir, c * 256 + (dir ? 2 - sbi : sbi + 1) * 64, rnxt);
        prep(F, b, h, dir, t0, rcur);
        rcur = rnxt;
        amats(F, false, ABFd);
        if (F.wave == 0) tinv(ABFd, (const bf16_t*)(L + O_AAB), Tm, T0T, XT, F.lane);
        { f32x16 acc = (f32x16){};
          acc = mm64((const bf16_t*)(L + O_AT), vr * 32, S0b + part * 64 * LDT, dc * 32, acc, r32, hi);
          if (part) acc = mm64((const bf16_t*)(L + O_AAK), vr * 32, (const bf16_t*)(L + O_VT), dc * 32, acc, r32, hi);
          st_tile_T((bf16_t*)(L + (part ? O_RT : O_BT)), vr * 32, dc * 32, acc, r32, hi); }
        __syncthreads();
        { f32x16 u = (f32x16){};
          u = mm64(Tm, vr * 32, (const bf16_t*)(L + (part ? O_RT : O_BT)), dc * 32, u, r32, hi);
          __syncthreads();
          st_tile_T((bf16_t*)(L + (part ? O_AT : O_UT)), vr * 32, dc * 32, u, r32, hi); }
        __syncthreads();
        { const bf16_t* UT = (const bf16_t*)(L + (part ? O_AT : O_UT));
          S = mm64(UT, vr * 32, (const bf16_t*)(L + O_BTT), dc * 32, S, r32, hi);
          if (part) S = mm64((const bf16_t*)(L + O_VT), vr * 32, (const bf16_t*)(L + O_KTT), dc * 32, S, r32, hi);
          const float gl = ((const float*)(L + O_GL))[dc * 32 + r32];
#pragma unroll
          for (int rr = 0; rr < 16; ++rr) { S[rr] *= gl; S0b[(part * 64 + vr * 32 + crow(rr, hi)) * LDT + dc * 32 + r32] = (bf16_t)f2bf(S[rr]); } }
        __syncthreads();
    }
    { const Frame F = unit_frame(F0); const int r32 = F.lane & 31, hi = F.lane >> 5;
      float* slot = slot_ptr(F, ((b * 8 + h) * 2 + dir) * NCH + c);
#pragma unroll
      for (int rr = 0; rr < 16; ++rr) slot[(part * 64 + vr * 32 + crow(rr, hi)) * 64 + dc * 32 + r32] = S[rr]; }
    __syncthreads();
}
constexpr int O_T0T = O_AL + 46080, O_XT = O_AL + 48640;
DEVI void amats4(const Frame& F) {
    unsigned char* L = F.lds; const int r32 = F.lane & 31, hi = F.lane >> 5, pair = F.wave >> 2, tr = (F.wave >> 1) & 1, tc = F.wave & 1;
    const bf16_t* X = (const bf16_t*)(L + (pair ? O_RT : O_AT));
#pragma unroll
    for (int which = 0; which < 2; ++which) { const bf16_t* Y = (const bf16_t*)(L + (which ? O_KT : O_BT)); bf16_t* dst = (bf16_t*)(L + (pair ? (which ? O_ARK : O_ARB) : (which ? O_AAK : O_AAB)));
        f32x16 acc = (f32x16){};
        if (tc <= tr) {
#pragma unroll
            for (int ks = 0; ks < 4; ++ks) acc = mfma32(ld8(Y + (tc * 32 + r32) * LDT + ks * 16 + hi * 8), ld8(X + (tr * 32 + r32) * LDT + ks * 16 + hi * 8), acc); }
        const int t = tr * 32 + r32;
#pragma unroll
        for (int g = 0; g < 4; ++g) { float v[4];
#pragma unroll
            for (int e = 0; e < 4; ++e) { const int s2 = tc * 32 + 8 * g + 4 * hi + e; const bool keep = pair ? (s2 <= t) : (s2 < t); v[e] = keep ? acc[4 * g + e] : 0.f; }
            u32x2 w; w[0] = pk2(v[0], v[1]); w[1] = pk2(v[2], v[3]); *(u32x2*)(dst + t * LDT + tc * 32 + 8 * g + 4 * hi) = w; } }
    __syncthreads();
}
DEVI void tinv_b(const bf16_t* Aab_in, bf16_t* Tm, bf16_t* T0T, bf16_t* XT, int lane) {
    const int blk = lane >> 5, j = lane & 31, r32 = lane & 31, hi = lane >> 5;
    const bf16_t* Ab = Aab_in + (blk * 32) * LDT + blk * 32;
    float x[32];
#pragma unroll
    for (int t = 0; t < 32; ++t) { float a0 = (t == j) ? 1.f : 0.f, a1 = 0.f; const bf16_t* rowp = Ab + t * LDT;
#ifndef HIPEMU
        if (t >= 2) asm volatile("" : "+v"(rowp), "+v"(x[t - 2]));
#endif
#pragma unroll
        for (int c = 0; c < (t + 7) / 8; ++c) { float a[8]; unpack8(ld8(rowp + c * 8), a);
#pragma unroll
            for (int e = 0; e < 8; ++e) if (c * 8 + e < t) { if (e & 1) a1 += a[e] * x[c * 8 + e]; else a0 += a[e] * x[c * 8 + e]; } }
        x[t] = a0 + a1; }
#pragma unroll
    for (int s2 = 0; s2 < 32; ++s2) { Tm[(blk * 32 + s2) * LDT + blk * 32 + j] = (bf16_t)f2bf(x[s2]); if (blk) Tm[s2 * LDT + 32 + j] = 0; }
    if (!blk) {
#pragma unroll
        for (int c = 0; c < 4; ++c) { float y[8];
#pragma unroll
            for (int e = 0; e < 8; ++e) y[e] = x[c * 8 + e];
            *(bf16x8*)(T0T + j * 40 + c * 8) = pack8(y); } }
    WAVE_SYNC();
    f32x16 acc = (f32x16){};
#pragma unroll
    for (int ks = 0; ks < 2; ++ks) acc = mfma32(ld8(Aab_in + (32 + r32) * LDT + ks * 16 + hi * 8), ld8(T0T + r32 * 40 + ks * 16 + hi * 8), acc);
#pragma unroll
    for (int rr = 0; rr < 16; ++rr) XT[r32 * 40 + crow(rr, hi)] = (bf16_t)f2bf(acc[rr]);
    WAVE_SYNC();
    acc = (f32x16){};
#pragma unroll
    for (int ks = 0; ks < 2; ++ks) acc = mfma32(ld8(Tm + (32 + r32) * LDT + 32 + ks * 16 + hi * 8), ld8(XT + r32 * 40 + ks * 16 + hi * 8), acc);
#pragma unroll
    for (int rr = 0; rr < 16; ++rr) Tm[(32 + crow(rr, hi)) * LDT + r32] = (bf16_t)f2bf(acc[rr]);
}
DEVI bf16x8 accfrag(const f32x16& X, int s2) { float x[8];
#pragma unroll
    for (int e = 0; e < 8; ++e) x[e] = X[8 * s2 + e];
    return pack8(x); }
DEVI bf16x8 ldk(const bf16_t* rowp, int s2, int hi) { const u32x2 lo = *(const u32x2*)(rowp + 16 * s2 + 4 * hi), h2 = *(const u32x2*)(rowp + 16 * s2 + 8 + 4 * hi); u32x4 w; w[0] = lo[0]; w[1] = lo[1]; w[2] = h2[0]; w[3] = h2[1]; return __builtin_bit_cast(bf16x8, w); }
DEVI void inv32(const bf16_t* Ab, f32x16& Tm_, f32x16& Tt_, int n, int hi) {
    f32x16 S, St;
#pragma unroll
    for (int r = 0; r < 16; ++r) S[r] = bf2f(Ab[crow(r, hi) * LDT + n]);
#pragma unroll
    for (int g = 0; g < 4; ++g) { const u32x2 w = *(const u32x2*)(Ab + n * LDT + 8 * g + 4 * hi); const unsigned a = w[0], b2 = w[1]; St[4 * g] = bf2f(a); St[4 * g + 1] = bf2f(a >> 16); St[4 * g + 2] = bf2f(b2); St[4 * g + 3] = bf2f(b2 >> 16); }
    Tm_ = S; Tt_ = St;
#pragma unroll
    for (int r = 0; r < 16; ++r) { const float d = (crow(r, hi) == n) ? 1.f : 0.f; Tm_[r] += d; Tt_[r] += d; }
#pragma unroll
    for (int k = 0; k < 4; ++k) {
        { const bf16x8 fs0 = accfrag(S, 0), fs1 = accfrag(S, 1), ft0 = accfrag(St, 0), ft1 = accfrag(St, 1);
          f32x16 Sn = (f32x16){}; Sn = mfma32(ft0, fs0, Sn); Sn = mfma32(ft1, fs1, Sn);
          f32x16 Stn = (f32x16){}; Stn = mfma32(fs0, ft0, Stn); Stn = mfma32(fs1, ft1, Stn);
          S = Sn; St = Stn; }
        { const bf16x8 fs0 = accfrag(S, 0), fs1 = accfrag(S, 1), ft0 = accfrag(Tt_, 0), ft1 = accfrag(Tt_, 1);
          Tm_ = mfma32(ft0, fs0, Tm_); Tm_ = mfma32(ft1, fs1, Tm_);
          Tt_ = mfma32(fs0, ft0, Tt_); Tt_ = mfma32(fs1, ft1, Tt_); } }
}
DEVI void tinv_mfma(const bf16_t* Aab, bf16_t* Tm, int lane) {
    const int n = lane & 31, hi = lane >> 5;
    f32x16 X = (f32x16){};
    { f32x16 T0, T0t; inv32(Aab, T0, T0t, n, hi);
#pragma unroll
      for (int s2 = 0; s2 < 2; ++s2) X = mfma32(ldk(Aab + (32 + n) * LDT, s2, hi), accfrag(T0, s2), X);
#pragma unroll
      for (int g = 0; g < 4; ++g) { u32x2 w; w[0] = pk2(T0t[4 * g], T0t[4 * g + 1]); w[1] = pk2(T0t[4 * g + 2], T0t[4 * g + 3]); *(u32x2*)(Tm + n * LDT + 8 * g + 4 * hi) = w;
          u32x2 z; z[0] = 0u; z[1] = 0u; *(u32x2*)(Tm + n * LDT + 32 + 8 * g + 4 * hi) = z; } }
    { f32x16 T1, T1t; inv32(Aab + 32 * LDT + 32, T1, T1t, n, hi);
      f32x16 T10 = (f32x16){};
#pragma unroll
      for (int s2 = 0; s2 < 2; ++s2) T10 = mfma32(accfrag(T1t, s2), accfrag(X, s2), T10);
#pragma unroll
      for (int g = 0; g < 4; ++g) { u32x2 w; w[0] = pk2(T1t[4 * g], T1t[4 * g + 1]); w[1] = pk2(T1t[4 * g + 2], T1t[4 * g + 3]); *(u32x2*)(Tm + (32 + n) * LDT + 32 + 8 * g + 4 * hi) = w; }
#pragma unroll
      for (int r = 0; r < 16; ++r) Tm[(32 + crow(r, hi)) * LDT + n] = (bf16_t)f2bf(T10[r]); }
}
DEVI void tinv_half(const bf16_t* Aab, bf16_t* Tm, bf16_t* XL, int which, int lane) {
    const int n = lane & 31, hi = lane >> 5;
    f32x16 Tq, Tqt; inv32(Aab + which * (32 * LDT + 32), Tq, Tqt, n, hi);
#pragma unroll
    for (int g = 0; g < 4; ++g) { u32x2 w; w[0] = pk2(Tqt[4 * g], Tqt[4 * g + 1]); w[1] = pk2(Tqt[4 * g + 2], Tqt[4 * g + 3]); *(u32x2*)(Tm + (which * 32 + n) * LDT + which * 32 + 8 * g + 4 * hi) = w; }
    if (!which) { f32x16 X = (f32x16){};
#pragma unroll
        for (int s2 = 0; s2 < 2; ++s2) X = mfma32(ldk(Aab + (32 + n) * LDT, s2, hi), accfrag(Tq, s2), X);
#pragma unroll
        for (int r = 0; r < 16; ++r) XL[crow(r, hi) * LDT + n] = (bf16_t)f2bf(X[r]); }
}
template <class QT> DEVI void heavy_unit(const Frame& F0, int b, int h, int dir, int c, RawPrep& rcur, QT& Q, int nrw, int& next_u, bool& next_loaded) {
    unsigned char* L = F0.lds; const int part = F0.wave >> 2, vr = (F0.wave >> 1) & 1, dc = F0.wave & 1;
    bf16_t* S0b = (bf16_t*)(L + O_S0B); bf16_t* Tm = (bf16_t*)(L + O_BTT);
    const int stream = (b * 8 + h) * 2 + dir; float* YRW = F0.out; float* BON = (float*)(F0.ws + WS_RWT + RWT_BON);
    f32x16 S;
    next_u = -1; next_loaded = false;
    { const Frame F = unit_frame(F0); const int r32 = F.lane & 31, hi = F.lane >> 5;
      copy16(F, L + O_W2T, F.ws + WS_RWT + RWT_W2 + (size_t)(dir * 8 + h) * 9216, 576); copy16(F, L + O_A2T, F.ws + WS_RWT + RWT_A2 + (size_t)(dir * 8 + h) * 9216, 576); stage_consts(F, h, dir);
#pragma unroll
      for (int rr = 0; rr < 16; ++rr) { const int v = vr * 32 + crow(rr, hi), d = dc * 32 + r32; S[rr] = (part == 0 && v == d) ? 1.f : 0.f; S0b[(part * 64 + v) * LDT + d] = (bf16_t)f2bf(S[rr]); } }
    __syncthreads();
#pragma unroll 1
    for (int sbi = 0; sbi < 4; ++sbi) { const int sub = dir ? 3 - sbi : sbi; const int t0 = c * 256 + sub * 64;
        const Frame F = unit_frame(F0);
        const int r32 = F.lane & 31, hi = F.lane >> 5;
        prep(F, b, h, dir, t0, rcur, BON);
        amats4(F);
        if (F.wave < 2) tinv_half((const bf16_t*)(L + O_AAB), Tm, (bf16_t*)(L + O_KTT), F.wave, F.lane);
        f32x16 W0 = (f32x16){}, W1 = (f32x16){};
        W0 = mm64((const bf16_t*)(L + O_AT), 0, S0b + part * 64 * LDT, dc * 32, W0, r32, hi); W1 = mm64((const bf16_t*)(L + O_AT), 32, S0b + part * 64 * LDT, dc * 32, W1, r32, hi);
        if (part) { W0 = mm64_yt((const bf16_t*)(L + O_AAK), 0, (const bf16_t*)(L + O_VT), dc * 32, W0, r32, hi, F.lane); W1 = mm64_yt((const bf16_t*)(L + O_AAK), 32, (const bf16_t*)(L + O_VT), dc * 32, W1, r32, hi, F.lane); }
        __syncthreads();
        if (sbi < 3) prep_load(F, b, h, dir, c * 256 + (dir ? 2 - sbi : sbi + 1) * 64, rcur);
        else { next_u = Q.pop(F);
            if (next_u >= 0 && next_u < nrw) { const int b2 = next_u / (16 * NCH), h2 = (next_u / (2 * NCH)) % 8, d2 = (next_u / NCH) % 2, c2 = next_u % NCH;
                prep_load(F, b2, h2, d2, c2 * 256 + (d2 ? 3 : 0) * 64, rcur); next_loaded = true; } }
        { f32x16 u = (f32x16){}; const bf16_t* trow = Tm + (vr * 32 + r32) * LDT;
#pragma unroll
          for (int s2 = 0; s2 < 2; ++s2) u = mfma32(ldk(vr ? (const bf16_t*)(L + O_KTT) + r32 * LDT : trow, s2, hi), accfrag(W0, s2), u);
          if (vr) {
#pragma unroll
              for (int e = 0; e < 16; ++e) W1[e] += u[e];
              u = (f32x16){};
#pragma unroll
              for (int s2 = 0; s2 < 2; ++s2) u = mfma32(ldk(trow + 32, s2, hi), accfrag(W1, s2), u); }
          st_tile_T((bf16_t*)(L + (part ? O_AT : O_UT)), vr * 32, dc * 32, u, r32, hi); }
        __syncthreads();
        { const bf16_t* UT = (const bf16_t*)(L + (part ? O_AT : O_UT));
          f32x16 y = (f32x16){};
          y = mm64((const bf16_t*)(L + O_RT), vr * 32, S0b + part * 64 * LDT, dc * 32, y, r32, hi);
          y = mm64((const bf16_t*)(L + O_ARB), vr * 32, UT, dc * 32, y, r32, hi);
          if (part) { y = mm64_yt((const bf16_t*)(L + O_ARK), vr * 32, (const bf16_t*)(L + O_VT), dc * 32, y, r32, hi, F.lane);
#pragma unroll
              for (int rr = 0; rr < 16; ++rr) { const int i = vr * 32 + crow(rr, hi), tok = dir ? t0 + 63 - i : t0 + i; ((bf16_t*)YRW)[(size_t)dir * M * 512 + (size_t)grow(b, tok) * 512 + h * 64 + dc * 32 + r32] = (bf16_t)f2bf(y[rr]); } }
          else { bf16_t* Z = (bf16_t*)(F.ws + WS_ACT) + ((size_t)(stream * NCH + c) * 4 + sbi) * 4096;
#pragma unroll
              for (int rr = 0; rr < 16; ++rr) Z[(vr * 32 + crow(rr, hi)) * 64 + dc * 32 + r32] = (bf16_t)f2bf(y[rr]); }
          S = mm64_yt(UT, vr * 32, (const bf16_t*)(L + O_BT), dc * 32, S, r32, hi, F.lane);
          if (part) S = mm64_xyt((const bf16_t*)(L + O_VT), vr * 32, (const bf16_t*)(L + O_KT), dc * 32, S, F.lane);
          const float gl = ((const float*)(L + O_GL))[dc * 32 + r32];
#pragma unroll
          for (int rr = 0; rr < 16; ++rr) S[rr] *= gl; }
        __syncthreads();
#pragma unroll
        for (int rr = 0; rr < 16; ++rr) S0b[(part * 64 + vr * 32 + crow(rr, hi)) * LDT + dc * 32 + r32] = (bf16_t)f2bf(S[rr]);
    }
    { const Frame F = unit_frame(F0); const int r32 = F.lane & 31, hi = F.lane >> 5;
      float* slot = slot_ptr(F, stream * NCH + c);
#pragma unroll
      for (int rr = 0; rr < 16; ++rr) slot[(part * 64 + vr * 32 + crow(rr, hi)) * 64 + dc * 32 + r32] = S[rr]; }
    __syncthreads();
}
struct FixPre { f32x4 a, a2; bf16x8 z[2][2]; };
DEVI void fixup_load(const Frame& F, int stream, int c, FixPre& P) {
    const float* Sin = slot_ptr(F, stream * NCH + c) + 4096; const bf16_t* Zb = (const bf16_t*)(F.ws + WS_ACT) + (size_t)(stream * NCH + c) * 4 * 4096;
    const int sv = F.tid >> 3, j8 = (F.tid & 7) * 8, zw = F.tid >> 8, zt = (F.tid & 255) >> 2, q16 = (F.tid & 3) * 16;
    P.a = *(const f32x4*)(Sin + sv * 64 + j8); P.a2 = *(const f32x4*)(Sin + sv * 64 + j8 + 4);
#pragma unroll
    for (int rnd = 0; rnd < 2; ++rnd) { const bf16_t* zp = Zb + (size_t)(rnd * 2 + zw) * 4096 + zt * 64 + q16; P.z[rnd][0] = ld8(zp); P.z[rnd][1] = ld8(zp + 8); }
}
DEVI void fixup_unit(const Frame& F0, int stream, int c, FixPre& P, bool has_next, int nstream, int nc) {
    const Frame F = unit_frame(F0);
    unsigned char* L = F.lds; bf16_t* Sb = (bf16_t*)L; bf16_t* Cz = (bf16_t*)(L + 9216);
    const int r32 = F.lane & 31, hi = F.lane >> 5, half = F.wave >> 2, tr = (F.wave >> 1) & 1, vc = F.wave & 1;
    const int dir = stream & 1, h = (stream >> 1) & 7, b = stream >> 4; float* YRW = F.out;
    const int sv = F.tid >> 3, j8 = (F.tid & 7) * 8, zw = F.tid >> 8, zt = (F.tid & 255) >> 2, q16 = (F.tid & 3) * 16;
    __syncthreads();
    { float x[8];
#pragma unroll
      for (int e = 0; e < 4; ++e) { x[e] = P.a[e]; x[4 + e] = P.a2[e]; }
      *(bf16x8*)(Sb + sv * LDT + j8) = pack8(x); }
#pragma unroll
    for (int rnd = 0; rnd < 2; ++rnd) { bf16_t* cz = Cz + ((rnd * 2 + zw) * 64 + zt) * LDT + q16; *(bf16x8*)cz = P.z[rnd][0]; *(bf16x8*)(cz + 8) = P.z[rnd][1]; }
    __syncthreads();
    if (has_next) fixup_load(F, nstream, nc, P);
#pragma unroll 1
    for (int rnd = 0; rnd < 2; ++rnd) {
        const int sbi = rnd * 2 + half, sub = dir ? 3 - sbi : sbi, t0 = c * 256 + sub * 64;
        f32x16 y = (f32x16){}; y = mm64(Cz + sbi * 64 * LDT, tr * 32, Sb, vc * 32, y, r32, hi);
#pragma unroll
        for (int rr = 0; rr < 16; ++rr) { const int i = tr * 32 + crow(rr, hi), tok = dir ? t0 + 63 - i : t0 + i; atomic_add_f32(YRW + (size_t)grow(b, tok) * 512 + h * 64 + vc * 32 + r32, y[rr]); }
    }
}
struct FixPre2 { f32x4 a[2], a2[2]; bf16x8 z[2][2]; bf16x8 y[2][2]; };
DEVI void fixup2_load(const Frame& F, int u, FixPre2& P) {
    const int rnd = u & 1, vq = u >> 1, c = vq % NCH, bh = vq / NCH, b = bh >> 3, h = bh & 7;
    const int sv = F.tid >> 3, j8 = (F.tid & 7) * 8, zw = F.tid >> 8, zt = (F.tid & 255) >> 2, q16 = (F.tid & 3) * 16;
#pragma unroll
    for (int dir = 0; dir < 2; ++dir) { const int stream = (b * 8 + h) * 2 + dir; const float* Sin = slot_ptr(F, stream * NCH + c) + 4096;
        const int sub = 2 * rnd + zw, sbi = dir ? 3 - sub : sub; const bf16_t* zp = (const bf16_t*)(F.ws + WS_ACT) + ((size_t)(stream * NCH + c) * 4 + sbi) * 4096 + zt * 64 + q16;
        P.a[dir] = *(const f32x4*)(Sin + sv * 64 + j8); P.a2[dir] = *(const f32x4*)(Sin + sv * 64 + j8 + 4); P.z[dir][0] = ld8(zp); P.z[dir][1] = ld8(zp + 8); }
#pragma unroll
    for (int blk = 0; blk < 2; ++blk) { const bf16_t* yp = (const bf16_t*)F.out + (size_t)grow(b, c * 256 + (2 * rnd + blk) * 64 + sv) * 512 + h * 64 + j8; P.y[blk][0] = ld8(yp); P.y[blk][1] = ld8(yp + (size_t)M * 512); }
}
DEVI void fixup2_unit(const Frame& F0, int u, FixPre2& P, bool has_next, int un) {
    const Frame F = unit_frame(F0);
    unsigned char* L = F.lds; bf16_t* Sb = (bf16_t*)L; bf16_t* Cz = Sb + 2 * 64 * LDT; float* YF = (float*)(Cz + 4 * 64 * LDT);
    const int r32 = F.lane & 31, hi = F.lane >> 5, dir = F.wave >> 2, tr = (F.wave >> 1) & 1, vc = F.wave & 1;
    const int rnd = u & 1, vq = u >> 1, c = vq % NCH, bh = vq / NCH, b = bh >> 3, h = bh & 7;
    const int sv = F.tid >> 3, j8 = (F.tid & 7) * 8, zw = F.tid >> 8, zt = (F.tid & 255) >> 2, q16 = (F.tid & 3) * 16;
    __syncthreads();
#pragma unroll
    for (int d = 0; d < 2; ++d) { float x[8];
#pragma unroll
        for (int e = 0; e < 4; ++e) { x[e] = P.a[d][e]; x[4 + e] = P.a2[d][e]; }
        *(bf16x8*)(Sb + (d * 64 + sv) * LDT + j8) = pack8(x);
        bf16_t* cz = Cz + ((d * 2 + zw) * 64 + zt) * LDT + q16; *(bf16x8*)cz = P.z[d][0]; *(bf16x8*)(cz + 8) = P.z[d][1]; }
    bf16x8 yr[2][2];
#pragma unroll
    for (int blk = 0; blk < 2; ++blk) { yr[blk][0] = P.y[blk][0]; yr[blk][1] = P.y[blk][1]; }
    __syncthreads();
    if (has_next) fixup2_load(F, un, P);
#pragma unroll
    for (int blk = 0; blk < 2; ++blk) { f32x16 y = (f32x16){}; y = mm64(Cz + (dir * 2 + blk) * 64 * LDT, tr * 32, Sb + dir * 64 * LDT, vc * 32, y, r32, hi);
#pragma unroll
        for (int rr = 0; rr < 16; ++rr) { const int i = tr * 32 + crow(rr, hi); YF[((dir * 2 + blk) * 64 + (dir ? 63 - i : i)) * 65 + vc * 32 + r32] = y[rr]; } }
    __syncthreads();
#pragma unroll
    for (int blk = 0; blk < 2; ++blk) { bf16_t* yp = (bf16_t*)F.out + (size_t)grow(b, c * 256 + (2 * rnd + blk) * 64 + sv) * 512 + h * 64 + j8; float yf[8], yb[8], o[8]; unpack8(yr[blk][0], yf); unpack8(yr[blk][1], yb);
#pragma unroll
        for (int e = 0; e < 8; ++e) o[e] = (yf[e] + yb[e]) + (YF[(blk * 64 + sv) * 65 + j8 + e] + YF[((2 + blk) * 64 + sv) * 65 + j8 + e]);
        *(bf16x8*)yp = pack8(o); }
}
DEVI void phaseB(const Frame& F) {
    constexpr int SLD = 66, MLD = 80;
    float* Sl = (float*)F.lds; float* Ml = Sl + 16 * SLD; float* Nl = Ml + 64 * MLD;
    const int v = F.tid >> 5, d2 = (F.tid & 31) * 2, lj = F.lane & 15, lq = F.lane >> 4;
    for (int item = F.bid; item < NSTR_RW * 4; item += F.G) { const int stream = (item & 7) + 8 * (item >> 5), q = (item >> 3) & 3, dir = stream & 1;
        __syncthreads();
        for (int i = F.tid; i < 16 * SLD; i += NTHREADS) Sl[i] = 0.f;
        f32x4 pm0, pm1, pn = (f32x4){}, qm0, qm1, qn = (f32x4){}, rm0, rm1, rn = (f32x4){};
#define RWB_LD(M0, M1, NN, kk) do { const float* ns_ = slot_ptr(F, stream * NCH + ml_chunk_at(dir, (kk))); M0 = ((const f32x4*)ns_)[F.tid]; M1 = ((const f32x4*)ns_)[512 + F.tid]; if (F.tid < 256) NN = ((const f32x4*)(ns_ + 4096 + q * 1024))[F.tid]; } while (0)
        RWB_LD(pm0, pm1, pn, 0); qm0 = pm0; qm1 = pm1; rm0 = pm0; rm1 = pm1;
        if (1 < NCH) RWB_LD(qm0, qm1, qn, 1);
        if (2 < NCH) RWB_LD(rm0, rm1, rn, 2);
        for (int k = 0; k < NCH; ++k) { const int c = ml_chunk_at(dir, k); float* slot = slot_ptr(F, stream * NCH + c);
            __syncthreads();
            *(f32x4*)(Ml + (F.tid >> 4) * MLD + (F.tid & 15) * 4) = pm0; *(f32x4*)(Ml + (32 + (F.tid >> 4)) * MLD + (F.tid & 15) * 4) = pm1; if (F.tid < 256) ((f32x4*)Nl)[F.tid] = pn;
            pm0 = qm0; pm1 = qm1; pn = qn; qm0 = rm0; qm1 = rm1; qn = rn;
            if (k + 3 < NCH) RWB_LD(rm0, rm1, rn, k + 3);
            __syncthreads();
            f32x4 acc = (f32x4){};
            if (F.wave < 4) {
#pragma unroll
                for (int r = 0; r < 4; ++r) acc[r] = Nl[(4 * lq + r) * 64 + 16 * F.wave + lj];
#pragma unroll
                for (int kk = 0; kk < 16; ++kk) acc = mfma16f(Sl[lj * SLD + 4 * kk + lq], Ml[(4 * kk + lq) * MLD + 16 * F.wave + lj], acc); }
            slot[4096 + (q * 16 + v) * 64 + d2] = Sl[v * SLD + d2]; slot[4096 + (q * 16 + v) * 64 + d2 + 1] = Sl[v * SLD + d2 + 1];
            __syncthreads();
            if (F.wave < 4) {
#pragma unroll
                for (int r = 0; r < 4; ++r) Sl[(4 * lq + r) * SLD + 16 * F.wave + lj] = acc[r]; }
        }
    }
    __syncthreads();
}
DEVI void phaseC_unit(const Frame& F0, int b, int h, int dir, int c) {
    unsigned char* L = F0.lds; const int half = F0.wave >> 2, vr = (F0.wave >> 1) & 1, dc = F0.wave & 1;
    bf16_t* S0b = (bf16_t*)(L + O_S0B); float* ABFd = (float*)(L + O_ABF_C); bf16_t* T0T = (bf16_t*)(L + O_ABF_C + 8192); bf16_t* XT = T0T + 32 * 40; bf16_t* Tm = (bf16_t*)(L + O_KT);
    float* YRW = F0.out;
    f32x16 S = (f32x16){};
    { const Frame F = unit_frame(F0); const int r32 = F.lane & 31, hi = F.lane >> 5;
      rw_stage_weights(F, h, (bf16_t*)(L + O_W2T), (bf16_t*)(L + O_A2T), nullptr, 1 << dir); stage_consts(F, h, dir);
      const float* Sin = slot_ptr(F, ((b * 8 + h) * 2 + dir) * NCH + c) + 4096;
      if (half == 1) {
#pragma unroll
        for (int rr = 0; rr < 16; ++rr) { const int v = vr * 32 + crow(rr, hi), d = dc * 32 + r32; S[rr] = Sin[v * 64 + d]; S0b[v * LDT + d] = (bf16_t)f2bf(S[rr]); } } }
    __syncthreads();
    RawPrep rcur, rnxt;
    { const Frame F = unit_frame(F0); prep_load(F, b, h, dir, c * 256 + (dir ? 3 : 0) * 64, rcur); }
#pragma unroll 1
    for (int sbi = 0; sbi < 4; ++sbi) { const int sub = dir ? 3 - sbi : sbi; const int t0 = c * 256 + sub * 64;
        const Frame F = unit_frame(F0);
        const int r32 = F.lane & 31, hi = F.lane >> 5;
        if (sbi < 3) prep_load(F, b, h, dir, c * 256 + (dir ? 2 - sbi : sbi + 1) * 64, rnxt);
        prep(F, b, h, dir, t0, rcur);
        rcur = rnxt;
        amats(F, true, ABFd);
        if (F.wave == 4) tinv(ABFd, (const bf16_t*)(L + O_AAB), Tm, T0T, XT, F.lane);
        if (half == 0) { f32x16 acc = (f32x16){};
          acc = mm64((const bf16_t*)(L + O_AT), vr * 32, S0b, dc * 32, acc, r32, hi);
          acc = mm64((const bf16_t*)(L + O_AAK), vr * 32, (const bf16_t*)(L + O_VT), dc * 32, acc, r32, hi);
          st_tile_T((bf16_t*)(L + O_BT), vr * 32, dc * 32, acc, r32, hi); }
        __syncthreads();
        if (half == 0) { f32x16 u = (f32x16){}; u = mm64(Tm, vr * 32, (const bf16_t*)(L + O_BT), dc * 32, u, r32, hi); st_tile_T((bf16_t*)(L + O_UT), vr * 32, dc * 32, u, r32, hi); }
        __syncthreads();
        if (half == 0) {
            f32x16 y = (f32x16){};
            y = mm64((const bf16_t*)(L + O_RT), vr * 32, S0b, dc * 32, y, r32, hi);
            y = mm64((const bf16_t*)(L + O_ARB), vr * 32, (const bf16_t*)(L + O_UT), dc * 32, y, r32, hi);
            y = mm64((const bf16_t*)(L + O_ARK), vr * 32, (const bf16_t*)(L + O_VT), dc * 32, y, r32, hi);
#pragma unroll
            for (int rr = 0; rr < 16; ++rr) { const int i = vr * 32 + crow(rr, hi), tok = dir ? t0 + 63 - i : t0 + i; atomic_add_f32(YRW + (size_t)grow(b, tok) * 512 + h * 64 + dc * 32 + r32, y[rr]); }
        } else {
            S = mm64((const bf16_t*)(L + O_UT), vr * 32, (const bf16_t*)(L + O_BTT), dc * 32, S, r32, hi);
            S = mm64((const bf16_t*)(L + O_VT), vr * 32, (const bf16_t*)(L + O_KTT), dc * 32, S, r32, hi);
            const float gl = ((const float*)(L + O_GL))[dc * 32 + r32];
#pragma unroll
            for (int rr = 0; rr < 16; ++rr) S[rr] *= gl;
        }
        __syncthreads();
        if (half == 1) {
#pragma unroll
            for (int rr = 0; rr < 16; ++rr) S0b[(vr * 32 + crow(rr, hi)) * LDT + dc * 32 + r32] = (bf16_t)f2bf(S[rr]); }
        __syncthreads();
    }
}
}

constexpr float HG_QSCALE = 0.08838834764831845f;
constexpr int LDS32 = 40;
DEVI float hg_lb(const Frame& F, int ch) { return sigmoidf_(F.ap->in[I_HGLB][512 + ch] - F.ap->in[I_HGLB][ch]); }
DEVI void hg_fk(float pre, float lb, float& lf, float& k) { const float sg = sigmoidf_(pre); lf = __logf(lb + (1.f - lb) * sg); k = (1.f - lb) * (1.f - sg); }
DEVI void hg_fk2(float pre, float lb, float& f, float& k) { const float sg = sigmoidf_(pre); f = lb + (1.f - lb) * sg; k = (1.f - lb) * (1.f - sg); }
template <int DSEL> DEVI void hg_phaseA_unit(const Frame& F, int b, int h, int c) {
    constexpr bool FWO = DSEL >= 0;
    const bf16_t* PROJ = (const bf16_t*)(F.ws + WS_BIG);
    constexpr int RSV = 160;
    bf16_t* KTf = (bf16_t*)F.lds; bf16_t* KTb = KTf + 128 * LDT; bf16_t* VTa = KTb + 128 * LDT; bf16_t* VTb = VTa + 64 * RSV; bf16_t* HFf = VTb + 64 * RSV; bf16_t* HFb = HFf + 64 * LDK;
    constexpr int NG = FWO ? 2 : 4, NSEG = FWO ? 4 : 2, NPOS = 64 / NSEG, NV = FWO ? 2 : 4;
    const int r32 = F.lane & 31, hi = F.lane >> 5, dir = FWO ? DSEL : (F.wave >> 2), dt = F.wave & 3, vt0 = FWO ? (F.wave >> 2) * 2 : 0;
    const int lw = FWO ? DSEL : (F.tid >> 8), lj = FWO ? (F.tid >> 3) : ((F.tid & 255) >> 2), lch = FWO ? (F.tid & 7) * 16 : (F.tid & 3) * 32;
    f32x16 acc[NV];
#pragma unroll
    for (int i = 0; i < NV; ++i) acc[i] = (f32x16){};
    float Pacc = 1.f; const int sd = FWO ? DSEL : (F.tid >> 8), seg = FWO ? (F.tid >> 7) : ((F.tid >> 7) & 1), sdch = F.tid & 127;
    const float lb = hg_lb(F, h * 128 + sdch); float* xch = (float*)(HFb + 64 * LDK);
    bf16x8 pf[NG], pv[NG];
#define HGA_ISSUE(itb_) do { const int blk = lw ? (itb_) : 3 - (itb_); const size_t rb = (size_t)grow(b, c * 256 + blk * 64 + lj) * ODP; const int colf = (lw ? O_HFB : O_HFF) + h * 128; \
        _Pragma("unroll") for (int g = 0; g < NG; ++g) { const int ch = lch + g * 8; pf[g] = ld8(PROJ + rb + colf + ch); pv[g] = ld8(PROJ + rb + O_HI + h * 128 + ch); } } while (0)
    HGA_ISSUE(0);
    for (int itb = 0; itb < 4; ++itb) {
        __syncthreads();
        { bf16_t* VT = lw ? VTb : VTa; bf16_t* HF = lw ? HFb : HFf;
#pragma unroll
          for (int g = 0; g < NG; ++g) { const int ch = lch + g * 8; *(bf16x8*)(HF + lj * LDK + ch) = pf[g]; *(bf16x8*)(VT + lj * RSV + ch) = pv[g]; } }
        __syncthreads();
        if (itb + 1 < 4) HGA_ISSUE(itb + 1);
        { bf16_t* KT = sd ? KTb : KTf; const bf16_t* HF = sd ? HFb : HFf; float cp[NPOS], kk[NPOS]; float run = 1.f;
#pragma unroll
            for (int i = 0; i < NPOS; ++i) { const int sp = seg * NPOS + i, j = sd ? sp : 63 - sp; float f; hg_fk2(bf2f(HF[j * LDK + sdch]), lb, f, kk[i]); cp[i] = run; run *= f; }
            xch[(sd * 4 + seg) * 128 + sdch] = run;
            __syncthreads();
            float base = Pacc, tot = 1.f;
#pragma unroll
            for (int q = 0; q < NSEG; ++q) { const float rq = xch[(sd * 4 + q) * 128 + sdch]; base *= (q < seg) ? rq : 1.f; tot *= rq; }
#pragma unroll
            for (int i = 0; i < NPOS; ++i) { const int sp = seg * NPOS + i, j = sd ? sp : 63 - sp; KT[sdch * LDT + j] = (bf16_t)f2bf(kk[i] * (base * cp[i])); }
            Pacc *= tot; }
        __syncthreads();
        const bf16_t* KT = dir ? KTb : KTf; const bf16_t* VT = dir ? VTb : VTa;
#pragma unroll
        for (int ks = 0; ks < 4; ++ks) { const bf16x8 a = ld8(KT + (dt * 32 + r32) * LDT + ks * 16 + hi * 8);
#pragma unroll
            for (int vt = 0; vt < NV; ++vt) acc[vt] = mfma32(a, ld_tr_B(VT, RSV, ks * 16, (vt0 + vt) * 32, F.lane), acc[vt]); }
    }
    const int stream = (b * 4 + h) * 2 + dir; bf16_t* Sg = (bf16_t*)(F.ws + WS_HGS) + ((size_t)stream * NCH + c) * 16384;
#pragma unroll
    for (int vt = 0; vt < NV; ++vt)
#pragma unroll
        for (int r = 0; r < 16; ++r) Sg[(dt * 32 + crow(r, hi)) * 128 + (vt0 + vt) * 32 + r32] = (bf16_t)f2bf(acc[vt][r]);
#undef HGA_ISSUE
    if (seg == 0) ((float*)(F.ws + WS_ACT))[((size_t)((b * 4 + h) * 2 + sd) * NCH + c) * 128 + sdch] = Pacc;
    __syncthreads();
}
DEVI void hg_phaseB(const Frame& F) {
    const int nvb = NSTR_ML * 16;
    for (int vb = F.bid; vb < nvb; vb += F.G) {
        const int stream = vb >> 4, e0 = ((vb & 15) * NTHREADS + F.tid) * 2, dir = stream & 1, d = e0 >> 7;
        bf16_t* Ss = (bf16_t*)(F.ws + WS_HGS) + (size_t)stream * NCH * 16384; const float* Bt = (const float*)(F.ws + WS_ACT) + (size_t)stream * NCH * 128;
        unsigned lv[NCH]; float dkv[NCH];
#pragma unroll
        for (int k = 0; k < NCH; ++k) { const int c = ml_chunk_at(dir, k); lv[k] = *(const unsigned*)(Ss + (size_t)c * 16384 + e0); dkv[k] = Bt[c * 128 + d]; }
        float s0 = 0.f, s1 = 0.f;
#pragma unroll
        for (int k = 0; k < NCH; ++k) { const int c = ml_chunk_at(dir, k); *(unsigned*)(Ss + (size_t)c * 16384 + e0) = pk2(s0, s1);
            s0 = dkv[k] * s0 + bf2f(lv[k]); s1 = dkv[k] * s1 + bf2f(lv[k] >> 16); }
    }
}
DEVI void hg_phaseC_unit(const Frame& F0, int b, int h, int c) {
    const Frame F = unit_frame(F0); PS_DECL PS_B(9)
    const bf16_t* PROJ = (const bf16_t*)(F.ws + WS_BIG); bf16_t* YM = (bf16_t*)(F.ws + WS_ACT);
    const int dir = F.wave >> 2, vt = F.wave & 3;
    int r32 = F.lane & 31, hi = F.lane >> 5, tl = F.tid & 255;
    unsigned char* dbase = F.lds + dir * 40960;
    bf16_t* QH = (bf16_t*)dbase; bf16_t* KB = QH + 32 * LDK; bf16_t* KBT = KB + 32 * LDK; bf16_t* VT = KBT + 128 * LDS32; float* blast = (float*)(VT + 128 * LDS32);
    bf16_t* stash = (bf16_t*)(F.lds + 81920);
    float* ssb = (float*)(F.lds + 81920 + 65536);
    f32x16 S[4];
    { const int stream = (b * 4 + h) * 2 + dir; const bf16_t* Sg = (const bf16_t*)(F.ws + WS_HGS) + ((size_t)stream * NCH + c) * 16384;
#pragma unroll
      for (int dt = 0; dt < 4; ++dt)
#pragma unroll
          for (int r = 0; r < 16; ++r) S[dt][r] = bf2f(Sg[(dt * 32 + crow(r, hi)) * 128 + vt * 32 + r32]); }
    const float lb = hg_lb(F, h * 128 + (tl & 127));
#pragma unroll 1
    for (int step = 0; step < 8; ++step) {
        const int sb = dir ? 7 - step : step; const int tb = c * 256 + sb * 32;
        { const Frame Fs = unit_frame(F0); r32 = Fs.lane & 31; hi = Fs.lane >> 5; tl = Fs.tid & 255; }
        PS_B(1) __syncthreads();
        { const int j = tl >> 3, g8 = tl & 7; const size_t rb = (size_t)grow(b, tb + j) * ODP;
#pragma unroll
          for (int hf2 = 0; hf2 < 2; ++hf2) { const int ch = g8 * 16 + hf2 * 8;
              *(bf16x8*)(QH + j * LDK + ch) = ld8(PROJ + rb + O_HQ + h * 128 + ch); *(bf16x8*)(KB + j * LDK + ch) = ld8(PROJ + rb + (dir ? O_HFB : O_HFF) + h * 128 + ch);
              *(bf16x8*)(VT + j * 160 + ch) = ld8(PROJ + rb + O_HI + h * 128 + ch); } }
        __syncthreads(); PS_E(1) PS_B(2)
        { const int d = tl & 127, hf = tl >> 7; float cp[16]; float run = 1.f;
#pragma unroll
          for (int s = 0; s < 16; ++s) { const int sp = hf * 16 + s, j = dir ? 31 - sp : sp; float f, k; hg_fk2(bf2f(KB[j * LDK + d]), lb, f, k);
              run *= f; cp[s] = run; KB[j * LDK + d] = (bf16_t)f2bf(k); QH[j * LDK + d] = (bf16_t)f2bf(siluf_(bf2f(QH[j * LDK + d])) * HG_QSCALE); }
          if (hf == 0) blast[d] = run;
          __syncthreads();
          const float off = hf ? blast[d] : 1.f;
          __syncthreads();
#pragma unroll
          for (int s = 0; s < 16; ++s) { const int sp = hf * 16 + s, j = dir ? 31 - sp : sp; const float P = cp[s] * off;
              QH[j * LDK + d] = (bf16_t)f2bf(bf2f(QH[j * LDK + d]) * P); const unsigned kb = f2bf(bf2f(KB[j * LDK + d]) * RCP(fmaxf(P, 1.8e-35f))); KB[j * LDK + d] = (bf16_t)kb; KBT[d * LDS32 + j] = (bf16_t)kb; }
          if (hf) blast[d] = cp[15] * off; }
        __syncthreads(); PS_E(2) PS_B(3)
        f32x16 p = (f32x16){};
#pragma unroll
        for (int ks = 0; ks < 8; ++ks) p = mfma32(ld8(KB + r32 * LDK + ks * 16 + hi * 8), ld8(QH + r32 * LDK + ks * 16 + hi * 8), p);
#pragma unroll
        for (int r = 0; r < 16; ++r) { const int s = crow(r, hi); const bool ok = dir ? (s >= r32) : (s <= r32); p[r] = ok ? p[r] : 0.f; }
        const bf16x8 pa0 = pk4frag(p, 0), pa1 = pk4frag(p, 8);
        f32x16 o = (f32x16){};
        const bf16x8 vb0 = ld_tr_B(VT, 160, 0, vt * 32, F.lane), vb1 = ld_tr_B(VT, 160, 16, vt * 32, F.lane);
        o = mfma32(pa0, vb0, o); o = mfma32(pa1, vb1, o);
#pragma unroll
        for (int dt = 0; dt < 4; ++dt)
#pragma unroll
            for (int s2 = 0; s2 < 2; ++s2) { float sf[8];
#pragma unroll
                for (int e = 0; e < 8; ++e) sf[e] = S[dt][8 * s2 + e];
                const bf16_t* qp = QH + r32 * LDK + dt * 32 + 16 * s2 + 4 * hi; u32x4 aw; const u32x2 lo = *(const u32x2*)qp, hh = *(const u32x2*)(qp + 8); aw[0] = lo[0]; aw[1] = lo[1]; aw[2] = hh[0]; aw[3] = hh[1];
                o = mfma32(__builtin_bit_cast(bf16x8, aw), pack8(sf), o); }
#pragma unroll
        for (int dt = 0; dt < 4; ++dt) {
#pragma unroll
            for (int ks = 0; ks < 2; ++ks) S[dt] = mfma32(ld8(KBT + (dt * 32 + r32) * LDS32 + ks * 16 + hi * 8), ks ? vb1 : vb0, S[dt]);
#pragma unroll
            for (int g = 0; g < 4; ++g) { const f32x4 b4 = *(const f32x4*)(blast + dt * 32 + 8 * g + 4 * hi);
#pragma unroll
                for (int e = 0; e < 4; ++e) S[dt][4 * g + e] *= b4[e]; } }
        PS_E(3) PS_B(4)
        bf16_t hgraw[16];
        if (step < 4) {
#pragma unroll
            for (int r = 0; r < 16; ++r) stash[(sb * 32 + crow(r, hi)) * 128 + vt * 32 + r32] = (bf16_t)f2bf(o[r]);
        } else {
#pragma unroll
            for (int r = 0; r < 16; ++r) hgraw[r] = PROJ[(size_t)grow(b, tb + crow(r, hi)) * ODP + O_HG + h * 128 + vt * 32 + r32];
#pragma unroll
            for (int r = 0; r < 16; ++r) { o[r] += bf2f(stash[(sb * 32 + crow(r, hi)) * 128 + vt * 32 + r32]); const float sq = half_sum32(o[r] * o[r]); if (r32 == 0) ssb[(dir * 32 + crow(r, hi)) * 4 + vt] = sq; }
        }
        __syncthreads();
        if (step >= 4) { const int v = h * 128 + vt * 32 + r32; const float gn = F.ap->in[I_HGNORM][v];
#pragma unroll
            for (int r = 0; r < 16; ++r) { const int tr = crow(r, hi); const f32x4 sp = *(const f32x4*)(ssb + (dir * 32 + tr) * 4); const float rs = RSQ(((sp[0] + sp[1]) + (sp[2] + sp[3])) * (1.f / 128.f) + EPS);
                YM[(size_t)grow(b, tb + tr) * D + v] = (bf16_t)f2bf(o[r] * rs * gn * siluf_(bf2f(hgraw[r]))); }
        }
        PS_E(4)
    }
    __syncthreads(); PS_E(9) PS_SPIN;
}
DEVI void mla_prep_unit(const Frame& F, int u) {
    const bf16_t* PROJ = (const bf16_t*)(F.ws + WS_BIG); float* rq = (float*)(F.ws + WS_RSTD); float* rkv = rq + M; bf16_t* KR = (bf16_t*)(F.ws + WS_SCR + SC_KR);
    const float* rc = (const float*)(F.ws + WS_ROPE); const float* rsn = rc + 128 * 16;
    const int r0 = u * 64 + F.wave * 8;
    bf16x8 q8[4], c8[2]; float kr[8];
#pragma unroll
    for (int i = 0; i < 4; ++i) q8[i] = ld8(PROJ + (size_t)(r0 + 2 * i + (F.lane >> 5)) * ODP + O_CQ + (F.lane & 31) * 8);
#pragma unroll
    for (int i = 0; i < 2; ++i) c8[i] = ld8(PROJ + (size_t)(r0 + 4 * i + (F.lane >> 4)) * ODP + O_CKV + (F.lane & 15) * 8);
#pragma unroll
    for (int i = 0; i < 8; ++i) kr[i] = bf2f(PROJ[(size_t)(r0 + i) * ODP + O_KR + F.lane]);
#pragma unroll
    for (int i = 0; i < 4; ++i) { float x[8]; unpack8(q8[i], x); float sq = 0.f;
#pragma unroll
        for (int e = 0; e < 8; ++e) sq += x[e] * x[e];
        sq = half_sum32(sq); if ((F.lane & 31) == 0) rq[r0 + 2 * i + (F.lane >> 5)] = RSQ(sq * (1.f / 256.f) + EPS); }
#pragma unroll
    for (int i = 0; i < 2; ++i) { float x[8]; unpack8(c8[i], x); float sq = 0.f;
#pragma unroll
        for (int e = 0; e < 8; ++e) sq += x[e] * x[e];
        sq = sum16(sq); if ((F.lane & 15) == 0) rkv[r0 + 4 * i + (F.lane >> 4)] = RSQ(sq * (1.f / 128.f) + EPS); }
#pragma unroll
    for (int i = 0; i < 8; ++i) { const int r = r0 + i; const float x = kr[i]; const float pr = shx<16>(x);
        const int tt = r % T; float y = x;
        if (tt >= CTX) { const int li = tt - CTX, half = F.lane >> 5, w = F.lane & 31, pos = half ? (li % GRIDW) : (li / GRIDW); const bool lo = w < 16; const int i0 = lo ? w : w - 16;
            const float cc = rc[pos * 16 + i0], sn = rsn[pos * 16 + i0]; y = lo ? (x * cc - pr * sn) : (pr * sn + x * cc); }
        KR[(size_t)r * 64 + F.lane] = (bf16_t)f2bf(y); }
}

namespace att {
constexpr int NW = 8, QBLK = 32, KVBLK = 64;
constexpr float SCALE = 0.07216878364870322f;
#ifndef ATT_THR
#define ATT_THR 8.f
#endif
constexpr float THR = ATT_THR;
constexpr size_t SHM_V = KVBLK * 128 * 2, SHM_K = KVBLK * 128 * 2, SHM_R = KVBLK * 64 * 2;
constexpr size_t OFF_V = 0, OFF_K = 2 * SHM_V, OFF_R = OFF_K + 2 * SHM_K, OFF_WS = OFF_R + 2 * SHM_R, OFF_QR = OFF_WS + NW * 64 * 4, QRLD = 144, SHM_ATTN = OFF_QR + NW * 32 * QRLD * 2;
static_assert(SHM_ATTN <= 160 * 1024, "attention LDS");
#define KSWZ(row, colB) ((row) * 256 + ((colB) ^ (((row) & 7) << 4)))
#define RSWZ(row, colB) ((row) * 128 + ((colB) ^ (((row) & 7) << 4)))
#ifndef HIPEMU
#define SBAR() __builtin_amdgcn_sched_barrier(0)
#define LGKM0() asm volatile("s_waitcnt lgkmcnt(0)" ::: "memory")
#else
#define SBAR()
#define LGKM0()
#endif
DEVI void partialSM(f32x16& p0, f32x16& p1, float& m_reg, float& mn, float& alpha) {
    constexpr float C = SCALE * 1.4426950408889634f;
    float pmax = p0[0];
#pragma unroll
    for (int r = 1; r < 16; ++r) pmax = fmaxf(pmax, p0[r]);
#pragma unroll
    for (int r = 0; r < 16; ++r) pmax = fmaxf(pmax, p1[r]);
    { const u32x2 rr = plswap(f2u(pmax), f2u(pmax)); const unsigned ra = rr[0], rb = rr[1]; pmax = fmaxf(u2f(ra), u2f(rb)); }
    bool keep = (pmax - m_reg <= THR / SCALE);
    int allk = 1;
#ifdef HIPEMU
    { float f = keep ? 1.f : 0.f; for (int o = 1; o < 64; o <<= 1) f = fminf(f, __shfl_xor(f, o)); allk = f > 0.5f; }
#else
    allk = __all(keep);
#endif
    if (allk) { mn = m_reg; alpha = 1.f; }
    else { mn = fmaxf(m_reg, pmax); alpha = EXP2F((m_reg - mn) * C); m_reg = mn; }
    const float mnC = -mn * C;
#pragma unroll
    for (int r = 0; r < 16; ++r) { p0[r] = EXP2F(fmaf(p0[r], C, mnC)); p1[r] = fmaf(p1[r], C, mnC); }
}
DEVI void finishSM(f32x16& p0, f32x16& p1, float alpha, float& l_reg, bf16x8& pa0, bf16x8& pa1, bf16x8& pa2, bf16x8& pa3) {
    float ps = 0.f;
#pragma unroll
    for (int r = 0; r < 16; ++r) { p1[r] = EXP2F(p1[r]); ps += p0[r] + p1[r]; }
    { const u32x2 rr = plswap(f2u(ps), f2u(ps)); const unsigned ra = rr[0], rb = rr[1]; ps = u2f(ra) + u2f(rb); }
    l_reg = l_reg * alpha + ps;
    pa0 = pk4frag(p0, 0); pa1 = pk4frag(p0, 8); pa2 = pk4frag(p1, 0); pa3 = pk4frag(p1, 8);
#ifdef ATT_DEBUG
    { float ones[8] = {1,1,1,1,1,1,1,1}; bf16x8 b1 = pack8(ones); f32x16 t = (f32x16){}; t = mfma32(pa0, b1, t); t = mfma32(pa1, b1, t); t = mfma32(pa2, b1, t); t = mfma32(pa3, b1, t);
      { float own = 0.f, ownb = 0.f; for (int r = 0; r < 16; ++r) { own += p0[r] + p1[r]; ownb += bf2f(f2bf(p0[r])) + bf2f(f2bf(p1[r])); }
        float fa = 0.f; for (int j = 0; j < 8; ++j) fa += bf2f((unsigned short)pa0[j]) + bf2f((unsigned short)pa1[j]) + bf2f((unsigned short)pa2[j]) + bf2f((unsigned short)pa3[j]);
        if (blockIdx.x == 0 && (threadIdx.x == 0 || threadIdx.x == 32)) printf("  lane %d own=%g ownbf=%g fragsum=%g\n", (int)threadIdx.x, own, ownb, fa); }
      if (blockIdx.x == 0 && threadIdx.x == 0) printf("T ps=%g mfma_row0=%g alpha=%g l=%g\n", ps, t[0], alpha, l_reg); }
#endif
}
DEVI void qkt(f32x16& p0, f32x16& p1, const unsigned char* Ks, const unsigned char* Rs, const bf16x8* qr, const bf16_t* qrl, int r32, int hi) {
    p0 = (f32x16){}; p1 = (f32x16){};
#pragma unroll
    for (int d0 = 0; d0 < 8; ++d0) { const int cb = (d0 * 16 + hi * 8) * 2; const bf16x8 qf = (d0 < 4) ? qr[d0 & 3] : ld8(qrl + (d0 - 4) * 16);
        p0 = mfma32(*(const bf16x8*)(Ks + KSWZ(r32, cb)), qf, p0); p1 = mfma32(*(const bf16x8*)(Ks + KSWZ(32 + r32, cb)), qf, p1); }
#pragma unroll
    for (int d0 = 0; d0 < 4; ++d0) { const int cb = (d0 * 16 + hi * 8) * 2;
        const bf16x8 qf = ld8(qrl + 64 + d0 * 16);
        p0 = mfma32(*(const bf16x8*)(Rs + RSWZ(r32, cb)), qf, p0); p1 = mfma32(*(const bf16x8*)(Rs + RSWZ(32 + r32, cb)), qf, p1); }
}
DEVI int v_st(int k, int c) { const int kk = (k & ~0xC) | ((k & 4) << 1) | ((k & 8) >> 1); return ((kk >> 3) * 4 + (c >> 5)) * 512 + ((kk & 7) * 32 + (c & 31)) * 2; }
DEVI int v_rd_base(int lane) { return ((lane & 3) << 3) | (((lane >> 2) & 3) << 6) | (((lane >> 4) & 1) << 5) | (((lane >> 5) & 1) << 8); }
DEVI bf16x8 v_frag(const unsigned char* Vs, int d0, int ks, int r32, int hi) {
    bf16x8 o;
#pragma unroll
    for (int j = 0; j < 8; ++j) o[j] = *(const short*)(Vs + v_st(16 * ks + 8 * hi + j, 32 * d0 + r32));
    return o;
}
#ifndef HIPEMU
template <int OFF> DEVI bf16x8 tr_pair(int vb) {
    typedef short s16x4 __attribute__((ext_vector_type(4)));
    s16x4 l, h2; asm volatile("ds_read_b64_tr_b16 %0, %1 offset:%2" : "=&v"(l) : "v"(vb), "i"(OFF) : "memory"); asm volatile("ds_read_b64_tr_b16 %0, %1 offset:%2" : "=&v"(h2) : "v"(vb), "i"(OFF + 2048) : "memory");
    return (bf16x8){l[0], l[1], l[2], l[3], h2[0], h2[1], h2[2], h2[3]};
}
template <int D0> DEVI void pv_one(f32x16& od, int vb, bf16x8 pa0, bf16x8 pa1, bf16x8 pa2, bf16x8 pa3) {
    const bf16x8 b0 = tr_pair<D0 * 512 + 0 * 4096>(vb), b1 = tr_pair<D0 * 512 + 1 * 4096>(vb), b2 = tr_pair<D0 * 512 + 2 * 4096>(vb), b3 = tr_pair<D0 * 512 + 3 * 4096>(vb);
    LGKM0(); SBAR();
    od = mfma32(pa0, b0, od); od = mfma32(pa1, b1, od); od = mfma32(pa2, b2, od); od = mfma32(pa3, b3, od);
}
DEVI void pv_d0(f32x16* o, const unsigned char* Vs, int r32, int hi, int lane, bf16x8 pa0, bf16x8 pa1, bf16x8 pa2, bf16x8 pa3) {
    const int vb = (int)(uintptr_t)Vs + v_rd_base(lane);
    pv_one<0>(o[0], vb, pa0, pa1, pa2, pa3); pv_one<1>(o[1], vb, pa0, pa1, pa2, pa3); pv_one<2>(o[2], vb, pa0, pa1, pa2, pa3); pv_one<3>(o[3], vb, pa0, pa1, pa2, pa3);
}
#else
DEVI void pv_d0(f32x16* o, const unsigned char* Vs, int r32, int hi, int lane, bf16x8 pa0, bf16x8 pa1, bf16x8 pa2, bf16x8 pa3) {
    for (int d0 = 0; d0 < 4; ++d0) { o[d0] = mfma32(pa0, v_frag(Vs, d0, 0, r32, hi), o[d0]); o[d0] = mfma32(pa1, v_frag(Vs, d0, 1, r32, hi), o[d0]);
        o[d0] = mfma32(pa2, v_frag(Vs, d0, 2, r32, hi), o[d0]); o[d0] = mfma32(pa3, v_frag(Vs, d0, 3, r32, hi), o[d0]); }
}
#endif
#ifdef HIPEMU
DEVI void dma16(const bf16_t* gsrc, unsigned char* lds_wave_base, int lane) { *(bf16x8*)(lds_wave_base + lane * 16) = ld8(gsrc); }
#else
DEVI void dma16(const bf16_t* gsrc, unsigned char* lds_wave_base, int lane) {
    __builtin_amdgcn_global_load_lds((const unsigned*)gsrc, (__attribute__((address_space(3))) unsigned*)lds_wave_base, 16, 0, 0); }
#endif
DEVI void attn_unit(const Frame& F, int b, int h, int qb) {
    unsigned char* wsl = F.ws;
    const bf16_t* Q = (const bf16_t*)(wsl + WS_SCR + SC_Q); const bf16_t* KN = (const bf16_t*)(wsl + WS_SCR + SC_KN); const bf16_t* Vg = (const bf16_t*)(wsl + WS_SCR + SC_V); const bf16_t* KR = (const bf16_t*)(wsl + WS_SCR + SC_KR);
    bf16_t* YM = (bf16_t*)(wsl + WS_ACT);
    unsigned char* lds = F.lds;
    const int wid = F.wave, lane = F.lane, r32 = lane & 31, hi = lane >> 5;
    unsigned char* V_lds = lds + OFF_V; unsigned char* K_lds = lds + OFF_K; unsigned char* R_lds = lds + OFF_R;
    float* wsf = (float*)(lds + OFF_WS) + wid * 64; float* li_l = wsf; float* al_l = wsf + 32;
    float m_reg = -1e30f, l_reg = 0.f; f32x16 o[4]; o[0] = o[1] = o[2] = o[3] = (f32x16){}; bf16x8 qr[4];
    bf16_t* qrl = (bf16_t*)(lds + OFF_QR) + (wid * 32 + r32) * QRLD + hi * 8;
    const int qrow = grow(b, CTX + qb * 256 + wid * QBLK + r32);
    { const bf16_t* Qw = Q + (size_t)qrow * 768 + h * 192 + hi * 8;
#pragma unroll
      for (int d0 = 0; d0 < 4; ++d0) qr[d0] = ld8(Qw + d0 * 16);
#pragma unroll
      for (int d0 = 0; d0 < 8; ++d0) *(bf16x8*)(qrl + d0 * 16) = ld8(Qw + 64 + d0 * 16); }
    const bf16_t* Kh = KN + (size_t)grow(b, 0) * 512 + h * 128; const bf16_t* Vh = Vg + (size_t)grow(b, 0) * 512 + h * 128; const bf16_t* Rh = KR + (size_t)grow(b, 0) * 64;
    int koff[2], voff[2], roff;
#pragma unroll
    for (int i = 0; i < 2; ++i) { const int p = wid * 2048 + i * 1024 + lane * 16; const int row = p >> 8, slot = (p >> 4) & 15; koff[i] = row * 512 + ((slot ^ (row & 7)) * 8);
        const int sI = p >> 4, sub = sI >> 5, rowin = (sI >> 2) & 7, chq = sI & 3; const int kk = (sub >> 2) * 8 + rowin, c = (sub & 3) * 32 + chq * 8; const int k = (kk & ~0xC) | ((kk & 4) << 1) | ((kk & 8) >> 1); voff[i] = k * 512 + c; }
    { const int p = wid * 1024 + lane * 16; const int row = p >> 7, slot = (p >> 4) & 7; roff = row * 64 + ((slot ^ (row & 7)) * 8); }
#define DMA_KR(t, bq) do { const bf16_t* kb_ = Kh + (size_t)(t) * KVBLK * 512; dma16(kb_ + koff[0], K_lds + (bq) * SHM_K + wid * 2048, lane); dma16(kb_ + koff[1], K_lds + (bq) * SHM_K + wid * 2048 + 1024, lane); \
    dma16(Rh + (size_t)(t) * KVBLK * 64 + roff, R_lds + (bq) * SHM_R + wid * 1024, lane); } while (0)
#define DMA_V(t, bq) do { const bf16_t* vb_ = Vh + (size_t)(t) * KVBLK * 512; dma16(vb_ + voff[0], V_lds + (bq) * SHM_V + wid * 2048, lane); dma16(vb_ + voff[1], V_lds + (bq) * SHM_V + wid * 2048 + 1024, lane); } while (0)
#define RESC(a) do { const int any_ = WAVE_ANY((a) < 1.f); \
    if (any_) { WAVE_SYNC(); if (hi == 0) al_l[r32] = (a); LGKM0(); WAVE_SYNC(); \
    _Pragma("unroll") for (int d = 0; d < 4; ++d) _Pragma("unroll") for (int r = 0; r < 16; ++r) o[d][r] *= al_l[crow(r, hi)]; } } while (0)
    f32x16 pA0, pA1, pB0, pB1; float mnA, mnB, alA, alB; bf16x8 pa0, pa1, pa2, pa3; const int NT = T / KVBLK;
    DMA_KR(0, 0); __syncthreads();
    DMA_KR(1, 1); DMA_V(0, 0);
    qkt(pA0, pA1, K_lds, R_lds, qr, qrl, r32, hi); partialSM(pA0, pA1, m_reg, mnA, alA);
    __syncthreads();
    for (int j = 1; j + 1 < NT; j += 2) {
        DMA_KR(j + 1, 0); DMA_V(j, 1);
        SBAR(); qkt(pB0, pB1, K_lds + SHM_K, R_lds + SHM_R, qr, qrl, r32, hi);
        finishSM(pA0, pA1, alA, l_reg, pa0, pa1, pa2, pa3); SBAR();
        pv_d0(o, V_lds, r32, hi, lane, pa0, pa1, pa2, pa3); partialSM(pB0, pB1, m_reg, mnB, alB);
        RESC(alB); __syncthreads();
        if (j + 2 < NT) DMA_KR(j + 2, 1);
        DMA_V(j + 1, 0);
        SBAR(); qkt(pA0, pA1, K_lds, R_lds, qr, qrl, r32, hi);
        finishSM(pB0, pB1, alB, l_reg, pa0, pa1, pa2, pa3); SBAR();
        pv_d0(o, V_lds + SHM_V, r32, hi, lane, pa0, pa1, pa2, pa3); partialSM(pA0, pA1, m_reg, mnA, alA);
        RESC(alA); __syncthreads();
    }
    DMA_V(NT - 1, 1);
    SBAR(); qkt(pB0, pB1, K_lds + SHM_K, R_lds + SHM_R, qr, qrl, r32, hi);
    finishSM(pA0, pA1, alA, l_reg, pa0, pa1, pa2, pa3); SBAR();
    pv_d0(o, V_lds, r32, hi, lane, pa0, pa1, pa2, pa3); partialSM(pB0, pB1, m_reg, mnB, alB);
    RESC(alB); __syncthreads();
    finishSM(pB0, pB1, alB, l_reg, pa0, pa1, pa2, pa3); SBAR();
    pv_d0(o, V_lds + SHM_V, r32, hi, lane, pa0, pa1, pa2, pa3);
    if (hi == 0) li_l[r32] = l_reg; LGKM0();
    __syncthreads();
    float rli[16];
#pragma unroll
    for (int r = 0; r < 16; ++r) rli[r] = 1.f / li_l[crow(r, hi)];
    const int orow0 = grow(b, CTX + qb * 256 + wid * QBLK);
#pragma unroll
    for (int r = 0; r < 16; ++r) { const int orow = orow0 + crow(r, hi);
#pragma unroll
        for (int d0 = 0; d0 < 4; ++d0) YM[(size_t)orow * D + 512 + h * 128 + d0 * 32 + r32] = (bf16_t)f2bf(o[d0][r] * rli[r]); }
    __syncthreads();
#undef DMA_KR
#undef DMA_V
#undef RESC
}
}

#ifndef HIPEMU
DEVI void grid_barrier(cg::grid_group& grid) { grid.sync(); }
#endif

#ifndef HIPEMU
#define XB_TMO      128
#define XB_XCNT(j)  (256  + 64 * (j))
#define XB_XSUB(j)  (1280 + 64 * (j))
#define XB_XGEN(j)  (2304 + 64 * (j))
#define XB_TOP      3328
#define XB_TOPGEN   3392
#define XB_SPIN_CAP (1u << 22)
typedef __attribute__((address_space(3))) unsigned lds_u32;
DEVI unsigned xb_ld(unsigned* p)              { return __hip_atomic_load(p, __ATOMIC_RELAXED, __HIP_MEMORY_SCOPE_AGENT); }
DEVI unsigned xb_add(unsigned* p, unsigned v) { return __hip_atomic_fetch_add(p, v, __ATOMIC_RELAXED, __HIP_MEMORY_SCOPE_AGENT); }
DEVI unsigned xb_xcc_id() { return (unsigned)__builtin_amdgcn_s_getreg((3 << 11) | 20) & 0xFu; }
#define XB_SPIN(cond, bar) do { unsigned _sp = 0; while (cond) { __builtin_amdgcn_s_sleep(1); \
    if ((++_sp & 255u) == 0u) { if (xb_ld(&(bar)[XB_TMO])) break; if (_sp > XB_SPIN_CAP) { atomicAdd(&(bar)[XB_TMO], 1u); break; } } } } while (0)
DEVI void xcd_barrier_complete(unsigned* bar, unsigned x, unsigned G, unsigned& nloc, unsigned& nx) {
    unsigned sum, cnt, mine, sp = 0u;
    for (;;) {
        sum = 0u; cnt = 0u; mine = 0u;
#pragma unroll
        for (unsigned j = 0; j < 16; ++j) { const unsigned c = xb_ld(&bar[XB_XCNT(j)]); sum += c; cnt += (c > 0u) ? 1u : 0u; mine = (j == x) ? c : mine; }
        if (sum == G) break;
        __builtin_amdgcn_s_sleep(1);
        if ((++sp & 255u) == 0u) { if (xb_ld(&bar[XB_TMO])) break; if (sp > XB_SPIN_CAP) { atomicAdd(&bar[XB_TMO], 1u); break; } }
    }
    nloc = mine > 0u ? mine : 1u; nx = cnt > 0u ? cnt : 1u;
}
DEVI void xcd_barrier(unsigned* bar, volatile lds_u32* st, bool is_t0, unsigned G) {
    asm volatile("s_waitcnt vmcnt(0)" ::: "memory");
    __syncthreads();
    if (is_t0) {
        __builtin_amdgcn_s_waitcnt(0);
        const unsigned x = xb_xcc_id();
        unsigned nloc = st[0], nx = st[1];
        if (nloc == 0u) { xcd_barrier_complete(bar, x, G, nloc, nx); st[0] = nloc; st[1] = nx; }
        const unsigned old = xb_add(&bar[XB_XSUB(x)], 1u);
        const unsigned gen = old / nloc;
        if (old + 1u == (gen + 1u) * nloc) {
            __builtin_amdgcn_fence(__ATOMIC_RELEASE, "agent");
            asm volatile("s_waitcnt vmcnt(0)" ::: "memory");
            const unsigned og = xb_add(&bar[XB_TOP], 1u);
            const unsigned tg = og / nx;
            if (og + 1u == (tg + 1u) * nx) xb_add(&bar[XB_TOPGEN], 1u);
            else XB_SPIN(xb_ld(&bar[XB_TOPGEN]) == tg, bar);
            __builtin_amdgcn_fence(__ATOMIC_ACQUIRE, "agent");
            xb_add(&bar[XB_XGEN(x)], 1u);
            asm volatile("s_waitcnt vmcnt(0)" ::: "memory");
        } else {
            XB_SPIN(xb_ld(&bar[XB_XGEN(x)]) == gen, bar);
            __builtin_amdgcn_fence(__ATOMIC_ACQUIRE, "agent");
            asm volatile("s_waitcnt vmcnt(0)" ::: "memory");
        }
    }
    __syncthreads();
}
#endif

constexpr int LDS_QW = 160 * 1024 - 256 + 64;
#ifdef HIPEMU
struct WorkQ { int next, total, G, bid; DEVI void init(const Frame& F, int q, int tot) { next = F.bid; total = tot; G = F.G; bid = F.bid; } DEVI int pop(const Frame& F) { const int r = next; next += G; return r < total ? r : -1; } };
#else
struct WorkQ { unsigned* ctr; int total; int pending;
    DEVI void init(const Frame& F, int q, int tot) { ctr = (unsigned*)(F.ws + WS_CTL) + 8192 + 64 * q; total = tot; pending = -1;
        if (F.tid == 0) pending = (int)__hip_atomic_fetch_add(ctr, 1u, __ATOMIC_RELAXED, __HIP_MEMORY_SCOPE_AGENT); }
    DEVI int pop(const Frame& F) { volatile int* w = (volatile int*)(F.lds + LDS_QW);
        __syncthreads(); if (F.tid == 0) { *w = pending; pending = (int)__hip_atomic_fetch_add(ctr, 1u, __ATOMIC_RELAXED, __HIP_MEMORY_SCOPE_AGENT); }
        __syncthreads(); const int r = *w; return (r < total) ? __builtin_amdgcn_readfirstlane(r) : -1; } };
#endif
template <int ACTF> DEVI void ctx_gemm(const Frame& F, const bf16_t* A, int lda, const bf16_t* Bt, int ldb, int N, bf16_t* O, int ldc) {
    constexpr int RS = 528, KC = 256, NCHK = D / KC;
    const int ncq = N / 1024, NBU = (NB * CTX / 64) * (N / 128);
    const int l31 = F.lane & 31, h = F.lane >> 5, dr = F.wave >> 2, dc = F.wave & 3, trow = F.tid >> 5, tc = F.tid & 31;
    for (int bu = F.bid; bu < NBU; bu += F.G) {
        const int x = bu & 7, j = bu >> 3, pr = j / ncq, pc = j % ncq, col0 = (x * ncq + pc) * 128;
        u32x4 pre[12]; f32x16 acc;
#pragma unroll
        for (int e = 0; e < 16; ++e) acc[e] = 0.f;
#define CTXG_SRC(i) ((i) < 4 ? A + (size_t)grow((pr * 64 + 16 * (i) + trow) / CTX, (pr * 64 + 16 * (i) + trow) % CTX) * lda + tc * 8 : Bt + (size_t)(col0 + 16 * ((i) - 4) + trow) * ldb + tc * 8)
#pragma unroll
        for (int i = 0; i < 12; ++i) pre[i] = *(const u32x4*)(CTXG_SRC(i));
        for (int ck = 0; ck < NCHK; ++ck) {
            __syncthreads();
#pragma unroll
            for (int i = 0; i < 12; ++i) *(u32x4*)(F.lds + (16 * i + trow) * RS + tc * 16) = pre[i];
            __syncthreads();
            if (ck + 1 < NCHK) {
#pragma unroll
                for (int i = 0; i < 12; ++i) pre[i] = *(const u32x4*)(CTXG_SRC(i) + (ck + 1) * KC); }
#pragma unroll
            for (int s = 0; s < 16; ++s) { const bf16x8 wf = *(const bf16x8*)(F.lds + (64 + dc * 32 + l31) * RS + s * 32 + h * 16), xf = *(const bf16x8*)(F.lds + (dr * 32 + l31) * RS + s * 32 + h * 16);
                acc = mfma32(wf, xf, acc); }
        }
#undef CTXG_SRC
        const int cr = pr * 64 + dr * 32 + l31; bf16_t* orow = O + (size_t)grow(cr / CTX, cr % CTX) * ldc + col0 + dc * 32 + 4 * h;
#pragma unroll
        for (int g = 0; g < 4; ++g) { float v[4];
#pragma unroll
            for (int e = 0; e < 4; ++e) { float a = acc[4 * g + e]; if (ACTF == 1) { a = a > 0.f ? a : 0.f; a = a * a; } v[e] = a; }
            *(unsigned long long*)(orow + 8 * g) = (unsigned long long)pk2(v[0], v[1]) | ((unsigned long long)pk2(v[2], v[3]) << 32); }
    }
    __syncthreads();
}
constexpr int NPHASES = 21;
#ifndef PH_MASK
#define PH_MASK 0xFFFFFFFFu
#endif
#define PH_ON(k) ((PH_MASK >> (k)) & 1u)
template <int ph> DEVI void run_phase_t(const Frame& F) {
    bf16_t* Wb = (bf16_t*)(F.ws + WS_W); bf16_t* ACT = (bf16_t*)(F.ws + WS_ACT); bf16_t* BIGb = (bf16_t*)(F.ws + WS_BIG); bf16_t* HJ1 = (bf16_t*)(F.ws + WS_HGS);
    float* BIGf = (float*)(F.ws + WS_BIG); float* ACTf = (float*)(F.ws + WS_ACT);
    pg8::Order S;
    switch (ph) {
    case 0: if (!PH_ON(0)) break; {
        ada_units(F);
#ifndef HIPEMU
        unsigned* adac = (unsigned*)(F.ws + WS_CTL) + 8192 + 64 * 40;
        asm volatile("s_waitcnt vmcnt(0)" ::: "memory"); __syncthreads();
        if (F.tid == 0) { __builtin_amdgcn_fence(__ATOMIC_RELEASE, "agent"); asm volatile("s_waitcnt vmcnt(0)" ::: "memory"); xb_add(adac, 1u); }
#endif
        convert_layer_weights(F, 0); rope_tables(F); rw_build_tables(F);
#ifndef HIPEMU
        if (F.tid == 0) { unsigned* bar = (unsigned*)(F.ws + WS_CTL); XB_SPIN(xb_ld(adac) < (unsigned)F.G, bar); __builtin_amdgcn_fence(__ATOMIC_ACQUIRE, "agent"); asm volatile("s_waitcnt vmcnt(0)" ::: "memory"); }
        __syncthreads();
        { const Frame F2 = relaunder(F); phase_hj0(F2); }
#endif
    } break;
    case 1: if (!PH_ON(1)) break;
#ifdef HIPEMU
        phase_hj0(F);
#endif
        break;
    case 2: if (!PH_ON(2)) break; { { pg8::Gemm g{ACT, Wb + W_IN / 2, D, D, D}; S.init(NB * NLT, EVP / 256, F.G, F.bid, 1); pg8::EpiBf16<0> E{BIGb, EVP}; pg8::gemm_phase(F.lds, g, S, E, F.tid); }
        ctx_gemm<0>(F, ACT, D, Wb + W_IN / 2, D, EVP, BIGb, EVP); } break;
    case 3: if (!PH_ON(3)) break; { constexpr int NML = NB * 4 * NCH, NRW = NSTR_RW * NCH; WorkQ Q; Q.init(F, 3, NML + NRW);
        rw2::RawPrep R; bool loaded = false;
        for (int u = Q.pop(F); u >= 0; ) { const Frame F2 = relaunder(F);
            if (u < NRW) { const int b2 = u / (16 * NCH), h2 = (u / (2 * NCH)) % 8, d2 = (u / NCH) % 2, c2 = u % NCH;
                if (!loaded) rw2::prep_load(F2, b2, h2, d2, c2 * 256 + (d2 ? 3 : 0) * 64, R);
                int nu; bool nl; rw2::heavy_unit(F2, b2, h2, d2, c2, R, Q, NRW, nu, nl); u = nu; loaded = nl; }
            else { const int v = u - NRW; ml_phaseA_unit(F2, v / (4 * NCH), (v / NCH) % 4, v % NCH); u = Q.pop(F); loaded = false; } } } break;
    case 4: if (!PH_ON(4)) break; { ml_phaseB(F); const Frame F2 = relaunder(F); rw2::phaseB(F2); } break;
    case 5: if (!PH_ON(5)) break; { constexpr int NU = NB * 8 * NCH * 2; rw2::FixPre2 P;
        if (F.bid < NU) rw2::fixup2_load(F, F.bid, P);
        for (int u = F.bid; u < NU; u += F.G) { const int un = u + F.G; rw2::fixup2_unit(F, u, P, un < NU, un); } } break;
    case 6: if (!PH_ON(6)) break; {
        constexpr int NML = NB * 4 * NCH, NFI = NB * 8 * (T / 64); WorkQ Q; Q.init(F, 6, NML + NFI);
        for (int u = Q.pop(F); u >= 0; u = Q.pop(F)) { const Frame F2 = relaunder(F);
            if (u < NML) { constexpr int NLC = NCH - NCTXCH, NLU = NB * 4 * NLC;
                if (u < NLU) ml_phaseC_unit(F2, u / (4 * NLC), (u / NLC) % 4, NCTXCH + u % NLC);
                else { const int v = u - NLU; ml_phaseC_unit(F2, v / (4 * NCTXCH), (v / NCTXCH) % 4, v % NCTXCH); } }
            else { const int v = u - NML; rw_finish2_unit(F2, v / (8 * (T / 64)), (v / (T / 64)) % 8, v % (T / 64)); } }
    } break;
    case 7: if (!PH_ON(7)) break; { { pg8::Gemm g{ACT, Wb + W_OUT / 2, D, D, D}; S.init(NB * NLT, 4, F.G, F.bid, 1); pg8::EpiBf16<0> E{BIGb, D}; pg8::gemm_phase(F.lds, g, S, E, F.tid); }
        { pg8::Gemm g{ACT, Wb + W_OUT / 2, 256, D, D}; S.init(NB * NCTXCH, 4, F.G, F.bid, 2, 4); pg8::EpiF32Slab E{(float*)(F.ws + WS_BIG + 70 * MiB), D}; pg8::gemm_phase(F.lds, g, S, E, F.tid); } } break;
    case 8: if (!PH_ON(8)) break; phase_resid(F, 0, 0, BIGb, false, ACT, (const float*)(F.ws + WS_BIG + 70 * MiB), 4); break;
    case 9: if (!PH_ON(9)) break; { { pg8::Gemm g{ACT, Wb + W_1 / 2, D, D, D}; S.init(NB * NLT, 16, F.G, F.bid, 1); pg8::EpiBf16<1> E{BIGb, DFF}; pg8::gemm_phase(F.lds, g, S, E, F.tid); }
        ctx_gemm<1>(F, ACT, D, Wb + W_1 / 2, D, DFF, BIGb, DFF); } break;
    case 10: if (!PH_ON(10)) break; { { pg8::Gemm g{BIGb, Wb + W_2 / 2, DFF, DFF, DFF}; S.init(NB * NLT, 4, F.G, F.bid, 1); pg8::EpiBf16<0> E{ACT, D}; pg8::gemm_phase(F.lds, g, S, E, F.tid); }
        { pg8::Gemm g{BIGb, Wb + W_2 / 2, 512, DFF, DFF}; S.init(NB * NCTXCH, 4, F.G, F.bid, 2, 8); pg8::EpiF32Slab E{(float*)(F.ws + WS_SCR + 34 * MiB), D}; pg8::gemm_phase(F.lds, g, S, E, F.tid); } } break;
    case 11: if (!PH_ON(11)) break; phase_resid(F, 0, 1, ACT, false, HJ1, (const float*)(F.ws + WS_SCR + 34 * MiB), 8); convert_layer_weights(F, 1); break;
    case 12: if (!PH_ON(12)) break; { { pg8::Gemm g{HJ1, Wb + W_IN / 2, D, D, D}; S.init(NB * NLT, ODP / 256, F.G, F.bid, 1); pg8::EpiBf16<0> E{BIGb, ODP}; pg8::gemm_phase(F.lds, g, S, E, F.tid); }
        ctx_gemm<0>(F, HJ1, D, Wb + W_IN / 2, D, ODP, BIGb, ODP); } break;
    case 13: if (!PH_ON(13)) break; { constexpr int NHA = NB * 4 * NCH, NMP = M / 64; WorkQ Q; Q.init(F, 13, NHA + NMP);
        for (int u = Q.pop(F); u >= 0; u = Q.pop(F)) { const Frame F2 = relaunder(F);
            if (u < NHA - 2 * NB * 4) { const int k = u / (NB * 4), bh = u % (NB * 4); const int cc = (k < NCTXCH) ? k : k + 1; hg_phaseA_unit<-1>(F2, bh / 4, bh % 4, cc); }
            else if (u < NHA - NB * 4) { const int bh = u - (NHA - 2 * NB * 4); hg_phaseA_unit<0>(F2, bh / 4, bh % 4, NCTXCH); }
            else if (u < NHA) { const int bh = u - (NHA - NB * 4); hg_phaseA_unit<1>(F2, bh / 4, bh % 4, NCH - 1); }
            else mla_prep_unit(F2, u - NHA); } } break;
    case 14: if (!PH_ON(14)) break; {
#ifndef NO_HGB
        hg_phaseB(F);
#endif
#ifndef NO_GQ
        { pg8::Gemm g{BIGb + O_CQ, Wb + W_QB / 2, 256, ODP, 256}; S.init(NB * NLT, 3, F.G, F.bid, 1);
          pg8::EpiQ E{F.ws}; pg8::gemm_phase(F.lds, g, S, E, F.tid); }
#endif
#ifndef NO_GKV
        { pg8::Gemm g{BIGb + O_CKV, Wb + W_KVB / 2, 256, ODP, 256}; const int nq = NB * NLT * 3, rot = (nq / 8) * 8 % F.G;
          S.init(M / 256, 4, F.G, (F.bid - rot + F.G) % F.G, 0);
          pg8::EpiKV E{F.ws}; pg8::gemm_phase(F.lds, g, S, E, F.tid); }
#endif
    } break;
    case 15: if (!PH_ON(15)) break; {
#ifndef NO_ATT
        for (int u = F.bid; u < NB * 4 * NLT; u += F.G) { const int bh = u % (NB * 4), qt = u / (NB * 4);
            att::attn_unit(F, bh / 4, bh % 4, qt); }
#endif
#ifndef NO_HGC
        const Frame F2 = relaunder(F);
        for (int u = F2.bid; u < NB * 4 * NLT; u += F2.G) hg_phaseC_unit(F2, u / (4 * NLT), (u / NLT) % 4, NCTXCH + u % NLT);
#endif
    } break;
    case 16: if (!PH_ON(16)) break; { pg8::Gemm g{ACT, Wb + W_OUT / 2, D, D, D}; S.init(NB * NLT, 4, F.G, F.bid, 1); pg8::EpiBf16<0> E{BIGb, D}; pg8::gemm_phase(F.lds, g, S, E, F.tid); } break;
    case 17: if (!PH_ON(17)) break; phase_resid(F, 1, 0, BIGb, true, ACT); break;
    case 18: if (!PH_ON(18)) break; { pg8::Gemm g{ACT, Wb + W_1 / 2, D, D, D}; S.init(NB * NLT, 16, F.G, F.bid, 1); pg8::EpiBf16<1> E{BIGb, DFF}; pg8::gemm_phase(F.lds, g, S, E, F.tid); } break;
    case 19: if (!PH_ON(19)) break; { pg8::Gemm g{BIGb, Wb + W_2 / 2, DFF, DFF, DFF}; S.init(NB * NLT, 4, F.G, F.bid, 1); pg8::EpiBf16<0> E{ACT, D}; pg8::gemm_phase(F.lds, g, S, E, F.tid); } break;
    case 20: if (!PH_ON(20)) break; phase_resid(F, 1, 1, ACT, true, nullptr); break;
    default: break;
    }
}

#ifdef HIPEMU
static inline void run_phase_rt(const Frame& F, int ph) {
    switch (ph) {
#define PHC(k) case k: run_phase_t<k>(F); break;
    PHC(0) PHC(1) PHC(2) PHC(3) PHC(4) PHC(5) PHC(6) PHC(7) PHC(8) PHC(9) PHC(10) PHC(11) PHC(12) PHC(13) PHC(14) PHC(15) PHC(16) PHC(17) PHC(18) PHC(19) PHC(20)
#undef PHC
    default: break; }
}
#endif
#ifndef HIPEMU
constexpr int LDS_BYTES = 160 * 1024;
extern __shared__ __attribute__((aligned(16))) unsigned char g_lds[];
template <int PH> __device__ __forceinline__ void phase_fn(const CONSTAS Args* ap_in, int wave_in) {
    const CONSTAS Args* ap = ap_in; int wv = wave_in, bid = blockIdx.x, G = gridDim.x;
    int ln = __builtin_amdgcn_mbcnt_hi(~0u, __builtin_amdgcn_mbcnt_lo(~0u, 0u));
    asm volatile("" : "+s"(ap)); asm volatile("" : "+v"(ln)); asm volatile("" : "+s"(bid), "+s"(G), "+s"(wv));
    __builtin_assume(ln >= 0 && ln < 64); __builtin_assume(wv >= 0 && wv < 8); __builtin_assume(bid >= 0 && bid < 1024); __builtin_assume(G > 0 && G <= 1024);
    const int tid = wv * 64 + ln;
    Frame F; F.lds = g_lds; F.ap = ap; F.out = ap->out; F.ws = ap->ws; F.tid = tid; F.lane = ln; F.wave = wv; F.G = G; F.bid = bid;
    run_phase_t<PH>(F);
}
constexpr int LDS_MISC = LDS_BYTES - 256;
__global__ void __launch_bounds__(NTHREADS, 2) mk_fwd(Args a) {
    cg::grid_group grid = cg::this_grid();
    const CONSTAS Args* ap = (const CONSTAS Args*)__builtin_amdgcn_kernarg_segment_ptr();
    const int lo = a.ph_lo, hi = a.ph_hi; const int wv0 = __builtin_amdgcn_readfirstlane(threadIdx.x >> 6);
    volatile lds_u32* st = (volatile lds_u32*)(g_lds + LDS_MISC);
    unsigned* bar = (unsigned*)(a.ws + WS_CTL);
    if (threadIdx.x == 0) { st[0] = 0u; st[1] = 0u; (void)xb_add(&bar[XB_XCNT(xb_xcc_id())], 1u); }
    __syncthreads();
#ifdef PROBE_MASK
#define PROBE_PRE(k) unsigned long long tp0_ = 0; if ((PROBE_MASK >> (k)) & 1u) tp0_ = __builtin_amdgcn_s_memrealtime();
#define PROBE_POST(k) if ((PROBE_MASK >> (k)) & 1u) { __syncthreads(); const unsigned long long tp1_ = __builtin_amdgcn_s_memrealtime(); const unsigned long long dt_ = (tp1_ - tp0_) * PROBE_AMP; while (__builtin_amdgcn_s_memrealtime() - tp1_ < dt_) __builtin_amdgcn_s_sleep(8); }
#else
#define PROBE_PRE(k)
#define PROBE_POST(k)
#endif
#define PHC(k) if (lo <= k && k < hi) { PROBE_PRE(k) phase_fn<k>(ap, wv0); PROBE_POST(k) if (k + 1 < hi) { if (k == 0 && hi > NPHASES) grid.sync();     \
        { const bool t0_ = (wv0 == 0) && (__builtin_amdgcn_mbcnt_hi(~0u, __builtin_amdgcn_mbcnt_lo(~0u, 0u)) == 0); xcd_barrier(bar, st, t0_, gridDim.x); } } }
    PHC(0) PHC(2) PHC(3) PHC(4) PHC(5) PHC(6) PHC(7) PHC(8) PHC(9) PHC(10) PHC(11) PHC(12) PHC(13) PHC(14) PHC(15) PHC(16) PHC(17) PHC(18) PHC(19) PHC(20)
#undef PHC
}
#ifndef MK_N_LAUNCHES
#define MK_N_LAUNCHES 1
#endif
extern "C" void kernel_launch(void* const* d_in, const int* in_sizes, int n_in, void* d_out, int out_size, void* d_ws, size_t ws_size, hipStream_t stream) {
    static int grid = 0;
    if (grid == 0) {
        if (n_in != 32 || out_size != NB * SEQ * D || ws_size < WS_END) { fprintf(stderr, "kernel_launch: shape mismatch n_in %d out %d ws %zu\n", n_in, out_size, ws_size); grid = -1; return; }
        int dev = 0, cus = 0, per_cu = 0; hipGetDevice(&dev); hipDeviceGetAttribute(&cus, hipDeviceAttributeMultiprocessorCount, dev);
        hipFuncSetAttribute((const void*)mk_fwd, hipFuncAttributeMaxDynamicSharedMemorySize, LDS_BYTES);
        hipOccupancyMaxActiveBlocksPerMultiprocessor(&per_cu, (const void*)mk_fwd, NTHREADS, LDS_BYTES);
        fprintf(stderr, "kernel_launch: cus %d per_cu %d\n", cus, per_cu);
        if (per_cu < 1) { grid = -1; return; }
        grid = cus;
    }
    if (grid < 0) return;
    Args a{}; for (int i = 0; i < 32; ++i) a.in[i] = (const float*)d_in[i];
    a.out = (float*)d_out; a.ws = (unsigned char*)d_ws;
    if (hipMemsetAsync((char*)d_ws + WS_CTL, 0, CTL_BYTES, stream) != hipSuccess) { fprintf(stderr, "kernel_launch: memset failed\n"); return; }
    if (MK_N_LAUNCHES == 1) { a.ph_lo = 0; a.ph_hi = NPHASES; void* args[] = {&a};
        hipError_t e = hipLaunchCooperativeKernel((void*)mk_fwd, dim3(grid), dim3(NTHREADS), args, LDS_BYTES, stream);
        if (e != hipSuccess) fprintf(stderr, "coop launch failed: %s\n", hipGetErrorString(e));
    } else {
        for (int ph = 0; ph < NPHASES; ++ph) { a.ph_lo = ph; a.ph_hi = ph + 1; void* args[] = {&a};
            hipError_t e = hipLaunchCooperativeKernel((void*)mk_fwd, dim3(grid), dim3(NTHREADS), args, LDS_BYTES, stream);
            if (e != hipSuccess) { fprintf(stderr, "launch %d failed: %s\n", ph, hipGetErrorString(e)); break; } }
    }
}
#endif
```
